# Optimizing an MI355X kernel written in HIP

```python
import jax, jax.numpy as jnp
from jax import lax
import numpy as np

D_MODEL = 1024
BATCH = 2
SEQ = 8192
DEPTH = 2

GRID_W = 64
CTX_LEN = 256
EPS = 1e-6
D_FF = 4 * D_MODEL
SGU_HEADS = 4
SGU_HEAD_DIM = 64
SGU_WIDTH = SGU_HEADS * SGU_HEAD_DIM
SGU_CHUNK = 128
GLA_HEADS = 4
GLA_DK = 32
GLA_DV = 64
GLA_K_WIDTH = GLA_HEADS * GLA_DK
GLA_V_WIDTH = GLA_HEADS * GLA_DV
GLA_GATE_RANK = 16
GLA_TAU = 16.0
GLA_CHUNK = 64
MLA_HEADS = 4
MLA_Q_RANK = 256
MLA_KV_RANK = 256
MLA_NOPE = 128
MLA_ROPE = 64
MLA_V = 128
MLA_WIDTH = MLA_HEADS * MLA_V
ROPE_BASE = 10000.0
ATTN_BLOCK = 128
MIX_WIDTH = SGU_WIDTH + GLA_V_WIDTH + MLA_WIDTH
KV_SPLITS = (GLA_K_WIDTH, GLA_V_WIDTH, GLA_GATE_RANK, GLA_GATE_RANK, MLA_KV_RANK, MLA_ROPE)
Q_SPLITS = (SGU_WIDTH, SGU_WIDTH, GLA_K_WIDTH, GLA_V_WIDTH, MLA_Q_RANK)
KV_COLS = sum(KV_SPLITS)
IN_COLS = KV_COLS + sum(Q_SPLITS)

kernel_name = "hybrid_sgu_gla_mla_prefix_dit_block"


def split_cols(t, widths):
    idx = np.cumsum(widths)[:-1].tolist()
    return jnp.split(t, idx, axis=-1)


def rmsnorm(x, w):
    xf = x.astype(jnp.float32)
    y = xf * lax.rsqrt(jnp.mean(xf * xf, axis=-1, keepdims=True) + EPS)
    return (y * w.astype(jnp.float32)).astype(x.dtype)


def layernorm(x, w, b):
    xf = x.astype(jnp.float32)
    mu = jnp.mean(xf, axis=-1, keepdims=True)
    var = jnp.mean(jnp.square(xf - mu), axis=-1, keepdims=True)
    y = (xf - mu) * lax.rsqrt(var + EPS)
    return (y * w.astype(jnp.float32) + b.astype(jnp.float32)).astype(x.dtype)


def modulate(xn, shift, scale):
    return xn * (1.0 + scale) + shift


def axial_angles(n):
    rows = n // GRID_W
    row = jnp.repeat(jnp.arange(rows), GRID_W).astype(jnp.float32)
    col = jnp.tile(jnp.arange(GRID_W), rows).astype(jnp.float32)
    half = MLA_ROPE // 2
    freq = ROPE_BASE ** (-jnp.arange(half // 2, dtype=jnp.float32) * 2.0 / half)
    return row[:, None] * freq[None, :], col[:, None] * freq[None, :]


def rotate(x, ang):
    m = x.shape[-1] // 2
    xf = x.astype(jnp.float32)
    x1, x2 = xf[..., :m], xf[..., m:]
    cos, sin = jnp.cos(ang), jnp.sin(ang)
    return jnp.concatenate([x1 * cos - x2 * sin, x1 * sin + x2 * cos], axis=-1).astype(x.dtype)


def axial_rope(x, ang_row, ang_col):
    half = x.shape[-1] // 2
    return jnp.concatenate([rotate(x[..., :half], ang_row), rotate(x[..., half:], ang_col)], axis=-1)


def to_heads(t, d):
    bsz, n, _ = t.shape
    return t.reshape(bsz, n, -1, d).transpose(0, 2, 1, 3)


def sgu(p_u, p_v, norm_w, norm_b, w_s, b_s):
    bsz, n, _ = p_u.shape
    u = jax.nn.gelu(p_u)
    v = layernorm(jax.nn.gelu(p_v), norm_w, norm_b)
    v = v.reshape(bsz, n // SGU_CHUNK, SGU_CHUNK, SGU_HEADS, SGU_HEAD_DIM)
    s = jnp.einsum('hij,bcjhe->bcihe', w_s, v) + b_s.T[:, :, None]
    return u * s.reshape(bsz, n, SGU_WIDTH)


def gla_log_gate(p_g, w, b):
    z = (p_g @ w + b).astype(jnp.float32)
    return jax.nn.log_sigmoid(z) / GLA_TAU


def gla_scan(q, k, v, g, s0):
    bsz, h, n, _ = q.shape
    nc = n // GLA_CHUNK

    def to_chunks(t):
        return jnp.moveaxis(t.reshape(bsz, h, nc, GLA_CHUNK, t.shape[-1]), 2, 0)

    mask = jnp.tril(jnp.ones((GLA_CHUNK, GLA_CHUNK), bool))[:, :, None]

    def step(s, inp):
        qc, kc, vc, gc = inp
        b = jnp.cumsum(gc, axis=2)
        diff = b[:, :, :, None, :] - b[:, :, None, :, :]
        decay = jnp.where(mask, jnp.exp(jnp.where(mask, diff, 0.0)), 0.0)
        att = jnp.einsum('bhid,bhjd,bhijd->bhij', qc, kc, decay)
        o = jnp.einsum('bhij,bhje->bhie', att, vc) + jnp.einsum('bhid,bhde->bhie', qc * jnp.exp(b), s)
        b_last = b[:, :, -1:, :]
        s_new = jnp.exp(b_last)[:, :, 0, :, None] * s + jnp.einsum('bhjd,bhje->bhde', kc * jnp.exp(b_last - b), vc)
        return s_new, o

    s_fin, o = lax.scan(step, s0, (to_chunks(q), to_chunks(k), to_chunks(v), to_chunks(g)))
    o = jnp.moveaxis(o, 0, 2).reshape(bsz, h, n, v.shape[-1])
    return o, s_fin


def gla_final_state(k, v, g):
    b = jnp.cumsum(g, axis=2)
    return jnp.einsum('bhjd,bhje->bhde', k * jnp.exp(b[:, :, -1:, :] - b), v)


def gla_output(o, r, norm_w, dtype):
    bsz, h, n, dv = o.shape
    o = rmsnorm(o.transpose(0, 2, 1, 3), norm_w)
    o = o * jax.nn.silu(r.reshape(bsz, n, h, dv).astype(jnp.float32))
    return o.reshape(bsz, n, h * dv).astype(dtype)


def mla_kv(p_ckv, p_krope, kv_norm_w, w_ukv, ang):
    bsz, n, _ = p_ckv.shape
    kv = (rmsnorm(p_ckv, kv_norm_w) @ w_ukv).reshape(bsz, n, MLA_HEADS, MLA_NOPE + MLA_V)
    k_nope, v = kv[..., :MLA_NOPE], kv[..., MLA_NOPE:]
    k_rope = p_krope if ang is None else axial_rope(p_krope, ang[0], ang[1])
    return k_nope, k_rope, v


def mla_q(p_dq, q_norm_w, w_uq, ang):
    bsz, n, _ = p_dq.shape
    q = (rmsnorm(p_dq, q_norm_w) @ w_uq).reshape(bsz, n, MLA_HEADS, MLA_NOPE + MLA_ROPE)
    q_nope, q_rope = q[..., :MLA_NOPE], q[..., MLA_NOPE:]
    if ang is not None:
        q_rope = axial_rope(q_rope, ang[0][:, None, :], ang[1][:, None, :])
    return q_nope, q_rope


def mla_attend(q_nope, q_rope, k_nope, k_rope, v):
    scale = (MLA_NOPE + MLA_ROPE) ** -0.5
    s = jnp.einsum('bqhd,bkhd->bhqk', q_nope, k_nope) + jnp.einsum('bqhr,bkr->bhqk', q_rope, k_rope)
    p = jax.nn.softmax(s.astype(jnp.float32) * scale, axis=-1).astype(v.dtype)
    return jnp.einsum('bhqk,bkhd->bqhd', p, v)


def mla_attend_blocked(q_nope, q_rope, k_nope, k_rope, v):
    bsz, n = q_nope.shape[:2]
    nb = n // ATTN_BLOCK
    qn = jnp.moveaxis(q_nope.reshape(bsz, nb, ATTN_BLOCK, MLA_HEADS, MLA_NOPE), 1, 0)
    qr = jnp.moveaxis(q_rope.reshape(bsz, nb, ATTN_BLOCK, MLA_HEADS, MLA_ROPE), 1, 0)
    out = lax.map(lambda qs: mla_attend(qs[0], qs[1], k_nope, k_rope, v), (qn, qr))
    return jnp.moveaxis(out, 0, 1).reshape(bsz, n, MLA_WIDTH)


def mixing(h, hc, with_ctx_out, w_in, sgu_norm_w, sgu_norm_b, sgu_w, sgu_b, gla_wg_fwd, gla_bg_fwd,
           gla_wg_bwd, gla_bg_bwd, gla_norm_w, mla_q_norm_w, mla_w_uq, mla_kv_norm_w, mla_w_ukv, ang):
    bsz, n, _ = h.shape
    p = h @ w_in
    gk, gv, ggf, ggb, ckv, kr = split_cols(p[..., :KV_COLS], KV_SPLITS)
    su, sv, gq, gr, dq = split_cols(p[..., KV_COLS:], Q_SPLITS)
    pc = hc @ (w_in if with_ctx_out else w_in[:, :KV_COLS])
    gk_c, gv_c, ggf_c, ggb_c, ckv_c, kr_c = split_cols(pc[..., :KV_COLS], KV_SPLITS)

    y_sgu = sgu(su, sv, sgu_norm_w, sgu_norm_b, sgu_w, sgu_b)

    def kvg(k_, v_, gf_, gb_):
        return (to_heads(k_, GLA_DK).astype(jnp.float32), to_heads(v_, GLA_DV).astype(jnp.float32),
                to_heads(gla_log_gate(gf_, gla_wg_fwd, gla_bg_fwd), GLA_DK),
                to_heads(gla_log_gate(gb_, gla_wg_bwd, gla_bg_bwd), GLA_DK))

    def gq_heads(q_):
        return to_heads(q_, GLA_DK).astype(jnp.float32) * (GLA_DK ** -0.5)

    flip = lambda t: jnp.flip(t, axis=2)
    k_l, v_l, gf_l, gb_l = kvg(gk, gv, ggf, ggb)
    k_c, v_c, gf_c, gb_c = kvg(gk_c, gv_c, ggf_c, ggb_c)
    q_l = gq_heads(gq)
    if with_ctx_out:
        su_c, sv_c, gq_c, gr_c, dq_c = split_cols(pc[..., KV_COLS:], Q_SPLITS)
        q_c = gq_heads(gq_c)
        zero = jnp.zeros((bsz, GLA_HEADS, GLA_DK, GLA_DV), jnp.float32)
        o_cf, s_f = gla_scan(q_c, k_c, v_c, gf_c, zero)
        o_cb, s_b = gla_scan(flip(q_c), flip(k_c), flip(v_c), flip(gb_c), zero)
        y_gla_c = gla_output(o_cf + flip(o_cb), gr_c, gla_norm_w, hc.dtype)
    else:
        s_f = gla_final_state(k_c, v_c, gf_c)
        s_b = gla_final_state(flip(k_c), flip(v_c), flip(gb_c))
    o_lf, _ = gla_scan(q_l, k_l, v_l, gf_l, s_f)
    o_lb, _ = gla_scan(flip(q_l), flip(k_l), flip(v_l), flip(gb_l), s_b)
    y_gla = gla_output(o_lf + flip(o_lb), gr, gla_norm_w, h.dtype)

    kn_c, krp_c, vv_c = mla_kv(ckv_c, kr_c, mla_kv_norm_w, mla_w_ukv, None)
    kn_l, krp_l, vv_l = mla_kv(ckv, kr, mla_kv_norm_w, mla_w_ukv, ang)
    qn_l, qr_l = mla_q(dq, mla_q_norm_w, mla_w_uq, ang)
    y_mla = mla_attend_blocked(qn_l, qr_l, jnp.concatenate([kn_c, kn_l], axis=1),
                               jnp.concatenate([krp_c, krp_l], axis=1), jnp.concatenate([vv_c, vv_l], axis=1))
    y = jnp.concatenate([y_sgu, y_gla, y_mla], axis=-1)

    yc = None
    if with_ctx_out:
        y_sgu_c = sgu(su_c, sv_c, sgu_norm_w, sgu_norm_b, sgu_w, sgu_b)
        qn_c, qr_c = mla_q(dq_c, mla_q_norm_w, mla_w_uq, None)
        y_mla_c = mla_attend(qn_c, qr_c, kn_c, krp_c, vv_c).reshape(bsz, -1, MLA_WIDTH)
        yc = jnp.concatenate([y_sgu_c, y_gla_c, y_mla_c], axis=-1)
    return y, yc


def ffn(h, w1, w2):
    a = jax.nn.relu(h @ w1)
    return (a * a) @ w2


def setup_inputs(seed: int = 0) -> dict:
    key = jax.random.key(seed)
    ks = jax.random.split(key, 32)
    L, D = DEPTH, D_MODEL

    def nrm(k, shape, scale):
        return jax.random.normal(k, shape, jnp.float32) * scale

    return {
        "x": nrm(ks[0], (BATCH, SEQ, D), 1.0),
        "c": nrm(ks[1], (BATCH, D), 1.0),
        "ctx": nrm(ks[2], (BATCH, CTX_LEN, D), 1.0),
        "c_ctx": nrm(ks[3], (D,), 1.0),
        "w_mod": nrm(ks[4], (L, D, 6 * D), 0.5 * D ** -0.5),
        "b_mod": nrm(ks[5], (L, 6 * D), 0.02),
        "norm1_w": 1.0 + nrm(ks[6], (L, D), 0.02),
        "w_in": nrm(ks[7], (L, D, IN_COLS), D ** -0.5),
        "w_out": nrm(ks[8], (L, MIX_WIDTH, D), MIX_WIDTH ** -0.5),
        "sgu_norm_w": 1.0 + nrm(ks[9], (L, SGU_WIDTH), 0.02),
        "sgu_norm_b": nrm(ks[10], (L, SGU_WIDTH), 0.02),
        "sgu_w": nrm(ks[11], (L, SGU_HEADS, SGU_CHUNK, SGU_CHUNK), SGU_CHUNK ** -0.5),
        "sgu_b": 1.0 + nrm(ks[12], (L, SGU_HEADS, SGU_CHUNK), 0.02),
        "gla_wg_fwd": nrm(ks[13], (L, GLA_GATE_RANK, GLA_K_WIDTH), GLA_GATE_RANK ** -0.5),
        "gla_bg_fwd": nrm(ks[14], (L, GLA_K_WIDTH), 0.1),
        "gla_wg_bwd": nrm(ks[15], (L, GLA_GATE_RANK, GLA_K_WIDTH), GLA_GATE_RANK ** -0.5),
        "gla_bg_bwd": nrm(ks[16], (L, GLA_K_WIDTH), 0.1),
        "gla_norm_w": 1.0 + nrm(ks[17], (L, GLA_DV), 0.02),
        "mla_q_norm_w": 1.0 + nrm(ks[18], (L, MLA_Q_RANK), 0.02),
        "mla_w_uq": nrm(ks[19], (L, MLA_Q_RANK, MLA_HEADS * (MLA_NOPE + MLA_ROPE)), MLA_Q_RANK ** -0.5),
        "mla_kv_norm_w": 1.0 + nrm(ks[20], (L, MLA_KV_RANK), 0.02),
        "mla_w_ukv": nrm(ks[21], (L, MLA_KV_RANK, MLA_HEADS * (MLA_NOPE + MLA_V)), MLA_KV_RANK ** -0.5),
        "norm2_w": 1.0 + nrm(ks[22], (L, D), 0.02),
        "w_ff1": nrm(ks[23], (L, D, D_FF), D ** -0.5),
        "w_ff2": nrm(ks[24], (L, D_FF, D), D_FF ** -0.5),
        "final_norm_w": 1.0 + nrm(ks[25], (D,), 0.02),
    }


def reference(x, c, ctx, c_ctx, w_mod, b_mod, norm1_w, w_in, w_out, sgu_norm_w, sgu_norm_b, sgu_w, sgu_b,
              gla_wg_fwd, gla_bg_fwd, gla_wg_bwd, gla_bg_bwd, gla_norm_w, mla_q_norm_w, mla_w_uq,
              mla_kv_norm_w, mla_w_ukv, norm2_w, w_ff1, w_ff2, final_norm_w):
    n = x.shape[1]
    ang = axial_angles(n)
    silu_c = jax.nn.silu(c)
    silu_cc = jax.nn.silu(c_ctx)
    xc = ctx
    for l in range(DEPTH):
        last = l == DEPTH - 1
        mod = (silu_c @ w_mod[l] + b_mod[l])[:, None, :]
        sh1, sc1, g1, sh2, sc2, g2 = jnp.split(mod, 6, axis=-1)
        if last:
            mod_c = silu_cc @ w_mod[l][:, :2 * D_MODEL] + b_mod[l][:2 * D_MODEL]
            sh1c, sc1c = jnp.split(mod_c, 2, axis=-1)
        else:
            mod_c = silu_cc @ w_mod[l] + b_mod[l]
            sh1c, sc1c, g1c, sh2c, sc2c, g2c = jnp.split(mod_c, 6, axis=-1)
        h = modulate(rmsnorm(x, norm1_w[l]), sh1, sc1)
        hc = modulate(rmsnorm(xc, norm1_w[l]), sh1c, sc1c)
        y, yc = mixing(h, hc, not last, w_in[l], sgu_norm_w[l], sgu_norm_b[l], sgu_w[l], sgu_b[l],
                       gla_wg_fwd[l], gla_bg_fwd[l], gla_wg_bwd[l], gla_bg_bwd[l], gla_norm_w[l],
                       mla_q_norm_w[l], mla_w_uq[l], mla_kv_norm_w[l], mla_w_ukv[l], ang)
        x = x + g1 * (y @ w_out[l])
        x = x + g2 * ffn(modulate(rmsnorm(x, norm2_w[l]), sh2, sc2), w_ff1[l], w_ff2[l])
        if not last:
            xc = xc + g1c * (yc @ w_out[l])
            xc = xc + g2c * ffn(modulate(rmsnorm(xc, norm2_w[l]), sh2c, sc2c), w_ff1[l], w_ff2[l])
    return rmsnorm(x, final_norm_w)
```

```cpp
#include <hip/hip_runtime.h>
#include <cstdio>
#include <cstdint>

#ifndef MK_ONE_LAUNCH
#define MK_ONE_LAUNCH 1
#endif

#define GAS __attribute__((address_space(1)))
#define LAS __attribute__((address_space(3)))
typedef unsigned short bf16_t;
typedef float f32x4 __attribute__((ext_vector_type(4)));
typedef unsigned u32x4 __attribute__((ext_vector_type(4)));
typedef unsigned u32x2 __attribute__((ext_vector_type(2)));

constexpr int DM = 1024, NB = 2, NL = 8192, NC = 256, ML = NB * NL, MC = NB * NC, MT = ML + MC;
constexpr int FF = 4096, INP = 2048, IN_COLS = 1888, NKEY = NC + NL;
constexpr float EPS = 1e-6f;
constexpr float QSCALE = 0.07216878364870322f * 1.4426950408889634f;
constexpr int NWAVES = 8, NTHR = 512;
constexpr int C_CKV = 0, C_DQ = 256, C_SU = 512, C_SV = 768, C_GV = 1024, C_GR = 1280, C_GK = 1536, C_GQ = 1664, C_KR = 1792, C_GGF = 1856, C_GGB = 1872;

constexpr size_t MiB = 1u << 20;
constexpr size_t WS_CTL = 0, CTL_ZERO_BYTES = 65536;
constexpr size_t WS_MOD = 1 * MiB;
constexpr size_t WS_ROPE = 1 * MiB + 256 * 1024;
constexpr size_t WS_WIN = 2 * MiB;
constexpr size_t WS_WOUT = 10 * MiB;
constexpr size_t WS_WUQ = 14 * MiB;
constexpr size_t WS_WUKV = 15 * MiB;
constexpr size_t WS_WFF1 = 16 * MiB;
constexpr size_t WS_WFF2 = 32 * MiB;
constexpr size_t WS_XC = 48 * MiB;
constexpr size_t WS_HY = 50 * MiB;
constexpr size_t WS_PB = 83 * MiB;
constexpr size_t WS_QH = 149 * MiB;
constexpr size_t WS_QCH = 173 * MiB;
constexpr size_t WS_KH = 174 * MiB;
constexpr size_t WS_VH = 199 * MiB;
constexpr size_t WS_LG = 216 * MiB;
constexpr size_t WS_OB = 233 * MiB;
constexpr size_t WS_A = 83 * MiB;
constexpr size_t WS_END = 250 * MiB;
static_assert(WS_A + (size_t)MT * FF * 2 <= WS_LG, "ffn hidden overlay");
static_assert(WS_PB + (size_t)MT * INP * 2 <= WS_QH && WS_QH + (size_t)8 * NL * 192 * 2 <= WS_QCH && WS_KH + (size_t)8 * NKEY * 192 * 2 <= WS_VH && WS_VH + (size_t)8 * NKEY * 128 * 2 <= WS_LG, "ws map");
static_assert(WS_LG + (size_t)MT * 256 * 4 <= WS_OB && WS_OB + (size_t)MT * 256 * 4 <= WS_END, "ws map 2");

constexpr int LDS_BYTES = 147456;

__device__ __forceinline__ float bf2f(bf16_t v) { return __uint_as_float(((unsigned)v) << 16); }
__device__ __forceinline__ unsigned f2bf(float f) { unsigned u = __float_as_uint(f); return (u + 0x7fffu + ((u >> 16) & 1u)) >> 16; }
__device__ __forceinline__ unsigned pk2(float lo, float hi) { return f2bf(lo) | (f2bf(hi) << 16); }
__device__ __forceinline__ float wave_sum(float v) {
#pragma unroll
    for (int o = 1; o < 64; o <<= 1) v += __shfl_xor(v, o);
    return v;
}
__device__ __forceinline__ float gelu_tanh(float x) { const float u = 1.5957691216057308f * (x + 0.044715f * x * x * x); return x / (1.f + __expf(-u)); }
__device__ __forceinline__ float silu_f(float x) { return x / (1.f + __expf(-x)); }
__device__ __forceinline__ float log_sigmoid_f(float z) { return fminf(z, 0.f) - log1pf(expf(-fabsf(z))); }
__device__ __forceinline__ void unpack8(u32x4 w, float* f) {
    f[0] = __uint_as_float(w.x << 16); f[1] = __uint_as_float(w.x & 0xffff0000u); f[2] = __uint_as_float(w.y << 16); f[3] = __uint_as_float(w.y & 0xffff0000u);
    f[4] = __uint_as_float(w.z << 16); f[5] = __uint_as_float(w.z & 0xffff0000u); f[6] = __uint_as_float(w.w << 16); f[7] = __uint_as_float(w.w & 0xffff0000u);
}

#define XB_TMO      128
#define XB_XCNT(j)  (256  + 64 * (j))
#define XB_XSUB(j)  (1280 + 64 * (j))
#define XB_XGEN(j)  (2304 + 64 * (j))
#define XB_TOP      3328
#define XB_TOPGEN   3392
#define XCD_BAR_WORDS 3456
#define XB_SPIN_CAP (1u << 22)
__device__ __forceinline__ unsigned xb_ld(unsigned* p)              { return __hip_atomic_load(p, __ATOMIC_RELAXED, __HIP_MEMORY_SCOPE_AGENT); }
__device__ __forceinline__ unsigned xb_add(unsigned* p, unsigned v) { return __hip_atomic_fetch_add(p, v, __ATOMIC_RELAXED, __HIP_MEMORY_SCOPE_AGENT); }
__device__ __forceinline__ unsigned xb_xcc_id() { return (unsigned)__builtin_amdgcn_s_getreg((3 << 11) | 20) & 0xFu; }
#define XB_SPIN(cond, bar) do { unsigned _sp = 0; while (cond) { __builtin_amdgcn_s_sleep(1); \
    if ((++_sp & 255u) == 0u) { if (xb_ld(&(bar)[XB_TMO])) break; if (_sp > XB_SPIN_CAP) { atomicAdd(&(bar)[XB_TMO], 1u); break; } } } } while (0)
struct XcdBarrier { unsigned* bar; unsigned x; volatile LAS unsigned* st; };
__device__ __forceinline__ XcdBarrier xcd_barrier_post(unsigned* bar, volatile LAS unsigned* st) {
    XcdBarrier b; b.bar = bar; b.x = xb_xcc_id(); b.st = st;
    if (threadIdx.x == 0) (void)xb_add(&bar[XB_XCNT(b.x)], 1u);
    return b;
}
__device__ __forceinline__ void xcd_barrier_complete(unsigned* bar, unsigned x, unsigned& nloc, unsigned& nx) {
    const unsigned G = gridDim.x * gridDim.y * gridDim.z;
    unsigned sum, cnt, mine, sp = 0u;
    for (;;) {
        sum = 0u; cnt = 0u; mine = 0u;
#pragma unroll
        for (unsigned j = 0; j < 16; ++j) { const unsigned c = xb_ld(&bar[XB_XCNT(j)]); sum += c; cnt += (c > 0u) ? 1u : 0u; mine = (j == x) ? c : mine; }
        if (sum == G) break;
        __builtin_amdgcn_s_sleep(1);
        if ((++sp & 255u) == 0u) { if (xb_ld(&bar[XB_TMO])) break; if (sp > XB_SPIN_CAP) { atomicAdd(&bar[XB_TMO], 1u); break; } }
    }
    nloc = mine > 0u ? mine : 1u; nx = cnt > 0u ? cnt : 1u;
}
__device__ __forceinline__ void xcd_barrier(const XcdBarrier& b) {
    asm volatile("s_waitcnt vmcnt(0)" ::: "memory");
    __syncthreads();
    if (threadIdx.x == 0) {
        unsigned* bar = b.bar;
        __builtin_amdgcn_s_waitcnt(0);
        unsigned nloc = b.st[0], nx = b.st[1];
        if (nloc == 0u) { xcd_barrier_complete(bar, b.x, nloc, nx); b.st[0] = nloc; b.st[1] = nx; }
        const unsigned old = xb_add(&bar[XB_XSUB(b.x)], 1u);
        const unsigned gen = old / nloc;
        if (old + 1u == (gen + 1u) * nloc) {
            __builtin_amdgcn_fence(__ATOMIC_RELEASE, "agent");
            asm volatile("s_waitcnt vmcnt(0)" ::: "memory");
            const unsigned og = xb_add(&bar[XB_TOP], 1u);
            const unsigned tg = og / nx;
            if (og + 1u == (tg + 1u) * nx) xb_add(&bar[XB_TOPGEN], 1u);
            else XB_SPIN(xb_ld(&bar[XB_TOPGEN]) == tg, bar);
            __builtin_amdgcn_fence(__ATOMIC_ACQUIRE, "agent");
            xb_add(&bar[XB_XGEN(b.x)], 1u);
            asm volatile("s_waitcnt vmcnt(0)" ::: "memory");
        } else {
            XB_SPIN(xb_ld(&bar[XB_XGEN(b.x)]) == gen, bar);
            __builtin_amdgcn_fence(__ATOMIC_ACQUIRE, "agent");
            asm volatile("s_waitcnt vmcnt(0)" ::: "memory");
        }
    }
    __syncthreads();
}

struct Args { const float* in[26]; float* out; unsigned char* ws; int ph_lo, ph_hi; };
enum { I_X = 0, I_C, I_CTX, I_CCTX, I_WMOD, I_BMOD, I_N1W, I_WIN, I_WOUT, I_SGNW, I_SGNB, I_SGW, I_SGB, I_GWF, I_GBF, I_GWB, I_GBB, I_GNW, I_QNW, I_WUQ, I_KVNW, I_WUKV, I_N2W, I_WFF1, I_WFF2, I_FNW };

__device__ __forceinline__ int rope_unperm(int jj) { return (jj < 32) ? ((jj >> 1) + 16 * (jj & 1)) : (32 + ((jj - 32) >> 1) + 16 * (jj & 1)); }
__device__ __forceinline__ int map_in(int n) {
    if (n < 256) return 416 + n;
    if (n < 512) return 1632 + (n - 256);
    if (n < 768) return 736 + (n - 512);
    if (n < 1024) return 992 + (n - 768);
    if (n < 1280) return 128 + (n - 1024);
    if (n < 1536) return 1376 + (n - 1280);
    if (n < 1664) return n - 1536;
    if (n < 1792) return 1248 + (n - 1664);
    if (n < 1856) return 672 + rope_unperm(n - 1792);
    if (n < 1872) return 384 + (n - 1856);
    if (n < 1888) return 400 + (n - 1872);
    return -1;
}
__device__ __forceinline__ int map_uq(int n) { const int h = n / 192, j = n % 192; return (j < 128) ? n : (h * 192 + 128 + rope_unperm(j - 128)); }
template <int MODE> __device__ __forceinline__ void transpose_w(const float* W, int K, int Nsrc, bf16_t* Wt, int Npad, int gtid, int gthreads) {
    const int total = Npad * (K / 8);
    for (int idx = gtid; idx < total; idx += gthreads) {
        const int n = idx % Npad, kc = idx / Npad;
        const int src = (MODE == 0) ? n : (MODE == 1 ? map_in(n) : map_uq(n));
        float f[8];
#pragma unroll
        for (int i = 0; i < 8; ++i) f[i] = (src >= 0) ? W[(size_t)(kc * 8 + i) * Nsrc + src] : 0.f;
        u32x4 o; o.x = pk2(f[0], f[1]); o.y = pk2(f[2], f[3]); o.z = pk2(f[4], f[5]); o.w = pk2(f[6], f[7]);
        *(u32x4*)(Wt + (size_t)n * K + kc * 8) = o;
    }
}
__device__ __forceinline__ void phase_prep(const Args& a, LAS unsigned char* lds) {
    unsigned char* ws = a.ws;
    const int tid = threadIdx.x, gtid = blockIdx.x * NTHR + tid, gthreads = gridDim.x * NTHR;
    for (int l = 0; l < 2; ++l) {
        transpose_w<1>(a.in[I_WIN] + (size_t)l * DM * IN_COLS, DM, IN_COLS, (bf16_t*)(ws + WS_WIN) + (size_t)l * INP * DM, INP, gtid, gthreads);
        transpose_w<0>(a.in[I_WOUT] + (size_t)l * DM * DM, DM, DM, (bf16_t*)(ws + WS_WOUT) + (size_t)l * DM * DM, DM, gtid, gthreads);
        transpose_w<2>(a.in[I_WUQ] + (size_t)l * 256 * 768, 256, 768, (bf16_t*)(ws + WS_WUQ) + (size_t)l * 768 * 256, 768, gtid, gthreads);
        transpose_w<0>(a.in[I_WUKV] + (size_t)l * 256 * 1024, 256, 1024, (bf16_t*)(ws + WS_WUKV) + (size_t)l * 1024 * 256, 1024, gtid, gthreads);
        transpose_w<0>(a.in[I_WFF1] + (size_t)l * DM * FF, DM, FF, (bf16_t*)(ws + WS_WFF1) + (size_t)l * FF * DM, FF, gtid, gthreads);
        transpose_w<0>(a.in[I_WFF2] + (size_t)l * FF * DM, FF, DM, (bf16_t*)(ws + WS_WFF2) + (size_t)l * DM * FF, DM, gtid, gthreads);
    }
    if (gtid < 128 * 16) {
        const int p = gtid >> 4, i = gtid & 15;
        const float freq = powf(10000.0f, -(float)i * 2.0f / 32.0f);
        const float ang = (float)p * freq;
        float* R = (float*)(ws + WS_ROPE);
        R[gtid * 2 + 0] = (float)cos((double)ang); R[gtid * 2 + 1] = (float)sin((double)ang);
    }
    {
        LAS float* red = (LAS float*)lds;
        const int wave = tid >> 6, lane = tid & 63;
        for (int item = blockIdx.x; item < 2 * 96; item += gridDim.x) {
            const int l = item / 96, j = (item % 96) * 64 + lane;
            const float* W = a.in[I_WMOD] + (size_t)l * DM * 6144;
            float s0 = 0.f, s1 = 0.f, s2 = 0.f;
#pragma unroll 8
            for (int kk = 0; kk < 128; ++kk) {
                const int k = wave * 128 + kk;
                const float w = W[(size_t)k * 6144 + j];
                s0 += silu_f(a.in[I_C][k]) * w; s1 += silu_f(a.in[I_C][DM + k]) * w; s2 += silu_f(a.in[I_CCTX][k]) * w;
            }
            red[(wave * 3 + 0) * 64 + lane] = s0; red[(wave * 3 + 1) * 64 + lane] = s1; red[(wave * 3 + 2) * 64 + lane] = s2;
            __syncthreads();
            if (tid < 192) {
                const int r = tid >> 6; float s = 0.f;
#pragma unroll
                for (int w = 0; w < 8; ++w) s += red[(w * 3 + r) * 64 + lane];
                ((float*)(ws + WS_MOD))[(size_t)(l * 3 + r) * 6144 + j] = s + a.in[I_BMOD][l * 6144 + j];
            }
            __syncthreads();
        }
    }
}

__device__ __forceinline__ void phase_norm_mod(const float* xl, const float* xc, const float* nw, const float* mod, int sh_off, int sc_off, bf16_t* H) {
    const int lane = threadIdx.x & 63, gw = blockIdx.x * NWAVES + (threadIdx.x >> 6), ngw = gridDim.x * NWAVES;
    for (int row = gw; row < MT; row += ngw) {
        const float* src = row < ML ? xl + (size_t)row * DM : xc + (size_t)(row - ML) * DM;
        const float* m = mod + (row < ML ? row / NL : 2) * 6144;
        f32x4 v[4]; float ss = 0.f;
#pragma unroll
        for (int j = 0; j < 4; ++j) { v[j] = *(const f32x4*)(src + lane * 4 + 256 * j); ss += v[j].x * v[j].x + v[j].y * v[j].y + v[j].z * v[j].z + v[j].w * v[j].w; }
        const float rstd = rsqrtf(wave_sum(ss) * (1.f / DM) + EPS);
#pragma unroll
        for (int j = 0; j < 4; ++j) {
            const int c = lane * 4 + 256 * j;
            const f32x4 w = *(const f32x4*)(nw + c), sc = *(const f32x4*)(m + sc_off + c), sh = *(const f32x4*)(m + sh_off + c);
            const f32x4 o = (v[j] * rstd * w) * (sc + 1.f) + sh;
            u32x2 pk; pk.x = pk2(o.x, o.y); pk.y = pk2(o.z, o.w);
            *(u32x2*)(H + (size_t)row * DM + c) = pk;
        }
    }
}

template <class Epi> __device__ __forceinline__ void gemm_naive(const bf16_t* A, int lda, const bf16_t* Bt, int M, int N, int K, const Epi& E, LAS unsigned char* lds) {
    LAS float* As = (LAS float*)lds;
    LAS float* Bs = As + 32 * 132;
    const int tid = threadIdx.x, ty = tid >> 4, tx = tid & 15;
    const int ntm = M / 128, ntn = N / 64, ntiles = ntm * ntn;
    for (int tile = blockIdx.x; tile < ntiles; tile += gridDim.x) {
        const int tm = tile / ntn, tn = tile % ntn, row0 = tm * 128, col0 = tn * 64;
        float acc[4][4];
#pragma unroll
        for (int i = 0; i < 4; ++i)
#pragma unroll
            for (int j = 0; j < 4; ++j) acc[i][j] = 0.f;
        for (int k0 = 0; k0 < K; k0 += 32) {
            {
                const int r = tid >> 2, kc = (tid & 3) * 8; float f[8];
                unpack8(*(const u32x4*)(A + (size_t)(row0 + r) * lda + k0 + kc), f);
#pragma unroll
                for (int i = 0; i < 8; ++i) As[(kc + i) * 132 + r] = f[i];
                if (tid < 256) {
                    unpack8(*(const u32x4*)(Bt + (size_t)(col0 + r) * K + k0 + kc), f);
#pragma unroll
                    for (int i = 0; i < 8; ++i) Bs[(kc + i) * 68 + r] = f[i];
                }
            }
            __syncthreads();
#pragma unroll 8
            for (int k = 0; k < 32; ++k) {
                const f32x4 av = *(const LAS f32x4*)(As + k * 132 + ty * 4), bv = *(const LAS f32x4*)(Bs + k * 68 + tx * 4);
#pragma unroll
                for (int i = 0; i < 4; ++i)
#pragma unroll
                    for (int j = 0; j < 4; ++j) acc[i][j] += av[i] * bv[j];
            }
            __syncthreads();
        }
#pragma unroll
        for (int i = 0; i < 4; ++i) E(row0 + ty * 4 + i, col0 + tx * 4, (f32x4){acc[i][0], acc[i][1], acc[i][2], acc[i][3]});
    }
}

__device__ __forceinline__ void st4bf(bf16_t* p, f32x4 v) { u32x2 pk; pk.x = pk2(v.x, v.y); pk.y = pk2(v.z, v.w); *(u32x2*)p = pk; }
__device__ __forceinline__ f32x4 rope4(f32x4 v, int jj, int t, const float* R) {
    const int pos = (jj < 32) ? (t >> 6) : (t & 63), i0 = ((jj & 31) >> 1);
    const f32x4 cs = *(const f32x4*)(R + (pos * 16 + i0) * 2);
    return (f32x4){v.x * cs.x - v.y * cs.y, v.x * cs.y + v.y * cs.x, v.z * cs.z - v.w * cs.w, v.z * cs.w + v.w * cs.z};
}
struct EpiInProj { bf16_t* PB; const float* R;
    __device__ __forceinline__ void operator()(int row, int col, f32x4 v) const {
        const int tile = col >> 8;
        if (tile == 2 || tile == 3) { v = (f32x4){gelu_tanh(v.x), gelu_tanh(v.y), gelu_tanh(v.z), gelu_tanh(v.w)}; }
        else if (tile == 5) { v = (f32x4){silu_f(v.x), silu_f(v.y), silu_f(v.z), silu_f(v.w)}; }
        else if (tile == 7) { const int cc = col - C_KR; if (cc < 64 && row < ML) v = rope4(v, cc, row & (NL - 1), R); }
        st4bf(PB + (size_t)row * INP + col, v);
    } };
struct EpiUQ { bf16_t* QH; bf16_t* QCH; const float* R;
    __device__ __forceinline__ void operator()(int row, int col, f32x4 v) const {
        const int h = col / 192, j = col % 192;
        if (row < ML) { const int b = row >> 13, t = row & (NL - 1);
            if (j >= 128) v = rope4(v, j - 128, t, R);
            st4bf(QH + ((size_t)(b * 4 + h) * NL + t) * 192 + j, v * QSCALE);
        } else { const int rc = row - ML, b = rc >> 8, t = rc & 255;
            st4bf(QCH + ((size_t)(b * 4 + h) * NC + t) * 192 + j, v * QSCALE); }
    } };
struct EpiUKV { bf16_t* KH; bf16_t* VH;
    __device__ __forceinline__ void operator()(int row, int col, f32x4 v) const {
        const int h = col >> 8, j = col & 255; int b, pos;
        if (row < ML) { b = row >> 13; pos = NC + (row & (NL - 1)); } else { const int rc = row - ML; b = rc >> 8; pos = rc & 255; }
        if (j < 128) st4bf(KH + ((size_t)(b * 4 + h) * NKEY + pos) * 192 + j, v);
        else st4bf(VH + ((size_t)(b * 4 + h) * NKEY + pos) * 128 + (j - 128), v);
    } };
struct EpiResid { const float* xin_l; const float* xin_c; float* xout_l; float* xout_c; const float* mod; int g_off;
    __device__ __forceinline__ void operator()(int row, int col, f32x4 v) const {
        if (row < ML) { const f32x4 g = *(const f32x4*)(mod + (row >> 13) * 6144 + g_off + col), xi = *(const f32x4*)(xin_l + (size_t)row * DM + col);
            *(f32x4*)(xout_l + (size_t)row * DM + col) = xi + g * v;
        } else { const int rc = row - ML; const f32x4 g = *(const f32x4*)(mod + 2 * 6144 + g_off + col), xi = *(const f32x4*)(xin_c + (size_t)rc * DM + col);
            *(f32x4*)(xout_c + (size_t)rc * DM + col) = xi + g * v; }
    } };
struct EpiFF1 { bf16_t* Ah;
    __device__ __forceinline__ void operator()(int row, int col, f32x4 v) const {
        f32x4 r = (f32x4){fmaxf(v.x, 0.f), fmaxf(v.y, 0.f), fmaxf(v.z, 0.f), fmaxf(v.w, 0.f)};
        st4bf(Ah + (size_t)row * FF + col, r * r);
    } };

__device__ __forceinline__ void phase_post(const Args& a, int l) {
    unsigned char* ws = a.ws;
    bf16_t* PB = (bf16_t*)(ws + WS_PB); bf16_t* KH = (bf16_t*)(ws + WS_KH); float* LG = (float*)(ws + WS_LG);
    const float* kvnw = a.in[I_KVNW] + l * 256; const float* qnw = a.in[I_QNW] + l * 256;
    const float* snw = a.in[I_SGNW] + l * 256; const float* snb = a.in[I_SGNB] + l * 256;
    const float* wgf = a.in[I_GWF] + l * 16 * 128; const float* bgf = a.in[I_GBF] + l * 128;
    const float* wgb = a.in[I_GWB] + l * 16 * 128; const float* bgb = a.in[I_GBB] + l * 128;
    const int lane = threadIdx.x & 63, gw = blockIdx.x * NWAVES + (threadIdx.x >> 6), ngw = gridDim.x * NWAVES;
    for (int row = gw; row < MT; row += ngw) {
        bf16_t* pr = PB + (size_t)row * INP;
        const int c = lane * 4;
        { u32x2 w = *(const u32x2*)(pr + C_CKV + c); f32x4 v = {__uint_as_float(w.x << 16), __uint_as_float(w.x & 0xffff0000u), __uint_as_float(w.y << 16), __uint_as_float(w.y & 0xffff0000u)};
          const float rstd = rsqrtf(wave_sum(v.x * v.x + v.y * v.y + v.z * v.z + v.w * v.w) * (1.f / 256.f) + EPS);
          st4bf(pr + C_CKV + c, v * rstd * *(const f32x4*)(kvnw + c)); }
        { u32x2 w = *(const u32x2*)(pr + C_DQ + c); f32x4 v = {__uint_as_float(w.x << 16), __uint_as_float(w.x & 0xffff0000u), __uint_as_float(w.y << 16), __uint_as_float(w.y & 0xffff0000u)};
          const float rstd = rsqrtf(wave_sum(v.x * v.x + v.y * v.y + v.z * v.z + v.w * v.w) * (1.f / 256.f) + EPS);
          st4bf(pr + C_DQ + c, v * rstd * *(const f32x4*)(qnw + c)); }
        { u32x2 w = *(const u32x2*)(pr + C_SV + c); f32x4 v = {__uint_as_float(w.x << 16), __uint_as_float(w.x & 0xffff0000u), __uint_as_float(w.y << 16), __uint_as_float(w.y & 0xffff0000u)};
          const float mu = wave_sum(v.x + v.y + v.z + v.w) * (1.f / 256.f);
          v = v - mu;
          const float rstd = rsqrtf(wave_sum(v.x * v.x + v.y * v.y + v.z * v.z + v.w * v.w) * (1.f / 256.f) + EPS);
          st4bf(pr + C_SV + c, v * rstd * *(const f32x4*)(snw + c) + *(const f32x4*)(snb + c)); }
        { const int o = lane * 4, isb = o >> 7, d = o & 127;
          const float* wg = isb ? wgb : wgf; const float* bg = isb ? bgb : bgf; const bf16_t* gg = pr + (isb ? C_GGB : C_GGF);
          f32x4 z = *(const f32x4*)(bg + d);
#pragma unroll
          for (int r = 0; r < 16; ++r) z += *(const f32x4*)(wg + r * 128 + d) * bf2f(gg[r]);
          *(f32x4*)(LG + (size_t)row * 256 + o) = (f32x4){log_sigmoid_f(z.x), log_sigmoid_f(z.y), log_sigmoid_f(z.z), log_sigmoid_f(z.w)} * (1.f / 16.f); }
        { int b, pos; if (row < ML) { b = row >> 13; pos = NC + (row & (NL - 1)); } else { const int rc = row - ML; b = rc >> 8; pos = rc & 255; }
          const bf16_t kv = pr[C_KR + lane];
#pragma unroll
          for (int h = 0; h < 4; ++h) KH[((size_t)(b * 4 + h) * NKEY + pos) * 192 + 128 + lane] = kv; }
    }
}

__device__ __forceinline__ void phase_sgu_naive(const Args& a, int l) {
    unsigned char* ws = a.ws;
    const bf16_t* PB = (const bf16_t*)(ws + WS_PB); bf16_t* Y = (bf16_t*)(ws + WS_HY);
    const float* Ws = a.in[I_SGW] + (size_t)l * 4 * 128 * 128; const float* bs = a.in[I_SGB] + l * 4 * 128;
    const int tid = threadIdx.x, i = tid >> 2, eg = (tid & 3) * 16;
    for (int unit = blockIdx.x; unit < (MT / 128) * 4; unit += gridDim.x) {
        const int cc = unit >> 2, h = unit & 3;
        float acc[16];
#pragma unroll
        for (int e = 0; e < 16; ++e) acc[e] = 0.f;
        const float* wrow = Ws + ((size_t)h * 128 + i) * 128;
        for (int j = 0; j < 128; ++j) {
            const float w = wrow[j];
            const bf16_t* vp = PB + (size_t)(cc * 128 + j) * INP + C_SV + h * 64 + eg;
            float f[8], g[8]; unpack8(*(const u32x4*)vp, f); unpack8(*(const u32x4*)(vp + 8), g);
#pragma unroll
            for (int e = 0; e < 8; ++e) { acc[e] += w * f[e]; acc[8 + e] += w * g[e]; }
        }
        const float bias = bs[h * 128 + i];
        const int row = cc * 128 + i;
        const bf16_t* up = PB + (size_t)row * INP + C_SU + h * 64 + eg;
        float f[8], g[8]; unpack8(*(const u32x4*)up, f); unpack8(*(const u32x4*)(up + 8), g);
        bf16_t* yp = Y + (size_t)row * DM + h * 64 + eg;
        u32x4 o0, o1;
        o0.x = pk2(f[0] * (acc[0] + bias), f[1] * (acc[1] + bias)); o0.y = pk2(f[2] * (acc[2] + bias), f[3] * (acc[3] + bias));
        o0.z = pk2(f[4] * (acc[4] + bias), f[5] * (acc[5] + bias)); o0.w = pk2(f[6] * (acc[6] + bias), f[7] * (acc[7] + bias));
        o1.x = pk2(g[0] * (acc[8] + bias), g[1] * (acc[9] + bias)); o1.y = pk2(g[2] * (acc[10] + bias), g[3] * (acc[11] + bias));
        o1.z = pk2(g[4] * (acc[12] + bias), g[5] * (acc[13] + bias)); o1.w = pk2(g[6] * (acc[14] + bias), g[7] * (acc[15] + bias));
        *(u32x4*)yp = o0; *(u32x4*)(yp + 8) = o1;
    }
}

__device__ __forceinline__ void phase_gla_naive(const Args& a, int l) {
    unsigned char* ws = a.ws;
    const bf16_t* PB = (const bf16_t*)(ws + WS_PB); bf16_t* Y = (bf16_t*)(ws + WS_HY);
    const float* LG = (const float*)(ws + WS_LG); float* OB = (float*)(ws + WS_OB);
    const float* gnw = a.in[I_GNW] + l * 64;
    if (blockIdx.x >= 8 || threadIdx.x >= 64) return;
    const int b = blockIdx.x >> 2, h = blockIdx.x & 3, e = threadIdx.x;
    const float gw_e = gnw[e];
    for (int dir = 1; dir >= 0; --dir) {
        float S[32];
#pragma unroll
        for (int d = 0; d < 32; ++d) S[d] = 0.f;
        for (int tau = 0; tau < NKEY; ++tau) {
            int row;
            if (dir == 0) row = tau < NC ? ML + b * NC + tau : b * NL + (tau - NC);
            else row = tau < NC ? ML + b * NC + (NC - 1 - tau) : b * NL + (NL - 1 - (tau - NC));
            const bf16_t* pr = PB + (size_t)row * INP;
            const float* lg = LG + (size_t)row * 256 + dir * 128 + h * 32;
            const float v = bf2f(pr[C_GV + h * 64 + e]);
            float o = 0.f;
#pragma unroll
            for (int d = 0; d < 32; ++d) {
                const float kk = bf2f(pr[C_GK + h * 32 + d]), qq = bf2f(pr[C_GQ + h * 32 + d]), al = expf(lg[d]);
                S[d] = al * S[d] + kk * v; o += qq * S[d];
            }
            o *= 0.17677669529663687f;
            if (dir == 1) OB[(size_t)row * 256 + h * 64 + e] = o;
            else {
                o += OB[(size_t)row * 256 + h * 64 + e];
                const float ms = wave_sum(o * o) * (1.f / 64.f);
                const float y = o * rsqrtf(ms + EPS) * gw_e * bf2f(pr[C_GR + h * 64 + e]);
                Y[(size_t)row * DM + 256 + h * 64 + e] = (bf16_t)f2bf(y);
            }
        }
    }
}

__device__ __forceinline__ void phase_attn_naive(const Args& a, int l, LAS unsigned char* lds) {
    unsigned char* ws = a.ws;
    const bf16_t* QH = (const bf16_t*)(ws + WS_QH); const bf16_t* QCH = (const bf16_t*)(ws + WS_QCH);
    const bf16_t* KH = (const bf16_t*)(ws + WS_KH); const bf16_t* VH = (const bf16_t*)(ws + WS_VH); bf16_t* Y = (bf16_t*)(ws + WS_HY);
    LAS float* Qs = (LAS float*)lds;
    LAS float* Ks = Qs + 192 * 64;
    LAS float* Vs = Ks + 96 * 64;
    LAS float* Ps = Vs + 64 * 128;
    const int tid = threadIdx.x, ty = tid >> 4, tx = tid & 15;
    const int nunits = 1024 + (l == 0 ? 32 : 0);
    for (int unit = blockIdx.x; unit < nunits; unit += gridDim.x) {
        int bh, nkeys, orow0; const bf16_t* Qp;
        if (unit < 1024) { bh = unit >> 7; const int qb = unit & 127; Qp = QH + ((size_t)bh * NL + qb * 64) * 192; nkeys = NKEY; orow0 = (bh >> 2) * NL + qb * 64; }
        else { const int u = unit - 1024; bh = u >> 2; const int qb = u & 3; Qp = QCH + ((size_t)bh * NC + qb * 64) * 192; nkeys = NC; orow0 = ML + (bh >> 2) * NC + qb * 64; }
        const int h = bh & 3;
        __syncthreads();
        for (int idx = tid; idx < 64 * 24; idx += NTHR) { const int r = idx / 24, ch = idx % 24; float f[8]; unpack8(*(const u32x4*)(Qp + (size_t)r * 192 + ch * 8), f);
#pragma unroll
            for (int i = 0; i < 8; ++i) Qs[(ch * 8 + i) * 64 + r] = f[i]; }
        float m[2] = {-1e30f, -1e30f}, lsum[2] = {0.f, 0.f}, o[2][8];
#pragma unroll
        for (int r = 0; r < 2; ++r)
#pragma unroll
            for (int c = 0; c < 8; ++c) o[r][c] = 0.f;
        for (int k0 = 0; k0 < nkeys; k0 += 64) {
            float s[2][4];
#pragma unroll
            for (int r = 0; r < 2; ++r)
#pragma unroll
                for (int j = 0; j < 4; ++j) s[r][j] = 0.f;
            for (int dh = 0; dh < 2; ++dh) {
                __syncthreads();
                for (int idx = tid; idx < 64 * 12; idx += NTHR) { const int key = idx / 12, ch = idx % 12; float f[8];
                    unpack8(*(const u32x4*)(KH + ((size_t)bh * NKEY + k0 + key) * 192 + dh * 96 + ch * 8), f);
#pragma unroll
                    for (int i = 0; i < 8; ++i) Ks[(ch * 8 + i) * 64 + key] = f[i]; }
                if (dh == 0) {
                    for (int idx = tid; idx < 64 * 16; idx += NTHR) { const int key = idx >> 4, ch = idx & 15; float f[8];
                        unpack8(*(const u32x4*)(VH + ((size_t)bh * NKEY + k0 + key) * 128 + ch * 8), f);
#pragma unroll
                        for (int i = 0; i < 8; ++i) Vs[key * 128 + ch * 8 + i] = f[i]; }
                }
                __syncthreads();
#pragma unroll 4
                for (int d = 0; d < 96; ++d) {
                    const float q0 = Qs[(dh * 96 + d) * 64 + 2 * ty], q1 = Qs[(dh * 96 + d) * 64 + 2 * ty + 1];
                    const f32x4 kv = *(const LAS f32x4*)(Ks + d * 64 + 4 * tx);
#pragma unroll
                    for (int j = 0; j < 4; ++j) { s[0][j] += q0 * kv[j]; s[1][j] += q1 * kv[j]; }
                }
            }
#pragma unroll
            for (int r = 0; r < 2; ++r) {
                float mx = fmaxf(fmaxf(s[r][0], s[r][1]), fmaxf(s[r][2], s[r][3]));
                mx = fmaxf(mx, __shfl_xor(mx, 1)); mx = fmaxf(mx, __shfl_xor(mx, 2)); mx = fmaxf(mx, __shfl_xor(mx, 4)); mx = fmaxf(mx, __shfl_xor(mx, 8));
                const float mn = fmaxf(m[r], mx), alpha = exp2f(m[r] - mn);
                float p[4], rs = 0.f;
#pragma unroll
                for (int j = 0; j < 4; ++j) { p[j] = exp2f(s[r][j] - mn); rs += p[j]; Ps[(2 * ty + r) * 65 + 4 * tx + j] = p[j]; }
                rs += __shfl_xor(rs, 1); rs += __shfl_xor(rs, 2); rs += __shfl_xor(rs, 4); rs += __shfl_xor(rs, 8);
                lsum[r] = lsum[r] * alpha + rs; m[r] = mn;
#pragma unroll
                for (int c = 0; c < 8; ++c) o[r][c] *= alpha;
            }
            __syncthreads();
#pragma unroll 4
            for (int j = 0; j < 64; ++j) {
                const float p0 = Ps[(2 * ty) * 65 + j], p1 = Ps[(2 * ty + 1) * 65 + j];
                const f32x4 v0 = *(const LAS f32x4*)(Vs + j * 128 + 8 * tx), v1 = *(const LAS f32x4*)(Vs + j * 128 + 8 * tx + 4);
#pragma unroll
                for (int c = 0; c < 4; ++c) { o[0][c] += p0 * v0[c]; o[0][4 + c] += p0 * v1[c]; o[1][c] += p1 * v0[c]; o[1][4 + c] += p1 * v1[c]; }
            }
        }
#pragma unroll
        for (int r = 0; r < 2; ++r) {
            const float il = 1.f / lsum[r];
            u32x4 w; w.x = pk2(o[r][0] * il, o[r][1] * il); w.y = pk2(o[r][2] * il, o[r][3] * il); w.z = pk2(o[r][4] * il, o[r][5] * il); w.w = pk2(o[r][6] * il, o[r][7] * il);
            *(u32x4*)(Y + (size_t)(orow0 + 2 * ty + r) * DM + 512 + h * 128 + 8 * tx) = w;
        }
    }
}

__device__ __forceinline__ void phase_final(const Args& a) {
    const float* fw = a.in[I_FNW];
    const int lane = threadIdx.x & 63, gw = blockIdx.x * NWAVES + (threadIdx.x >> 6), ngw = gridDim.x * NWAVES;
    for (int row = gw; row < ML; row += ngw) {
        float* p = a.out + (size_t)row * DM;
        f32x4 v[4]; float ss = 0.f;
#pragma unroll
        for (int j = 0; j < 4; ++j) { v[j] = *(const f32x4*)(p + lane * 4 + 256 * j); ss += v[j].x * v[j].x + v[j].y * v[j].y + v[j].z * v[j].z + v[j].w * v[j].w; }
        const float rstd = rsqrtf(wave_sum(ss) * (1.f / DM) + EPS);
#pragma unroll
        for (int j = 0; j < 4; ++j) *(f32x4*)(p + lane * 4 + 256 * j) = v[j] * rstd * *(const f32x4*)(fw + lane * 4 + 256 * j);
    }
}

constexpr int NPHASE = 24;
__global__ void __launch_bounds__(NTHR, 2) mega(Args a) {
    extern __shared__ __attribute__((aligned(16))) unsigned char lds_raw[];
    LAS unsigned char* lds = (LAS unsigned char*)lds_raw;
    unsigned char* ws = a.ws;
    volatile LAS unsigned* MISC = (volatile LAS unsigned*)(lds + LDS_BYTES - 256);
    if (threadIdx.x < 64) MISC[threadIdx.x] = 0u;
    __syncthreads();
    XcdBarrier bar; bar.bar = (unsigned*)(ws + WS_CTL); bar.x = 0; bar.st = nullptr;
    if (MK_ONE_LAUNCH) bar = xcd_barrier_post((unsigned*)(ws + WS_CTL), MISC + 8);
    const float* MOD = (const float*)(ws + WS_MOD); const float* ROPE = (const float*)(ws + WS_ROPE);
    bf16_t* HY = (bf16_t*)(ws + WS_HY); bf16_t* PB = (bf16_t*)(ws + WS_PB); float* XC = (float*)(ws + WS_XC);
    for (int ph = a.ph_lo; ph < a.ph_hi; ++ph) {
        if (ph == 0) phase_prep(a, lds);
        else if (ph == NPHASE - 1) phase_final(a);
        else {
            const int l = (ph - 1) / 11, s = (ph - 1) % 11;
            const float* mod = MOD + (size_t)l * 3 * 6144;
            const float* xl_in = (l == 0) ? a.in[I_X] : a.out;
            const float* xc_in = (l == 0) ? a.in[I_CTX] : XC;
            if (s == 0) phase_norm_mod(xl_in, xc_in, a.in[I_N1W] + l * DM, mod, 0, 1024, HY);
            else if (s == 1) { EpiInProj E{PB, ROPE}; gemm_naive(HY, DM, (const bf16_t*)(ws + WS_WIN) + (size_t)l * INP * DM, MT, INP, DM, E, lds); }
            else if (s == 2) phase_post(a, l);
            else if (s == 3) {
                EpiUQ E1{(bf16_t*)(ws + WS_QH), (bf16_t*)(ws + WS_QCH), ROPE}; gemm_naive(PB + C_DQ, INP, (const bf16_t*)(ws + WS_WUQ) + (size_t)l * 768 * 256, MT, 768, 256, E1, lds);
                EpiUKV E2{(bf16_t*)(ws + WS_KH), (bf16_t*)(ws + WS_VH)}; gemm_naive(PB + C_CKV, INP, (const bf16_t*)(ws + WS_WUKV) + (size_t)l * 1024 * 256, MT, 1024, 256, E2, lds);
            }
            else if (s == 4) phase_sgu_naive(a, l);
            else if (s == 5) phase_gla_naive(a, l);
            else if (s == 6) phase_attn_naive(a, l, lds);
            else if (s == 7) { EpiResid E{xl_in, xc_in, a.out, XC, mod, 2048}; gemm_naive(HY, DM, (const bf16_t*)(ws + WS_WOUT) + (size_t)l * DM * DM, MT, DM, DM, E, lds); }
            else if (s == 8) phase_norm_mod(a.out, XC, a.in[I_N2W] + l * DM, mod, 3072, 4096, HY);
            else if (s == 9) { EpiFF1 E{(bf16_t*)(ws + WS_A)}; gemm_naive(HY, DM, (const bf16_t*)(ws + WS_WFF1) + (size_t)l * FF * DM, MT, FF, DM, E, lds); }
            else { EpiResid E{a.out, XC, a.out, XC, mod, 5120}; gemm_naive((const bf16_t*)(ws + WS_A), FF, (const bf16_t*)(ws + WS_WFF2) + (size_t)l * DM * FF, MT, DM, FF, E, lds); }
        }
        if (MK_ONE_LAUNCH && ph + 1 < a.ph_hi) xcd_barrier(bar);
    }
}

extern "C" void kernel_launch(void* const* d_in, const int* in_sizes, int n_in, void* d_out, int out_size, void* d_ws, size_t ws_size, hipStream_t stream) {
    static int grid = 0;
    if (grid == 0) {
        if (n_in != 26 || in_sizes[0] != ML * DM || out_size != ML * DM || ws_size < WS_END) { fprintf(stderr, "kernel_launch: unexpected shapes (n_in %d, in0 %d, out %d, ws %zu)\n", n_in, n_in > 0 ? in_sizes[0] : -1, out_size, ws_size); grid = -1; return; }
        int dev = 0, cus = 0;
        if (hipGetDevice(&dev) != hipSuccess || hipDeviceGetAttribute(&cus, hipDeviceAttributeMultiprocessorCount, dev) != hipSuccess) { grid = -1; return; }
        if (hipFuncSetAttribute((const void*)mega, hipFuncAttributeMaxDynamicSharedMemorySize, LDS_BYTES) != hipSuccess) { fprintf(stderr, "kernel_launch: hipFuncSetAttribute failed\n"); grid = -1; return; }
        int per_cu = 0;
        if (hipOccupancyMaxActiveBlocksPerMultiprocessor(&per_cu, (const void*)mega, NTHR, LDS_BYTES) != hipSuccess || per_cu < 1) fprintf(stderr, "kernel_launch: occupancy query says %d\n", per_cu);
        (void)hipGetLastError();
        grid = cus;
    }
    if (grid < 0) return;
    (void)hipMemsetAsync((char*)d_ws + WS_CTL, 0, CTL_ZERO_BYTES, stream);
    Args a{};
    for (int i = 0; i < 26; ++i) a.in[i] = (const float*)d_in[i];
    a.out = (float*)d_out; a.ws = (unsigned char*)d_ws;
    if (MK_ONE_LAUNCH) { a.ph_lo = 0; a.ph_hi = NPHASE; hipLaunchKernelGGL(mega, dim3(grid), dim3(NTHR), LDS_BYTES, stream, a); }
    else for (int ph = 0; ph < NPHASE; ++ph) { a.ph_lo = ph; a.ph_hi = ph + 1; hipLaunchKernelGGL(mega, dim3(grid), dim3(NTHR), LDS_BYTES, stream, a); }
}
```

```cpp
#include <hip/hip_runtime.h>
#include <cstdio>
#include <cstdint>

#ifndef ATT_NQL
#define ATT_NQL 6
#endif
#ifndef ATTN_NAIVE
#define ATTN_NAIVE 0
#endif
#ifndef GLA_NAIVE
#define GLA_NAIVE 0
#endif
#ifndef MK_ONE_LAUNCH
#define MK_ONE_LAUNCH 1
#endif

#define GAS __attribute__((address_space(1)))
#define LAS __attribute__((address_space(3)))
typedef unsigned short bf16_t;
typedef float f32x4 __attribute__((ext_vector_type(4)));
typedef unsigned u32x4 __attribute__((ext_vector_type(4)));
typedef unsigned u32x2 __attribute__((ext_vector_type(2)));

constexpr int DM = 1024, NB = 2, NL = 8192, NC = 256, ML = NB * NL, MC = NB * NC, MT = ML + MC;
constexpr int FF = 4096, INP = 2048, IN_COLS = 1888, NKEY = NC + NL;
constexpr float EPS = 1e-6f;
constexpr float QSCALE = 0.07216878364870322f * 1.4426950408889634f;
constexpr int NWAVES = 8, NTHR = 512;
constexpr int C_CKV = 0, C_DQ = 256, C_SU = 512, C_SV = 768, C_GV = 1024, C_GR = 1280, C_GK = 1536, C_GQ = 1664, C_KR = 1792, C_GGF = 1856, C_GGB = 1872;

constexpr size_t MiB = 1u << 20;
constexpr size_t WS_CTL = 0, CTL_ZERO_BYTES = 65536;
constexpr size_t WS_MOD = 1 * MiB;
constexpr size_t WS_ROPE = 1 * MiB + 256 * 1024;
constexpr size_t WS_WIN = 2 * MiB;
constexpr size_t WS_WOUT = 10 * MiB;
constexpr size_t WS_WUQ = 14 * MiB;
constexpr size_t WS_WUKV = 15 * MiB;
constexpr size_t WS_WFF1 = 16 * MiB;
constexpr size_t WS_WFF2 = 32 * MiB;
constexpr size_t WS_XC = 48 * MiB;
constexpr size_t WS_HY = 50 * MiB;
constexpr size_t WS_PB = 83 * MiB;
constexpr size_t WS_QB = 149 * MiB;
constexpr size_t WS_KVB = 174 * MiB;
constexpr size_t WS_LG = 216 * MiB;
constexpr size_t WS_OB = 233 * MiB;
constexpr size_t WS_A = 83 * MiB;
constexpr size_t WS_END = 250 * MiB;
static_assert(WS_A + (size_t)MT * FF * 2 <= WS_LG, "ffn hidden overlay");
static_assert(WS_PB + (size_t)MT * INP * 2 <= WS_QB && WS_QB + (size_t)MT * 768 * 2 <= WS_KVB && WS_KVB + (size_t)MT * 1024 * 2 <= WS_LG, "ws map");
static_assert(WS_LG + (size_t)MT * 256 * 4 <= WS_OB && WS_OB + (size_t)MT * 256 * 4 <= WS_END, "ws map 2");

constexpr int LDS_BYTES = 147456;

struct Args { const float* in[26]; float* out; unsigned char* ws; int ph_lo, ph_hi, grid, pad; };
enum { I_X = 0, I_C, I_CTX, I_CCTX, I_WMOD, I_BMOD, I_N1W, I_WIN, I_WOUT, I_SGNW, I_SGNB, I_SGW, I_SGB, I_GWF, I_GBF, I_GWB, I_GBB, I_GNW, I_QNW, I_WUQ, I_KVNW, I_WUKV, I_N2W, I_WFF1, I_WFF2, I_FNW };

typedef __attribute__((address_space(4))) const Args* KArgsPtr;
__device__ __forceinline__ const Args& get_args() { KArgsPtr p = (KArgsPtr)__builtin_amdgcn_kernarg_segment_ptr(); asm volatile("" : "+s"(p)); return *(const Args*)p; }
constexpr int LDS_CTL_OFF = LDS_BYTES - 512;
__device__ __forceinline__ int klane() { int l; asm volatile("v_mbcnt_lo_u32_b32 %0, -1, 0\n\tv_mbcnt_hi_u32_b32 %0, -1, %0" : "=v"(l)); return l; }
__device__ __forceinline__ int kwave() { const unsigned id = (unsigned)__builtin_amdgcn_s_getreg((5 << 11) | 4) & 63u;
    return __builtin_amdgcn_readfirstlane((int)((volatile LAS unsigned*)(uintptr_t)(LDS_CTL_OFF + 256))[id]); }
#define KTID (kwave() * 64 + klane())
#define KGRID (get_args().grid)
__device__ __forceinline__ float bf2f(bf16_t v) { return __uint_as_float(((unsigned)v) << 16); }
__device__ __forceinline__ unsigned f2bf(float f) { unsigned u = __float_as_uint(f); return (u + 0x7fffu + ((u >> 16) & 1u)) >> 16; }
__device__ __forceinline__ unsigned pk2(float lo, float hi) { return f2bf(lo) | (f2bf(hi) << 16); }
__device__ __forceinline__ float wave_sum(float v) {
#pragma unroll
    for (int o = 1; o < 64; o <<= 1) v += __shfl_xor(v, o);
    return v;
}
__device__ __forceinline__ float gelu_tanh(float x) { const float u = 1.5957691216057308f * (x + 0.044715f * x * x * x); return x / (1.f + __expf(-u)); }
__device__ __forceinline__ float silu_f(float x) { return x / (1.f + __expf(-x)); }
__device__ __forceinline__ float log_sigmoid_f(float z) { return fminf(z, 0.f) - log1pf(expf(-fabsf(z))); }
__device__ __forceinline__ void unpack8(u32x4 w, float* f) {
    f[0] = __uint_as_float(w.x << 16); f[1] = __uint_as_float(w.x & 0xffff0000u); f[2] = __uint_as_float(w.y << 16); f[3] = __uint_as_float(w.y & 0xffff0000u);
    f[4] = __uint_as_float(w.z << 16); f[5] = __uint_as_float(w.z & 0xffff0000u); f[6] = __uint_as_float(w.w << 16); f[7] = __uint_as_float(w.w & 0xffff0000u);
}

#define XB_TMO      128
#define XB_XCNT(j)  (256  + 64 * (j))
#define XB_XSUB(j)  (1280 + 64 * (j))
#define XB_XGEN(j)  (2304 + 64 * (j))
#define XB_TOP      3328
#define XB_TOPGEN   3392
#define XCD_BAR_WORDS 3456
#define XB_SPIN_CAP (1u << 22)
__device__ __forceinline__ unsigned xb_ld(unsigned* p)              { return __hip_atomic_load(p, __ATOMIC_RELAXED, __HIP_MEMORY_SCOPE_AGENT); }
__device__ __forceinline__ unsigned xb_add(unsigned* p, unsigned v) { return __hip_atomic_fetch_add(p, v, __ATOMIC_RELAXED, __HIP_MEMORY_SCOPE_AGENT); }
__device__ __forceinline__ unsigned xb_xcc_id() { return (unsigned)__builtin_amdgcn_s_getreg((3 << 11) | 20) & 0xFu; }
#define XB_SPIN(cond, bar) do { unsigned _sp = 0; while (cond) { __builtin_amdgcn_s_sleep(1); \
    if ((++_sp & 255u) == 0u) { if (xb_ld(&(bar)[XB_TMO])) break; if (_sp > XB_SPIN_CAP) { atomicAdd(&(bar)[XB_TMO], 1u); break; } } } } while (0)
struct XcdBarrier { unsigned* bar; unsigned x; volatile LAS unsigned* st; };
__device__ __forceinline__ XcdBarrier xcd_barrier_post(unsigned* bar, volatile LAS unsigned* st) {
    XcdBarrier b; b.bar = bar; b.x = xb_xcc_id(); b.st = st;
    if (KTID == 0) (void)xb_add(&bar[XB_XCNT(b.x)], 1u);
    return b;
}
__device__ __forceinline__ void xcd_barrier_complete(unsigned* bar, unsigned x, unsigned& nloc, unsigned& nx) {
    const unsigned G = (unsigned)KGRID;
    unsigned sum, cnt, mine, sp = 0u;
    for (;;) {
        sum = 0u; cnt = 0u; mine = 0u;
#pragma unroll
        for (unsigned j = 0; j < 16; ++j) { const unsigned c = xb_ld(&bar[XB_XCNT(j)]); sum += c; cnt += (c > 0u) ? 1u : 0u; mine = (j == x) ? c : mine; }
        if (sum == G) break;
        __builtin_amdgcn_s_sleep(1);
        if ((++sp & 255u) == 0u) { if (xb_ld(&bar[XB_TMO])) break; if (sp > XB_SPIN_CAP) { atomicAdd(&bar[XB_TMO], 1u); break; } }
    }
    nloc = mine > 0u ? mine : 1u; nx = cnt > 0u ? cnt : 1u;
}
__device__ __forceinline__ void xcd_barrier(const XcdBarrier& b) {
    asm volatile("s_waitcnt vmcnt(0)" ::: "memory");
    __syncthreads();
    if (KTID == 0) {
        unsigned* bar = b.bar;
        __builtin_amdgcn_s_waitcnt(0);
        unsigned nloc = b.st[0], nx = b.st[1];
        if (nloc == 0u) { xcd_barrier_complete(bar, b.x, nloc, nx); b.st[0] = nloc; b.st[1] = nx; }
        const unsigned old = xb_add(&bar[XB_XSUB(b.x)], 1u);
        const unsigned gen = old / nloc;
        if (old + 1u == (gen + 1u) * nloc) {
            __builtin_amdgcn_fence(__ATOMIC_RELEASE, "agent");
            asm volatile("s_waitcnt vmcnt(0)" ::: "memory");
            const unsigned og = xb_add(&bar[XB_TOP], 1u);
            const unsigned tg = og / nx;
            if (og + 1u == (tg + 1u) * nx) xb_add(&bar[XB_TOPGEN], 1u);
            else XB_SPIN(xb_ld(&bar[XB_TOPGEN]) == tg, bar);
            __builtin_amdgcn_fence(__ATOMIC_ACQUIRE, "agent");
            xb_add(&bar[XB_XGEN(b.x)], 1u);
            asm volatile("s_waitcnt vmcnt(0)" ::: "memory");
        } else {
            XB_SPIN(xb_ld(&bar[XB_XGEN(b.x)]) == gen, bar);
            __builtin_amdgcn_fence(__ATOMIC_ACQUIRE, "agent");
            asm volatile("s_waitcnt vmcnt(0)" ::: "memory");
        }
    }
    __syncthreads();
}

__device__ __forceinline__ int rope_unperm(int jj) { return (jj < 32) ? ((jj >> 1) + 16 * (jj & 1)) : (32 + ((jj - 32) >> 1) + 16 * (jj & 1)); }
__device__ __forceinline__ int map_in(int n) {
    if (n < 256) return 416 + n;
    if (n < 512) return 1632 + (n - 256);
    if (n < 768) return 736 + (n - 512);
    if (n < 1024) return 992 + (n - 768);
    if (n < 1280) return 128 + (n - 1024);
    if (n < 1536) return 1376 + (n - 1280);
    if (n < 1664) return n - 1536;
    if (n < 1792) return 1248 + (n - 1664);
    if (n < 1856) return 672 + rope_unperm(n - 1792);
    if (n < 1872) return 384 + (n - 1856);
    if (n < 1888) return 400 + (n - 1872);
    return -1;
}
__device__ __forceinline__ int map_uq(int n) { const int h = n / 192, j = n % 192; return (j < 128) ? n : (h * 192 + 128 + rope_unperm(j - 128)); }
template <int MODE> __device__ __forceinline__ void transpose_w(const float* W, int K, int Nsrc, bf16_t* Wt, int Npad, int gtid, int gthreads) {
    const int total = Npad * (K / 8);
    for (int idx = gtid; idx < total; idx += gthreads) {
        const int n = idx % Npad, kc = idx / Npad;
        const int src = (MODE == 0) ? n : (MODE == 1 ? map_in(n) : map_uq(n));
        float f[8];
#pragma unroll
        for (int i = 0; i < 8; ++i) f[i] = (src >= 0) ? W[(size_t)(kc * 8 + i) * Nsrc + src] : 0.f;
        u32x4 o; o.x = pk2(f[0], f[1]); o.y = pk2(f[2], f[3]); o.z = pk2(f[4], f[5]); o.w = pk2(f[6], f[7]);
        *(u32x4*)(Wt + (size_t)n * K + kc * 8) = o;
    }
}
__device__ __forceinline__ void phase_prep(const Args& a, LAS unsigned char* lds) {
    unsigned char* ws = a.ws;
    const int tid = KTID, gtid = blockIdx.x * NTHR + tid, gthreads = KGRID * NTHR;
    for (int l = 0; l < 2; ++l) {
        transpose_w<1>(a.in[I_WIN] + (size_t)l * DM * IN_COLS, DM, IN_COLS, (bf16_t*)(ws + WS_WIN) + (size_t)l * INP * DM, INP, gtid, gthreads);
        transpose_w<0>(a.in[I_WOUT] + (size_t)l * DM * DM, DM, DM, (bf16_t*)(ws + WS_WOUT) + (size_t)l * DM * DM, DM, gtid, gthreads);
        transpose_w<2>(a.in[I_WUQ] + (size_t)l * 256 * 768, 256, 768, (bf16_t*)(ws + WS_WUQ) + (size_t)l * 768 * 256, 768, gtid, gthreads);
        transpose_w<0>(a.in[I_WUKV] + (size_t)l * 256 * 1024, 256, 1024, (bf16_t*)(ws + WS_WUKV) + (size_t)l * 1024 * 256, 1024, gtid, gthreads);
        transpose_w<0>(a.in[I_WFF1] + (size_t)l * DM * FF, DM, FF, (bf16_t*)(ws + WS_WFF1) + (size_t)l * FF * DM, FF, gtid, gthreads);
        transpose_w<0>(a.in[I_WFF2] + (size_t)l * FF * DM, FF, DM, (bf16_t*)(ws + WS_WFF2) + (size_t)l * DM * FF, DM, gtid, gthreads);
    }
    if (gtid < 128 * 16) {
        const int p = gtid >> 4, i = gtid & 15;
        const float freq = powf(10000.0f, -(float)i * 2.0f / 32.0f);
        const float ang = (float)p * freq;
        float* R = (float*)(ws + WS_ROPE);
        R[gtid * 2 + 0] = (float)cos((double)ang); R[gtid * 2 + 1] = (float)sin((double)ang);
    }
    {
        LAS float* red = (LAS float*)lds;
        const int wave = tid >> 6, lane = tid & 63;
        for (int item = blockIdx.x; item < 2 * 96; item += KGRID) {
            const int l = item / 96, j = (item % 96) * 64 + lane;
            const float* W = a.in[I_WMOD] + (size_t)l * DM * 6144;
            float s0 = 0.f, s1 = 0.f, s2 = 0.f;
#pragma unroll 8
            for (int kk = 0; kk < 128; ++kk) {
                const int k = wave * 128 + kk;
                const float w = W[(size_t)k * 6144 + j];
                s0 += silu_f(a.in[I_C][k]) * w; s1 += silu_f(a.in[I_C][DM + k]) * w; s2 += silu_f(a.in[I_CCTX][k]) * w;
            }
            red[(wave * 3 + 0) * 64 + lane] = s0; red[(wave * 3 + 1) * 64 + lane] = s1; red[(wave * 3 + 2) * 64 + lane] = s2;
            __syncthreads();
            if (tid < 192) {
                const int r = tid >> 6; float s = 0.f;
#pragma unroll
                for (int w = 0; w < 8; ++w) s += red[(w * 3 + r) * 64 + lane];
                ((float*)(ws + WS_MOD))[(size_t)(l * 3 + r) * 6144 + j] = s + a.in[I_BMOD][l * 6144 + j];
            }
            __syncthreads();
        }
    }
}

__device__ __forceinline__ void phase_norm_mod(const float* xl, const float* xc, const float* nw, const float* mod, int sh_off, int sc_off, bf16_t* H) {
    const int lane = klane(), gw = blockIdx.x * NWAVES + kwave(), ngw = KGRID * NWAVES;
    for (int row = gw; row < MT; row += ngw) {
        const float* src = row < ML ? xl + (size_t)row * DM : xc + (size_t)(row - ML) * DM;
        const float* m = mod + (row < ML ? row / NL : 2) * 6144;
        f32x4 v[4]; float ss = 0.f;
#pragma unroll
        for (int j = 0; j < 4; ++j) { v[j] = *(const f32x4*)(src + lane * 4 + 256 * j); ss += v[j].x * v[j].x + v[j].y * v[j].y + v[j].z * v[j].z + v[j].w * v[j].w; }
        const float rstd = rsqrtf(wave_sum(ss) * (1.f / DM) + EPS);
#pragma unroll
        for (int j = 0; j < 4; ++j) {
            const int c = lane * 4 + 256 * j;
            const f32x4 w = *(const f32x4*)(nw + c), sc = *(const f32x4*)(m + sc_off + c), sh = *(const f32x4*)(m + sh_off + c);
            const f32x4 o = (v[j] * rstd * w) * (sc + 1.f) + sh;
            u32x2 pk; pk.x = pk2(o.x, o.y); pk.y = pk2(o.z, o.w);
            *(u32x2*)(H + (size_t)row * DM + c) = pk;
        }
    }
}

template <class Epi> __device__ __forceinline__ void gemm_naive(const bf16_t* A, int lda, const bf16_t* Bt, int M, int N, int K, const Epi& E, LAS unsigned char* lds) {
    LAS float* As = (LAS float*)lds;
    LAS float* Bs = As + 32 * 132;
    const int tid = KTID, ty = tid >> 4, tx = tid & 15;
    const int ntm = M / 128, ntn = N / 64, ntiles = ntm * ntn;
    for (int tile = blockIdx.x; tile < ntiles; tile += KGRID) {
        const int tm = tile / ntn, tn = tile % ntn, row0 = tm * 128, col0 = tn * 64;
        float acc[4][4];
#pragma unroll
        for (int i = 0; i < 4; ++i)
#pragma unroll
            for (int j = 0; j < 4; ++j) acc[i][j] = 0.f;
        for (int k0 = 0; k0 < K; k0 += 32) {
            {
                const int r = tid >> 2, kc = (tid & 3) * 8; float f[8];
                unpack8(*(const u32x4*)(A + (size_t)(row0 + r) * lda + k0 + kc), f);
#pragma unroll
                for (int i = 0; i < 8; ++i) As[(kc + i) * 132 + r] = f[i];
                if (tid < 256) {
                    unpack8(*(const u32x4*)(Bt + (size_t)(col0 + r) * K + k0 + kc), f);
#pragma unroll
                    for (int i = 0; i < 8; ++i) Bs[(kc + i) * 68 + r] = f[i];
                }
            }
            __syncthreads();
#pragma unroll 8
            for (int k = 0; k < 32; ++k) {
                const f32x4 av = *(const LAS f32x4*)(As + k * 132 + ty * 4), bv = *(const LAS f32x4*)(Bs + k * 68 + tx * 4);
#pragma unroll
                for (int i = 0; i < 4; ++i)
#pragma unroll
                    for (int j = 0; j < 4; ++j) acc[i][j] += av[i] * bv[j];
            }
            __syncthreads();
        }
#pragma unroll
        for (int i = 0; i < 4; ++i) E(row0 + ty * 4 + i, col0 + tx * 4, (f32x4){acc[i][0], acc[i][1], acc[i][2], acc[i][3]});
    }
}

__device__ __forceinline__ void st4bf(bf16_t* p, f32x4 v) { u32x2 pk; pk.x = pk2(v.x, v.y); pk.y = pk2(v.z, v.w); *(u32x2*)p = pk; }
__device__ __forceinline__ f32x4 rope4(f32x4 v, int jj, int t, const float* R) {
    const int pos = (jj < 32) ? (t >> 6) : (t & 63), i0 = ((jj & 31) >> 1);
    const f32x4 cs = *(const f32x4*)(R + (pos * 16 + i0) * 2);
    return (f32x4){v.x * cs.x - v.y * cs.y, v.x * cs.y + v.y * cs.x, v.z * cs.z - v.w * cs.w, v.z * cs.w + v.w * cs.z};
}
struct EpiInProj { bf16_t* PB; const float* R;
    __device__ __forceinline__ void operator()(int row, int col, f32x4 v) const {
        const int tile = col >> 8;
        if (tile == 2 || tile == 3) { v = (f32x4){gelu_tanh(v.x), gelu_tanh(v.y), gelu_tanh(v.z), gelu_tanh(v.w)}; }
        else if (tile == 5) { v = (f32x4){silu_f(v.x), silu_f(v.y), silu_f(v.z), silu_f(v.w)}; }
        else if (tile == 7) { const int cc = col - C_KR; if (cc < 64 && row < ML) v = rope4(v, cc, row & (NL - 1), R); }
        st4bf(PB + (size_t)row * INP + col, v);
    } };
struct EpiUQ { bf16_t* QB;
    __device__ __forceinline__ void operator()(int row, int col, f32x4 v) const { st4bf(QB + (size_t)row * 768 + col, v * QSCALE); } };
struct EpiUKV { bf16_t* KVB;
    __device__ __forceinline__ void operator()(int row, int col, f32x4 v) const { st4bf(KVB + (size_t)row * 1024 + col, v); } };
struct EpiResid { const float* xin_l; const float* xin_c; float* xout_l; float* xout_c; const float* mod; int g_off;
    __device__ __forceinline__ void operator()(int row, int col, f32x4 v) const {
        if (row < ML) { const f32x4 g = *(const f32x4*)(mod + (row >> 13) * 6144 + g_off + col), xi = *(const f32x4*)(xin_l + (size_t)row * DM + col);
            *(f32x4*)(xout_l + (size_t)row * DM + col) = xi + g * v;
        } else { const int rc = row - ML; const f32x4 g = *(const f32x4*)(mod + 2 * 6144 + g_off + col), xi = *(const f32x4*)(xin_c + (size_t)rc * DM + col);
            *(f32x4*)(xout_c + (size_t)rc * DM + col) = xi + g * v; }
    } };
struct EpiFF1 { bf16_t* Ah;
    __device__ __forceinline__ void operator()(int row, int col, f32x4 v) const {
        f32x4 r = (f32x4){fmaxf(v.x, 0.f), fmaxf(v.y, 0.f), fmaxf(v.z, 0.f), fmaxf(v.w, 0.f)};
        st4bf(Ah + (size_t)row * FF + col, r * r);
    } };

__device__ __forceinline__ void phase_post(const Args& a, int l) {
    unsigned char* ws = a.ws;
    bf16_t* PB = (bf16_t*)(ws + WS_PB); float* LG = (float*)(ws + WS_LG);
    const float* kvnw = a.in[I_KVNW] + l * 256; const float* qnw = a.in[I_QNW] + l * 256;
    const float* snw = a.in[I_SGNW] + l * 256; const float* snb = a.in[I_SGNB] + l * 256;
    const float* wgf = a.in[I_GWF] + l * 16 * 128; const float* bgf = a.in[I_GBF] + l * 128;
    const float* wgb = a.in[I_GWB] + l * 16 * 128; const float* bgb = a.in[I_GBB] + l * 128;
    const int lane = klane(), gw = blockIdx.x * NWAVES + kwave(), ngw = KGRID * NWAVES;
    for (int row = gw; row < MT; row += ngw) {
        bf16_t* pr = PB + (size_t)row * INP;
        const int c = lane * 4;
        { u32x2 w = *(const u32x2*)(pr + C_CKV + c); f32x4 v = {__uint_as_float(w.x << 16), __uint_as_float(w.x & 0xffff0000u), __uint_as_float(w.y << 16), __uint_as_float(w.y & 0xffff0000u)};
          const float rstd = rsqrtf(wave_sum(v.x * v.x + v.y * v.y + v.z * v.z + v.w * v.w) * (1.f / 256.f) + EPS);
          st4bf(pr + C_CKV + c, v * rstd * *(const f32x4*)(kvnw + c)); }
        { u32x2 w = *(const u32x2*)(pr + C_DQ + c); f32x4 v = {__uint_as_float(w.x << 16), __uint_as_float(w.x & 0xffff0000u), __uint_as_float(w.y << 16), __uint_as_float(w.y & 0xffff0000u)};
          const float rstd = rsqrtf(wave_sum(v.x * v.x + v.y * v.y + v.z * v.z + v.w * v.w) * (1.f / 256.f) + EPS);
          st4bf(pr + C_DQ + c, v * rstd * *(const f32x4*)(qnw + c)); }
        { u32x2 w = *(const u32x2*)(pr + C_SV + c); f32x4 v = {__uint_as_float(w.x << 16), __uint_as_float(w.x & 0xffff0000u), __uint_as_float(w.y << 16), __uint_as_float(w.y & 0xffff0000u)};
          const float mu = wave_sum(v.x + v.y + v.z + v.w) * (1.f / 256.f);
          v = v - mu;
          const float rstd = rsqrtf(wave_sum(v.x * v.x + v.y * v.y + v.z * v.z + v.w * v.w) * (1.f / 256.f) + EPS);
          st4bf(pr + C_SV + c, v * rstd * *(const f32x4*)(snw + c) + *(const f32x4*)(snb + c)); }
        if (GLA_NAIVE) { const int o = lane * 4, isb = o >> 7, d = o & 127;
          const float* wg = isb ? wgb : wgf; const float* bg = isb ? bgb : bgf; const bf16_t* gg = pr + (isb ? C_GGB : C_GGF);
          f32x4 z = *(const f32x4*)(bg + d);
#pragma unroll
          for (int r = 0; r < 16; ++r) z += *(const f32x4*)(wg + r * 128 + d) * bf2f(gg[r]);
          *(f32x4*)(LG + (size_t)row * 256 + o) = (f32x4){log_sigmoid_f(z.x), log_sigmoid_f(z.y), log_sigmoid_f(z.z), log_sigmoid_f(z.w)} * (1.f / 16.f); }
    }
}

__device__ __forceinline__ void phase_sgu_naive(const Args& a, int l) {
    unsigned char* ws = a.ws;
    const bf16_t* PB = (const bf16_t*)(ws + WS_PB); bf16_t* Y = (bf16_t*)(ws + WS_HY);
    const float* Ws = a.in[I_SGW] + (size_t)l * 4 * 128 * 128; const float* bs = a.in[I_SGB] + l * 4 * 128;
    const int tid = KTID, i = tid >> 2, eg = (tid & 3) * 16;
    for (int unit = blockIdx.x; unit < (MT / 128) * 4; unit += KGRID) {
        const int cc = unit >> 2, h = unit & 3;
        float acc[16];
#pragma unroll
        for (int e = 0; e < 16; ++e) acc[e] = 0.f;
        const float* wrow = Ws + ((size_t)h * 128 + i) * 128;
        for (int j = 0; j < 128; ++j) {
            const float w = wrow[j];
            const bf16_t* vp = PB + (size_t)(cc * 128 + j) * INP + C_SV + h * 64 + eg;
            float f[8], g[8]; unpack8(*(const u32x4*)vp, f); unpack8(*(const u32x4*)(vp + 8), g);
#pragma unroll
            for (int e = 0; e < 8; ++e) { acc[e] += w * f[e]; acc[8 + e] += w * g[e]; }
        }
        const float bias = bs[h * 128 + i];
        const int row = cc * 128 + i;
        const bf16_t* up = PB + (size_t)row * INP + C_SU + h * 64 + eg;
        float f[8], g[8]; unpack8(*(const u32x4*)up, f); unpack8(*(const u32x4*)(up + 8), g);
        bf16_t* yp = Y + (size_t)row * DM + h * 64 + eg;
        u32x4 o0, o1;
        o0.x = pk2(f[0] * (acc[0] + bias), f[1] * (acc[1] + bias)); o0.y = pk2(f[2] * (acc[2] + bias), f[3] * (acc[3] + bias));
        o0.z = pk2(f[4] * (acc[4] + bias), f[5] * (acc[5] + bias)); o0.w = pk2(f[6] * (acc[6] + bias), f[7] * (acc[7] + bias));
        o1.x = pk2(g[0] * (acc[8] + bias), g[1] * (acc[9] + bias)); o1.y = pk2(g[2] * (acc[10] + bias), g[3] * (acc[11] + bias));
        o1.z = pk2(g[4] * (acc[12] + bias), g[5] * (acc[13] + bias)); o1.w = pk2(g[6] * (acc[14] + bias), g[7] * (acc[15] + bias));
        *(u32x4*)yp = o0; *(u32x4*)(yp + 8) = o1;
    }
}

__device__ __forceinline__ void phase_gla_naive(const Args& a, int l) {
    unsigned char* ws = a.ws;
    const bf16_t* PB = (const bf16_t*)(ws + WS_PB); bf16_t* Y = (bf16_t*)(ws + WS_HY);
    const float* LG = (const float*)(ws + WS_LG); float* OB = (float*)(ws + WS_OB);
    const float* gnw = a.in[I_GNW] + l * 64;
    if (blockIdx.x >= 8 || KTID >= 64) return;
    const int b = blockIdx.x >> 2, h = blockIdx.x & 3, e = KTID;
    const float gw_e = gnw[e];
    for (int dir = 1; dir >= 0; --dir) {
        float S[32];
#pragma unroll
        for (int d = 0; d < 32; ++d) S[d] = 0.f;
        for (int tau = 0; tau < NKEY; ++tau) {
            int row;
            if (dir == 0) row = tau < NC ? ML + b * NC + tau : b * NL + (tau - NC);
            else row = tau < NC ? ML + b * NC + (NC - 1 - tau) : b * NL + (NL - 1 - (tau - NC));
            const bf16_t* pr = PB + (size_t)row * INP;
            const float* lg = LG + (size_t)row * 256 + dir * 128 + h * 32;
            const float v = bf2f(pr[C_GV + h * 64 + e]);
            float o = 0.f;
#pragma unroll
            for (int d = 0; d < 32; ++d) {
                const float kk = bf2f(pr[C_GK + h * 32 + d]), qq = bf2f(pr[C_GQ + h * 32 + d]), al = expf(lg[d]);
                S[d] = al * S[d] + kk * v; o += qq * S[d];
            }
            o *= 0.17677669529663687f;
            if (dir == 1) OB[(size_t)row * 256 + h * 64 + e] = o;
            else {
                o += OB[(size_t)row * 256 + h * 64 + e];
                const float ms = wave_sum(o * o) * (1.f / 64.f);
                const float y = o * rsqrtf(ms + EPS) * gw_e * bf2f(pr[C_GR + h * 64 + e]);
                Y[(size_t)row * DM + 256 + h * 64 + e] = (bf16_t)f2bf(y);
            }
        }
    }
}

typedef short bf16x8 __attribute__((ext_vector_type(8)));
typedef float f32x16 __attribute__((ext_vector_type(16)));
typedef float f32x2_t __attribute__((ext_vector_type(2)));
typedef __bf16 bf16x2_t __attribute__((ext_vector_type(2)));
__device__ __forceinline__ unsigned cvtpk(float lo, float hi) { f32x2_t v = {lo, hi}; bf16x2_t b = __builtin_convertvector(v, bf16x2_t); return __builtin_bit_cast(unsigned, b); }
__device__ __forceinline__ int crow(int r, int hi) { return (r & 3) + 8 * (r >> 2) + 4 * hi; }
constexpr int GLA_WLDS = 17920, GLA_NB = 132;
constexpr size_t WS_BC = WS_LG, WS_GL = WS_OB, WS_GD = 1 * MiB + 512 * 1024;
static_assert((size_t)2112 * 2048 * 4 <= WS_END - WS_OB && (size_t)2112 * 32 * 4 <= 512 * 1024, "gla ws");
__device__ __forceinline__ int gla_row0(int b, int beta) { return beta < 4 ? ML + b * NC + beta * 64 : b * NL + (beta - 4) * 64; }
#define LDS_FENCE() do { asm volatile("s_waitcnt lgkmcnt(0)" ::: "memory"); __builtin_amdgcn_sched_barrier(0); } while (0)
__device__ __forceinline__ void gla_stage_vt(const bf16_t* pv, LAS bf16_t* VT, int lane) {
#pragma unroll
    for (int c8 = 0; c8 < 8; ++c8) { const u32x4 w = *(const u32x4*)(pv + c8 * 8);
        VT[(c8 * 8 + 0) * 64 + lane] = (bf16_t)(w.x & 0xffffu); VT[(c8 * 8 + 1) * 64 + lane] = (bf16_t)(w.x >> 16);
        VT[(c8 * 8 + 2) * 64 + lane] = (bf16_t)(w.y & 0xffffu); VT[(c8 * 8 + 3) * 64 + lane] = (bf16_t)(w.y >> 16);
        VT[(c8 * 8 + 4) * 64 + lane] = (bf16_t)(w.z & 0xffffu); VT[(c8 * 8 + 5) * 64 + lane] = (bf16_t)(w.z >> 16);
        VT[(c8 * 8 + 6) * 64 + lane] = (bf16_t)(w.w & 0xffffu); VT[(c8 * 8 + 7) * 64 + lane] = (bf16_t)(w.w >> 16); }
}
__device__ __forceinline__ void load32bf(const bf16_t* p, float* f) {
    unpack8(*(const u32x4*)(p), f); unpack8(*(const u32x4*)(p + 8), f + 8); unpack8(*(const u32x4*)(p + 16), f + 16); unpack8(*(const u32x4*)(p + 24), f + 24);
}
__device__ __forceinline__ void phase_gla_local(const Args& a, int l, LAS unsigned char* lds) {
    unsigned char* ws = a.ws;
    const bf16_t* PB = (const bf16_t*)(ws + WS_PB); float* BC = (float*)(ws + WS_BC); float* GL = (float*)(ws + WS_GL); float* GD = (float*)(ws + WS_GD);
    const int lane = klane(), wave = kwave(), gw = blockIdx.x * NWAVES + wave, ngw = KGRID * NWAVES;
    const int r32 = lane & 31, hi = lane >> 5;
    LAS bf16_t* KT = (LAS bf16_t*)(lds + wave * GLA_WLDS); LAS bf16_t* VT = KT + 32 * 64;
    for (int task = gw; task < 16 * GLA_NB; task += ngw) {
        const int beta = task % GLA_NB, t2 = task / GLA_NB, dir = t2 & 1, h = (t2 >> 1) & 3, b = t2 >> 3;
        const int row = gla_row0(b, beta) + lane; const bf16_t* pr = PB + (size_t)row * INP;
        LDS_FENCE();
        gla_stage_vt(pr + C_GV + h * 64, VT, lane);
        float c[32];
        {
          const float* wg = (dir ? a.in[I_GWB] : a.in[I_GWF]) + l * 16 * 128 + h * 32; const float* bg = (dir ? a.in[I_GBB] : a.in[I_GBF]) + l * 128 + h * 32;
          LAS float* WGL = (LAS float*)(VT + 64 * 64); LAS float* BGL = WGL + 16 * 32;
          { const int r = lane >> 2, d0 = (lane & 3) * 8;
            *(LAS f32x4*)(WGL + r * 32 + d0) = *(const f32x4*)(wg + r * 128 + d0); *(LAS f32x4*)(WGL + r * 32 + d0 + 4) = *(const f32x4*)(wg + r * 128 + d0 + 4);
            if (lane < 32) BGL[lane] = bg[lane]; }
          float gg[16]; unpack8(*(const u32x4*)(pr + (dir ? C_GGB : C_GGF)), gg); unpack8(*(const u32x4*)(pr + (dir ? C_GGB : C_GGF) + 8), gg + 8);
          LDS_FENCE();
#pragma unroll
          for (int d = 0; d < 32; d += 4) { f32x4 z = *(const LAS f32x4*)(BGL + d);
#pragma unroll
              for (int r = 0; r < 16; ++r) z += *(const LAS f32x4*)(WGL + r * 32 + d) * gg[r];
              c[d] = log_sigmoid_f(z.x) * (1.f / 16.f); c[d + 1] = log_sigmoid_f(z.y) * (1.f / 16.f); c[d + 2] = log_sigmoid_f(z.z) * (1.f / 16.f); c[d + 3] = log_sigmoid_f(z.w) * (1.f / 16.f); } }
        if (dir == 0) {
#pragma unroll
            for (int d = 0; d < 32; ++d) { float v = c[d];
#pragma unroll
                for (int off = 1; off < 64; off <<= 1) { const float t = __shfl_up(v, off); if (lane >= off) v += t; }
                c[d] = v; }
        } else {
#pragma unroll
            for (int d = 0; d < 32; ++d) { float v = c[d];
#pragma unroll
                for (int off = 1; off < 64; off <<= 1) { const float t = __shfl_down(v, off); if (lane + off < 64) v += t; }
                c[d] = v; }
        }
        { float* bc = BC + (size_t)row * 256 + dir * 128 + h * 32;
#pragma unroll
          for (int d = 0; d < 32; d += 4) *(f32x4*)(bc + d) = (f32x4){c[d], c[d + 1], c[d + 2], c[d + 3]}; }
        float kk[32]; load32bf(pr + C_GK + h * 32, kk);
        const int tl = dir ? 0 : 63;
#pragma unroll
        for (int d = 0; d < 32; ++d) { const float T = __shfl(c[d], tl);
            KT[d * 64 + lane] = (bf16_t)(cvtpk(kk[d] * __expf(T - c[d]), 0.f) & 0xffffu);
            if (lane == 0) GD[(size_t)task * 32 + d] = __expf(T); }
        LDS_FENCE();
        f32x16 acc0 = {}, acc1 = {};
#pragma unroll
        for (int s = 0; s < 4; ++s) {
            const bf16x8 af = *(const LAS bf16x8*)(KT + r32 * 64 + 16 * s + 8 * hi);
            const bf16x8 b0 = *(const LAS bf16x8*)(VT + r32 * 64 + 16 * s + 8 * hi), b1 = *(const LAS bf16x8*)(VT + (32 + r32) * 64 + 16 * s + 8 * hi);
            acc0 = __builtin_amdgcn_mfma_f32_32x32x16_bf16(af, b0, acc0, 0, 0, 0); acc1 = __builtin_amdgcn_mfma_f32_32x32x16_bf16(af, b1, acc1, 0, 0, 0);
        }
        float* gl = GL + (size_t)task * 2048;
#pragma unroll
        for (int r = 0; r < 16; ++r) { gl[crow(r, hi) * 64 + r32] = acc0[r]; gl[crow(r, hi) * 64 + 32 + r32] = acc1[r]; }
    }
}
__device__ __forceinline__ void phase_gla_scan(const Args& a) {
    unsigned char* ws = a.ws; float* GL = (float*)(ws + WS_GL); const float* GD = (const float*)(ws + WS_GD);
    const int idx = blockIdx.x * NTHR + KTID;
    if (idx >= 16 * 2048) return;
    const int seq = idx >> 11, de = idx & 2047, d = de >> 6, dir = seq & 1;
    float S = 0.f;
    for (int c0 = 0; c0 < GLA_NB; c0 += 12) {
        float Lv[12], Dv[12];
#pragma unroll
        for (int u = 0; u < 12; ++u) { const int c = c0 + u, beta = dir ? (c < 4 ? 3 - c : 135 - c) : c; const size_t slot = (size_t)seq * GLA_NB + beta;
            Lv[u] = GL[slot * 2048 + de]; Dv[u] = GD[slot * 32 + d]; }
#pragma unroll
        for (int u = 0; u < 12; ++u) { const int c = c0 + u, beta = dir ? (c < 4 ? 3 - c : 135 - c) : c; const size_t slot = (size_t)seq * GLA_NB + beta;
            GL[slot * 2048 + de] = S; S = Dv[u] * S + Lv[u]; }
    }
}
template <int DIR> __device__ __forceinline__ void gla_dir(const bf16_t* pr, const float* bc, const float* sin, int h, LAS bf16_t* QS, LAS bf16_t* KS, const LAS bf16_t* VT, int lane,
                                                            f32x16& o00, f32x16& o01, f32x16& o10, f32x16& o11) {
    const int r32 = lane & 31, hi = lane >> 5;
    {
        float c[32], q[32], k[32];
#pragma unroll
        for (int d = 0; d < 32; d += 4) { const f32x4 v = *(const f32x4*)(bc + d); c[d] = v.x; c[d + 1] = v.y; c[d + 2] = v.z; c[d + 3] = v.w; }
        load32bf(pr + C_GQ + h * 32, q); load32bf(pr + C_GK + h * 32, k);
#pragma unroll
        for (int d = 0; d < 32; d += 8) {
            u32x4 wq, wk; float eq[8], ek[8];
#pragma unroll
            for (int i = 0; i < 8; ++i) { eq[i] = q[d + i] * __expf(c[d + i]) * 0.17677669529663687f; ek[i] = k[d + i] * __expf(-c[d + i]); }
            wq.x = cvtpk(eq[0], eq[1]); wq.y = cvtpk(eq[2], eq[3]); wq.z = cvtpk(eq[4], eq[5]); wq.w = cvtpk(eq[6], eq[7]);
            wk.x = cvtpk(ek[0], ek[1]); wk.y = cvtpk(ek[2], ek[3]); wk.z = cvtpk(ek[4], ek[5]); wk.w = cvtpk(ek[6], ek[7]);
            *(LAS u32x4*)(QS + lane * 32 + d) = wq; *(LAS u32x4*)(KS + lane * 32 + d) = wk;
        }
    }
    LDS_FENCE();
    bf16x8 qf[2][2], kf[2][2];
#pragma unroll
    for (int t = 0; t < 2; ++t)
#pragma unroll
        for (int s = 0; s < 2; ++s) { qf[t][s] = *(const LAS bf16x8*)(QS + (32 * t + r32) * 32 + 16 * s + 8 * hi); kf[t][s] = *(const LAS bf16x8*)(KS + (32 * t + r32) * 32 + 16 * s + 8 * hi); }
    LDS_FENCE();
    {
        u32x4 w[4];
#pragma unroll
        for (int d = 0; d < 32; d += 8) {
            float sv[8];
#pragma unroll
            for (int i = 0; i < 8; ++i) sv[i] = sin[(d + i) * 64 + lane];
            w[d >> 3].x = cvtpk(sv[0], sv[1]); w[d >> 3].y = cvtpk(sv[2], sv[3]); w[d >> 3].z = cvtpk(sv[4], sv[5]); w[d >> 3].w = cvtpk(sv[6], sv[7]);
        }
#pragma unroll
        for (int i = 0; i < 4; ++i) *(LAS u32x4*)(QS + lane * 32 + 8 * i) = w[i];
    }
#define GLA_X(tj, ti) __builtin_amdgcn_mfma_f32_32x32x16_bf16(kf[tj][1], qf[ti][1], __builtin_amdgcn_mfma_f32_32x32x16_bf16(kf[tj][0], qf[ti][0], (f32x16){}, 0, 0, 0), 0, 0, 0)
#define GLA_MASK(X) do { _Pragma("unroll") for (int r = 0; r < 16; ++r) { const int jl = crow(r, hi); const bool keep = DIR == 0 ? (jl <= r32) : (jl >= r32); X[r] = keep ? X[r] : 0.f; } } while (0)
#define GLA_XA(X, s) __builtin_bit_cast(bf16x8, (u32x4){cvtpk(X[8 * (s) + 0], X[8 * (s) + 1]), cvtpk(X[8 * (s) + 2], X[8 * (s) + 3]), cvtpk(X[8 * (s) + 4], X[8 * (s) + 5]), cvtpk(X[8 * (s) + 6], X[8 * (s) + 7])})
#define GLA_VF(tj, s, te) __builtin_bit_cast(bf16x8, (u32x4){((const LAS u32x2*)(VT + (32 * (te) + r32) * 64 + 32 * (tj) + 16 * (s) + 4 * hi))->x, ((const LAS u32x2*)(VT + (32 * (te) + r32) * 64 + 32 * (tj) + 16 * (s) + 4 * hi))->y, \
                                                              ((const LAS u32x2*)(VT + (32 * (te) + r32) * 64 + 32 * (tj) + 16 * (s) + 8 + 4 * hi))->x, ((const LAS u32x2*)(VT + (32 * (te) + r32) * 64 + 32 * (tj) + 16 * (s) + 8 + 4 * hi))->y})
#define GLA_PV(X, tj, O0, O1) do { _Pragma("unroll") for (int s = 0; s < 2; ++s) { const bf16x8 xa = GLA_XA(X, s); \
        O0 = __builtin_amdgcn_mfma_f32_32x32x16_bf16(xa, GLA_VF(tj, s, 0), O0, 0, 0, 0); O1 = __builtin_amdgcn_mfma_f32_32x32x16_bf16(xa, GLA_VF(tj, s, 1), O1, 0, 0, 0); } } while (0)
    __builtin_amdgcn_sched_barrier(0);
    { f32x16 X = GLA_X(0, 0); GLA_MASK(X); GLA_PV(X, 0, o00, o01); }
    __builtin_amdgcn_sched_barrier(0);
    { f32x16 X = GLA_X(1, 1); GLA_MASK(X); GLA_PV(X, 1, o10, o11); }
    __builtin_amdgcn_sched_barrier(0);
    if (DIR == 0) { f32x16 X = GLA_X(0, 1); GLA_PV(X, 0, o10, o11); }
    else          { f32x16 X = GLA_X(1, 0); GLA_PV(X, 1, o00, o01); }
    LDS_FENCE();
#pragma unroll
    for (int s = 0; s < 2; ++s) {
        const bf16x8 s0 = *(const LAS bf16x8*)(QS + r32 * 32 + 16 * s + 8 * hi), s1 = *(const LAS bf16x8*)(QS + (32 + r32) * 32 + 16 * s + 8 * hi);
        o00 = __builtin_amdgcn_mfma_f32_32x32x16_bf16(qf[0][s], s0, o00, 0, 0, 0); o01 = __builtin_amdgcn_mfma_f32_32x32x16_bf16(qf[0][s], s1, o01, 0, 0, 0);
        o10 = __builtin_amdgcn_mfma_f32_32x32x16_bf16(qf[1][s], s0, o10, 0, 0, 0); o11 = __builtin_amdgcn_mfma_f32_32x32x16_bf16(qf[1][s], s1, o11, 0, 0, 0);
    }
    LDS_FENCE();
#undef GLA_X
#undef GLA_MASK
#undef GLA_XA
#undef GLA_VF
#undef GLA_PV
}
__device__ __forceinline__ void phase_gla_out(const Args& a, int l, LAS unsigned char* lds) {
    unsigned char* ws = a.ws;
    const bf16_t* PB = (const bf16_t*)(ws + WS_PB); const float* BC = (const float*)(ws + WS_BC); const float* GL = (const float*)(ws + WS_GL); bf16_t* Y = (bf16_t*)(ws + WS_HY);
    const float* gnw = a.in[I_GNW] + l * 64;
    const int lane = klane(), wave = kwave(), gw = blockIdx.x * NWAVES + wave, ngw = KGRID * NWAVES;
    const int r32 = lane & 31, hi = lane >> 5;
    LAS bf16_t* QS = (LAS bf16_t*)(lds + wave * GLA_WLDS); LAS bf16_t* KS = QS + 64 * 32; LAS bf16_t* VT = KS + 64 * 32; LAS float* OS = (LAS float*)(lds + wave * GLA_WLDS);
    for (int task = gw; task < 8 * GLA_NB; task += ngw) {
        const int beta = task % GLA_NB, bh = task / GLA_NB, h = bh & 3, b = bh >> 2;
        const int row = gla_row0(b, beta) + lane; const bf16_t* pr = PB + (size_t)row * INP;
        LDS_FENCE();
        gla_stage_vt(pr + C_GV + h * 64, VT, lane);
        f32x16 o00 = {}, o01 = {}, o10 = {}, o11 = {};
        gla_dir<0>(pr, BC + (size_t)row * 256 + h * 32, GL + ((size_t)(bh * 2 + 0) * GLA_NB + beta) * 2048, h, QS, KS, VT, lane, o00, o01, o10, o11);
        gla_dir<1>(pr, BC + (size_t)row * 256 + 128 + h * 32, GL + ((size_t)(bh * 2 + 1) * GLA_NB + beta) * 2048, h, QS, KS, VT, lane, o00, o01, o10, o11);
#pragma unroll
        for (int r = 0; r < 16; ++r) { const int i = crow(r, hi);
            OS[i * 65 + r32] = o00[r]; OS[i * 65 + 32 + r32] = o01[r]; OS[(32 + i) * 65 + r32] = o10[r]; OS[(32 + i) * 65 + 32 + r32] = o11[r]; }
        LDS_FENCE();
        float ss = 0.f;
#pragma unroll
        for (int e = 0; e < 64; ++e) { const float v = OS[lane * 65 + e]; ss += v * v; }
        const float rstd = rsqrtf(ss * (1.f / 64.f) + EPS);
        bf16_t* yp = Y + (size_t)row * DM + 256 + h * 64;
#pragma unroll
        for (int c8 = 0; c8 < 8; ++c8) { float rr[8]; unpack8(*(const u32x4*)(pr + C_GR + h * 64 + c8 * 8), rr);
            float y[8];
#pragma unroll
            for (int i = 0; i < 8; ++i) y[i] = OS[lane * 65 + c8 * 8 + i] * rstd * gnw[c8 * 8 + i] * rr[i];
            u32x4 w; w.x = cvtpk(y[0], y[1]); w.y = cvtpk(y[2], y[3]); w.z = cvtpk(y[4], y[5]); w.w = cvtpk(y[6], y[7]);
            *(u32x4*)(yp + c8 * 8) = w; }
    }
}

__device__ __forceinline__ void phase_attn_naive(const Args& a, int l, LAS unsigned char* lds) {
    unsigned char* ws = a.ws;
    const bf16_t* QB = (const bf16_t*)(ws + WS_QB); const bf16_t* KVB = (const bf16_t*)(ws + WS_KVB); const bf16_t* PB = (const bf16_t*)(ws + WS_PB); bf16_t* Y = (bf16_t*)(ws + WS_HY);
    const float* ROPE = (const float*)(ws + WS_ROPE);
    LAS float* Qs = (LAS float*)lds;
    LAS float* Ks = Qs + 192 * 64;
    LAS float* Vs = Ks + 96 * 64;
    LAS float* Ps = Vs + 64 * 128;
    const int tid = KTID, ty = tid >> 4, tx = tid & 15;
    const int nunits = 1024 + (l == 0 ? 32 : 0);
    for (int unit = blockIdx.x; unit < nunits; unit += KGRID) {
        int bh, nkeys, orow0;
        if (unit < 1024) { bh = unit >> 7; const int qb = unit & 127; nkeys = NKEY; orow0 = (bh >> 2) * NL + qb * 64; }
        else { const int u = unit - 1024; bh = u >> 2; const int qb = u & 3; nkeys = NC; orow0 = ML + (bh >> 2) * NC + qb * 64; }
        const int h = bh & 3, b = bh >> 2;
        const bf16_t* Qp = QB + (size_t)orow0 * 768 + h * 192;
        __syncthreads();
        for (int idx = tid; idx < 64 * 24; idx += NTHR) { const int r = idx / 24, ch = idx % 24; float f[8]; unpack8(*(const u32x4*)(Qp + (size_t)r * 768 + ch * 8), f);
            if (ch >= 16 && unit < 1024) { const int t = (orow0 + r) & (NL - 1), jj = (ch - 16) * 8;
                const f32x4 r0 = rope4((f32x4){f[0], f[1], f[2], f[3]}, jj, t, ROPE), r1 = rope4((f32x4){f[4], f[5], f[6], f[7]}, jj + 4, t, ROPE);
                f[0] = r0.x; f[1] = r0.y; f[2] = r0.z; f[3] = r0.w; f[4] = r1.x; f[5] = r1.y; f[6] = r1.z; f[7] = r1.w; }
#pragma unroll
            for (int i = 0; i < 8; ++i) Qs[(ch * 8 + i) * 64 + r] = f[i]; }
        float m[2] = {-1e30f, -1e30f}, lsum[2] = {0.f, 0.f}, o[2][8];
#pragma unroll
        for (int r = 0; r < 2; ++r)
#pragma unroll
            for (int c = 0; c < 8; ++c) o[r][c] = 0.f;
        for (int k0 = 0; k0 < nkeys; k0 += 64) {
            const int krow0 = k0 < NC ? ML + b * NC + k0 : b * NL + (k0 - NC);
            float s[2][4];
#pragma unroll
            for (int r = 0; r < 2; ++r)
#pragma unroll
                for (int j = 0; j < 4; ++j) s[r][j] = 0.f;
            for (int dh = 0; dh < 2; ++dh) {
                __syncthreads();
                for (int idx = tid; idx < 64 * 12; idx += NTHR) { const int key = idx / 12, ch = idx % 12; float f[8];
                    const int dcol = dh * 96 + ch * 8;
                    unpack8(dcol < 128 ? *(const u32x4*)(KVB + (size_t)(krow0 + key) * 1024 + h * 256 + dcol) : *(const u32x4*)(PB + (size_t)(krow0 + key) * INP + C_KR + (dcol - 128)), f);
#pragma unroll
                    for (int i = 0; i < 8; ++i) Ks[(ch * 8 + i) * 64 + key] = f[i]; }
                if (dh == 0) {
                    for (int idx = tid; idx < 64 * 16; idx += NTHR) { const int key = idx >> 4, ch = idx & 15; float f[8];
                        unpack8(*(const u32x4*)(KVB + (size_t)(krow0 + key) * 1024 + h * 256 + 128 + ch * 8), f);
#pragma unroll
                        for (int i = 0; i < 8; ++i) Vs[key * 128 + ch * 8 + i] = f[i]; }
                }
                __syncthreads();
#pragma unroll 4
                for (int d = 0; d < 96; ++d) {
                    const float q0 = Qs[(dh * 96 + d) * 64 + 2 * ty], q1 = Qs[(dh * 96 + d) * 64 + 2 * ty + 1];
                    const f32x4 kv = *(const LAS f32x4*)(Ks + d * 64 + 4 * tx);
#pragma unroll
                    for (int j = 0; j < 4; ++j) { s[0][j] += q0 * kv[j]; s[1][j] += q1 * kv[j]; }
                }
            }
#pragma unroll
            for (int r = 0; r < 2; ++r) {
                float mx = fmaxf(fmaxf(s[r][0], s[r][1]), fmaxf(s[r][2], s[r][3]));
                mx = fmaxf(mx, __shfl_xor(mx, 1)); mx = fmaxf(mx, __shfl_xor(mx, 2)); mx = fmaxf(mx, __shfl_xor(mx, 4)); mx = fmaxf(mx, __shfl_xor(mx, 8));
                const float mn = fmaxf(m[r], mx), alpha = exp2f(m[r] - mn);
                float p[4], rs = 0.f;
#pragma unroll
                for (int j = 0; j < 4; ++j) { p[j] = exp2f(s[r][j] - mn); rs += p[j]; Ps[(2 * ty + r) * 65 + 4 * tx + j] = p[j]; }
                rs += __shfl_xor(rs, 1); rs += __shfl_xor(rs, 2); rs += __shfl_xor(rs, 4); rs += __shfl_xor(rs, 8);
                lsum[r] = lsum[r] * alpha + rs; m[r] = mn;
#pragma unroll
                for (int c = 0; c < 8; ++c) o[r][c] *= alpha;
            }
            __syncthreads();
#pragma unroll 4
            for (int j = 0; j < 64; ++j) {
                const float p0 = Ps[(2 * ty) * 65 + j], p1 = Ps[(2 * ty + 1) * 65 + j];
                const f32x4 v0 = *(const LAS f32x4*)(Vs + j * 128 + 8 * tx), v1 = *(const LAS f32x4*)(Vs + j * 128 + 8 * tx + 4);
#pragma unroll
                for (int c = 0; c < 4; ++c) { o[0][c] += p0 * v0[c]; o[0][4 + c] += p0 * v1[c]; o[1][c] += p1 * v0[c]; o[1][4 + c] += p1 * v1[c]; }
            }
        }
#pragma unroll
        for (int r = 0; r < 2; ++r) {
            const float il = 1.f / lsum[r];
            u32x4 w; w.x = pk2(o[r][0] * il, o[r][1] * il); w.y = pk2(o[r][2] * il, o[r][3] * il); w.z = pk2(o[r][4] * il, o[r][5] * il); w.w = pk2(o[r][6] * il, o[r][7] * il);
            *(u32x4*)(Y + (size_t)(orow0 + 2 * ty + r) * DM + 512 + h * 128 + 8 * tx) = w;
        }
    }
}

namespace att {
using s16x4 = __attribute__((ext_vector_type(4))) short;
constexpr int QBLK = 32, KVBLK = 64;
constexpr int SHM_V = KVBLK * 128 * 2, SHM_K = KVBLK * 192 * 2, SHM_SCR = 2 * SHM_V + 2 * SHM_K, SHM_QL = SHM_SCR + NWAVES * 64 * 4, SHM_ATTN = SHM_QL + NWAVES * ATT_NQL * 1024;
constexpr float THR2 = 11.5f;
#define KSWZ(row, colB) ((row) * 384 + ((colB) ^ (((row) & 7) << 4)))
#define SBAR() __builtin_amdgcn_sched_barrier(0)
__device__ __forceinline__ void partialSM(f32x16& p0, f32x16& p1, float& m_reg, float& mn, float& alpha) {
  float pmax = p0[0];
#pragma unroll
  for (int r = 1; r < 16; ++r) pmax = fmaxf(pmax, p0[r]);
#pragma unroll
  for (int r = 0; r < 16; ++r) pmax = fmaxf(pmax, p1[r]);
  { auto rr = __builtin_amdgcn_permlane32_swap(__float_as_uint(pmax), __float_as_uint(pmax), false, false);
    pmax = fmaxf(__uint_as_float(rr[0]), __uint_as_float(rr[1])); }
  if (__builtin_expect(__all(pmax - m_reg <= THR2), 1)) { mn = m_reg; alpha = 1.f; }
  else { mn = fmaxf(m_reg, pmax); alpha = __builtin_amdgcn_exp2f(m_reg - mn); m_reg = mn; }
#pragma unroll
  for (int r = 0; r < 16; ++r) p0[r] = p0[r] - mn;
#pragma unroll
  for (int r = 0; r < 16; ++r) p1[r] = p1[r] - mn;
#pragma unroll
  for (int r = 0; r < 16; ++r) p0[r] = __builtin_amdgcn_exp2f(p0[r]);
}
__device__ __forceinline__ void finishSM(f32x16& p0, f32x16& p1, float alpha, float& l_reg, bf16x8& pa0, bf16x8& pa1, bf16x8& pa2, bf16x8& pa3) {
#pragma unroll
  for (int r = 0; r < 16; ++r) p1[r] = __builtin_amdgcn_exp2f(p1[r]);
  float ps = 0;
#pragma unroll
  for (int r = 0; r < 16; ++r) ps += p0[r];
#pragma unroll
  for (int r = 0; r < 16; ++r) ps += p1[r];
  { auto rr = __builtin_amdgcn_permlane32_swap(__float_as_uint(ps), __float_as_uint(ps), false, false);
    ps = __uint_as_float(rr[0]) + __uint_as_float(rr[1]); }
  l_reg = l_reg * alpha + ps;
#define PK4(P, BASE, OUT) do { unsigned a0 = cvtpk(P[BASE + 0], P[BASE + 1]), a1 = cvtpk(P[BASE + 2], P[BASE + 3]);   \
    unsigned b0 = cvtpk(P[BASE + 4], P[BASE + 5]), b1 = cvtpk(P[BASE + 6], P[BASE + 7]);                              \
    auto r0 = __builtin_amdgcn_permlane32_swap(a0, b0, false, false); auto r1 = __builtin_amdgcn_permlane32_swap(a1, b1, false, false); \
    u32x4 w = {r0[0], r1[0], r0[1], r1[1]}; OUT = __builtin_bit_cast(bf16x8, w); } while (0)
  PK4(p0, 0, pa0); PK4(p0, 8, pa1); PK4(p1, 0, pa2); PK4(p1, 8, pa3);
#undef PK4
}
constexpr int NQR = 12 - ATT_NQL;
__device__ __forceinline__ void qkt(f32x16& p0, f32x16& p1, const LAS unsigned char* Ks, const bf16x8* qr, const LAS unsigned char* ql, int r32, int hi) {
  p0 = f32x16{}; p1 = f32x16{};
#pragma unroll
  for (int d0 = 0; d0 < 12; ++d0) { const int cb = (d0 * 16 + hi * 8) * 2;
    const bf16x8 b0 = *(const LAS bf16x8*)(Ks + KSWZ(r32, cb));
    const bf16x8 b1 = *(const LAS bf16x8*)(Ks + KSWZ(32 + r32, cb));
    const bf16x8 qf = d0 < NQR ? qr[d0 < NQR ? d0 : 0] : *(const LAS bf16x8*)(ql + (d0 - NQR) * 1024);
    p0 = __builtin_amdgcn_mfma_f32_32x32x16_bf16(b0, qf, p0, 0, 0, 0);
    p1 = __builtin_amdgcn_mfma_f32_32x32x16_bf16(b1, qf, p1, 0, 0, 0); }
}
__device__ __forceinline__ int v_st(int k, int c) { const int kk = (k & ~0xC) | ((k & 4) << 1) | ((k & 8) >> 1); return ((kk >> 3) * 4 + (c >> 5)) * 512 + ((kk & 7) * 32 + (c & 31)) * 2; }
__device__ __forceinline__ int v_rd_base(int lane) { return ((lane & 3) << 3) | (((lane >> 2) & 3) << 6) | (((lane >> 4) & 1) << 5) | (((lane >> 5) & 1) << 8); }
constexpr int v_rd_off(int d0, int ks, int half) { return d0 * 512 + ks * 4096 + half * 2048; }
template <int OFF> __device__ __forceinline__ s16x4 tr_read(int vb) {
  s16x4 r; asm volatile("ds_read_b64_tr_b16 %0, %1 offset:%2" : "=&v"(r) : "v"(vb), "i"(OFF) : "memory"); return r;
}
template <int D0> __device__ __forceinline__ void pv_one(f32x16& od, int vb, bf16x8 pa0, bf16x8 pa1, bf16x8 pa2, bf16x8 pa3) {
  const s16x4 l0 = tr_read<v_rd_off(D0, 0, 0)>(vb), h0 = tr_read<v_rd_off(D0, 0, 1)>(vb), l1 = tr_read<v_rd_off(D0, 1, 0)>(vb), h1 = tr_read<v_rd_off(D0, 1, 1)>(vb);
  const s16x4 l2 = tr_read<v_rd_off(D0, 2, 0)>(vb), h2 = tr_read<v_rd_off(D0, 2, 1)>(vb), l3 = tr_read<v_rd_off(D0, 3, 0)>(vb), h3 = tr_read<v_rd_off(D0, 3, 1)>(vb);
  asm volatile("s_waitcnt lgkmcnt(0)" ::: "memory"); SBAR();
#define PK(L, H) (bf16x8){L[0], L[1], L[2], L[3], H[0], H[1], H[2], H[3]}
  od = __builtin_amdgcn_mfma_f32_32x32x16_bf16(pa0, PK(l0, h0), od, 0, 0, 0);
  od = __builtin_amdgcn_mfma_f32_32x32x16_bf16(pa1, PK(l1, h1), od, 0, 0, 0);
  od = __builtin_amdgcn_mfma_f32_32x32x16_bf16(pa2, PK(l2, h2), od, 0, 0, 0);
  od = __builtin_amdgcn_mfma_f32_32x32x16_bf16(pa3, PK(l3, h3), od, 0, 0, 0);
#undef PK
}
__device__ __forceinline__ void pv_d0(f32x16* o, int vb, bf16x8 pa0, bf16x8 pa1, bf16x8 pa2, bf16x8 pa3) {
  pv_one<0>(o[0], vb, pa0, pa1, pa2, pa3); pv_one<1>(o[1], vb, pa0, pa1, pa2, pa3); pv_one<2>(o[2], vb, pa0, pa1, pa2, pa3); pv_one<3>(o[3], vb, pa0, pa1, pa2, pa3);
}
__device__ __forceinline__ void unit(const bf16_t* __restrict__ QB, const bf16_t* __restrict__ KVB, const bf16_t* __restrict__ PB, const float* __restrict__ ROPE, bf16_t* __restrict__ Y,
                                     int qrow0, int b, int h, int nkeys, bool ropeq, LAS unsigned char* lds) {
  const int wid = kwave(), lane = klane(), tid = wid * 64 + lane, r32 = lane & 31, hi = lane >> 5;
  LAS unsigned char* V_lds = lds; LAS unsigned char* K_lds = lds + 2 * SHM_V;
  LAS float* wsc = (LAS float*)(lds + SHM_SCR) + wid * 64; LAS float* li_l = wsc; LAS float* al_l = wsc + 32;
  LAS unsigned char* qlw = lds + SHM_QL + wid * (ATT_NQL * 1024); const LAS unsigned char* ql = qlw + lane * 16;
  float m_reg = -1e30f, l_reg = 0; f32x16 o[4] = {}; bf16x8 qr[NQR];
  {
    const int qrow = qrow0 + wid * QBLK + r32;
    const bf16_t* Qw = QB + (size_t)qrow * 768 + h * 192 + hi * 8;
#pragma unroll
    for (int d0 = 0; d0 < 12; ++d0) {
      u32x4 w = *(const u32x4*)(Qw + d0 * 16);
      if (d0 >= 8 && ropeq) { float f[8]; unpack8(w, f); const int t = qrow & (NL - 1), jj = (d0 - 8) * 16 + hi * 8;
        const f32x4 r0 = rope4((f32x4){f[0], f[1], f[2], f[3]}, jj, t, ROPE), r1 = rope4((f32x4){f[4], f[5], f[6], f[7]}, jj + 4, t, ROPE);
        w.x = cvtpk(r0.x, r0.y); w.y = cvtpk(r0.z, r0.w); w.z = cvtpk(r1.x, r1.y); w.w = cvtpk(r1.z, r1.w); }
      if (d0 < NQR) qr[d0 < NQR ? d0 : 0] = __builtin_bit_cast(bf16x8, w); else *(LAS u32x4*)(qlw + (d0 - NQR) * 1024 + lane * 16) = w;
    }
  }
  const int sr = tid >> 4, sc = (tid & 15) * 8, vst0 = v_st(sr, sc), vst1 = v_st(32 + sr, sc);
  const int krw = tid >> 3, kcg = tid & 7;
  const int kw0 = KSWZ(krw, kcg * 16), kw1 = KSWZ(krw, (kcg + 8) * 16), kw2 = KSWZ(krw, (kcg + 16) * 16);
  const int vb0 = (int)(uintptr_t)V_lds + v_rd_base(lane);
  u32x4 sv0, sv1, sk0, sk1, sk2;
#define KROW(k0) ((k0) < NC ? ML + b * NC + (k0) : b * NL + ((k0) - NC))
  const int gv0 = sr * 1024 + h * 256 + 128 + sc, gv1 = gv0 + 32 * 1024, gk0 = krw * 1024 + h * 256 + kcg * 8, gk1 = gk0 + 64, gk2 = krw * INP + C_KR + kcg * 8;
#define SLOAD(k0) do { const int kr_ = __builtin_amdgcn_readfirstlane(KROW(k0)); const bf16_t* kvb_ = KVB + (size_t)kr_ * 1024; const bf16_t* pb_ = PB + (size_t)kr_ * INP; \
    sv0 = *(const u32x4*)(kvb_ + gv0); sv1 = *(const u32x4*)(kvb_ + gv1); sk0 = *(const u32x4*)(kvb_ + gk0); sk1 = *(const u32x4*)(kvb_ + gk1); sk2 = *(const u32x4*)(pb_ + gk2); } while (0)
#define SWRITE(bf) do { *(LAS u32x4*)(V_lds + (bf) * SHM_V + vst0) = sv0; *(LAS u32x4*)(V_lds + (bf) * SHM_V + vst1) = sv1; \
    *(LAS u32x4*)(K_lds + (bf) * SHM_K + kw0) = sk0; *(LAS u32x4*)(K_lds + (bf) * SHM_K + kw1) = sk1; *(LAS u32x4*)(K_lds + (bf) * SHM_K + kw2) = sk2; } while (0)
#define SWAIT() asm volatile("s_waitcnt vmcnt(0)" ::: "memory")
#define RESC(a) do { if (__any((a) < 1.f)) { if (hi == 0) al_l[r32] = (a); asm volatile("s_waitcnt lgkmcnt(0)" ::: "memory"); \
    _Pragma("unroll") for (int d = 0; d < 4; ++d) _Pragma("unroll") for (int r = 0; r < 16; ++r) o[d][r] *= al_l[crow(r, hi)]; } } while (0)
  f32x16 pA0, pA1, pB0, pB1; float mnA, mnB, alA, alB; bf16x8 pa0, pa1, pa2, pa3; const int NT = nkeys / KVBLK;
  SLOAD(0); SWAIT(); SWRITE(0); __syncthreads();
  qkt(pA0, pA1, K_lds, qr, ql, r32, hi); partialSM(pA0, pA1, m_reg, mnA, alA);
  SLOAD(KVBLK);
  SWAIT(); SWRITE(1); __syncthreads();
  for (int j = 1; j + 1 < NT; j += 2) {
    SBAR(); qkt(pB0, pB1, K_lds + SHM_K, qr, ql, r32, hi);
    finishSM(pA0, pA1, alA, l_reg, pa0, pa1, pa2, pa3); SBAR();
    SLOAD((j + 1) * KVBLK); SBAR();
    pv_d0(o, vb0, pa0, pa1, pa2, pa3); partialSM(pB0, pB1, m_reg, mnB, alB);
    __syncthreads(); SWAIT(); SWRITE(0);
    RESC(alB); __syncthreads();
    SBAR(); qkt(pA0, pA1, K_lds, qr, ql, r32, hi);
    finishSM(pB0, pB1, alB, l_reg, pa0, pa1, pa2, pa3); SBAR();
    SLOAD((j + 2) * KVBLK); SBAR();
    pv_d0(o, vb0 + SHM_V, pa0, pa1, pa2, pa3); partialSM(pA0, pA1, m_reg, mnA, alA);
    __syncthreads(); SWAIT(); SWRITE(1);
    RESC(alA); __syncthreads();
  }
  SBAR(); qkt(pB0, pB1, K_lds + SHM_K, qr, ql, r32, hi);
  finishSM(pA0, pA1, alA, l_reg, pa0, pa1, pa2, pa3); SBAR();
  pv_d0(o, vb0, pa0, pa1, pa2, pa3); partialSM(pB0, pB1, m_reg, mnB, alB);
  __syncthreads(); RESC(alB);
  finishSM(pB0, pB1, alB, l_reg, pa0, pa1, pa2, pa3); SBAR();
  pv_d0(o, vb0 + SHM_V, pa0, pa1, pa2, pa3);
  if (hi == 0) li_l[r32] = l_reg; asm volatile("s_waitcnt lgkmcnt(0)" ::: "memory");
  float rli[16];
#pragma unroll
  for (int r = 0; r < 16; ++r) rli[r] = __builtin_amdgcn_rcpf(li_l[crow(r, hi)]);
  bf16_t* Ow = Y + (size_t)(qrow0 + wid * QBLK) * DM + 512 + h * 128;
#pragma unroll
  for (int r = 0; r < 16; ++r) { const int orow = crow(r, hi);
#pragma unroll
    for (int d0 = 0; d0 < 4; ++d0) Ow[(size_t)orow * DM + d0 * 32 + r32] = (bf16_t)(cvtpk(o[d0][r] * rli[r], 0.f) & 0xffffu); }
#undef KROW
#undef SLOAD
#undef SWRITE
#undef SWAIT
#undef RESC
}
#undef KSWZ
#undef SBAR
}
__device__ __forceinline__ void phase_attn_mfma(const Args& a, int l, LAS unsigned char* lds) {
    unsigned char* ws = a.ws;
    const bf16_t* QB = (const bf16_t*)(ws + WS_QB); const bf16_t* KVB = (const bf16_t*)(ws + WS_KVB); const bf16_t* PB = (const bf16_t*)(ws + WS_PB); bf16_t* Y = (bf16_t*)(ws + WS_HY);
    const float* ROPE = (const float*)(ws + WS_ROPE);
    const int nunits = 256 + (l == 0 ? 8 : 0);
    for (int u = blockIdx.x; u < nunits; u += KGRID) {
        __syncthreads();
        if (u < 256) { const int bh = u & 7, qb = u >> 3, b = bh >> 2, h = bh & 3; att::unit(QB, KVB, PB, ROPE, Y, b * NL + qb * 256, b, h, NKEY, true, lds); }
        else { const int bh = u - 256, b = bh >> 2, h = bh & 3; att::unit(QB, KVB, PB, ROPE, Y, ML + b * NC, b, h, NC, false, lds); }
    }
}

namespace pg8 {
#define PG8_LAS __attribute__((address_space(3)))
typedef unsigned short bf16_t;
typedef short bf16x8 __attribute__((ext_vector_type(8)));
typedef float f32x4 __attribute__((ext_vector_type(4)));
typedef unsigned u32x4 __attribute__((ext_vector_type(4)));
constexpr int BM = 256, BK = 64, HALF = 128, HTB = HALF * BK * 2  , STAGE_BYTES = 8 * HTB, NXCD = 8, WGM = 8;

__host__ __device__ __forceinline__ int lds_byte(int r, int c) { const int st = (r >> 4) * 2 + (c >> 5), rr = r & 15, cc = c & 31, ob = rr * 64 + cc * 2; return st * 1024 + (ob ^ (((ob >> 9) & 1) << 5)); }
__host__ __device__ __forceinline__ void stage_rc(int b, int& R, int& C) { const int st = b / 1024, sb = b % 1024, swz = sb ^ (((sb >> 9) & 1) << 5); R = (st >> 1) * 16 + swz / 64; C = (st & 1) * 32 + (swz % 64) / 2; }
__host__ __device__ __forceinline__ int perm32(int rho) { const int n = rho >> 4, i = rho & 15; return 8 * (i >> 2) + 4 * n + (i & 3); }

struct Unit { int pm, pn; };
struct Gemm { const bf16_t* A; int lda; const bf16_t* Bt; int M, N, K; };

struct StaticOrder {
    int nM, nN, nwg, G, c;
    __host__ __device__ void init(int M, int N, int G_, int c_) { nM = M / BM; nN = N / BM; nwg = nM * nN; G = G_; c = c_; }
    __host__ __device__ bool next(int i, Unit& u) const {
        const long L = (long)i * G + c; if (L >= nwg) return false;
        int wgid = (int)L; { const int q = nwg / NXCD, r = nwg % NXCD, xcd = wgid % NXCD, off = wgid / NXCD; wgid = (xcd < r ? xcd * (q + 1) : r * (q + 1) + (xcd - r) * q) + off; }
        const int nig = WGM * nN, gid = wgid / nig, fm = gid * WGM, gsz = (nM - fm) < WGM ? (nM - fm) : WGM;
        u.pm = fm + ((wgid % nig) % gsz); u.pn = (wgid % nig) / gsz; return true;
    }
    __device__ __forceinline__ void a_ready(const Unit&) const {}
    __device__ __forceinline__ void done(const Unit&) const {}
};
template <class Epi, class Sched, bool ALIGN_EPI = false, bool SP2 = false>
__device__ __forceinline__ void gemm_phase(PG8_LAS unsigned char* lds, const Gemm g, const Sched& S, const Epi& E) {
    const int wid = kwave(), lane = klane(), tid = wid * 64 + lane, wr = wid >> 2, wc = wid & 3, fr = lane & 15, fq = lane >> 4;
    const int K = g.K, nt = K / BK;
    unsigned voffA[2], voffB[2];
#pragma unroll
    for (int i = 0; i < 2; ++i) { int R, C; stage_rc(tid * 16 + i * 8192, R, C); const int Rb = Epi::PERM ? ((R & ~31) + perm32(R & 31)) : R;
        voffA[i] = (unsigned)(R * g.lda + C) * 2u; voffB[i] = (unsigned)(Rb * K + C) * 2u; }
    const size_t kstep = (size_t)(BK * 2);
    const size_t hstepA = (size_t)HALF * g.lda * 2, hstepB = (size_t)HALF * K * 2;
    const size_t tstepA = 2 * hstepA, tstepB = 2 * hstepB;
    const unsigned ldsw = (unsigned)wid * 1024u;
    const int aoff = lds_byte(wr * 64 + fr, fq * 8), boff = lds_byte(wc * 32 + fr, fq * 8);
#define PG8_SA(b, h) (((b) * 2 + (h)) * HTB)
#define PG8_SB(b, h) ((4 + (b) * 2 + (h)) * HTB)
#define PG8_STAGE(bufoff, gbase, voff) do { _Pragma("unroll") for (int _i = 0; _i < 2; ++_i) \
        __builtin_amdgcn_global_load_lds((const unsigned*)((const char*)(gbase) + (voff)[_i]), (PG8_LAS unsigned*)(lds + (bufoff) + ldsw + _i * 8192), 16, 0, 0); } while (0)
#define PG8_LDA(dst, b, h) do { _Pragma("unroll") for (int m = 0; m < 4; ++m) _Pragma("unroll") for (int k = 0; k < 2; ++k) dst[m][k] = *(const PG8_LAS bf16x8*)(lds + PG8_SA(b, h) + aoff + m * 2048 + k * 1024); } while (0)
#define PG8_LDB(dst, b, h) do { _Pragma("unroll") for (int n = 0; n < 2; ++n) _Pragma("unroll") for (int k = 0; k < 2; ++k) dst[n][k] = *(const PG8_LAS bf16x8*)(lds + PG8_SB(b, h) + boff + n * 2048 + k * 1024); } while (0)
#define PG8_MMA(ai, bj, At, Bt) do { __builtin_amdgcn_s_setprio(1); _Pragma("unroll") for (int m = 0; m < 4; ++m) _Pragma("unroll") for (int n = 0; n < 2; ++n) _Pragma("unroll") for (int k = 0; k < 2; ++k) \
        acc[ai][bj][m][n] = __builtin_amdgcn_mfma_f32_16x16x32_bf16(Bt[n][k], At[m][k], acc[ai][bj][m][n], 0, 0, 0); __builtin_amdgcn_s_setprio(0); } while (0)
#define PG8_WAIT_V(n) asm volatile("s_waitcnt vmcnt(" #n ")" ::: "memory")
#define PG8_WAIT_L(n) asm volatile("s_waitcnt lgkmcnt(" #n ")" ::: "memory")
#define PG8_BAR __builtin_amdgcn_s_barrier()
#define PG8_SCHED __builtin_amdgcn_sched_barrier(0)
    Unit cur, nxt; int ui = 0;
    if (!S.next(0, cur)) return;
    f32x4 acc[2][2][4][2];
#pragma unroll
    for (int a = 0; a < 2; ++a)
#pragma unroll
        for (int b = 0; b < 2; ++b)
#pragma unroll
            for (int m = 0; m < 4; ++m)
#pragma unroll
                for (int n = 0; n < 2; ++n) acc[a][b][m][n] = (f32x4){0.f, 0.f, 0.f, 0.f};
    bf16x8 At[4][2], B0[2][2], B1[2][2];
    const char* cA = (const char*)g.A + (size_t)cur.pm * tstepA; const char* cB = (const char*)g.Bt + (size_t)cur.pn * tstepB;
    S.a_ready(cur);
    if constexpr (SP2) {
        PG8_STAGE(PG8_SB(0, 0), cB, voffB); PG8_STAGE(PG8_SB(0, 1), cB + hstepB, voffB); PG8_STAGE(PG8_SA(0, 0), cA, voffA); PG8_STAGE(PG8_SA(0, 1), cA + hstepA, voffA);
        if (wr == 1) PG8_BAR;
        PG8_WAIT_V(2); PG8_BAR;
        PG8_STAGE(PG8_SB(1, 0), cB + kstep, voffB); PG8_STAGE(PG8_SA(1, 0), cA + kstep, voffA); PG8_STAGE(PG8_SB(1, 1), cB + hstepB + kstep, voffB);
        PG8_WAIT_V(6); PG8_BAR;
    } else {
        PG8_STAGE(PG8_SB(0, 0), cB, voffB); PG8_STAGE(PG8_SA(0, 0), cA, voffA); PG8_STAGE(PG8_SB(0, 1), cB + hstepB, voffB); PG8_STAGE(PG8_SA(0, 1), cA + hstepA, voffA);
        if (wr == 1) PG8_BAR;
        PG8_WAIT_V(4); PG8_BAR;
        PG8_STAGE(PG8_SB(1, 0), cB + kstep, voffB); PG8_STAGE(PG8_SA(1, 0), cA + kstep, voffA); PG8_STAGE(PG8_SB(1, 1), cB + hstepB + kstep, voffB);
        PG8_WAIT_V(6); PG8_BAR;
    }
    for (;;) {
        const bool has_next = S.next(ui + 1, nxt);
        const char* nA = has_next ? (const char*)g.A + (size_t)nxt.pm * tstepA : cA; const char* nB = has_next ? (const char*)g.Bt + (size_t)nxt.pn * tstepB : cB;
#pragma nounroll
        for (int t = 0; t < nt; t += 2) {
            const bool last = (t == nt - 2);
            const char* a1 = cA + (size_t)(t + 1) * kstep;
            const char* a2 = last ? nA : cA + (size_t)(t + 2) * kstep; const char* b2 = last ? nB : cB + (size_t)(t + 2) * kstep;
            const char* a3 = a2 + kstep; const char* b3 = b2 + kstep;
            if (last && has_next) S.a_ready(nxt);
            if constexpr (SP2) {
            PG8_LDB(B0, 0, 0); PG8_LDB(B1, 0, 1); PG8_SCHED; PG8_LDA(At, 0, 0); PG8_STAGE(PG8_SA(1, 1), a1 + hstepA, voffA);
            PG8_WAIT_V(8); PG8_WAIT_L(0); PG8_BAR; PG8_MMA(0, 0, At, B0); PG8_MMA(0, 1, At, B1); PG8_BAR; PG8_SCHED;
            PG8_LDA(At, 0, 1); PG8_STAGE(PG8_SB(0, 0), b2, voffB); PG8_STAGE(PG8_SB(0, 1), b2 + hstepB, voffB); PG8_STAGE(PG8_SA(0, 0), a2, voffA);
            PG8_WAIT_V(8); PG8_WAIT_L(0); PG8_BAR; PG8_MMA(1, 0, At, B0); PG8_MMA(1, 1, At, B1); PG8_BAR; PG8_SCHED;
            PG8_LDB(B0, 1, 0); PG8_LDB(B1, 1, 1); PG8_SCHED; PG8_LDA(At, 1, 0); PG8_STAGE(PG8_SA(0, 1), a2 + hstepA, voffA);
            PG8_WAIT_V(8); PG8_WAIT_L(0); PG8_BAR; PG8_MMA(0, 0, At, B0); PG8_MMA(0, 1, At, B1); PG8_BAR; PG8_SCHED;
            PG8_LDA(At, 1, 1); PG8_STAGE(PG8_SB(1, 0), b3, voffB); PG8_STAGE(PG8_SB(1, 1), b3 + hstepB, voffB); PG8_STAGE(PG8_SA(1, 0), a3, voffA);
            PG8_WAIT_V(8); PG8_WAIT_L(0); PG8_BAR; PG8_MMA(1, 0, At, B0); PG8_MMA(1, 1, At, B1); PG8_BAR; PG8_SCHED;
            } else {
            PG8_LDB(B0, 0, 0); PG8_SCHED; PG8_LDA(At, 0, 0); PG8_STAGE(PG8_SA(1, 1), a1 + hstepA, voffA);
            PG8_WAIT_L(8); PG8_BAR; PG8_WAIT_L(0); PG8_MMA(0, 0, At, B0); PG8_BAR; PG8_SCHED;
            PG8_LDB(B1, 0, 1); PG8_STAGE(PG8_SB(0, 0), b2, voffB);
            PG8_BAR; PG8_WAIT_L(0); PG8_MMA(0, 1, At, B1); PG8_BAR;
            PG8_LDA(At, 0, 1); PG8_STAGE(PG8_SA(0, 0), a2, voffA);
            PG8_BAR; PG8_WAIT_L(0); PG8_MMA(1, 0, At, B0); PG8_BAR; PG8_SCHED;
            PG8_STAGE(PG8_SB(0, 1), b2 + hstepB, voffB);
            PG8_WAIT_V(6); PG8_BAR; PG8_MMA(1, 1, At, B1); PG8_BAR;
            PG8_LDB(B0, 1, 0); PG8_SCHED; PG8_LDA(At, 1, 0); PG8_STAGE(PG8_SA(0, 1), a2 + hstepA, voffA);
            PG8_WAIT_L(8); PG8_BAR; PG8_WAIT_L(0); PG8_MMA(0, 0, At, B0); PG8_BAR; PG8_SCHED;
            PG8_LDB(B1, 1, 1); PG8_STAGE(PG8_SB(1, 0), b3, voffB);
            PG8_BAR; PG8_WAIT_L(0); PG8_MMA(0, 1, At, B1); PG8_BAR;
            PG8_LDA(At, 1, 1); PG8_STAGE(PG8_SA(1, 0), a3, voffA);
            PG8_BAR; PG8_WAIT_L(0); PG8_MMA(1, 0, At, B0); PG8_BAR; PG8_SCHED;
            PG8_STAGE(PG8_SB(1, 1), b3 + hstepB, voffB);
            PG8_WAIT_V(6); PG8_BAR; PG8_MMA(1, 1, At, B1); PG8_BAR;
            }
        }
        if constexpr (ALIGN_EPI) { if (wr == 0) PG8_BAR; }
        if constexpr (!Epi::AFTER_DRAIN) { E(acc, cur, wr, wc, fr, fq); S.done(cur); }
        if (!has_next) break;
#pragma unroll
        for (int a = 0; a < 2; ++a)
#pragma unroll
            for (int b = 0; b < 2; ++b)
#pragma unroll
                for (int m = 0; m < 4; ++m)
#pragma unroll
                    for (int n = 0; n < 2; ++n) acc[a][b][m][n] = (f32x4){0.f, 0.f, 0.f, 0.f};
        cur = nxt; cA = nA; cB = nB; ++ui;
        if constexpr (ALIGN_EPI) { if (wr == 1) PG8_BAR; }
    }
    PG8_WAIT_V(0);
    if constexpr (!ALIGN_EPI) { if (wr == 0) PG8_BAR; }
    PG8_BAR;
    if constexpr (Epi::AFTER_DRAIN) { E.fused(acc, cur, wr, wc, fr, fq, lds, wid, lane); S.done(cur); }
#undef PG8_SA
#undef PG8_SB
#undef PG8_STAGE
#undef PG8_LDA
#undef PG8_LDB
#undef PG8_MMA
#undef PG8_WAIT_V
#undef PG8_WAIT_L
#undef PG8_BAR
#undef PG8_SCHED
}
}

template <class F> struct EpiAdapt {
    static constexpr bool PERM = false, AFTER_DRAIN = false;
    F f;
    __device__ __forceinline__ void operator()(const pg8::f32x4 (&acc)[2][2][4][2], const pg8::Unit& u, int wr, int wc, int fr, int fq) const {
#pragma unroll
        for (int ai = 0; ai < 2; ++ai)
#pragma unroll
            for (int m = 0; m < 4; ++m) { const int row = u.pm * 256 + ai * 128 + wr * 64 + m * 16 + fr;
#pragma unroll
                for (int bj = 0; bj < 2; ++bj)
#pragma unroll
                    for (int n = 0; n < 2; ++n) f(row, u.pn * 256 + bj * 128 + wc * 32 + n * 16 + 4 * fq, acc[ai][bj][m][n]); }
    }
};
template <class F> __device__ __forceinline__ void gemm_mfma(const bf16_t* A, int lda, const bf16_t* Bt, int M, int N, int K, const F& f, LAS unsigned char* lds) {
    pg8::Gemm g{A, lda, Bt, M, N, K}; pg8::StaticOrder S; S.init(M, N, KGRID, (int)blockIdx.x);
    EpiAdapt<F> E{f};
    pg8::gemm_phase<EpiAdapt<F>, pg8::StaticOrder, true, true>(lds, g, S, E);
}


#ifndef GEMM_MASK
#define GEMM_MASK 63
#endif
template <int BIT, class F> __device__ __forceinline__ void gemm_sel(const bf16_t* A, int lda, const bf16_t* Bt, int M, int N, int K, const F& f, LAS unsigned char* lds) {
    if constexpr ((GEMM_MASK >> BIT) & 1) gemm_mfma(A, lda, Bt, M, N, K, f, lds); else gemm_naive(A, lda, Bt, M, N, K, f, lds);
}

__device__ __forceinline__ void phase_final(const Args& a) {
    const float* fw = a.in[I_FNW];
    const int lane = klane(), gw = blockIdx.x * NWAVES + kwave(), ngw = KGRID * NWAVES;
    for (int row = gw; row < ML; row += ngw) {
        float* p = a.out + (size_t)row * DM;
        f32x4 v[4]; float ss = 0.f;
#pragma unroll
        for (int j = 0; j < 4; ++j) { v[j] = *(const f32x4*)(p + lane * 4 + 256 * j); ss += v[j].x * v[j].x + v[j].y * v[j].y + v[j].z * v[j].z + v[j].w * v[j].w; }
        const float rstd = rsqrtf(wave_sum(ss) * (1.f / DM) + EPS);
#pragma unroll
        for (int j = 0; j < 4; ++j) *(f32x4*)(p + lane * 4 + 256 * j) = v[j] * rstd * *(const f32x4*)(fw + lane * 4 + 256 * j);
    }
}

constexpr int NPHASE = 28;
#define PH_BEGIN(k) if (lo <= (k) && (k) < hi) { const Args& a = get_args(); unsigned char* ws = a.ws; (void)ws;
#define PH_END(k) if (MK_ONE_LAUNCH && (k) + 1 < hi) xcd_barrier(bar); }
template <int L> __device__ __forceinline__ void layer_phases(LAS unsigned char* lds, const XcdBarrier& bar, const int lo, const int hi) {
    constexpr int P = 1 + 13 * L;
#define MODL ((const float*)(ws + WS_MOD) + (size_t)L * 3 * 6144)
#define ROPET ((const float*)(ws + WS_ROPE))
#define HYB ((bf16_t*)(ws + WS_HY))
#define PBB ((bf16_t*)(ws + WS_PB))
#define XCB ((float*)(ws + WS_XC))
#define XL_IN ((L == 0) ? a.in[I_X] : (const float*)a.out)
#define XC_IN ((L == 0) ? a.in[I_CTX] : (const float*)XCB)
    PH_BEGIN(P + 0) phase_norm_mod(XL_IN, XC_IN, a.in[I_N1W] + L * DM, MODL, 0, 1024, HYB); PH_END(P + 0)
    PH_BEGIN(P + 1) { EpiInProj E{PBB, ROPET}; gemm_sel<0>(HYB, DM, (const bf16_t*)(ws + WS_WIN) + (size_t)L * INP * DM, MT, INP, DM, E, lds); } PH_END(P + 1)
    PH_BEGIN(P + 2) phase_post(a, L); PH_END(P + 2)
    PH_BEGIN(P + 3) {
        { EpiUQ E1{(bf16_t*)(ws + WS_QB)}; gemm_sel<1>(PBB + C_DQ, INP, (const bf16_t*)(ws + WS_WUQ) + (size_t)L * 768 * 256, MT, 768, 256, E1, lds); }
        { EpiUKV E2{(bf16_t*)(ws + WS_KVB)}; gemm_sel<2>(PBB + C_CKV, INP, (const bf16_t*)(ws + WS_WUKV) + (size_t)L * 1024 * 256, MT, 1024, 256, E2, lds); }
    } PH_END(P + 3)
    PH_BEGIN(P + 4) phase_sgu_naive(a, L); PH_END(P + 4)
#if GLA_NAIVE
    PH_BEGIN(P + 5) phase_gla_naive(a, L); PH_END(P + 5)
#else
    PH_BEGIN(P + 5) phase_gla_local(a, L, lds); PH_END(P + 5)
    PH_BEGIN(P + 6) phase_gla_scan(a); PH_END(P + 6)
    PH_BEGIN(P + 7) phase_gla_out(a, L, lds); PH_END(P + 7)
#endif
    #if ATTN_NAIVE
    PH_BEGIN(P + 8) phase_attn_naive(a, L, lds); PH_END(P + 8)
#else
    PH_BEGIN(P + 8) phase_attn_mfma(a, L, lds); PH_END(P + 8)
#endif
    PH_BEGIN(P + 9) { EpiResid E{XL_IN, XC_IN, a.out, XCB, MODL, 2048}; gemm_sel<3>(HYB, DM, (const bf16_t*)(ws + WS_WOUT) + (size_t)L * DM * DM, MT, DM, DM, E, lds); } PH_END(P + 9)
    PH_BEGIN(P + 10) phase_norm_mod(a.out, XCB, a.in[I_N2W] + L * DM, MODL, 3072, 4096, HYB); PH_END(P + 10)
    PH_BEGIN(P + 11) { EpiFF1 E{(bf16_t*)(ws + WS_A)}; gemm_sel<4>(HYB, DM, (const bf16_t*)(ws + WS_WFF1) + (size_t)L * FF * DM, MT, FF, DM, E, lds); } PH_END(P + 11)
    PH_BEGIN(P + 12) { EpiResid E{a.out, XCB, a.out, XCB, MODL, 5120}; gemm_sel<5>((const bf16_t*)(ws + WS_A), FF, (const bf16_t*)(ws + WS_WFF2) + (size_t)L * DM * FF, MT, DM, FF, E, lds); } PH_END(P + 12)
}
__global__ void __launch_bounds__(NTHR, 2) mega(Args a_kernarg_only) {
    extern __shared__ __attribute__((aligned(16))) unsigned char lds_raw[];
    LAS unsigned char* lds = (LAS unsigned char*)lds_raw;
    volatile LAS unsigned* MISC = (volatile LAS unsigned*)(lds + LDS_CTL_OFF);
    { const int t0 = __builtin_amdgcn_workitem_id_x();
      if (t0 < 64) MISC[t0] = 0u;
      if ((t0 & 63) == 0) { const unsigned id = (unsigned)__builtin_amdgcn_s_getreg((5 << 11) | 4) & 63u; MISC[64 + id] = (unsigned)(t0 >> 6); } }
    __syncthreads();
    XcdBarrier bar; bar.bar = (unsigned*)(get_args().ws + WS_CTL); bar.x = 0; bar.st = nullptr;
    if (MK_ONE_LAUNCH) bar = xcd_barrier_post((unsigned*)(get_args().ws + WS_CTL), MISC + 8);
    const int lo = MK_ONE_LAUNCH ? 0 : get_args().ph_lo, hi = MK_ONE_LAUNCH ? NPHASE : get_args().ph_hi;
    PH_BEGIN(0) phase_prep(a, lds); PH_END(0)
    layer_phases<0>(lds, bar, lo, hi);
    layer_phases<1>(lds, bar, lo, hi);
    PH_BEGIN(NPHASE - 1) phase_final(a); PH_END(NPHASE - 1)
}

extern "C" void kernel_launch(void* const* d_in, const int* in_sizes, int n_in, void* d_out, int out_size, void* d_ws, size_t ws_size, hipStream_t stream) {
    static int grid = 0;
    if (grid == 0) {
        if (n_in != 26 || in_sizes[0] != ML * DM || out_size != ML * DM || ws_size < WS_END) { fprintf(stderr, "kernel_launch: unexpected shapes (n_in %d, in0 %d, out %d, ws %zu)\n", n_in, n_in > 0 ? in_sizes[0] : -1, out_size, ws_size); grid = -1; return; }
        int dev = 0, cus = 0;
        if (hipGetDevice(&dev) != hipSuccess || hipDeviceGetAttribute(&cus, hipDeviceAttributeMultiprocessorCount, dev) != hipSuccess) { grid = -1; return; }
        if (hipFuncSetAttribute((const void*)mega, hipFuncAttributeMaxDynamicSharedMemorySize, LDS_BYTES) != hipSuccess) { fprintf(stderr, "kernel_launch: hipFuncSetAttribute failed\n"); grid = -1; return; }
        int per_cu = 0;
        if (hipOccupancyMaxActiveBlocksPerMultiprocessor(&per_cu, (const void*)mega, NTHR, LDS_BYTES) != hipSuccess || per_cu < 1) fprintf(stderr, "kernel_launch: occupancy query says %d\n", per_cu);
        (void)hipGetLastError();
        grid = cus;
    }
    if (grid < 0) return;
    (void)hipMemsetAsync((char*)d_ws + WS_CTL, 0, CTL_ZERO_BYTES, stream);
    Args a{};
    for (int i = 0; i < 26; ++i) a.in[i] = (const float*)d_in[i];
    a.out = (float*)d_out; a.ws = (unsigned char*)d_ws; a.grid = grid;
    if (MK_ONE_LAUNCH) { a.ph_lo = 0; a.ph_hi = NPHASE; hipLaunchKernelGGL(mega, dim3(grid), dim3(NTHR), LDS_BYTES, stream, a); }
    else for (int ph = 0; ph < NPHASE; ++ph) { a.ph_lo = ph; a.ph_hi = ph + 1; hipLaunchKernelGGL(mega, dim3(grid), dim3(NTHR), LDS_BYTES, stream, a); }
}
```

```cpp
#include <hip/hip_runtime.h>
#include <cstdio>
#include <cstdint>

#ifndef REP_FF1
#define REP_FF1 1
#endif
#ifndef REP_INP
#define REP_INP 1
#endif
#ifndef REP_GLAL
#define REP_GLAL 1
#endif
#ifndef REP_UP
#define REP_UP 1
#endif
#ifndef REP_PREP
#define REP_PREP 1
#endif
#ifndef REP_SGU
#define REP_SGU 1
#endif
#ifndef REP_ATTN
#define REP_ATTN 1
#endif
#ifndef REP_GLA
#define REP_GLA 1
#endif
#ifndef REP_NORM
#define REP_NORM 1
#endif
#ifndef ATT_NQL
#define ATT_NQL 6
#endif
#ifndef ATTN_NAIVE
#define ATTN_NAIVE 0
#endif
#ifndef GLA_NAIVE
#define GLA_NAIVE 0
#endif
#ifndef MK_ONE_LAUNCH
#define MK_ONE_LAUNCH 1
#endif

#define GAS __attribute__((address_space(1)))
#define LAS __attribute__((address_space(3)))
typedef unsigned short bf16_t;
typedef float f32x4 __attribute__((ext_vector_type(4)));
typedef unsigned u32x4 __attribute__((ext_vector_type(4)));
typedef unsigned u32x2 __attribute__((ext_vector_type(2)));

constexpr int DM = 1024, NB = 2, NL = 8192, NC = 256, ML = NB * NL, MC = NB * NC, MT = ML + MC;
constexpr int FF = 4096, INP = 2048, IN_COLS = 1888, NKEY = NC + NL;
constexpr float EPS = 1e-6f;
constexpr float QSCALE = 0.07216878364870322f * 1.4426950408889634f;
constexpr int NWAVES = 8, NTHR = 512;
constexpr int C_CKV = 0, C_DQ = 256, C_SU = 512, C_SV = 768, C_GV = 1024, C_GR = 1280, C_GK = 1536, C_GQ = 1664, C_KR = 1792, C_GGF = 1856, C_GGB = 1872;

constexpr size_t MiB = 1u << 20;
constexpr size_t WS_CTL = 0, CTL_ZERO_BYTES = 65536;
constexpr size_t WS_MOD = 1 * MiB;
constexpr size_t WS_ROPE = 1 * MiB + 256 * 1024;
constexpr size_t WS_WSB = 14 * MiB + 768 * 1024;
constexpr size_t WS_WIN = 2 * MiB;
constexpr size_t WS_WOUT = 10 * MiB;
constexpr size_t WS_WUQ = 14 * MiB;
constexpr size_t WS_WUKV = 15 * MiB;
constexpr size_t WS_WFF1 = 16 * MiB;
constexpr size_t WS_WFF2 = 32 * MiB;
constexpr size_t WS_XC = 48 * MiB;
constexpr size_t WS_HY = 50 * MiB;
constexpr size_t WS_PB = 83 * MiB;
constexpr size_t WS_QB = 149 * MiB;
constexpr size_t WS_KVB = 174 * MiB;
constexpr size_t WS_LG = 216 * MiB;
constexpr size_t WS_OB = 233 * MiB;
constexpr size_t WS_A = 83 * MiB;
constexpr size_t WS_END = 250 * MiB;
static_assert(WS_A + (size_t)MT * FF * 2 <= WS_LG, "ffn hidden overlay");
static_assert(WS_PB + (size_t)MT * INP * 2 <= WS_QB && WS_QB + (size_t)MT * 768 * 2 <= WS_KVB && WS_KVB + (size_t)MT * 1024 * 2 <= WS_LG, "ws map");
static_assert(WS_LG + (size_t)MT * 256 * 4 <= WS_OB && WS_OB + (size_t)MT * 256 * 4 <= WS_END, "ws map 2");

constexpr int LDS_BYTES = 147456;

struct Args { const float* in[26]; float* out; unsigned char* ws; int ph_lo, ph_hi, grid, pad; };
enum { I_X = 0, I_C, I_CTX, I_CCTX, I_WMOD, I_BMOD, I_N1W, I_WIN, I_WOUT, I_SGNW, I_SGNB, I_SGW, I_SGB, I_GWF, I_GBF, I_GWB, I_GBB, I_GNW, I_QNW, I_WUQ, I_KVNW, I_WUKV, I_N2W, I_WFF1, I_WFF2, I_FNW };

typedef __attribute__((address_space(4))) const Args* KArgsPtr;
__device__ __forceinline__ const Args& get_args() { KArgsPtr p = (KArgsPtr)__builtin_amdgcn_kernarg_segment_ptr(); asm volatile("" : "+s"(p)); return *(const Args*)p; }
constexpr int LDS_CTL_OFF = LDS_BYTES - 512;
__device__ __forceinline__ int klane() { int l; asm volatile("v_mbcnt_lo_u32_b32 %0, -1, 0\n\tv_mbcnt_hi_u32_b32 %0, -1, %0" : "=v"(l)); return l; }
__device__ __forceinline__ int kwave() { const unsigned id = (unsigned)__builtin_amdgcn_s_getreg((5 << 11) | 4) & 63u;
    return __builtin_amdgcn_readfirstlane((int)((volatile LAS unsigned*)(uintptr_t)(LDS_CTL_OFF + 256))[id]); }
#define KTID (kwave() * 64 + klane())
#define KGRID (get_args().grid)
__device__ __forceinline__ float bf2f(bf16_t v) { return __uint_as_float(((unsigned)v) << 16); }
__device__ __forceinline__ unsigned f2bf(float f) { unsigned u = __float_as_uint(f); return (u + 0x7fffu + ((u >> 16) & 1u)) >> 16; }
__device__ __forceinline__ unsigned pk2(float lo, float hi) { return f2bf(lo) | (f2bf(hi) << 16); }
__device__ __forceinline__ float wave_sum(float v) {
#pragma unroll
    for (int o = 1; o < 64; o <<= 1) v += __shfl_xor(v, o);
    return v;
}
__device__ __forceinline__ float gelu_tanh(float x) { const float u = 1.5957691216057308f * (x + 0.044715f * x * x * x); return x / (1.f + __expf(-u)); }
__device__ __forceinline__ float silu_f(float x) { return x / (1.f + __expf(-x)); }
__device__ __forceinline__ float log_sigmoid_f(float z) { return fminf(z, 0.f) - log1pf(expf(-fabsf(z))); }
__device__ __forceinline__ void unpack8(u32x4 w, float* f) {
    f[0] = __uint_as_float(w.x << 16); f[1] = __uint_as_float(w.x & 0xffff0000u); f[2] = __uint_as_float(w.y << 16); f[3] = __uint_as_float(w.y & 0xffff0000u);
    f[4] = __uint_as_float(w.z << 16); f[5] = __uint_as_float(w.z & 0xffff0000u); f[6] = __uint_as_float(w.w << 16); f[7] = __uint_as_float(w.w & 0xffff0000u);
}

#define XB_TMO      128
#define XB_XCNT(j)  (256  + 64 * (j))
#define XB_XSUB(j)  (1280 + 64 * (j))
#define XB_XGEN(j)  (2304 + 64 * (j))
#define XB_TOP      3328
#define XB_TOPGEN   3392
#define XCD_BAR_WORDS 3456
#define XB_SPIN_CAP (1u << 22)
__device__ __forceinline__ unsigned xb_ld(unsigned* p)              { return __hip_atomic_load(p, __ATOMIC_RELAXED, __HIP_MEMORY_SCOPE_AGENT); }
__device__ __forceinline__ unsigned xb_add(unsigned* p, unsigned v) { return __hip_atomic_fetch_add(p, v, __ATOMIC_RELAXED, __HIP_MEMORY_SCOPE_AGENT); }
__device__ __forceinline__ unsigned xb_xcc_id() { return (unsigned)__builtin_amdgcn_s_getreg((3 << 11) | 20) & 0xFu; }
#define XB_SPIN(cond, bar) do { unsigned _sp = 0; while (cond) { __builtin_amdgcn_s_sleep(1); \
    if ((++_sp & 255u) == 0u) { if (xb_ld(&(bar)[XB_TMO])) break; if (_sp > XB_SPIN_CAP) { atomicAdd(&(bar)[XB_TMO], 1u); break; } } } } while (0)
struct XcdBarrier { unsigned* bar; unsigned x; volatile LAS unsigned* st; };
__device__ __forceinline__ XcdBarrier xcd_barrier_post(unsigned* bar, volatile LAS unsigned* st) {
    XcdBarrier b; b.bar = bar; b.x = xb_xcc_id(); b.st = st;
    if (KTID == 0) (void)xb_add(&bar[XB_XCNT(b.x)], 1u);
    return b;
}
__device__ __forceinline__ void xcd_barrier_complete(unsigned* bar, unsigned x, unsigned& nloc, unsigned& nx) {
    const unsigned G = (unsigned)KGRID;
    unsigned sum, cnt, mine, sp = 0u;
    for (;;) {
        sum = 0u; cnt = 0u; mine = 0u;
#pragma unroll
        for (unsigned j = 0; j < 16; ++j) { const unsigned c = xb_ld(&bar[XB_XCNT(j)]); sum += c; cnt += (c > 0u) ? 1u : 0u; mine = (j == x) ? c : mine; }
        if (sum == G) break;
        __builtin_amdgcn_s_sleep(1);
        if ((++sp & 255u) == 0u) { if (xb_ld(&bar[XB_TMO])) break; if (sp > XB_SPIN_CAP) { atomicAdd(&bar[XB_TMO], 1u); break; } }
    }
    nloc = mine > 0u ? mine : 1u; nx = cnt > 0u ? cnt : 1u;
}
__device__ __forceinline__ void xcd_barrier(const XcdBarrier& b) {
    asm volatile("s_waitcnt vmcnt(0)" ::: "memory");
    __syncthreads();
    if (KTID == 0) {
        unsigned* bar = b.bar;
        __builtin_amdgcn_s_waitcnt(0);
        unsigned nloc = b.st[0], nx = b.st[1];
        if (nloc == 0u) { xcd_barrier_complete(bar, b.x, nloc, nx); b.st[0] = nloc; b.st[1] = nx; }
        const unsigned old = xb_add(&bar[XB_XSUB(b.x)], 1u);
        const unsigned gen = old / nloc;
        if (old + 1u == (gen + 1u) * nloc) {
            __builtin_amdgcn_fence(__ATOMIC_RELEASE, "agent");
            asm volatile("s_waitcnt vmcnt(0)" ::: "memory");
            const unsigned og = xb_add(&bar[XB_TOP], 1u);
            const unsigned tg = og / nx;
            if (og + 1u == (tg + 1u) * nx) xb_add(&bar[XB_TOPGEN], 1u);
            else XB_SPIN(xb_ld(&bar[XB_TOPGEN]) == tg, bar);
            __builtin_amdgcn_fence(__ATOMIC_ACQUIRE, "agent");
            xb_add(&bar[XB_XGEN(b.x)], 1u);
            asm volatile("s_waitcnt vmcnt(0)" ::: "memory");
        } else {
            XB_SPIN(xb_ld(&bar[XB_XGEN(b.x)]) == gen, bar);
            __builtin_amdgcn_fence(__ATOMIC_ACQUIRE, "agent");
            asm volatile("s_waitcnt vmcnt(0)" ::: "memory");
        }
    }
    __syncthreads();
}

__device__ __forceinline__ int rope_unperm(int jj) { return (jj < 32) ? ((jj >> 1) + 16 * (jj & 1)) : (32 + ((jj - 32) >> 1) + 16 * (jj & 1)); }
__device__ __forceinline__ int map_in(int n) {
    if (n < 256) return 416 + n;
    if (n < 512) return 1632 + (n - 256);
    if (n < 768) return 736 + (n - 512);
    if (n < 1024) return 992 + (n - 768);
    if (n < 1280) return 128 + (n - 1024);
    if (n < 1536) return 1376 + (n - 1280);
    if (n < 1664) return n - 1536;
    if (n < 1792) return 1248 + (n - 1664);
    if (n < 1856) return 672 + rope_unperm(n - 1792);
    if (n < 1872) return 384 + (n - 1856);
    if (n < 1888) return 400 + (n - 1872);
    return -1;
}
__device__ __forceinline__ int map_uq(int n) { const int h = n / 192, j = n % 192; return (j < 128) ? n : (h * 192 + 128 + rope_unperm(j - 128)); }
template <int MODE> __device__ __forceinline__ void transpose_w(const float* W, int K, int Nsrc, bf16_t* Wt, int Npad, int gtid, int gthreads) {
    const int total = Npad * (K / 8);
    for (int idx = gtid; idx < total; idx += gthreads) {
        const int n = idx % Npad, kc = idx / Npad;
        const int src = (MODE == 0) ? n : (MODE == 1 ? map_in(n) : map_uq(n));
        float f[8];
#pragma unroll
        for (int i = 0; i < 8; ++i) f[i] = (src >= 0) ? W[(size_t)(kc * 8 + i) * Nsrc + src] : 0.f;
        u32x4 o; o.x = pk2(f[0], f[1]); o.y = pk2(f[2], f[3]); o.z = pk2(f[4], f[5]); o.w = pk2(f[6], f[7]);
        *(u32x4*)(Wt + (size_t)n * K + kc * 8) = o;
    }
}
template <int MODE> __device__ __forceinline__ void transpose_item(const float* W, int K, int Nsrc, bf16_t* Wt, int Npad, LAS float* scr, int item, int lane) {
    const int nblk = Npad / 32, kb = item / nblk, nb = item % nblk, k0 = 64 * kb, n0 = 32 * nb;
    const int nn = n0 + (lane & 31), src = (MODE == 0) ? nn : (MODE == 1 ? map_in(nn) : map_uq(nn));
#pragma unroll 8
    for (int i = 0; i < 32; ++i) { const int kk = 2 * i + (lane >> 5); scr[kk * 33 + (lane & 31)] = (src >= 0) ? W[(size_t)(k0 + kk) * Nsrc + src] : 0.f; }
    asm volatile("s_waitcnt lgkmcnt(0)" ::: "memory");
    const int c = lane & 7;
#pragma unroll
    for (int j = 0; j < 4; ++j) { const int n = (lane >> 3) + 8 * j; const LAS float* s = scr + (8 * c) * 33 + n;
        u32x4 o; o.x = pk2(s[0 * 33], s[1 * 33]); o.y = pk2(s[2 * 33], s[3 * 33]); o.z = pk2(s[4 * 33], s[5 * 33]); o.w = pk2(s[6 * 33], s[7 * 33]);
        *(u32x4*)(Wt + (size_t)(n0 + n) * K + k0 + 8 * c) = o; }
    asm volatile("s_waitcnt lgkmcnt(0)" ::: "memory");
}
__device__ __forceinline__ void phase_prep(const Args& a, LAS unsigned char* lds) {
    unsigned char* ws = a.ws;
    const int tid = KTID, gtid = blockIdx.x * NTHR + tid, gthreads = KGRID * NTHR;
    {
        const int wave = kwave(), lane = klane(), gw = blockIdx.x * NWAVES + wave, ngw = KGRID * NWAVES;
        LAS float* scr = (LAS float*)(lds + 8192 + wave * 8704);
        for (int it = gw; it < 2 * 5856; it += ngw) {
            const int l = it / 5856; int r = it % 5856;
            if (r < 1024) { transpose_item<1>(a.in[I_WIN] + (size_t)l * DM * IN_COLS, DM, IN_COLS, (bf16_t*)(ws + WS_WIN) + (size_t)l * INP * DM, INP, scr, r, lane); continue; } r -= 1024;
            if (r < 512) { transpose_item<0>(a.in[I_WOUT] + (size_t)l * DM * DM, DM, DM, (bf16_t*)(ws + WS_WOUT) + (size_t)l * DM * DM, DM, scr, r, lane); continue; } r -= 512;
            if (r < 96) { transpose_item<2>(a.in[I_WUQ] + (size_t)l * 256 * 768, 256, 768, (bf16_t*)(ws + WS_WUQ) + (size_t)l * 768 * 256, 768, scr, r, lane); continue; } r -= 96;
            if (r < 128) { transpose_item<0>(a.in[I_WUKV] + (size_t)l * 256 * 1024, 256, 1024, (bf16_t*)(ws + WS_WUKV) + (size_t)l * 1024 * 256, 1024, scr, r, lane); continue; } r -= 128;
            if (r < 2048) { transpose_item<0>(a.in[I_WFF1] + (size_t)l * DM * FF, DM, FF, (bf16_t*)(ws + WS_WFF1) + (size_t)l * FF * DM, FF, scr, r, lane); continue; } r -= 2048;
            transpose_item<0>(a.in[I_WFF2] + (size_t)l * FF * DM, FF, DM, (bf16_t*)(ws + WS_WFF2) + (size_t)l * DM * FF, DM, scr, r, lane);
        }
    }
    for (int idx = gtid; idx < 2 * 4 * 128 * 128 / 4; idx += gthreads) { const f32x4 v = *(const f32x4*)(a.in[I_SGW] + (size_t)idx * 4); u32x2 o; o.x = pk2(v.x, v.y); o.y = pk2(v.z, v.w); *(u32x2*)((bf16_t*)(ws + WS_WSB) + (size_t)idx * 4) = o; }
    { const int ridx = ((int)blockIdx.x - (KGRID - 4)) * NTHR + tid;
      if (ridx >= 0 && ridx < 128 * 16) {
        const int p = ridx >> 4, i = ridx & 15;
        const float freq = powf(10000.0f, -(float)i * 2.0f / 32.0f);
        const float ang = (float)p * freq;
        float sn, cs; sincosf(ang, &sn, &cs);
        float* R = (float*)(ws + WS_ROPE);
        R[ridx * 2 + 0] = cs; R[ridx * 2 + 1] = sn;
      } }
    {
        LAS float* red = (LAS float*)lds;
        LAS float* sil = (LAS float*)(lds + 80 * 1024);
        const int wave = kwave(), lane = klane();
        if ((int)blockIdx.x < 2 * 96) {
            for (int i = tid; i < 3 * DM; i += NTHR) { const float v = i < 2 * DM ? a.in[I_C][i] : a.in[I_CCTX][i - 2 * DM]; sil[i] = silu_f(v); }
        }
        __syncthreads();
        for (int item = blockIdx.x; item < 2 * 96; item += KGRID) {
            const int l = item / 96, j = (item % 96) * 64 + lane;
            const float* W = a.in[I_WMOD] + (size_t)l * DM * 6144 + (size_t)(wave * 128) * 6144 + j;
            float s0 = 0.f, s1 = 0.f, s2 = 0.f;
#pragma unroll 16
            for (int kk = 0; kk < 128; ++kk) {
                const float w = W[(size_t)kk * 6144];
                const int k2 = wave * 128 + kk;
                s0 += sil[k2] * w; s1 += sil[DM + k2] * w; s2 += sil[2 * DM + k2] * w;
            }
            red[(wave * 3 + 0) * 64 + lane] = s0; red[(wave * 3 + 1) * 64 + lane] = s1; red[(wave * 3 + 2) * 64 + lane] = s2;
            __syncthreads();
            if (tid < 192) {
                const int r = tid >> 6; float s = 0.f;
#pragma unroll
                for (int w = 0; w < 8; ++w) s += red[(w * 3 + r) * 64 + lane];
                ((float*)(ws + WS_MOD))[(size_t)(l * 3 + r) * 6144 + j] = s + a.in[I_BMOD][l * 6144 + j];
            }
            __syncthreads();
        }
    }
}

__device__ __forceinline__ void phase_norm_mod(const float* xl, const float* xc, const float* nw, const float* mod, int sh_off, int sc_off, bf16_t* H, int nrows) {
    const int lane = klane(), gw = blockIdx.x * NWAVES + kwave(), ngw = KGRID * NWAVES;
    for (int row = gw; row < nrows; row += ngw) {
        const float* src = row < ML ? xl + (size_t)row * DM : xc + (size_t)(row - ML) * DM;
        const float* m = mod + (row < ML ? row / NL : 2) * 6144;
        f32x4 v[4]; float ss = 0.f;
#pragma unroll
        for (int j = 0; j < 4; ++j) { v[j] = *(const f32x4*)(src + lane * 4 + 256 * j); ss += v[j].x * v[j].x + v[j].y * v[j].y + v[j].z * v[j].z + v[j].w * v[j].w; }
        const float rstd = rsqrtf(wave_sum(ss) * (1.f / DM) + EPS);
#pragma unroll
        for (int j = 0; j < 4; ++j) {
            const int c = lane * 4 + 256 * j;
            const f32x4 w = *(const f32x4*)(nw + c), sc = *(const f32x4*)(m + sc_off + c), sh = *(const f32x4*)(m + sh_off + c);
            const f32x4 o = (v[j] * rstd * w) * (sc + 1.f) + sh;
            u32x2 pk; pk.x = pk2(o.x, o.y); pk.y = pk2(o.z, o.w);
            *(u32x2*)(H + (size_t)row * DM + c) = pk;
        }
    }
}

template <class Epi> __device__ __forceinline__ void gemm_naive(const bf16_t* A, int lda, const bf16_t* Bt, int M, int N, int K, const Epi& E, LAS unsigned char* lds) {
    LAS float* As = (LAS float*)lds;
    LAS float* Bs = As + 32 * 132;
    const int tid = KTID, ty = tid >> 4, tx = tid & 15;
    const int ntm = M / 128, ntn = N / 64, ntiles = ntm * ntn;
    for (int tile = blockIdx.x; tile < ntiles; tile += KGRID) {
        const int tm = tile / ntn, tn = tile % ntn, row0 = tm * 128, col0 = tn * 64;
        float acc[4][4];
#pragma unroll
        for (int i = 0; i < 4; ++i)
#pragma unroll
            for (int j = 0; j < 4; ++j) acc[i][j] = 0.f;
        for (int k0 = 0; k0 < K; k0 += 32) {
            {
                const int r = tid >> 2, kc = (tid & 3) * 8; float f[8];
                unpack8(*(const u32x4*)(A + (size_t)(row0 + r) * lda + k0 + kc), f);
#pragma unroll
                for (int i = 0; i < 8; ++i) As[(kc + i) * 132 + r] = f[i];
                if (tid < 256) {
                    unpack8(*(const u32x4*)(Bt + (size_t)(col0 + r) * K + k0 + kc), f);
#pragma unroll
                    for (int i = 0; i < 8; ++i) Bs[(kc + i) * 68 + r] = f[i];
                }
            }
            __syncthreads();
#pragma unroll 8
            for (int k = 0; k < 32; ++k) {
                const f32x4 av = *(const LAS f32x4*)(As + k * 132 + ty * 4), bv = *(const LAS f32x4*)(Bs + k * 68 + tx * 4);
#pragma unroll
                for (int i = 0; i < 4; ++i)
#pragma unroll
                    for (int j = 0; j < 4; ++j) acc[i][j] += av[i] * bv[j];
            }
            __syncthreads();
        }
#pragma unroll
        for (int i = 0; i < 4; ++i) E(row0 + ty * 4 + i, col0 + tx * 4, (f32x4){acc[i][0], acc[i][1], acc[i][2], acc[i][3]});
    }
}

__device__ __forceinline__ void st4bf(bf16_t* p, f32x4 v) { u32x2 pk; pk.x = pk2(v.x, v.y); pk.y = pk2(v.z, v.w); *(u32x2*)p = pk; }
__device__ __forceinline__ f32x4 rope4(f32x4 v, int jj, int t, const float* R) {
    const int pos = (jj < 32) ? (t >> 6) : (t & 63), i0 = ((jj & 31) >> 1);
    const f32x4 cs = *(const f32x4*)(R + (pos * 16 + i0) * 2);
    return (f32x4){v.x * cs.x - v.y * cs.y, v.x * cs.y + v.y * cs.x, v.z * cs.z - v.w * cs.w, v.z * cs.w + v.w * cs.z};
}
struct EpiInProj { bf16_t* PB; const float* R;
    __device__ __forceinline__ void operator()(int row, int col, f32x4 v) const {
        const int tile = col >> 8;
        if (tile == 2 || tile == 3) { v = (f32x4){gelu_tanh(v.x), gelu_tanh(v.y), gelu_tanh(v.z), gelu_tanh(v.w)}; }
        else if (tile == 5) { v = (f32x4){silu_f(v.x), silu_f(v.y), silu_f(v.z), silu_f(v.w)}; }
        else if (tile == 7) { const int cc = col - C_KR; if (cc < 64 && row < ML) v = rope4(v, cc, row & (NL - 1), R); }
        st4bf(PB + (size_t)row * INP + col, v);
    } };
struct EpiUQ { bf16_t* QB;
    __device__ __forceinline__ void operator()(int row, int col, f32x4 v) const { st4bf(QB + (size_t)row * 768 + col, v * QSCALE); } };
struct EpiUKV { bf16_t* KVB;
    __device__ __forceinline__ void operator()(int row, int col, f32x4 v) const { st4bf(KVB + (size_t)row * 1024 + col, v); } };
struct EpiResid { const float* xin_l; const float* xin_c; float* xout_l; float* xout_c; const float* mod; int g_off;
    __device__ __forceinline__ void operator()(int row, int col, f32x4 v) const {
        if (row < ML) { const f32x4 g = *(const f32x4*)(mod + (row >> 13) * 6144 + g_off + col), xi = *(const f32x4*)(xin_l + (size_t)row * DM + col);
            *(f32x4*)(xout_l + (size_t)row * DM + col) = xi + g * v;
        } else { const int rc = row - ML; const f32x4 g = *(const f32x4*)(mod + 2 * 6144 + g_off + col), xi = *(const f32x4*)(xin_c + (size_t)rc * DM + col);
            *(f32x4*)(xout_c + (size_t)rc * DM + col) = xi + g * v; }
    } };
struct EpiFF1 { bf16_t* Ah;
    __device__ __forceinline__ void operator()(int row, int col, f32x4 v) const {
        f32x4 r = (f32x4){fmaxf(v.x, 0.f), fmaxf(v.y, 0.f), fmaxf(v.z, 0.f), fmaxf(v.w, 0.f)};
        st4bf(Ah + (size_t)row * FF + col, r * r);
    } };

__device__ __forceinline__ void phase_post(const Args& a, int l) {
    unsigned char* ws = a.ws;
    bf16_t* PB = (bf16_t*)(ws + WS_PB); float* LG = (float*)(ws + WS_LG);
    const float* kvnw = a.in[I_KVNW] + l * 256; const float* qnw = a.in[I_QNW] + l * 256;
    const float* snw = a.in[I_SGNW] + l * 256; const float* snb = a.in[I_SGNB] + l * 256;
    const float* wgf = a.in[I_GWF] + l * 16 * 128; const float* bgf = a.in[I_GBF] + l * 128;
    const float* wgb = a.in[I_GWB] + l * 16 * 128; const float* bgb = a.in[I_GBB] + l * 128;
    const int lane = klane(), gw = blockIdx.x * NWAVES + kwave(), ngw = KGRID * NWAVES;
    for (int row = gw; row < MT; row += ngw) {
        bf16_t* pr = PB + (size_t)row * INP;
        const int c = lane * 4;
        { u32x2 w = *(const u32x2*)(pr + C_CKV + c); f32x4 v = {__uint_as_float(w.x << 16), __uint_as_float(w.x & 0xffff0000u), __uint_as_float(w.y << 16), __uint_as_float(w.y & 0xffff0000u)};
          const float rstd = rsqrtf(wave_sum(v.x * v.x + v.y * v.y + v.z * v.z + v.w * v.w) * (1.f / 256.f) + EPS);
          st4bf(pr + C_CKV + c, v * rstd * *(const f32x4*)(kvnw + c)); }
        { u32x2 w = *(const u32x2*)(pr + C_DQ + c); f32x4 v = {__uint_as_float(w.x << 16), __uint_as_float(w.x & 0xffff0000u), __uint_as_float(w.y << 16), __uint_as_float(w.y & 0xffff0000u)};
          const float rstd = rsqrtf(wave_sum(v.x * v.x + v.y * v.y + v.z * v.z + v.w * v.w) * (1.f / 256.f) + EPS);
          st4bf(pr + C_DQ + c, v * rstd * *(const f32x4*)(qnw + c)); }
        { u32x2 w = *(const u32x2*)(pr + C_SV + c); f32x4 v = {__uint_as_float(w.x << 16), __uint_as_float(w.x & 0xffff0000u), __uint_as_float(w.y << 16), __uint_as_float(w.y & 0xffff0000u)};
          const float mu = wave_sum(v.x + v.y + v.z + v.w) * (1.f / 256.f);
          v = v - mu;
          const float rstd = rsqrtf(wave_sum(v.x * v.x + v.y * v.y + v.z * v.z + v.w * v.w) * (1.f / 256.f) + EPS);
          st4bf(pr + C_SV + c, v * rstd * *(const f32x4*)(snw + c) + *(const f32x4*)(snb + c)); }
        if (GLA_NAIVE) { const int o = lane * 4, isb = o >> 7, d = o & 127;
          const float* wg = isb ? wgb : wgf; const float* bg = isb ? bgb : bgf; const bf16_t* gg = pr + (isb ? C_GGB : C_GGF);
          f32x4 z = *(const f32x4*)(bg + d);
#pragma unroll
          for (int r = 0; r < 16; ++r) z += *(const f32x4*)(wg + r * 128 + d) * bf2f(gg[r]);
          *(f32x4*)(LG + (size_t)row * 256 + o) = (f32x4){log_sigmoid_f(z.x), log_sigmoid_f(z.y), log_sigmoid_f(z.z), log_sigmoid_f(z.w)} * (1.f / 16.f); }
    }
}

__device__ __forceinline__ void phase_sgu_naive(const Args& a, int l) {
    unsigned char* ws = a.ws;
    const bf16_t* PB = (const bf16_t*)(ws + WS_PB); bf16_t* Y = (bf16_t*)(ws + WS_HY);
    const float* Ws = a.in[I_SGW] + (size_t)l * 4 * 128 * 128; const float* bs = a.in[I_SGB] + l * 4 * 128;
    const int tid = KTID, i = tid >> 2, eg = (tid & 3) * 16;
    for (int unit = blockIdx.x; unit < (MT / 128) * 4; unit += KGRID) {
        const int cc = unit >> 2, h = unit & 3;
        float acc[16];
#pragma unroll
        for (int e = 0; e < 16; ++e) acc[e] = 0.f;
        const float* wrow = Ws + ((size_t)h * 128 + i) * 128;
        for (int j = 0; j < 128; ++j) {
            const float w = wrow[j];
            const bf16_t* vp = PB + (size_t)(cc * 128 + j) * INP + C_SV + h * 64 + eg;
            float f[8], g[8]; unpack8(*(const u32x4*)vp, f); unpack8(*(const u32x4*)(vp + 8), g);
#pragma unroll
            for (int e = 0; e < 8; ++e) { acc[e] += w * f[e]; acc[8 + e] += w * g[e]; }
        }
        const float bias = bs[h * 128 + i];
        const int row = cc * 128 + i;
        const bf16_t* up = PB + (size_t)row * INP + C_SU + h * 64 + eg;
        float f[8], g[8]; unpack8(*(const u32x4*)up, f); unpack8(*(const u32x4*)(up + 8), g);
        bf16_t* yp = Y + (size_t)row * DM + h * 64 + eg;
        u32x4 o0, o1;
        o0.x = pk2(f[0] * (acc[0] + bias), f[1] * (acc[1] + bias)); o0.y = pk2(f[2] * (acc[2] + bias), f[3] * (acc[3] + bias));
        o0.z = pk2(f[4] * (acc[4] + bias), f[5] * (acc[5] + bias)); o0.w = pk2(f[6] * (acc[6] + bias), f[7] * (acc[7] + bias));
        o1.x = pk2(g[0] * (acc[8] + bias), g[1] * (acc[9] + bias)); o1.y = pk2(g[2] * (acc[10] + bias), g[3] * (acc[11] + bias));
        o1.z = pk2(g[4] * (acc[12] + bias), g[5] * (acc[13] + bias)); o1.w = pk2(g[6] * (acc[14] + bias), g[7] * (acc[15] + bias));
        *(u32x4*)yp = o0; *(u32x4*)(yp + 8) = o1;
    }
}

__device__ __forceinline__ void phase_gla_naive(const Args& a, int l) {
    unsigned char* ws = a.ws;
    const bf16_t* PB = (const bf16_t*)(ws + WS_PB); bf16_t* Y = (bf16_t*)(ws + WS_HY);
    const float* LG = (const float*)(ws + WS_LG); float* OB = (float*)(ws + WS_OB);
    const float* gnw = a.in[I_GNW] + l * 64;
    if (blockIdx.x >= 8 || KTID >= 64) return;
    const int b = blockIdx.x >> 2, h = blockIdx.x & 3, e = KTID;
    const float gw_e = gnw[e];
    for (int dir = 1; dir >= 0; --dir) {
        float S[32];
#pragma unroll
        for (int d = 0; d < 32; ++d) S[d] = 0.f;
        for (int tau = 0; tau < NKEY; ++tau) {
            int row;
            if (dir == 0) row = tau < NC ? ML + b * NC + tau : b * NL + (tau - NC);
            else row = tau < NC ? ML + b * NC + (NC - 1 - tau) : b * NL + (NL - 1 - (tau - NC));
            const bf16_t* pr = PB + (size_t)row * INP;
            const float* lg = LG + (size_t)row * 256 + dir * 128 + h * 32;
            const float v = bf2f(pr[C_GV + h * 64 + e]);
            float o = 0.f;
#pragma unroll
            for (int d = 0; d < 32; ++d) {
                const float kk = bf2f(pr[C_GK + h * 32 + d]), qq = bf2f(pr[C_GQ + h * 32 + d]), al = expf(lg[d]);
                S[d] = al * S[d] + kk * v; o += qq * S[d];
            }
            o *= 0.17677669529663687f;
            if (dir == 1) OB[(size_t)row * 256 + h * 64 + e] = o;
            else {
                o += OB[(size_t)row * 256 + h * 64 + e];
                const float ms = wave_sum(o * o) * (1.f / 64.f);
                const float y = o * rsqrtf(ms + EPS) * gw_e * bf2f(pr[C_GR + h * 64 + e]);
                Y[(size_t)row * DM + 256 + h * 64 + e] = (bf16_t)f2bf(y);
            }
        }
    }
}

typedef short bf16x8 __attribute__((ext_vector_type(8)));
typedef float f32x16 __attribute__((ext_vector_type(16)));
typedef float f32x2_t __attribute__((ext_vector_type(2)));
typedef __bf16 bf16x2_t __attribute__((ext_vector_type(2)));
__device__ __forceinline__ unsigned cvtpk(float lo, float hi) { f32x2_t v = {lo, hi}; bf16x2_t b = __builtin_convertvector(v, bf16x2_t); return __builtin_bit_cast(unsigned, b); }
__device__ __forceinline__ int crow(int r, int hi) { return (r & 3) + 8 * (r >> 2) + 4 * hi; }
constexpr int GLA_WLDS = 17920, GLA_NB = 132;
constexpr size_t WS_BC = WS_LG, WS_GL = WS_OB, WS_GD = 1 * MiB + 512 * 1024;
static_assert((size_t)2112 * 2048 * 4 <= WS_END - WS_OB && WS_GD + (size_t)2112 * 32 * 4 <= WS_WIN && WS_ROPE + 16384 <= WS_GD && WS_WSB + 262144 <= WS_WUKV && WS_WUQ + (size_t)2 * 768 * 256 * 2 <= WS_WSB, "gla ws");
__device__ __forceinline__ int gla_row0(int b, int beta) { return beta < 4 ? ML + b * NC + beta * 64 : b * NL + (beta - 4) * 64; }
#define LDS_FENCE() do { asm volatile("s_waitcnt lgkmcnt(0)" ::: "memory"); __builtin_amdgcn_sched_barrier(0); } while (0)
__device__ __forceinline__ void gla_stage_vt(const bf16_t* pv, LAS bf16_t* VT, int lane) {
#pragma unroll
    for (int c8 = 0; c8 < 8; ++c8) { const u32x4 w = *(const u32x4*)(pv + c8 * 8);
        VT[(c8 * 8 + 0) * 64 + lane] = (bf16_t)(w.x & 0xffffu); VT[(c8 * 8 + 1) * 64 + lane] = (bf16_t)(w.x >> 16);
        VT[(c8 * 8 + 2) * 64 + lane] = (bf16_t)(w.y & 0xffffu); VT[(c8 * 8 + 3) * 64 + lane] = (bf16_t)(w.y >> 16);
        VT[(c8 * 8 + 4) * 64 + lane] = (bf16_t)(w.z & 0xffffu); VT[(c8 * 8 + 5) * 64 + lane] = (bf16_t)(w.z >> 16);
        VT[(c8 * 8 + 6) * 64 + lane] = (bf16_t)(w.w & 0xffffu); VT[(c8 * 8 + 7) * 64 + lane] = (bf16_t)(w.w >> 16); }
}
__device__ __forceinline__ void load32bf(const bf16_t* p, float* f) {
    unpack8(*(const u32x4*)(p), f); unpack8(*(const u32x4*)(p + 8), f + 8); unpack8(*(const u32x4*)(p + 16), f + 16); unpack8(*(const u32x4*)(p + 24), f + 24);
}
__device__ __forceinline__ void phase_gla_local(const Args& a, int l, LAS unsigned char* lds) {
    unsigned char* ws = a.ws;
    const bf16_t* PB = (const bf16_t*)(ws + WS_PB); float* BC = (float*)(ws + WS_BC); float* GL = (float*)(ws + WS_GL); float* GD = (float*)(ws + WS_GD);
    const int lane = klane(), wave = kwave(), gw = blockIdx.x * NWAVES + wave, ngw = KGRID * NWAVES;
    const int r32 = lane & 31, hi = lane >> 5;
    LAS bf16_t* KT = (LAS bf16_t*)(lds + wave * GLA_WLDS); LAS bf16_t* VT = KT + 32 * 64;
    for (int task = gw; task < 16 * GLA_NB; task += ngw) {
        const int beta = task % GLA_NB, t2 = task / GLA_NB, dir = t2 & 1, h = (t2 >> 1) & 3, b = t2 >> 3;
        const int row = gla_row0(b, beta) + lane; const bf16_t* pr = PB + (size_t)row * INP;
        LDS_FENCE();
        gla_stage_vt(pr + C_GV + h * 64, VT, lane);
        float c[32];
        {
          const float* wg = (dir ? a.in[I_GWB] : a.in[I_GWF]) + l * 16 * 128 + h * 32; const float* bg = (dir ? a.in[I_GBB] : a.in[I_GBF]) + l * 128 + h * 32;
          LAS float* WGL = (LAS float*)(VT + 64 * 64); LAS float* BGL = WGL + 16 * 32;
          { const int r = lane >> 2, d0 = (lane & 3) * 8;
            *(LAS f32x4*)(WGL + r * 32 + d0) = *(const f32x4*)(wg + r * 128 + d0); *(LAS f32x4*)(WGL + r * 32 + d0 + 4) = *(const f32x4*)(wg + r * 128 + d0 + 4);
            if (lane < 32) BGL[lane] = bg[lane]; }
          float gg[16]; unpack8(*(const u32x4*)(pr + (dir ? C_GGB : C_GGF)), gg); unpack8(*(const u32x4*)(pr + (dir ? C_GGB : C_GGF) + 8), gg + 8);
          LDS_FENCE();
#pragma unroll
          for (int d = 0; d < 32; d += 4) { f32x4 z = *(const LAS f32x4*)(BGL + d);
#pragma unroll
              for (int r = 0; r < 16; ++r) z += *(const LAS f32x4*)(WGL + r * 32 + d) * gg[r];
              c[d] = log_sigmoid_f(z.x) * (1.f / 16.f); c[d + 1] = log_sigmoid_f(z.y) * (1.f / 16.f); c[d + 2] = log_sigmoid_f(z.z) * (1.f / 16.f); c[d + 3] = log_sigmoid_f(z.w) * (1.f / 16.f); } }
        if (dir == 0) {
#pragma unroll
            for (int d = 0; d < 32; ++d) { float v = c[d];
#pragma unroll
                for (int off = 1; off < 64; off <<= 1) { const float t = __shfl_up(v, off); if (lane >= off) v += t; }
                c[d] = v; }
        } else {
#pragma unroll
            for (int d = 0; d < 32; ++d) { float v = c[d];
#pragma unroll
                for (int off = 1; off < 64; off <<= 1) { const float t = __shfl_down(v, off); if (lane + off < 64) v += t; }
                c[d] = v; }
        }
        { float* bc = BC + (size_t)row * 256 + dir * 128 + h * 32;
#pragma unroll
          for (int d = 0; d < 32; d += 4) *(f32x4*)(bc + d) = (f32x4){c[d], c[d + 1], c[d + 2], c[d + 3]}; }
        float kk[32]; load32bf(pr + C_GK + h * 32, kk);
        const int tl = dir ? 0 : 63;
#pragma unroll
        for (int d = 0; d < 32; ++d) { const float T = __shfl(c[d], tl);
            KT[d * 64 + lane] = (bf16_t)(cvtpk(kk[d] * __expf(T - c[d]), 0.f) & 0xffffu);
            if (lane == 0) GD[(size_t)task * 32 + d] = __expf(T); }
        LDS_FENCE();
        f32x16 acc0 = {}, acc1 = {};
#pragma unroll
        for (int s = 0; s < 4; ++s) {
            const bf16x8 af = *(const LAS bf16x8*)(KT + r32 * 64 + 16 * s + 8 * hi);
            const bf16x8 b0 = *(const LAS bf16x8*)(VT + r32 * 64 + 16 * s + 8 * hi), b1 = *(const LAS bf16x8*)(VT + (32 + r32) * 64 + 16 * s + 8 * hi);
            acc0 = __builtin_amdgcn_mfma_f32_32x32x16_bf16(af, b0, acc0, 0, 0, 0); acc1 = __builtin_amdgcn_mfma_f32_32x32x16_bf16(af, b1, acc1, 0, 0, 0);
        }
        float* gl = GL + (size_t)task * 2048;
#pragma unroll
        for (int r = 0; r < 16; ++r) { gl[crow(r, hi) * 64 + r32] = acc0[r]; gl[crow(r, hi) * 64 + 32 + r32] = acc1[r]; }
    }
}
__device__ __forceinline__ void phase_gla_scan(const Args& a) {
    unsigned char* ws = a.ws; float* GL = (float*)(ws + WS_GL); const float* GD = (const float*)(ws + WS_GD);
    const int idx = ((int)blockIdx.x - (KGRID - 64)) * NTHR + KTID;
    if (idx < 0 || idx >= 16 * 2048) return;
    const int seq = idx >> 11, de = idx & 2047, d = de >> 6, dir = seq & 1;
    float S = 0.f;
    for (int c0 = 0; c0 < GLA_NB; c0 += 12) {
        float Lv[12], Dv[12];
#pragma unroll
        for (int u = 0; u < 12; ++u) { const int c = c0 + u, beta = dir ? (c < 4 ? 3 - c : 135 - c) : c; const size_t slot = (size_t)seq * GLA_NB + beta;
            Lv[u] = GL[slot * 2048 + de]; Dv[u] = GD[slot * 32 + d]; }
#pragma unroll
        for (int u = 0; u < 12; ++u) { const int c = c0 + u, beta = dir ? (c < 4 ? 3 - c : 135 - c) : c; const size_t slot = (size_t)seq * GLA_NB + beta;
            GL[slot * 2048 + de] = S; S = Dv[u] * S + Lv[u]; }
    }
}
template <int DIR> __device__ __forceinline__ void gla_dir(const bf16_t* pr, const float* bc, const float* sin, int h, LAS bf16_t* QS, LAS bf16_t* KS, const LAS bf16_t* VT, int lane,
                                                            f32x16& o00, f32x16& o01, f32x16& o10, f32x16& o11) {
    const int r32 = lane & 31, hi = lane >> 5;
    {
        float c[32], q[32], k[32];
#pragma unroll
        for (int d = 0; d < 32; d += 4) { const f32x4 v = *(const f32x4*)(bc + d); c[d] = v.x; c[d + 1] = v.y; c[d + 2] = v.z; c[d + 3] = v.w; }
        load32bf(pr + C_GQ + h * 32, q); load32bf(pr + C_GK + h * 32, k);
#pragma unroll
        for (int d = 0; d < 32; d += 8) {
            u32x4 wq, wk; float eq[8], ek[8];
#pragma unroll
            for (int i = 0; i < 8; ++i) { eq[i] = q[d + i] * __expf(c[d + i]) * 0.17677669529663687f; ek[i] = k[d + i] * __expf(-c[d + i]); }
            wq.x = cvtpk(eq[0], eq[1]); wq.y = cvtpk(eq[2], eq[3]); wq.z = cvtpk(eq[4], eq[5]); wq.w = cvtpk(eq[6], eq[7]);
            wk.x = cvtpk(ek[0], ek[1]); wk.y = cvtpk(ek[2], ek[3]); wk.z = cvtpk(ek[4], ek[5]); wk.w = cvtpk(ek[6], ek[7]);
            *(LAS u32x4*)(QS + lane * 32 + d) = wq; *(LAS u32x4*)(KS + lane * 32 + d) = wk;
        }
    }
    LDS_FENCE();
    bf16x8 qf[2][2], kf[2][2];
#pragma unroll
    for (int t = 0; t < 2; ++t)
#pragma unroll
        for (int s = 0; s < 2; ++s) { qf[t][s] = *(const LAS bf16x8*)(QS + (32 * t + r32) * 32 + 16 * s + 8 * hi); kf[t][s] = *(const LAS bf16x8*)(KS + (32 * t + r32) * 32 + 16 * s + 8 * hi); }
    LDS_FENCE();
    {
        u32x4 w[4];
#pragma unroll
        for (int d = 0; d < 32; d += 8) {
            float sv[8];
#pragma unroll
            for (int i = 0; i < 8; ++i) sv[i] = sin[(d + i) * 64 + lane];
            w[d >> 3].x = cvtpk(sv[0], sv[1]); w[d >> 3].y = cvtpk(sv[2], sv[3]); w[d >> 3].z = cvtpk(sv[4], sv[5]); w[d >> 3].w = cvtpk(sv[6], sv[7]);
        }
#pragma unroll
        for (int i = 0; i < 4; ++i) *(LAS u32x4*)(QS + lane * 32 + 8 * i) = w[i];
    }
#define GLA_X(tj, ti) __builtin_amdgcn_mfma_f32_32x32x16_bf16(kf[tj][1], qf[ti][1], __builtin_amdgcn_mfma_f32_32x32x16_bf16(kf[tj][0], qf[ti][0], (f32x16){}, 0, 0, 0), 0, 0, 0)
#define GLA_MASK(X) do { _Pragma("unroll") for (int r = 0; r < 16; ++r) { const int jl = crow(r, hi); const bool keep = DIR == 0 ? (jl <= r32) : (jl >= r32); X[r] = keep ? X[r] : 0.f; } } while (0)
#define GLA_XA(X, s) __builtin_bit_cast(bf16x8, (u32x4){cvtpk(X[8 * (s) + 0], X[8 * (s) + 1]), cvtpk(X[8 * (s) + 2], X[8 * (s) + 3]), cvtpk(X[8 * (s) + 4], X[8 * (s) + 5]), cvtpk(X[8 * (s) + 6], X[8 * (s) + 7])})
#define GLA_VF(tj, s, te) __builtin_bit_cast(bf16x8, (u32x4){((const LAS u32x2*)(VT + (32 * (te) + r32) * 64 + 32 * (tj) + 16 * (s) + 4 * hi))->x, ((const LAS u32x2*)(VT + (32 * (te) + r32) * 64 + 32 * (tj) + 16 * (s) + 4 * hi))->y, \
                                                              ((const LAS u32x2*)(VT + (32 * (te) + r32) * 64 + 32 * (tj) + 16 * (s) + 8 + 4 * hi))->x, ((const LAS u32x2*)(VT + (32 * (te) + r32) * 64 + 32 * (tj) + 16 * (s) + 8 + 4 * hi))->y})
#define GLA_PV(X, tj, O0, O1) do { _Pragma("unroll") for (int s = 0; s < 2; ++s) { const bf16x8 xa = GLA_XA(X, s); \
        O0 = __builtin_amdgcn_mfma_f32_32x32x16_bf16(xa, GLA_VF(tj, s, 0), O0, 0, 0, 0); O1 = __builtin_amdgcn_mfma_f32_32x32x16_bf16(xa, GLA_VF(tj, s, 1), O1, 0, 0, 0); } } while (0)
    __builtin_amdgcn_sched_barrier(0);
    { f32x16 X = GLA_X(0, 0); GLA_MASK(X); GLA_PV(X, 0, o00, o01); }
    __builtin_amdgcn_sched_barrier(0);
    { f32x16 X = GLA_X(1, 1); GLA_MASK(X); GLA_PV(X, 1, o10, o11); }
    __builtin_amdgcn_sched_barrier(0);
    if (DIR == 0) { f32x16 X = GLA_X(0, 1); GLA_PV(X, 0, o10, o11); }
    else          { f32x16 X = GLA_X(1, 0); GLA_PV(X, 1, o00, o01); }
    LDS_FENCE();
#pragma unroll
    for (int s = 0; s < 2; ++s) {
        const bf16x8 s0 = *(const LAS bf16x8*)(QS + r32 * 32 + 16 * s + 8 * hi), s1 = *(const LAS bf16x8*)(QS + (32 + r32) * 32 + 16 * s + 8 * hi);
        o00 = __builtin_amdgcn_mfma_f32_32x32x16_bf16(qf[0][s], s0, o00, 0, 0, 0); o01 = __builtin_amdgcn_mfma_f32_32x32x16_bf16(qf[0][s], s1, o01, 0, 0, 0);
        o10 = __builtin_amdgcn_mfma_f32_32x32x16_bf16(qf[1][s], s0, o10, 0, 0, 0); o11 = __builtin_amdgcn_mfma_f32_32x32x16_bf16(qf[1][s], s1, o11, 0, 0, 0);
    }
    LDS_FENCE();
#undef GLA_X
#undef GLA_MASK
#undef GLA_XA
#undef GLA_VF
#undef GLA_PV
}
__device__ __forceinline__ void phase_gla_out(const Args& a, int l, LAS unsigned char* lds) {
    unsigned char* ws = a.ws;
    const bf16_t* PB = (const bf16_t*)(ws + WS_PB); const float* BC = (const float*)(ws + WS_BC); const float* GL = (const float*)(ws + WS_GL); bf16_t* Y = (bf16_t*)(ws + WS_HY);
    const float* gnw = a.in[I_GNW] + l * 64;
    const int lane = klane(), wave = kwave(), gw = blockIdx.x * NWAVES + wave, ngw = KGRID * NWAVES;
    const int r32 = lane & 31, hi = lane >> 5;
    LAS bf16_t* QS = (LAS bf16_t*)(lds + wave * GLA_WLDS); LAS bf16_t* KS = QS + 64 * 32; LAS bf16_t* VT = KS + 64 * 32; LAS float* OS = (LAS float*)(lds + wave * GLA_WLDS);
    for (int task = gw; task < 8 * GLA_NB; task += ngw) {
        const int beta = task % GLA_NB, bh = task / GLA_NB, h = bh & 3, b = bh >> 2;
        const int row = gla_row0(b, beta) + lane; const bf16_t* pr = PB + (size_t)row * INP;
        LDS_FENCE();
        gla_stage_vt(pr + C_GV + h * 64, VT, lane);
        f32x16 o00 = {}, o01 = {}, o10 = {}, o11 = {};
        gla_dir<0>(pr, BC + (size_t)row * 256 + h * 32, GL + ((size_t)(bh * 2 + 0) * GLA_NB + beta) * 2048, h, QS, KS, VT, lane, o00, o01, o10, o11);
        gla_dir<1>(pr, BC + (size_t)row * 256 + 128 + h * 32, GL + ((size_t)(bh * 2 + 1) * GLA_NB + beta) * 2048, h, QS, KS, VT, lane, o00, o01, o10, o11);
#pragma unroll
        for (int r = 0; r < 16; ++r) { const int i = crow(r, hi);
            OS[i * 65 + r32] = o00[r]; OS[i * 65 + 32 + r32] = o01[r]; OS[(32 + i) * 65 + r32] = o10[r]; OS[(32 + i) * 65 + 32 + r32] = o11[r]; }
        LDS_FENCE();
        float ss = 0.f;
#pragma unroll
        for (int e = 0; e < 64; ++e) { const float v = OS[lane * 65 + e]; ss += v * v; }
        const float rstd = rsqrtf(ss * (1.f / 64.f) + EPS);
        bf16_t* yp = Y + (size_t)row * DM + 256 + h * 64;
#pragma unroll
        for (int c8 = 0; c8 < 8; ++c8) { float rr[8]; unpack8(*(const u32x4*)(pr + C_GR + h * 64 + c8 * 8), rr);
            float y[8];
#pragma unroll
            for (int i = 0; i < 8; ++i) y[i] = OS[lane * 65 + c8 * 8 + i] * rstd * gnw[c8 * 8 + i] * rr[i];
            u32x4 w; w.x = cvtpk(y[0], y[1]); w.y = cvtpk(y[2], y[3]); w.z = cvtpk(y[4], y[5]); w.w = cvtpk(y[6], y[7]);
            *(u32x4*)(yp + c8 * 8) = w; }
    }
}

__device__ __forceinline__ void phase_sgu_mfma(const Args& a, int l, LAS unsigned char* lds) {
    unsigned char* ws = a.ws;
    const bf16_t* PB = (const bf16_t*)(ws + WS_PB); bf16_t* Y = (bf16_t*)(ws + WS_HY);
    const bf16_t* WSB = (const bf16_t*)(ws + WS_WSB) + (size_t)l * 4 * 128 * 128; const float* bs = a.in[I_SGB] + l * 4 * 128;
    const int lane = klane(), wave = kwave(), gw = blockIdx.x * NWAVES + wave, ngw = KGRID * NWAVES;
    const int r32 = lane & 31, hi = lane >> 5;
    LAS bf16_t* VT = (LAS bf16_t*)(lds + wave * GLA_WLDS);
    for (int task = gw; task < (MT / 128) * 4; task += ngw) {
        const int cc = task >> 2, h = task & 3;
        LDS_FENCE();
#pragma unroll
        for (int half = 0; half < 2; ++half) { const int j = lane + 64 * half; const bf16_t* pv = PB + (size_t)(cc * 128 + j) * INP + C_SV + h * 64;
#pragma unroll
            for (int c8 = 0; c8 < 8; ++c8) { const u32x4 w = *(const u32x4*)(pv + c8 * 8);
                VT[(c8 * 8 + 0) * 128 + j] = (bf16_t)(w.x & 0xffffu); VT[(c8 * 8 + 1) * 128 + j] = (bf16_t)(w.x >> 16);
                VT[(c8 * 8 + 2) * 128 + j] = (bf16_t)(w.y & 0xffffu); VT[(c8 * 8 + 3) * 128 + j] = (bf16_t)(w.y >> 16);
                VT[(c8 * 8 + 4) * 128 + j] = (bf16_t)(w.z & 0xffffu); VT[(c8 * 8 + 5) * 128 + j] = (bf16_t)(w.z >> 16);
                VT[(c8 * 8 + 6) * 128 + j] = (bf16_t)(w.w & 0xffffu); VT[(c8 * 8 + 7) * 128 + j] = (bf16_t)(w.w >> 16); } }
        LDS_FENCE();
#pragma unroll 1
        for (int ti = 0; ti < 4; ++ti) {
            f32x16 acc0 = {}, acc1 = {};
            const bf16_t* wrow = WSB + ((size_t)h * 128 + 32 * ti + r32) * 128 + 8 * hi;
#pragma unroll
            for (int s = 0; s < 8; ++s) {
                const bf16x8 bw = *(const bf16x8*)(wrow + 16 * s);
                const bf16x8 a0 = *(const LAS bf16x8*)(VT + r32 * 128 + 16 * s + 8 * hi), a1 = *(const LAS bf16x8*)(VT + (32 + r32) * 128 + 16 * s + 8 * hi);
                acc0 = __builtin_amdgcn_mfma_f32_32x32x16_bf16(a0, bw, acc0, 0, 0, 0); acc1 = __builtin_amdgcn_mfma_f32_32x32x16_bf16(a1, bw, acc1, 0, 0, 0);
            }
            const int i = 32 * ti + r32, row = cc * 128 + i; const float bias = bs[h * 128 + i];
            const bf16_t* up = PB + (size_t)row * INP + C_SU + h * 64 + 4 * hi; bf16_t* yp = Y + (size_t)row * DM + h * 64 + 4 * hi;
#pragma unroll
            for (int g = 0; g < 4; ++g) {
                { const u32x2 u = *(const u32x2*)(up + 8 * g); u32x2 o;
                  o.x = cvtpk(__uint_as_float(u.x << 16) * (acc0[4 * g + 0] + bias), __uint_as_float(u.x & 0xffff0000u) * (acc0[4 * g + 1] + bias));
                  o.y = cvtpk(__uint_as_float(u.y << 16) * (acc0[4 * g + 2] + bias), __uint_as_float(u.y & 0xffff0000u) * (acc0[4 * g + 3] + bias));
                  *(u32x2*)(yp + 8 * g) = o; }
                { const u32x2 u = *(const u32x2*)(up + 32 + 8 * g); u32x2 o;
                  o.x = cvtpk(__uint_as_float(u.x << 16) * (acc1[4 * g + 0] + bias), __uint_as_float(u.x & 0xffff0000u) * (acc1[4 * g + 1] + bias));
                  o.y = cvtpk(__uint_as_float(u.y << 16) * (acc1[4 * g + 2] + bias), __uint_as_float(u.y & 0xffff0000u) * (acc1[4 * g + 3] + bias));
                  *(u32x2*)(yp + 32 + 8 * g) = o; }
            }
        }
    }
}

__device__ __forceinline__ void phase_attn_naive(const Args& a, int l, LAS unsigned char* lds) {
    unsigned char* ws = a.ws;
    const bf16_t* QB = (const bf16_t*)(ws + WS_QB); const bf16_t* KVB = (const bf16_t*)(ws + WS_KVB); const bf16_t* PB = (const bf16_t*)(ws + WS_PB); bf16_t* Y = (bf16_t*)(ws + WS_HY);
    const float* ROPE = (const float*)(ws + WS_ROPE);
    LAS float* Qs = (LAS float*)lds;
    LAS float* Ks = Qs + 192 * 64;
    LAS float* Vs = Ks + 96 * 64;
    LAS float* Ps = Vs + 64 * 128;
    const int tid = KTID, ty = tid >> 4, tx = tid & 15;
    const int nunits = 1024 + (l == 0 ? 32 : 0);
    for (int unit = blockIdx.x; unit < nunits; unit += KGRID) {
        int bh, nkeys, orow0;
        if (unit < 1024) { bh = unit >> 7; const int qb = unit & 127; nkeys = NKEY; orow0 = (bh >> 2) * NL + qb * 64; }
        else { const int u = unit - 1024; bh = u >> 2; const int qb = u & 3; nkeys = NC; orow0 = ML + (bh >> 2) * NC + qb * 64; }
        const int h = bh & 3, b = bh >> 2;
        const bf16_t* Qp = QB + (size_t)orow0 * 768 + h * 192;
        __syncthreads();
        for (int idx = tid; idx < 64 * 24; idx += NTHR) { const int r = idx / 24, ch = idx % 24; float f[8]; unpack8(*(const u32x4*)(Qp + (size_t)r * 768 + ch * 8), f);
            if (ch >= 16 && unit < 1024) { const int t = (orow0 + r) & (NL - 1), jj = (ch - 16) * 8;
                const f32x4 r0 = rope4((f32x4){f[0], f[1], f[2], f[3]}, jj, t, ROPE), r1 = rope4((f32x4){f[4], f[5], f[6], f[7]}, jj + 4, t, ROPE);
                f[0] = r0.x; f[1] = r0.y; f[2] = r0.z; f[3] = r0.w; f[4] = r1.x; f[5] = r1.y; f[6] = r1.z; f[7] = r1.w; }
#pragma unroll
            for (int i = 0; i < 8; ++i) Qs[(ch * 8 + i) * 64 + r] = f[i]; }
        float m[2] = {-1e30f, -1e30f}, lsum[2] = {0.f, 0.f}, o[2][8];
#pragma unroll
        for (int r = 0; r < 2; ++r)
#pragma unroll
            for (int c = 0; c < 8; ++c) o[r][c] = 0.f;
        for (int k0 = 0; k0 < nkeys; k0 += 64) {
            const int krow0 = k0 < NC ? ML + b * NC + k0 : b * NL + (k0 - NC);
            float s[2][4];
#pragma unroll
            for (int r = 0; r < 2; ++r)
#pragma unroll
                for (int j = 0; j < 4; ++j) s[r][j] = 0.f;
            for (int dh = 0; dh < 2; ++dh) {
                __syncthreads();
                for (int idx = tid; idx < 64 * 12; idx += NTHR) { const int key = idx / 12, ch = idx % 12; float f[8];
                    const int dcol = dh * 96 + ch * 8;
                    unpack8(dcol < 128 ? *(const u32x4*)(KVB + (size_t)(krow0 + key) * 1024 + h * 256 + dcol) : *(const u32x4*)(PB + (size_t)(krow0 + key) * INP + C_KR + (dcol - 128)), f);
#pragma unroll
                    for (int i = 0; i < 8; ++i) Ks[(ch * 8 + i) * 64 + key] = f[i]; }
                if (dh == 0) {
                    for (int idx = tid; idx < 64 * 16; idx += NTHR) { const int key = idx >> 4, ch = idx & 15; float f[8];
                        unpack8(*(const u32x4*)(KVB + (size_t)(krow0 + key) * 1024 + h * 256 + 128 + ch * 8), f);
#pragma unroll
                        for (int i = 0; i < 8; ++i) Vs[key * 128 + ch * 8 + i] = f[i]; }
                }
                __syncthreads();
#pragma unroll 4
                for (int d = 0; d < 96; ++d) {
                    const float q0 = Qs[(dh * 96 + d) * 64 + 2 * ty], q1 = Qs[(dh * 96 + d) * 64 + 2 * ty + 1];
                    const f32x4 kv = *(const LAS f32x4*)(Ks + d * 64 + 4 * tx);
#pragma unroll
                    for (int j = 0; j < 4; ++j) { s[0][j] += q0 * kv[j]; s[1][j] += q1 * kv[j]; }
                }
            }
#pragma unroll
            for (int r = 0; r < 2; ++r) {
                float mx = fmaxf(fmaxf(s[r][0], s[r][1]), fmaxf(s[r][2], s[r][3]));
                mx = fmaxf(mx, __shfl_xor(mx, 1)); mx = fmaxf(mx, __shfl_xor(mx, 2)); mx = fmaxf(mx, __shfl_xor(mx, 4)); mx = fmaxf(mx, __shfl_xor(mx, 8));
                const float mn = fmaxf(m[r], mx), alpha = exp2f(m[r] - mn);
                float p[4], rs = 0.f;
#pragma unroll
                for (int j = 0; j < 4; ++j) { p[j] = exp2f(s[r][j] - mn); rs += p[j]; Ps[(2 * ty + r) * 65 + 4 * tx + j] = p[j]; }
                rs += __shfl_xor(rs, 1); rs += __shfl_xor(rs, 2); rs += __shfl_xor(rs, 4); rs += __shfl_xor(rs, 8);
                lsum[r] = lsum[r] * alpha + rs; m[r] = mn;
#pragma unroll
                for (int c = 0; c < 8; ++c) o[r][c] *= alpha;
            }
            __syncthreads();
#pragma unroll 4
            for (int j = 0; j < 64; ++j) {
                const float p0 = Ps[(2 * ty) * 65 + j], p1 = Ps[(2 * ty + 1) * 65 + j];
                const f32x4 v0 = *(const LAS f32x4*)(Vs + j * 128 + 8 * tx), v1 = *(const LAS f32x4*)(Vs + j * 128 + 8 * tx + 4);
#pragma unroll
                for (int c = 0; c < 4; ++c) { o[0][c] += p0 * v0[c]; o[0][4 + c] += p0 * v1[c]; o[1][c] += p1 * v0[c]; o[1][4 + c] += p1 * v1[c]; }
            }
        }
#pragma unroll
        for (int r = 0; r < 2; ++r) {
            const float il = 1.f / lsum[r];
            u32x4 w; w.x = pk2(o[r][0] * il, o[r][1] * il); w.y = pk2(o[r][2] * il, o[r][3] * il); w.z = pk2(o[r][4] * il, o[r][5] * il); w.w = pk2(o[r][6] * il, o[r][7] * il);
            *(u32x4*)(Y + (size_t)(orow0 + 2 * ty + r) * DM + 512 + h * 128 + 8 * tx) = w;
        }
    }
}

namespace att {
using s16x4 = __attribute__((ext_vector_type(4))) short;
constexpr int QBLK = 32, KVBLK = 64;
constexpr int SHM_V = KVBLK * 128 * 2, SHM_K = KVBLK * 192 * 2, SHM_SCR = 2 * SHM_V + 2 * SHM_K, SHM_QL = SHM_SCR + NWAVES * 64 * 4, SHM_ATTN = SHM_QL + NWAVES * ATT_NQL * 1024;
constexpr float THR2 = 11.5f;
#define KSWZ(row, colB) ((row) * 384 + ((colB) ^ ((((row) >> 1) & 7) << 4)))
#define SBAR() __builtin_amdgcn_sched_barrier(0)
__device__ __forceinline__ void partialSM(f32x16& p0, f32x16& p1, float& m_reg, float& mn, float& alpha) {
  float pmax = p0[0];
#pragma unroll
  for (int r = 1; r < 16; ++r) pmax = fmaxf(pmax, p0[r]);
#pragma unroll
  for (int r = 0; r < 16; ++r) pmax = fmaxf(pmax, p1[r]);
  { auto rr = __builtin_amdgcn_permlane32_swap(__float_as_uint(pmax), __float_as_uint(pmax), false, false);
    pmax = fmaxf(__uint_as_float(rr[0]), __uint_as_float(rr[1])); }
  if (__builtin_expect(__all(pmax - m_reg <= THR2), 1)) { mn = m_reg; alpha = 1.f; }
  else { mn = fmaxf(m_reg, pmax); alpha = __builtin_amdgcn_exp2f(m_reg - mn); m_reg = mn; }
#pragma unroll
  for (int r = 0; r < 16; ++r) p0[r] = p0[r] - mn;
#pragma unroll
  for (int r = 0; r < 16; ++r) p1[r] = p1[r] - mn;
#pragma unroll
  for (int r = 0; r < 16; ++r) p0[r] = __builtin_amdgcn_exp2f(p0[r]);
}
__device__ __forceinline__ void finishSM(f32x16& p0, f32x16& p1, float alpha, float& l_reg, bf16x8& pa0, bf16x8& pa1, bf16x8& pa2, bf16x8& pa3) {
#pragma unroll
  for (int r = 0; r < 16; ++r) p1[r] = __builtin_amdgcn_exp2f(p1[r]);
  float ps = 0;
#pragma unroll
  for (int r = 0; r < 16; ++r) ps += p0[r];
#pragma unroll
  for (int r = 0; r < 16; ++r) ps += p1[r];
  { auto rr = __builtin_amdgcn_permlane32_swap(__float_as_uint(ps), __float_as_uint(ps), false, false);
    ps = __uint_as_float(rr[0]) + __uint_as_float(rr[1]); }
  l_reg = l_reg * alpha + ps;
#define PK4(P, BASE, OUT) do { unsigned a0 = cvtpk(P[BASE + 0], P[BASE + 1]), a1 = cvtpk(P[BASE + 2], P[BASE + 3]);   \
    unsigned b0 = cvtpk(P[BASE + 4], P[BASE + 5]), b1 = cvtpk(P[BASE + 6], P[BASE + 7]);                              \
    auto r0 = __builtin_amdgcn_permlane32_swap(a0, b0, false, false); auto r1 = __builtin_amdgcn_permlane32_swap(a1, b1, false, false); \
    u32x4 w = {r0[0], r1[0], r0[1], r1[1]}; OUT = __builtin_bit_cast(bf16x8, w); } while (0)
  PK4(p0, 0, pa0); PK4(p0, 8, pa1); PK4(p1, 0, pa2); PK4(p1, 8, pa3);
#undef PK4
}
constexpr int NQR = 12 - ATT_NQL;
__device__ __forceinline__ void qkt(f32x16& p0, f32x16& p1, const LAS unsigned char* Ks, const bf16x8* qr, const LAS unsigned char* ql, int r32, int hi) {
  p0 = f32x16{}; p1 = f32x16{};
#pragma unroll
  for (int d0 = 0; d0 < 12; ++d0) { const int cb = (d0 * 16 + hi * 8) * 2;
    const bf16x8 b0 = *(const LAS bf16x8*)(Ks + KSWZ(r32, cb));
    const bf16x8 b1 = *(const LAS bf16x8*)(Ks + KSWZ(32 + r32, cb));
    const bf16x8 qf = d0 < NQR ? qr[d0 < NQR ? d0 : 0] : *(const LAS bf16x8*)(ql + (d0 - NQR) * 1024);
    p0 = __builtin_amdgcn_mfma_f32_32x32x16_bf16(b0, qf, p0, 0, 0, 0);
    p1 = __builtin_amdgcn_mfma_f32_32x32x16_bf16(b1, qf, p1, 0, 0, 0); }
}
__device__ __forceinline__ int v_st(int k, int c) { const int kk = (k & ~0xC) | ((k & 4) << 1) | ((k & 8) >> 1); return ((kk >> 3) * 4 + (c >> 5)) * 512 + ((kk & 7) * 32 + (c & 31)) * 2; }
__device__ __forceinline__ int v_rd_base(int lane) { return ((lane & 3) << 3) | (((lane >> 2) & 3) << 6) | (((lane >> 4) & 1) << 5) | (((lane >> 5) & 1) << 8); }
constexpr int v_rd_off(int d0, int ks, int half) { return d0 * 512 + ks * 4096 + half * 2048; }
template <int OFF> __device__ __forceinline__ s16x4 tr_read(int vb) {
  s16x4 r; asm volatile("ds_read_b64_tr_b16 %0, %1 offset:%2" : "=&v"(r) : "v"(vb), "i"(OFF) : "memory"); return r;
}
template <int D0> __device__ __forceinline__ void pv_one(f32x16& od, int vb, bf16x8 pa0, bf16x8 pa1, bf16x8 pa2, bf16x8 pa3) {
  const s16x4 l0 = tr_read<v_rd_off(D0, 0, 0)>(vb), h0 = tr_read<v_rd_off(D0, 0, 1)>(vb), l1 = tr_read<v_rd_off(D0, 1, 0)>(vb), h1 = tr_read<v_rd_off(D0, 1, 1)>(vb);
  const s16x4 l2 = tr_read<v_rd_off(D0, 2, 0)>(vb), h2 = tr_read<v_rd_off(D0, 2, 1)>(vb), l3 = tr_read<v_rd_off(D0, 3, 0)>(vb), h3 = tr_read<v_rd_off(D0, 3, 1)>(vb);
  asm volatile("s_waitcnt lgkmcnt(0)" ::: "memory"); SBAR();
#define PK(L, H) (bf16x8){L[0], L[1], L[2], L[3], H[0], H[1], H[2], H[3]}
  od = __builtin_amdgcn_mfma_f32_32x32x16_bf16(pa0, PK(l0, h0), od, 0, 0, 0);
  od = __builtin_amdgcn_mfma_f32_32x32x16_bf16(pa1, PK(l1, h1), od, 0, 0, 0);
  od = __builtin_amdgcn_mfma_f32_32x32x16_bf16(pa2, PK(l2, h2), od, 0, 0, 0);
  od = __builtin_amdgcn_mfma_f32_32x32x16_bf16(pa3, PK(l3, h3), od, 0, 0, 0);
#undef PK
}
__device__ __forceinline__ void pv_d0(f32x16* o, int vb, bf16x8 pa0, bf16x8 pa1, bf16x8 pa2, bf16x8 pa3) {
  pv_one<0>(o[0], vb, pa0, pa1, pa2, pa3); pv_one<1>(o[1], vb, pa0, pa1, pa2, pa3); pv_one<2>(o[2], vb, pa0, pa1, pa2, pa3); pv_one<3>(o[3], vb, pa0, pa1, pa2, pa3);
}
__device__ __forceinline__ void unit(const bf16_t* __restrict__ QB, const bf16_t* __restrict__ KVB, const bf16_t* __restrict__ PB, const float* __restrict__ ROPE, bf16_t* __restrict__ Y,
                                     int qrow0, int b, int h, int nkeys, bool ropeq, LAS unsigned char* lds) {
  const int wid = kwave(), lane = klane(), tid = wid * 64 + lane, r32 = lane & 31, hi = lane >> 5;
  LAS unsigned char* V_lds = lds; LAS unsigned char* K_lds = lds + 2 * SHM_V;
  LAS float* wsc = (LAS float*)(lds + SHM_SCR) + wid * 64; LAS float* li_l = wsc; LAS float* al_l = wsc + 32;
  LAS unsigned char* qlw = lds + SHM_QL + wid * (ATT_NQL * 1024); const LAS unsigned char* ql = qlw + lane * 16;
  float m_reg = -1e30f, l_reg = 0; f32x16 o[4] = {}; bf16x8 qr[NQR];
  {
    const int qrow = qrow0 + wid * QBLK + r32;
    const bf16_t* Qw = QB + (size_t)qrow * 768 + h * 192 + hi * 8;
#pragma unroll
    for (int d0 = 0; d0 < 12; ++d0) {
      u32x4 w = *(const u32x4*)(Qw + d0 * 16);
      if (d0 >= 8 && ropeq) { float f[8]; unpack8(w, f); const int t = qrow & (NL - 1), jj = (d0 - 8) * 16 + hi * 8;
        const f32x4 r0 = rope4((f32x4){f[0], f[1], f[2], f[3]}, jj, t, ROPE), r1 = rope4((f32x4){f[4], f[5], f[6], f[7]}, jj + 4, t, ROPE);
        w.x = cvtpk(r0.x, r0.y); w.y = cvtpk(r0.z, r0.w); w.z = cvtpk(r1.x, r1.y); w.w = cvtpk(r1.z, r1.w); }
      if (d0 < NQR) qr[d0 < NQR ? d0 : 0] = __builtin_bit_cast(bf16x8, w); else *(LAS u32x4*)(qlw + (d0 - NQR) * 1024 + lane * 16) = w;
    }
  }
  const int sr = tid >> 4, sc = (tid & 15) * 8, vst0 = v_st(sr, sc), vst1 = v_st(32 + sr, sc);
  const int krw = tid >> 3, kcg = tid & 7;
  const int kw0 = KSWZ(krw, kcg * 16), kw1 = KSWZ(krw, (kcg + 8) * 16), kw2 = KSWZ(krw, (kcg + 16) * 16);
  const int vb0 = (int)(uintptr_t)V_lds + v_rd_base(lane);
  u32x4 sv0, sv1, sk0, sk1, sk2;
#define KROW(k0) ((k0) < NC ? ML + b * NC + (k0) : b * NL + ((k0) - NC))
  const int gv0 = sr * 1024 + h * 256 + 128 + sc, gv1 = gv0 + 32 * 1024, gk0 = krw * 1024 + h * 256 + kcg * 8, gk1 = gk0 + 64, gk2 = krw * INP + C_KR + kcg * 8;
#define SLOAD(k0) do { const int kr_ = __builtin_amdgcn_readfirstlane(KROW(k0)); const bf16_t* kvb_ = KVB + (size_t)kr_ * 1024; const bf16_t* pb_ = PB + (size_t)kr_ * INP; \
    sv0 = *(const u32x4*)(kvb_ + gv0); sv1 = *(const u32x4*)(kvb_ + gv1); sk0 = *(const u32x4*)(kvb_ + gk0); sk1 = *(const u32x4*)(kvb_ + gk1); sk2 = *(const u32x4*)(pb_ + gk2); } while (0)
#define SWRITE(bf) do { *(LAS u32x4*)(V_lds + (bf) * SHM_V + vst0) = sv0; *(LAS u32x4*)(V_lds + (bf) * SHM_V + vst1) = sv1; \
    *(LAS u32x4*)(K_lds + (bf) * SHM_K + kw0) = sk0; *(LAS u32x4*)(K_lds + (bf) * SHM_K + kw1) = sk1; *(LAS u32x4*)(K_lds + (bf) * SHM_K + kw2) = sk2; } while (0)
#define SWAIT() asm volatile("s_waitcnt vmcnt(0)" ::: "memory")
#define RESC(a) do { if (__any((a) < 1.f)) { if (hi == 0) al_l[r32] = (a); asm volatile("s_waitcnt lgkmcnt(0)" ::: "memory"); \
    _Pragma("unroll") for (int d = 0; d < 4; ++d) _Pragma("unroll") for (int r = 0; r < 16; ++r) o[d][r] *= al_l[crow(r, hi)]; } } while (0)
  f32x16 pA0, pA1, pB0, pB1; float mnA, mnB, alA, alB; bf16x8 pa0, pa1, pa2, pa3; const int NT = nkeys / KVBLK;
  SLOAD(0); SWAIT(); SWRITE(0); __syncthreads();
  qkt(pA0, pA1, K_lds, qr, ql, r32, hi); partialSM(pA0, pA1, m_reg, mnA, alA);
  SLOAD(KVBLK);
  SWAIT(); SWRITE(1); __syncthreads();
  for (int j = 1; j + 1 < NT; j += 2) {
    SBAR(); qkt(pB0, pB1, K_lds + SHM_K, qr, ql, r32, hi);
    finishSM(pA0, pA1, alA, l_reg, pa0, pa1, pa2, pa3); SBAR();
    SLOAD((j + 1) * KVBLK); SBAR();
    pv_d0(o, vb0, pa0, pa1, pa2, pa3); partialSM(pB0, pB1, m_reg, mnB, alB);
    __syncthreads(); SWAIT(); SWRITE(0);
    RESC(alB); __syncthreads();
    SBAR(); qkt(pA0, pA1, K_lds, qr, ql, r32, hi);
    finishSM(pB0, pB1, alB, l_reg, pa0, pa1, pa2, pa3); SBAR();
    SLOAD((j + 2) * KVBLK); SBAR();
    pv_d0(o, vb0 + SHM_V, pa0, pa1, pa2, pa3); partialSM(pA0, pA1, m_reg, mnA, alA);
    __syncthreads(); SWAIT(); SWRITE(1);
    RESC(alA); __syncthreads();
  }
  SBAR(); qkt(pB0, pB1, K_lds + SHM_K, qr, ql, r32, hi);
  finishSM(pA0, pA1, alA, l_reg, pa0, pa1, pa2, pa3); SBAR();
  pv_d0(o, vb0, pa0, pa1, pa2, pa3); partialSM(pB0, pB1, m_reg, mnB, alB);
  __syncthreads(); RESC(alB);
  finishSM(pB0, pB1, alB, l_reg, pa0, pa1, pa2, pa3); SBAR();
  pv_d0(o, vb0 + SHM_V, pa0, pa1, pa2, pa3);
  if (hi == 0) li_l[r32] = l_reg; asm volatile("s_waitcnt lgkmcnt(0)" ::: "memory");
  float rli[16];
#pragma unroll
  for (int r = 0; r < 16; ++r) rli[r] = __builtin_amdgcn_rcpf(li_l[crow(r, hi)]);
  bf16_t* Ow = Y + (size_t)(qrow0 + wid * QBLK) * DM + 512 + h * 128;
#pragma unroll
  for (int r = 0; r < 16; ++r) { const int orow = crow(r, hi);
#pragma unroll
    for (int d0 = 0; d0 < 4; ++d0) Ow[(size_t)orow * DM + d0 * 32 + r32] = (bf16_t)(cvtpk(o[d0][r] * rli[r], 0.f) & 0xffffu); }
#undef KROW
#undef SLOAD
#undef SWRITE
#undef SWAIT
#undef RESC
}
#undef KSWZ
#undef SBAR
}
__device__ __forceinline__ void phase_attn_mfma(const Args& a, int l, LAS unsigned char* lds) {
    unsigned char* ws = a.ws;
    const bf16_t* QB = (const bf16_t*)(ws + WS_QB); const bf16_t* KVB = (const bf16_t*)(ws + WS_KVB); const bf16_t* PB = (const bf16_t*)(ws + WS_PB); bf16_t* Y = (bf16_t*)(ws + WS_HY);
    const float* ROPE = (const float*)(ws + WS_ROPE);
    const int nunits = 256 + (l == 0 ? 8 : 0);
    for (int u = blockIdx.x; u < nunits; u += KGRID) {
        __syncthreads();
        if (u < 256) { const int bh = u & 7, qb = u >> 3, b = bh >> 2, h = bh & 3; att::unit(QB, KVB, PB, ROPE, Y, b * NL + qb * 256, b, h, NKEY, true, lds); }
        else { const int bh = u - 256, b = bh >> 2, h = bh & 3; att::unit(QB, KVB, PB, ROPE, Y, ML + b * NC, b, h, NC, false, lds); }
    }
}

namespace pg8 {
#define PG8_LAS __attribute__((address_space(3)))
typedef unsigned short bf16_t;
typedef short bf16x8 __attribute__((ext_vector_type(8)));
typedef float f32x4 __attribute__((ext_vector_type(4)));
typedef unsigned u32x4 __attribute__((ext_vector_type(4)));
constexpr int BM = 256, BK = 64, HALF = 128, HTB = HALF * BK * 2  , STAGE_BYTES = 8 * HTB, NXCD = 8, WGM = 8;

__host__ __device__ __forceinline__ int lds_byte(int r, int c) { const int st = (r >> 4) * 2 + (c >> 5), rr = r & 15, cc = c & 31, ob = rr * 64 + cc * 2; return st * 1024 + (ob ^ (((ob >> 9) & 1) << 5)); }
__host__ __device__ __forceinline__ void stage_rc(int b, int& R, int& C) { const int st = b / 1024, sb = b % 1024, swz = sb ^ (((sb >> 9) & 1) << 5); R = (st >> 1) * 16 + swz / 64; C = (st & 1) * 32 + (swz % 64) / 2; }
__host__ __device__ __forceinline__ int perm32(int rho) { const int n = rho >> 4, i = rho & 15; return 8 * (i >> 2) + 4 * n + (i & 3); }

struct Unit { int pm, pn; };
struct Gemm { const bf16_t* A; int lda; const bf16_t* Bt; int M, N, K; };

struct StaticOrder {
    int nM, nN, nwg, G, c;
    __host__ __device__ void init(int M, int N, int G_, int c_) { nM = M / BM; nN = N / BM; nwg = nM * nN; G = G_; c = c_; }
    __host__ __device__ bool next(int i, Unit& u) const {
        const long L = (long)i * G + c; if (L >= nwg) return false;
        int wgid = (int)L; { const int q = nwg / NXCD, r = nwg % NXCD, xcd = wgid % NXCD, off = wgid / NXCD; wgid = (xcd < r ? xcd * (q + 1) : r * (q + 1) + (xcd - r) * q) + off; }
        const int nig = WGM * nN, gid = wgid / nig, fm = gid * WGM, gsz = (nM - fm) < WGM ? (nM - fm) : WGM;
        u.pm = fm + ((wgid % nig) % gsz); u.pn = (wgid % nig) / gsz; return true;
    }
    __device__ __forceinline__ void a_ready(const Unit&) const {}
    __device__ __forceinline__ void done(const Unit&) const {}
};
template <class Epi, class Sched, bool ALIGN_EPI = false, bool SP2 = false>
__device__ __forceinline__ void gemm_phase(PG8_LAS unsigned char* lds, const Gemm g, const Sched& S, const Epi& E) {
    const int wid = kwave(), lane = klane(), tid = wid * 64 + lane, wr = wid >> 2, wc = wid & 3, fr = lane & 15, fq = lane >> 4;
    const int K = g.K, nt = K / BK;
    unsigned voffA[2], voffB[2];
#pragma unroll
    for (int i = 0; i < 2; ++i) { int R, C; stage_rc(tid * 16 + i * 8192, R, C); const int Rb = Epi::PERM ? ((R & ~31) + perm32(R & 31)) : R;
        voffA[i] = (unsigned)(R * g.lda + C) * 2u; voffB[i] = (unsigned)(Rb * K + C) * 2u; }
    const size_t kstep = (size_t)(BK * 2);
    const size_t hstepA = (size_t)HALF * g.lda * 2, hstepB = (size_t)HALF * K * 2;
    const size_t tstepA = 2 * hstepA, tstepB = 2 * hstepB;
    const unsigned ldsw = (unsigned)wid * 1024u;
    const int aoff = lds_byte(wr * 64 + fr, fq * 8), boff = lds_byte(wc * 32 + fr, fq * 8);
#define PG8_SA(b, h) (((b) * 2 + (h)) * HTB)
#define PG8_SB(b, h) ((4 + (b) * 2 + (h)) * HTB)
#define PG8_STAGE(bufoff, gbase, voff) do { _Pragma("unroll") for (int _i = 0; _i < 2; ++_i) \
        __builtin_amdgcn_global_load_lds((const unsigned*)((const char*)(gbase) + (voff)[_i]), (PG8_LAS unsigned*)(lds + (bufoff) + ldsw + _i * 8192), 16, 0, 0); } while (0)
#define PG8_LDA(dst, b, h) do { _Pragma("unroll") for (int m = 0; m < 4; ++m) _Pragma("unroll") for (int k = 0; k < 2; ++k) dst[m][k] = *(const PG8_LAS bf16x8*)(lds + PG8_SA(b, h) + aoff + m * 2048 + k * 1024); } while (0)
#define PG8_LDB(dst, b, h) do { _Pragma("unroll") for (int n = 0; n < 2; ++n) _Pragma("unroll") for (int k = 0; k < 2; ++k) dst[n][k] = *(const PG8_LAS bf16x8*)(lds + PG8_SB(b, h) + boff + n * 2048 + k * 1024); } while (0)
#define PG8_MMA(ai, bj, At, Bt) do { __builtin_amdgcn_s_setprio(1); _Pragma("unroll") for (int m = 0; m < 4; ++m) _Pragma("unroll") for (int n = 0; n < 2; ++n) _Pragma("unroll") for (int k = 0; k < 2; ++k) \
        acc[ai][bj][m][n] = __builtin_amdgcn_mfma_f32_16x16x32_bf16(Bt[n][k], At[m][k], acc[ai][bj][m][n], 0, 0, 0); __builtin_amdgcn_s_setprio(0); } while (0)
#define PG8_WAIT_V(n) asm volatile("s_waitcnt vmcnt(" #n ")" ::: "memory")
#define PG8_WAIT_L(n) asm volatile("s_waitcnt lgkmcnt(" #n ")" ::: "memory")
#define PG8_BAR __builtin_amdgcn_s_barrier()
#define PG8_SCHED __builtin_amdgcn_sched_barrier(0)
    Unit cur, nxt; int ui = 0;
    if (!S.next(0, cur)) return;
    f32x4 acc[2][2][4][2];
#pragma unroll
    for (int a = 0; a < 2; ++a)
#pragma unroll
        for (int b = 0; b < 2; ++b)
#pragma unroll
            for (int m = 0; m < 4; ++m)
#pragma unroll
                for (int n = 0; n < 2; ++n) acc[a][b][m][n] = (f32x4){0.f, 0.f, 0.f, 0.f};
    bf16x8 At[4][2], B0[2][2], B1[2][2];
    const char* cA = (const char*)g.A + (size_t)cur.pm * tstepA; const char* cB = (const char*)g.Bt + (size_t)cur.pn * tstepB;
    S.a_ready(cur);
    if constexpr (SP2) {
        PG8_STAGE(PG8_SB(0, 0), cB, voffB); PG8_STAGE(PG8_SB(0, 1), cB + hstepB, voffB); PG8_STAGE(PG8_SA(0, 0), cA, voffA); PG8_STAGE(PG8_SA(0, 1), cA + hstepA, voffA);
        if (wr == 1) PG8_BAR;
        PG8_WAIT_V(2); PG8_BAR;
        PG8_STAGE(PG8_SB(1, 0), cB + kstep, voffB); PG8_STAGE(PG8_SA(1, 0), cA + kstep, voffA); PG8_STAGE(PG8_SB(1, 1), cB + hstepB + kstep, voffB);
        PG8_WAIT_V(6); PG8_BAR;
    } else {
        PG8_STAGE(PG8_SB(0, 0), cB, voffB); PG8_STAGE(PG8_SA(0, 0), cA, voffA); PG8_STAGE(PG8_SB(0, 1), cB + hstepB, voffB); PG8_STAGE(PG8_SA(0, 1), cA + hstepA, voffA);
        if (wr == 1) PG8_BAR;
        PG8_WAIT_V(4); PG8_BAR;
        PG8_STAGE(PG8_SB(1, 0), cB + kstep, voffB); PG8_STAGE(PG8_SA(1, 0), cA + kstep, voffA); PG8_STAGE(PG8_SB(1, 1), cB + hstepB + kstep, voffB);
        PG8_WAIT_V(6); PG8_BAR;
    }
    for (;;) {
        const bool has_next = S.next(ui + 1, nxt);
        const char* nA = has_next ? (const char*)g.A + (size_t)nxt.pm * tstepA : cA; const char* nB = has_next ? (const char*)g.Bt + (size_t)nxt.pn * tstepB : cB;
#pragma nounroll
        for (int t = 0; t < nt; t += 2) {
            const bool last = (t == nt - 2);
            const char* a1 = cA + (size_t)(t + 1) * kstep;
            const char* a2 = last ? nA : cA + (size_t)(t + 2) * kstep; const char* b2 = last ? nB : cB + (size_t)(t + 2) * kstep;
            const char* a3 = a2 + kstep; const char* b3 = b2 + kstep;
            if (last && has_next) S.a_ready(nxt);
            if constexpr (SP2) {
            PG8_LDB(B0, 0, 0); PG8_LDB(B1, 0, 1); PG8_SCHED; PG8_LDA(At, 0, 0); PG8_STAGE(PG8_SA(1, 1), a1 + hstepA, voffA);
            PG8_WAIT_V(8); PG8_WAIT_L(0); PG8_BAR; PG8_MMA(0, 0, At, B0); PG8_MMA(0, 1, At, B1); PG8_BAR; PG8_SCHED;
            PG8_LDA(At, 0, 1); PG8_STAGE(PG8_SB(0, 0), b2, voffB); PG8_STAGE(PG8_SB(0, 1), b2 + hstepB, voffB); PG8_STAGE(PG8_SA(0, 0), a2, voffA);
            PG8_WAIT_V(8); PG8_WAIT_L(0); PG8_BAR; PG8_MMA(1, 0, At, B0); PG8_MMA(1, 1, At, B1); PG8_BAR; PG8_SCHED;
            PG8_LDB(B0, 1, 0); PG8_LDB(B1, 1, 1); PG8_SCHED; PG8_LDA(At, 1, 0); PG8_STAGE(PG8_SA(0, 1), a2 + hstepA, voffA);
            PG8_WAIT_V(8); PG8_WAIT_L(0); PG8_BAR; PG8_MMA(0, 0, At, B0); PG8_MMA(0, 1, At, B1); PG8_BAR; PG8_SCHED;
            PG8_LDA(At, 1, 1); PG8_STAGE(PG8_SB(1, 0), b3, voffB); PG8_STAGE(PG8_SB(1, 1), b3 + hstepB, voffB); PG8_STAGE(PG8_SA(1, 0), a3, voffA);
            PG8_WAIT_V(8); PG8_WAIT_L(0); PG8_BAR; PG8_MMA(1, 0, At, B0); PG8_MMA(1, 1, At, B1); PG8_BAR; PG8_SCHED;
            } else {
            PG8_LDB(B0, 0, 0); PG8_SCHED; PG8_LDA(At, 0, 0); PG8_STAGE(PG8_SA(1, 1), a1 + hstepA, voffA);
            PG8_WAIT_L(8); PG8_BAR; PG8_WAIT_L(0); PG8_MMA(0, 0, At, B0); PG8_BAR; PG8_SCHED;
            PG8_LDB(B1, 0, 1); PG8_STAGE(PG8_SB(0, 0), b2, voffB);
            PG8_BAR; PG8_WAIT_L(0); PG8_MMA(0, 1, At, B1); PG8_BAR;
            PG8_LDA(At, 0, 1); PG8_STAGE(PG8_SA(0, 0), a2, voffA);
            PG8_BAR; PG8_WAIT_L(0); PG8_MMA(1, 0, At, B0); PG8_BAR; PG8_SCHED;
            PG8_STAGE(PG8_SB(0, 1), b2 + hstepB, voffB);
            PG8_WAIT_V(6); PG8_BAR; PG8_MMA(1, 1, At, B1); PG8_BAR;
            PG8_LDB(B0, 1, 0); PG8_SCHED; PG8_LDA(At, 1, 0); PG8_STAGE(PG8_SA(0, 1), a2 + hstepA, voffA);
            PG8_WAIT_L(8); PG8_BAR; PG8_WAIT_L(0); PG8_MMA(0, 0, At, B0); PG8_BAR; PG8_SCHED;
            PG8_LDB(B1, 1, 1); PG8_STAGE(PG8_SB(1, 0), b3, voffB);
            PG8_BAR; PG8_WAIT_L(0); PG8_MMA(0, 1, At, B1); PG8_BAR;
            PG8_LDA(At, 1, 1); PG8_STAGE(PG8_SA(1, 0), a3, voffA);
            PG8_BAR; PG8_WAIT_L(0); PG8_MMA(1, 0, At, B0); PG8_BAR; PG8_SCHED;
            PG8_STAGE(PG8_SB(1, 1), b3 + hstepB, voffB);
            PG8_WAIT_V(6); PG8_BAR; PG8_MMA(1, 1, At, B1); PG8_BAR;
            }
        }
        if constexpr (ALIGN_EPI) { if (wr == 0) PG8_BAR; }
        if constexpr (!Epi::AFTER_DRAIN) { E(acc, cur, wr, wc, fr, fq); S.done(cur); }
        if (!has_next) break;
#pragma unroll
        for (int a = 0; a < 2; ++a)
#pragma unroll
            for (int b = 0; b < 2; ++b)
#pragma unroll
                for (int m = 0; m < 4; ++m)
#pragma unroll
                    for (int n = 0; n < 2; ++n) acc[a][b][m][n] = (f32x4){0.f, 0.f, 0.f, 0.f};
        cur = nxt; cA = nA; cB = nB; ++ui;
        if constexpr (ALIGN_EPI) { if (wr == 1) PG8_BAR; }
    }
    PG8_WAIT_V(0);
    if constexpr (!ALIGN_EPI) { if (wr == 0) PG8_BAR; }
    PG8_BAR;
    if constexpr (Epi::AFTER_DRAIN) { E.fused(acc, cur, wr, wc, fr, fq, lds, wid, lane); S.done(cur); }
#undef PG8_SA
#undef PG8_SB
#undef PG8_STAGE
#undef PG8_LDA
#undef PG8_LDB
#undef PG8_MMA
#undef PG8_WAIT_V
#undef PG8_WAIT_L
#undef PG8_BAR
#undef PG8_SCHED
}
}

template <class F> struct EpiAdapt {
    static constexpr bool PERM = false, AFTER_DRAIN = false;
    F f;
    __device__ __forceinline__ void operator()(const pg8::f32x4 (&acc)[2][2][4][2], const pg8::Unit& u, int wr, int wc, int fr, int fq) const {
#pragma unroll
        for (int ai = 0; ai < 2; ++ai)
#pragma unroll
            for (int m = 0; m < 4; ++m) { const int row = u.pm * 256 + ai * 128 + wr * 64 + m * 16 + fr;
#pragma unroll
                for (int bj = 0; bj < 2; ++bj)
#pragma unroll
                    for (int n = 0; n < 2; ++n) f(row, u.pn * 256 + bj * 128 + wc * 32 + n * 16 + 4 * fq, acc[ai][bj][m][n]); }
    }
};
template <class F> __device__ __forceinline__ void gemm_mfma(const bf16_t* A, int lda, const bf16_t* Bt, int M, int N, int K, const F& f, LAS unsigned char* lds) {
    pg8::Gemm g{A, lda, Bt, M, N, K}; pg8::StaticOrder S; S.init(M, N, KGRID, (int)blockIdx.x);
    EpiAdapt<F> E{f};
    pg8::gemm_phase<EpiAdapt<F>, pg8::StaticOrder, true, true>(lds, g, S, E);
}


#ifndef GEMM_MASK
#define GEMM_MASK 63
#endif
template <int BIT, class F> __device__ __forceinline__ void gemm_sel(const bf16_t* A, int lda, const bf16_t* Bt, int M, int N, int K, const F& f, LAS unsigned char* lds) {
    if constexpr ((GEMM_MASK >> BIT) & 1) gemm_mfma(A, lda, Bt, M, N, K, f, lds); else gemm_naive(A, lda, Bt, M, N, K, f, lds);
}

template <int CT, class F> __device__ __forceinline__ void gemm_ctx_small(const bf16_t* A, int lda, const bf16_t* Bt, int N, int K, const F& f) {
    const int lane = klane(), wave = kwave(), r32 = lane & 31, hi = lane >> 5;
    const int nct = N / (32 * CT), ntasks = 8 * nct, G = KGRID;
    for (int task = wave * G + (int)blockIdx.x; task < ntasks; task += NWAVES * G) {
        const int rt = task / nct, ct = task % nct, row0 = ML + rt * 64, col0 = ct * 32 * CT;
        const bf16_t* ap0 = A + (size_t)(row0 + r32) * lda + 8 * hi; const bf16_t* ap1 = ap0 + (size_t)32 * lda;
        const bf16_t* bp = Bt + (size_t)(col0 + r32) * K + 8 * hi;
        f32x16 acc[CT][2];
#pragma unroll
        for (int c = 0; c < CT; ++c) { acc[c][0] = f32x16{}; acc[c][1] = f32x16{}; }
#pragma unroll 1
        for (int k0 = 0; k0 < K; k0 += 64) {
            bf16x8 av[4][2], bv[4][CT];
#pragma unroll
            for (int s = 0; s < 4; ++s) { av[s][0] = *(const bf16x8*)(ap0 + k0 + 16 * s); av[s][1] = *(const bf16x8*)(ap1 + k0 + 16 * s);
#pragma unroll
                for (int c = 0; c < CT; ++c) bv[s][c] = *(const bf16x8*)(bp + (size_t)(32 * c) * K + k0 + 16 * s); }
#pragma unroll
            for (int s = 0; s < 4; ++s)
#pragma unroll
                for (int c = 0; c < CT; ++c) { acc[c][0] = __builtin_amdgcn_mfma_f32_32x32x16_bf16(bv[s][c], av[s][0], acc[c][0], 0, 0, 0); acc[c][1] = __builtin_amdgcn_mfma_f32_32x32x16_bf16(bv[s][c], av[s][1], acc[c][1], 0, 0, 0); }
        }
#pragma unroll
        for (int c = 0; c < CT; ++c)
#pragma unroll
            for (int t = 0; t < 2; ++t)
#pragma unroll
                for (int g = 0; g < 4; ++g) f(row0 + 32 * t + r32, col0 + 32 * c + 8 * g + 4 * hi, (f32x4){acc[c][t][4 * g], acc[c][t][4 * g + 1], acc[c][t][4 * g + 2], acc[c][t][4 * g + 3]});
    }
}

__device__ __forceinline__ void phase_final(const Args& a) {
    const float* fw = a.in[I_FNW];
    const int lane = klane(), gw = blockIdx.x * NWAVES + kwave(), ngw = KGRID * NWAVES;
    for (int row = gw; row < ML; row += ngw) {
        float* p = a.out + (size_t)row * DM;
        f32x4 v[4]; float ss = 0.f;
#pragma unroll
        for (int j = 0; j < 4; ++j) { v[j] = *(const f32x4*)(p + lane * 4 + 256 * j); ss += v[j].x * v[j].x + v[j].y * v[j].y + v[j].z * v[j].z + v[j].w * v[j].w; }
        const float rstd = rsqrtf(wave_sum(ss) * (1.f / DM) + EPS);
#pragma unroll
        for (int j = 0; j < 4; ++j) *(f32x4*)(p + lane * 4 + 256 * j) = v[j] * rstd * *(const f32x4*)(fw + lane * 4 + 256 * j);
    }
}

constexpr int NPHASE = 20;
#define PH_BEGIN(k) if (lo <= (k) && (k) < hi) { const Args& a = get_args(); unsigned char* ws = a.ws; (void)ws;
#define PH_END(k) if (MK_ONE_LAUNCH && (k) + 1 < hi) xcd_barrier(bar); }
template <int L> __device__ __forceinline__ void layer_phases(LAS unsigned char* lds, const XcdBarrier& bar, const int lo, const int hi) {
    constexpr int P = 1 + 9 * L;
#define MODL ((const float*)(ws + WS_MOD) + (size_t)L * 3 * 6144)
#define ROPET ((const float*)(ws + WS_ROPE))
#define HYB ((bf16_t*)(ws + WS_HY))
#define PBB ((bf16_t*)(ws + WS_PB))
#define XCB ((float*)(ws + WS_XC))
#define XL_IN ((L == 0) ? a.in[I_X] : (const float*)a.out)
#define XC_IN ((L == 0) ? a.in[I_CTX] : (const float*)XCB)
    PH_BEGIN(P + 0) phase_norm_mod(XL_IN, XC_IN, a.in[I_N1W] + L * DM, MODL, 0, 1024, HYB, MT); PH_END(P + 0)
    PH_BEGIN(P + 1) { EpiInProj E{PBB, ROPET}; const bf16_t* W = (const bf16_t*)(ws + WS_WIN) + (size_t)L * INP * DM;
        gemm_sel<0>(HYB, DM, W, ML, INP, DM, E, lds); gemm_ctx_small<2>(HYB, DM, W, INP, DM, E); } PH_END(P + 1)
    PH_BEGIN(P + 2) phase_post(a, L); phase_gla_local(a, L, lds); PH_END(P + 2)
    PH_BEGIN(P + 3) {
        { EpiUQ E1{(bf16_t*)(ws + WS_QB)}; const bf16_t* W = (const bf16_t*)(ws + WS_WUQ) + (size_t)L * 768 * 256; gemm_sel<1>(PBB + C_DQ, INP, W, ML, 768, 256, E1, lds); if (L == 0) gemm_ctx_small<2>(PBB + C_DQ, INP, W, 768, 256, E1); }
        { EpiUKV E2{(bf16_t*)(ws + WS_KVB)}; const bf16_t* W = (const bf16_t*)(ws + WS_WUKV) + (size_t)L * 1024 * 256; gemm_sel<2>(PBB + C_CKV, INP, W, ML, 1024, 256, E2, lds); gemm_ctx_small<2>(PBB + C_CKV, INP, W, 1024, 256, E2); }
        phase_gla_scan(a);
        phase_sgu_mfma(a, L, lds);
    } PH_END(P + 3)
    PH_BEGIN(P + 4) phase_gla_out(a, L, lds); phase_attn_mfma(a, L, lds); PH_END(P + 4)
    PH_BEGIN(P + 5) { EpiResid E{XL_IN, XC_IN, a.out, XCB, MODL, 2048}; const bf16_t* W = (const bf16_t*)(ws + WS_WOUT) + (size_t)L * DM * DM;
        gemm_sel<3>(HYB, DM, W, ML, DM, DM, E, lds); if (L == 0) gemm_ctx_small<2>(HYB, DM, W, DM, DM, E); } PH_END(P + 5)
    PH_BEGIN(P + 6) phase_norm_mod(a.out, XCB, a.in[I_N2W] + L * DM, MODL, 3072, 4096, HYB, L == 0 ? MT : ML); PH_END(P + 6)
    PH_BEGIN(P + 7) { EpiFF1 E{(bf16_t*)(ws + WS_A)}; const bf16_t* W = (const bf16_t*)(ws + WS_WFF1) + (size_t)L * FF * DM;
        gemm_sel<4>(HYB, DM, W, ML, FF, DM, E, lds); if (L == 0) gemm_ctx_small<2>(HYB, DM, W, FF, DM, E); } PH_END(P + 7)
    PH_BEGIN(P + 8) { EpiResid E{a.out, XCB, a.out, XCB, MODL, 5120}; const bf16_t* W = (const bf16_t*)(ws + WS_WFF2) + (size_t)L * DM * FF;
        gemm_sel<5>((const bf16_t*)(ws + WS_A), FF, W, ML, DM, FF, E, lds); if (L == 0) gemm_ctx_small<1>((const bf16_t*)(ws + WS_A), FF, W, DM, FF, E); } PH_END(P + 8)
}
__global__ void __launch_bounds__(NTHR, 2) mega(Args a_kernarg_only) {
    extern __shared__ __attribute__((aligned(16))) unsigned char lds_raw[];
    LAS unsigned char* lds = (LAS unsigned char*)lds_raw;
    volatile LAS unsigned* MISC = (volatile LAS unsigned*)(lds + LDS_CTL_OFF);
    { const int t0 = __builtin_amdgcn_workitem_id_x();
      if (t0 < 64) MISC[t0] = 0u;
      if ((t0 & 63) == 0) { const unsigned id = (unsigned)__builtin_amdgcn_s_getreg((5 << 11) | 4) & 63u; MISC[64 + id] = (unsigned)(t0 >> 6); } }
    __syncthreads();
    XcdBarrier bar; bar.bar = (unsigned*)(get_args().ws + WS_CTL); bar.x = 0; bar.st = nullptr;
    if (MK_ONE_LAUNCH) bar = xcd_barrier_post((unsigned*)(get_args().ws + WS_CTL), MISC + 8);
    const int lo = MK_ONE_LAUNCH ? 0 : get_args().ph_lo, hi = MK_ONE_LAUNCH ? NPHASE : get_args().ph_hi;
    PH_BEGIN(0) phase_prep(a, lds); PH_END(0)
    layer_phases<0>(lds, bar, lo, hi);
    layer_phases<1>(lds, bar, lo, hi);
    PH_BEGIN(NPHASE - 1) phase_final(a); PH_END(NPHASE - 1)
}

extern "C" void kernel_launch(void* const* d_in, const int* in_sizes, int n_in, void* d_out, int out_size, void* d_ws, size_t ws_size, hipStream_t stream) {
    static int grid = 0;
    if (grid == 0) {
        if (n_in != 26 || in_sizes[0] != ML * DM || out_size != ML * DM || ws_size < WS_END) { fprintf(stderr, "kernel_launch: unexpected shapes (n_in %d, in0 %d, out %d, ws %zu)\n", n_in, n_in > 0 ? in_sizes[0] : -1, out_size, ws_size); grid = -1; return; }
        int dev = 0, cus = 0;
        if (hipGetDevice(&dev) != hipSuccess || hipDeviceGetAttribute(&cus, hipDeviceAttributeMultiprocessorCount, dev) != hipSuccess) { grid = -1; return; }
        if (hipFuncSetAttribute((const void*)mega, hipFuncAttributeMaxDynamicSharedMemorySize, LDS_BYTES) != hipSuccess) { fprintf(stderr, "kernel_launch: hipFuncSetAttribute failed\n"); grid = -1; return; }
        int per_cu = 0;
        if (hipOccupancyMaxActiveBlocksPerMultiprocessor(&per_cu, (const void*)mega, NTHR, LDS_BYTES) != hipSuccess || per_cu < 1) fprintf(stderr, "kernel_launch: occupancy query says %d\n", per_cu);
        (void)hipGetLastError();
        grid = cus;
    }
    if (grid < 0) return;
    (void)hipMemsetAsync((char*)d_ws + WS_CTL, 0, CTL_ZERO_BYTES, stream);
    Args a{};
    for (int i = 0; i < 26; ++i) a.in[i] = (const float*)d_in[i];
    a.out = (float*)d_out; a.ws = (unsigned char*)d_ws; a.grid = grid;
    if (MK_ONE_LAUNCH) { a.ph_lo = 0; a.ph_hi = NPHASE; hipLaunchKernelGGL(mega, dim3(grid), dim3(NTHR), LDS_BYTES, stream, a); }
    else for (int ph = 0; ph < NPHASE; ++ph) { a.ph_lo = ph; a.ph_hi = ph + 1; hipLaunchKernelGGL(mega, dim3(grid), dim3(NTHR), LDS_BYTES, stream, a); }
}
```

```cpp
#include <hip/hip_runtime.h>
#include <cstdio>
#include <cstdint>

#ifndef REP_FF1
#define REP_FF1 1
#endif
#ifndef REP_INP
#define REP_INP 1
#endif
#ifndef REP_GLAL
#define REP_GLAL 1
#endif
#ifndef REP_UP
#define REP_UP 1
#endif
#ifndef REP_OUT
#define REP_OUT 1
#endif
#ifndef ATT_ABL
#define ATT_ABL 5
#endif
#ifndef REP_PREP
#define REP_PREP 1
#endif
#ifndef REP_SGU
#define REP_SGU 1
#endif
#ifndef REP_ATTN
#define REP_ATTN 1
#endif
#ifndef REP_GLA
#define REP_GLA 1
#endif
#ifndef REP_NORM
#define REP_NORM 1
#endif
#ifndef ATT_NQL
#define ATT_NQL 6
#endif
#ifndef ATTN_NAIVE
#define ATTN_NAIVE 0
#endif
#ifndef GLA_NAIVE
#define GLA_NAIVE 0
#endif
#ifndef MK_ONE_LAUNCH
#define MK_ONE_LAUNCH 1
#endif

#define GAS __attribute__((address_space(1)))
#define LAS __attribute__((address_space(3)))
typedef unsigned short bf16_t;
typedef float f32x4 __attribute__((ext_vector_type(4)));
typedef unsigned u32x4 __attribute__((ext_vector_type(4)));
typedef unsigned u32x2 __attribute__((ext_vector_type(2)));

constexpr int DM = 1024, NB = 2, NL = 8192, NC = 256, ML = NB * NL, MC = NB * NC, MT = ML + MC;
constexpr int FF = 4096, INP = 2048, IN_COLS = 1888, NKEY = NC + NL;
constexpr float EPS = 1e-6f;
constexpr float QSCALE = 0.07216878364870322f * 1.4426950408889634f;
constexpr int NWAVES = 8, NTHR = 512;
constexpr int C_CKV = 0, C_DQ = 256, C_SU = 512, C_SV = 768, C_GV = 1024, C_GR = 1280, C_GK = 1536, C_GQ = 1664, C_KR = 1792, C_GGF = 1856, C_GGB = 1872;

constexpr size_t MiB = 1u << 20;
constexpr size_t WS_CTL = 0, CTL_ZERO_BYTES = 65536;
constexpr size_t WS_MOD = 1 * MiB;
constexpr size_t WS_ROPE = 1 * MiB + 256 * 1024;
constexpr size_t WS_WSB = 14 * MiB + 768 * 1024;
constexpr size_t WS_WIN = 2 * MiB;
constexpr size_t WS_WOUT = 10 * MiB;
constexpr size_t WS_WUQ = 14 * MiB;
constexpr size_t WS_WUKV = 15 * MiB;
constexpr size_t WS_WFF1 = 16 * MiB;
constexpr size_t WS_WFF2 = 32 * MiB;
constexpr size_t WS_XC = 48 * MiB;
constexpr size_t WS_HY = 50 * MiB;
constexpr size_t WS_PB = 83 * MiB;
constexpr size_t WS_QB = 149 * MiB;
constexpr size_t WS_KVB = 174 * MiB;
constexpr size_t WS_LG = 216 * MiB;
constexpr size_t WS_OB = 233 * MiB;
constexpr size_t WS_A = 83 * MiB;
constexpr size_t WS_END = 250 * MiB;
static_assert(WS_A + (size_t)MT * FF * 2 <= WS_LG, "ffn hidden overlay");
static_assert(WS_PB + (size_t)MT * INP * 2 <= WS_QB && WS_QB + (size_t)MT * 768 * 2 <= WS_KVB && WS_KVB + (size_t)MT * 1024 * 2 <= WS_LG, "ws map");
static_assert(WS_LG + (size_t)MT * 256 * 4 <= WS_OB && WS_OB + (size_t)MT * 256 * 4 <= WS_END, "ws map 2");

constexpr int LDS_BYTES = 147456;

struct Args { const float* in[26]; float* out; unsigned char* ws; int ph_lo, ph_hi, grid, pad; };
enum { I_X = 0, I_C, I_CTX, I_CCTX, I_WMOD, I_BMOD, I_N1W, I_WIN, I_WOUT, I_SGNW, I_SGNB, I_SGW, I_SGB, I_GWF, I_GBF, I_GWB, I_GBB, I_GNW, I_QNW, I_WUQ, I_KVNW, I_WUKV, I_N2W, I_WFF1, I_WFF2, I_FNW };

typedef __attribute__((address_space(4))) const Args* KArgsPtr;
__device__ __forceinline__ const Args& get_args() { KArgsPtr p = (KArgsPtr)__builtin_amdgcn_kernarg_segment_ptr(); asm volatile("" : "+s"(p)); return *(const Args*)p; }
constexpr int LDS_CTL_OFF = LDS_BYTES - 512;
__device__ __forceinline__ int klane() { int l; asm volatile("v_mbcnt_lo_u32_b32 %0, -1, 0\n\tv_mbcnt_hi_u32_b32 %0, -1, %0" : "=v"(l)); return l; }
__device__ __forceinline__ int kwave() { const unsigned id = (unsigned)__builtin_amdgcn_s_getreg((5 << 11) | 4) & 63u;
    return __builtin_amdgcn_readfirstlane((int)((volatile LAS unsigned*)(uintptr_t)(LDS_CTL_OFF + 256))[id]); }
#define KTID (kwave() * 64 + klane())
#define KGRID (get_args().grid)
__device__ __forceinline__ float bf2f(bf16_t v) { return __uint_as_float(((unsigned)v) << 16); }
__device__ __forceinline__ unsigned f2bf(float f) { unsigned u = __float_as_uint(f); return (u + 0x7fffu + ((u >> 16) & 1u)) >> 16; }
__device__ __forceinline__ unsigned pk2(float lo, float hi) { return f2bf(lo) | (f2bf(hi) << 16); }
__device__ __forceinline__ float wave_sum(float v) {
#pragma unroll
    for (int o = 1; o < 64; o <<= 1) v += __shfl_xor(v, o);
    return v;
}
__device__ __forceinline__ float gelu_tanh(float x) { const float u = 1.5957691216057308f * (x + 0.044715f * x * x * x); return x / (1.f + __expf(-u)); }
__device__ __forceinline__ float silu_f(float x) { return x / (1.f + __expf(-x)); }
__device__ __forceinline__ float log_sigmoid_f(float z) { return fminf(z, 0.f) - log1pf(expf(-fabsf(z))); }
__device__ __forceinline__ float log_sigmoid_fast(float z) { return fminf(z, 0.f) - __logf(1.f + __expf(-fabsf(z))); }
__device__ __forceinline__ void unpack8(u32x4 w, float* f) {
    f[0] = __uint_as_float(w.x << 16); f[1] = __uint_as_float(w.x & 0xffff0000u); f[2] = __uint_as_float(w.y << 16); f[3] = __uint_as_float(w.y & 0xffff0000u);
    f[4] = __uint_as_float(w.z << 16); f[5] = __uint_as_float(w.z & 0xffff0000u); f[6] = __uint_as_float(w.w << 16); f[7] = __uint_as_float(w.w & 0xffff0000u);
}

#define XB_TMO      128
#define XB_XCNT(j)  (256  + 64 * (j))
#define XB_XSUB(j)  (1280 + 64 * (j))
#define XB_XGEN(j)  (2304 + 64 * (j))
#define XB_TOP      3328
#define XB_TOPGEN   3392
#define XCD_BAR_WORDS 3456
#define XB_SPIN_CAP (1u << 22)
__device__ __forceinline__ unsigned xb_ld(unsigned* p)              { return __hip_atomic_load(p, __ATOMIC_RELAXED, __HIP_MEMORY_SCOPE_AGENT); }
__device__ __forceinline__ unsigned xb_add(unsigned* p, unsigned v) { return __hip_atomic_fetch_add(p, v, __ATOMIC_RELAXED, __HIP_MEMORY_SCOPE_AGENT); }
__device__ __forceinline__ unsigned xb_xcc_id() { return (unsigned)__builtin_amdgcn_s_getreg((3 << 11) | 20) & 0xFu; }
#define XB_SPIN(cond, bar) do { unsigned _sp = 0; while (cond) { __builtin_amdgcn_s_sleep(1); \
    if ((++_sp & 255u) == 0u) { if (xb_ld(&(bar)[XB_TMO])) break; if (_sp > XB_SPIN_CAP) { atomicAdd(&(bar)[XB_TMO], 1u); break; } } } } while (0)
struct XcdBarrier { unsigned* bar; unsigned x; volatile LAS unsigned* st; };
__device__ __forceinline__ XcdBarrier xcd_barrier_post(unsigned* bar, volatile LAS unsigned* st) {
    XcdBarrier b; b.bar = bar; b.x = xb_xcc_id(); b.st = st;
    if (KTID == 0) (void)xb_add(&bar[XB_XCNT(b.x)], 1u);
    return b;
}
__device__ __forceinline__ void xcd_barrier_complete(unsigned* bar, unsigned x, unsigned& nloc, unsigned& nx) {
    const unsigned G = (unsigned)KGRID;
    unsigned sum, cnt, mine, sp = 0u;
    for (;;) {
        sum = 0u; cnt = 0u; mine = 0u;
#pragma unroll
        for (unsigned j = 0; j < 16; ++j) { const unsigned c = xb_ld(&bar[XB_XCNT(j)]); sum += c; cnt += (c > 0u) ? 1u : 0u; mine = (j == x) ? c : mine; }
        if (sum == G) break;
        __builtin_amdgcn_s_sleep(1);
        if ((++sp & 255u) == 0u) { if (xb_ld(&bar[XB_TMO])) break; if (sp > XB_SPIN_CAP) { atomicAdd(&bar[XB_TMO], 1u); break; } }
    }
    nloc = mine > 0u ? mine : 1u; nx = cnt > 0u ? cnt : 1u;
}
__device__ __forceinline__ void xcd_barrier(const XcdBarrier& b) {
    asm volatile("s_waitcnt vmcnt(0)" ::: "memory");
    __syncthreads();
    if (KTID == 0) {
        unsigned* bar = b.bar;
        __builtin_amdgcn_s_waitcnt(0);
        unsigned nloc = b.st[0], nx = b.st[1];
        if (nloc == 0u) { xcd_barrier_complete(bar, b.x, nloc, nx); b.st[0] = nloc; b.st[1] = nx; }
        const unsigned old = xb_add(&bar[XB_XSUB(b.x)], 1u);
        const unsigned gen = old / nloc;
        if (old + 1u == (gen + 1u) * nloc) {
            __builtin_amdgcn_fence(__ATOMIC_RELEASE, "agent");
            asm volatile("s_waitcnt vmcnt(0)" ::: "memory");
            const unsigned og = xb_add(&bar[XB_TOP], 1u);
            const unsigned tg = og / nx;
            if (og + 1u == (tg + 1u) * nx) xb_add(&bar[XB_TOPGEN], 1u);
            else XB_SPIN(xb_ld(&bar[XB_TOPGEN]) == tg, bar);
            __builtin_amdgcn_fence(__ATOMIC_ACQUIRE, "agent");
            xb_add(&bar[XB_XGEN(b.x)], 1u);
            asm volatile("s_waitcnt vmcnt(0)" ::: "memory");
        } else {
            XB_SPIN(xb_ld(&bar[XB_XGEN(b.x)]) == gen, bar);
            __builtin_amdgcn_fence(__ATOMIC_ACQUIRE, "agent");
            asm volatile("s_waitcnt vmcnt(0)" ::: "memory");
        }
    }
    __syncthreads();
}

__device__ __forceinline__ int rope_unperm(int jj) { return (jj < 32) ? ((jj >> 1) + 16 * (jj & 1)) : (32 + ((jj - 32) >> 1) + 16 * (jj & 1)); }
__device__ __forceinline__ int map_in(int n) {
    if (n < 256) return 416 + n;
    if (n < 512) return 1632 + (n - 256);
    if (n < 768) return 736 + (n - 512);
    if (n < 1024) return 992 + (n - 768);
    if (n < 1280) return 128 + (n - 1024);
    if (n < 1536) return 1376 + (n - 1280);
    if (n < 1664) return n - 1536;
    if (n < 1792) return 1248 + (n - 1664);
    if (n < 1856) return 672 + rope_unperm(n - 1792);
    if (n < 1872) return 384 + (n - 1856);
    if (n < 1888) return 400 + (n - 1872);
    return -1;
}
__device__ __forceinline__ int map_uq(int n) { const int h = n / 192, j = n % 192; return (j < 128) ? n : (h * 192 + 128 + rope_unperm(j - 128)); }
template <int MODE> __device__ __forceinline__ void transpose_w(const float* W, int K, int Nsrc, bf16_t* Wt, int Npad, int gtid, int gthreads) {
    const int total = Npad * (K / 8);
    for (int idx = gtid; idx < total; idx += gthreads) {
        const int n = idx % Npad, kc = idx / Npad;
        const int src = (MODE == 0) ? n : (MODE == 1 ? map_in(n) : map_uq(n));
        float f[8];
#pragma unroll
        for (int i = 0; i < 8; ++i) f[i] = (src >= 0) ? W[(size_t)(kc * 8 + i) * Nsrc + src] : 0.f;
        u32x4 o; o.x = pk2(f[0], f[1]); o.y = pk2(f[2], f[3]); o.z = pk2(f[4], f[5]); o.w = pk2(f[6], f[7]);
        *(u32x4*)(Wt + (size_t)n * K + kc * 8) = o;
    }
}
template <int MODE> __device__ __forceinline__ void transpose_item(const float* W, int K, int Nsrc, bf16_t* Wt, int Npad, LAS float* scr, int item, int lane) {
    const int nblk = Npad / 32, kb = item / nblk, nb = item % nblk, k0 = 64 * kb, n0 = 32 * nb;
    const int nn = n0 + (lane & 31), src = (MODE == 0) ? nn : (MODE == 1 ? map_in(nn) : map_uq(nn));
    float tv[32];
#pragma unroll
    for (int i = 0; i < 32; ++i) { const int kk = 2 * i + (lane >> 5); tv[i] = (src >= 0) ? W[(size_t)(k0 + kk) * Nsrc + src] : 0.f; }
#pragma unroll
    for (int i = 0; i < 32; ++i) { const int kk = 2 * i + (lane >> 5); scr[kk * 33 + (lane & 31)] = tv[i]; }
    asm volatile("s_waitcnt lgkmcnt(0)" ::: "memory");
    const int c = lane & 7;
#pragma unroll
    for (int j = 0; j < 4; ++j) { const int n = (lane >> 3) + 8 * j; const LAS float* s = scr + (8 * c) * 33 + n;
        u32x4 o; o.x = pk2(s[0 * 33], s[1 * 33]); o.y = pk2(s[2 * 33], s[3 * 33]); o.z = pk2(s[4 * 33], s[5 * 33]); o.w = pk2(s[6 * 33], s[7 * 33]);
        *(u32x4*)(Wt + (size_t)(n0 + n) * K + k0 + 8 * c) = o; }
    asm volatile("s_waitcnt lgkmcnt(0)" ::: "memory");
}
__device__ __forceinline__ void phase_prep(const Args& a, LAS unsigned char* lds) {
    unsigned char* ws = a.ws;
    const int tid = KTID, gtid = blockIdx.x * NTHR + tid, gthreads = KGRID * NTHR;
    {
        const int wave = kwave(), lane = klane(), gw = blockIdx.x * NWAVES + wave, ngw = KGRID * NWAVES;
        LAS float* scr = (LAS float*)(lds + 8192 + wave * 8704);
        for (int it = gw; it < 2 * 5856; it += ngw) {
            const int l = it / 5856; int r = it % 5856;
            if (r < 1024) { transpose_item<1>(a.in[I_WIN] + (size_t)l * DM * IN_COLS, DM, IN_COLS, (bf16_t*)(ws + WS_WIN) + (size_t)l * INP * DM, INP, scr, r, lane); continue; } r -= 1024;
            if (r < 512) { transpose_item<0>(a.in[I_WOUT] + (size_t)l * DM * DM, DM, DM, (bf16_t*)(ws + WS_WOUT) + (size_t)l * DM * DM, DM, scr, r, lane); continue; } r -= 512;
            if (r < 96) { transpose_item<2>(a.in[I_WUQ] + (size_t)l * 256 * 768, 256, 768, (bf16_t*)(ws + WS_WUQ) + (size_t)l * 768 * 256, 768, scr, r, lane); continue; } r -= 96;
            if (r < 128) { transpose_item<0>(a.in[I_WUKV] + (size_t)l * 256 * 1024, 256, 1024, (bf16_t*)(ws + WS_WUKV) + (size_t)l * 1024 * 256, 1024, scr, r, lane); continue; } r -= 128;
            if (r < 2048) { transpose_item<0>(a.in[I_WFF1] + (size_t)l * DM * FF, DM, FF, (bf16_t*)(ws + WS_WFF1) + (size_t)l * FF * DM, FF, scr, r, lane); continue; } r -= 2048;
            transpose_item<0>(a.in[I_WFF2] + (size_t)l * FF * DM, FF, DM, (bf16_t*)(ws + WS_WFF2) + (size_t)l * DM * FF, DM, scr, r, lane);
        }
    }
    for (int idx = gtid; idx < 2 * 4 * 128 * 128 / 4; idx += gthreads) { const f32x4 v = *(const f32x4*)(a.in[I_SGW] + (size_t)idx * 4); u32x2 o; o.x = pk2(v.x, v.y); o.y = pk2(v.z, v.w); *(u32x2*)((bf16_t*)(ws + WS_WSB) + (size_t)idx * 4) = o; }
    { const int ridx = ((int)blockIdx.x - (KGRID - 4)) * NTHR + tid;
      if (ridx >= 0 && ridx < 128 * 16) {
        const int p = ridx >> 4, i = ridx & 15;
        const float freq = powf(10000.0f, -(float)i * 2.0f / 32.0f);
        const float ang = (float)p * freq;
        float sn, cs; sincosf(ang, &sn, &cs);
        float* R = (float*)(ws + WS_ROPE);
        R[ridx * 2 + 0] = cs; R[ridx * 2 + 1] = sn;
      } }
    {
        LAS float* red = (LAS float*)lds;
        LAS float* sil = (LAS float*)(lds + 80 * 1024);
        const int wave = kwave(), lane = klane();
        if ((int)blockIdx.x < 2 * 96) {
            for (int i = tid; i < 3 * DM; i += NTHR) { const float v = i < 2 * DM ? a.in[I_C][i] : a.in[I_CCTX][i - 2 * DM]; sil[i] = silu_f(v); }
        }
        __syncthreads();
        for (int item = blockIdx.x; item < 2 * 96; item += KGRID) {
            const int l = item / 96, j = (item % 96) * 64 + lane;
            const float* W = a.in[I_WMOD] + (size_t)l * DM * 6144 + (size_t)(wave * 128) * 6144 + j;
            float s0 = 0.f, s1 = 0.f, s2 = 0.f;
#pragma unroll 16
            for (int kk = 0; kk < 128; ++kk) {
                const float w = W[(size_t)kk * 6144];
                const int k2 = wave * 128 + kk;
                s0 += sil[k2] * w; s1 += sil[DM + k2] * w; s2 += sil[2 * DM + k2] * w;
            }
            red[(wave * 3 + 0) * 64 + lane] = s0; red[(wave * 3 + 1) * 64 + lane] = s1; red[(wave * 3 + 2) * 64 + lane] = s2;
            __syncthreads();
            if (tid < 192) {
                const int r = tid >> 6; float s = 0.f;
#pragma unroll
                for (int w = 0; w < 8; ++w) s += red[(w * 3 + r) * 64 + lane];
                ((float*)(ws + WS_MOD))[(size_t)(l * 3 + r) * 6144 + j] = s + a.in[I_BMOD][l * 6144 + j];
            }
            __syncthreads();
        }
    }
}

__device__ __forceinline__ void phase_norm_mod(const float* xl, const float* xc, const float* nw, const float* mod, int sh_off, int sc_off, bf16_t* H, int nrows) {
    const int lane = klane(), gw = blockIdx.x * NWAVES + kwave(), ngw = KGRID * NWAVES;
    for (int row = gw; row < nrows; row += ngw) {
        const float* src = row < ML ? xl + (size_t)row * DM : xc + (size_t)(row - ML) * DM;
        const float* m = mod + (row < ML ? row / NL : 2) * 6144;
        f32x4 v[4]; float ss = 0.f;
#pragma unroll
        for (int j = 0; j < 4; ++j) { v[j] = *(const f32x4*)(src + lane * 4 + 256 * j); ss += v[j].x * v[j].x + v[j].y * v[j].y + v[j].z * v[j].z + v[j].w * v[j].w; }
        const float rstd = rsqrtf(wave_sum(ss) * (1.f / DM) + EPS);
#pragma unroll
        for (int j = 0; j < 4; ++j) {
            const int c = lane * 4 + 256 * j;
            const f32x4 w = *(const f32x4*)(nw + c), sc = *(const f32x4*)(m + sc_off + c), sh = *(const f32x4*)(m + sh_off + c);
            const f32x4 o = (v[j] * rstd * w) * (sc + 1.f) + sh;
            u32x2 pk; pk.x = pk2(o.x, o.y); pk.y = pk2(o.z, o.w);
            *(u32x2*)(H + (size_t)row * DM + c) = pk;
        }
    }
}

template <class Epi> __device__ __forceinline__ void gemm_naive(const bf16_t* A, int lda, const bf16_t* Bt, int M, int N, int K, const Epi& E, LAS unsigned char* lds) {
    LAS float* As = (LAS float*)lds;
    LAS float* Bs = As + 32 * 132;
    const int tid = KTID, ty = tid >> 4, tx = tid & 15;
    const int ntm = M / 128, ntn = N / 64, ntiles = ntm * ntn;
    for (int tile = blockIdx.x; tile < ntiles; tile += KGRID) {
        const int tm = tile / ntn, tn = tile % ntn, row0 = tm * 128, col0 = tn * 64;
        float acc[4][4];
#pragma unroll
        for (int i = 0; i < 4; ++i)
#pragma unroll
            for (int j = 0; j < 4; ++j) acc[i][j] = 0.f;
        for (int k0 = 0; k0 < K; k0 += 32) {
            {
                const int r = tid >> 2, kc = (tid & 3) * 8; float f[8];
                unpack8(*(const u32x4*)(A + (size_t)(row0 + r) * lda + k0 + kc), f);
#pragma unroll
                for (int i = 0; i < 8; ++i) As[(kc + i) * 132 + r] = f[i];
                if (tid < 256) {
                    unpack8(*(const u32x4*)(Bt + (size_t)(col0 + r) * K + k0 + kc), f);
#pragma unroll
                    for (int i = 0; i < 8; ++i) Bs[(kc + i) * 68 + r] = f[i];
                }
            }
            __syncthreads();
#pragma unroll 8
            for (int k = 0; k < 32; ++k) {
                const f32x4 av = *(const LAS f32x4*)(As + k * 132 + ty * 4), bv = *(const LAS f32x4*)(Bs + k * 68 + tx * 4);
#pragma unroll
                for (int i = 0; i < 4; ++i)
#pragma unroll
                    for (int j = 0; j < 4; ++j) acc[i][j] += av[i] * bv[j];
            }
            __syncthreads();
        }
#pragma unroll
        for (int i = 0; i < 4; ++i) E(row0 + ty * 4 + i, col0 + tx * 4, (f32x4){acc[i][0], acc[i][1], acc[i][2], acc[i][3]});
    }
}

__device__ __forceinline__ void st4bf(bf16_t* p, f32x4 v) { u32x2 pk; pk.x = pk2(v.x, v.y); pk.y = pk2(v.z, v.w); *(u32x2*)p = pk; }
__device__ __forceinline__ f32x4 rope4(f32x4 v, int jj, int t, const float* R) {
    const int pos = (jj < 32) ? (t >> 6) : (t & 63), i0 = ((jj & 31) >> 1);
    const f32x4 cs = *(const f32x4*)(R + (pos * 16 + i0) * 2);
    return (f32x4){v.x * cs.x - v.y * cs.y, v.x * cs.y + v.y * cs.x, v.z * cs.z - v.w * cs.w, v.z * cs.w + v.w * cs.z};
}
__device__ __forceinline__ void st8bf(bf16_t* p, f32x4 a, f32x4 b) { u32x4 pk; pk.x = pk2(a.x, a.y); pk.y = pk2(a.z, a.w); pk.z = pk2(b.x, b.y); pk.w = pk2(b.z, b.w); *(u32x4*)p = pk; }
struct EpiInProj { bf16_t* PB; const float* R;
    __device__ __forceinline__ f32x4 xf(int row, int col, f32x4 v) const {
        const int tile = col >> 8;
        if (tile == 2 || tile == 3) { v = (f32x4){gelu_tanh(v.x), gelu_tanh(v.y), gelu_tanh(v.z), gelu_tanh(v.w)}; }
        else if (tile == 5) { v = (f32x4){silu_f(v.x), silu_f(v.y), silu_f(v.z), silu_f(v.w)}; }
        else if (tile == 7) { const int cc = col - C_KR; if (cc < 64 && row < ML) v = rope4(v, cc, row & (NL - 1), R); }
        return v; }
    __device__ __forceinline__ void operator()(int row, int col, f32x4 v) const { st4bf(PB + (size_t)row * INP + col, xf(row, col, v)); }
    __device__ __forceinline__ void op8(int row, int col, f32x4 v0, f32x4 v1) const { st8bf(PB + (size_t)row * INP + col, xf(row, col, v0), xf(row, col + 4, v1)); } };
struct EpiUQ { bf16_t* QB;
    __device__ __forceinline__ void operator()(int row, int col, f32x4 v) const { st4bf(QB + (size_t)row * 768 + col, v * QSCALE); }
    __device__ __forceinline__ void op8(int row, int col, f32x4 v0, f32x4 v1) const { st8bf(QB + (size_t)row * 768 + col, v0 * QSCALE, v1 * QSCALE); } };
struct EpiUKV { bf16_t* KVB;
    __device__ __forceinline__ void operator()(int row, int col, f32x4 v) const { st4bf(KVB + (size_t)row * 1024 + col, v); }
    __device__ __forceinline__ void op8(int row, int col, f32x4 v0, f32x4 v1) const { st8bf(KVB + (size_t)row * 1024 + col, v0, v1); } };
struct EpiResid { const float* xin_l; const float* xin_c; float* xout_l; float* xout_c; const float* mod; int g_off;
    __device__ __forceinline__ void operator()(int row, int col, f32x4 v) const {
        if (row < ML) { const f32x4 g = *(const f32x4*)(mod + (row >> 13) * 6144 + g_off + col), xi = *(const f32x4*)(xin_l + (size_t)row * DM + col);
            *(f32x4*)(xout_l + (size_t)row * DM + col) = xi + g * v;
        } else { const int rc = row - ML; const f32x4 g = *(const f32x4*)(mod + 2 * 6144 + g_off + col), xi = *(const f32x4*)(xin_c + (size_t)rc * DM + col);
            *(f32x4*)(xout_c + (size_t)rc * DM + col) = xi + g * v; }
    } };
struct EpiNull {
    __device__ __forceinline__ void operator()(int row, int col, f32x4 v) const { asm volatile("" :: "v"(v)); }
    __device__ __forceinline__ void op8(int row, int col, f32x4 v0, f32x4 v1) const { asm volatile("" :: "v"(v0), "v"(v1)); } };
struct EpiFF1 { bf16_t* Ah;
    __device__ __forceinline__ void operator()(int row, int col, f32x4 v) const {
        f32x4 r = (f32x4){fmaxf(v.x, 0.f), fmaxf(v.y, 0.f), fmaxf(v.z, 0.f), fmaxf(v.w, 0.f)};
        st4bf(Ah + (size_t)row * FF + col, r * r);
    }
    __device__ __forceinline__ void op8(int row, int col, f32x4 v0, f32x4 v1) const {
        f32x4 r0 = (f32x4){fmaxf(v0.x, 0.f), fmaxf(v0.y, 0.f), fmaxf(v0.z, 0.f), fmaxf(v0.w, 0.f)}, r1 = (f32x4){fmaxf(v1.x, 0.f), fmaxf(v1.y, 0.f), fmaxf(v1.z, 0.f), fmaxf(v1.w, 0.f)};
        st8bf(Ah + (size_t)row * FF + col, r0 * r0, r1 * r1);
    } };

__device__ __forceinline__ void phase_post(const Args& a, int l) {
    unsigned char* ws = a.ws;
    bf16_t* PB = (bf16_t*)(ws + WS_PB); float* LG = (float*)(ws + WS_LG);
    const float* kvnw = a.in[I_KVNW] + l * 256; const float* qnw = a.in[I_QNW] + l * 256;
    const float* snw = a.in[I_SGNW] + l * 256; const float* snb = a.in[I_SGNB] + l * 256;
    const float* wgf = a.in[I_GWF] + l * 16 * 128; const float* bgf = a.in[I_GBF] + l * 128;
    const float* wgb = a.in[I_GWB] + l * 16 * 128; const float* bgb = a.in[I_GBB] + l * 128;
    const int lane = klane(), gw = blockIdx.x * NWAVES + kwave(), ngw = KGRID * NWAVES;
    for (int row = gw; row < MT; row += ngw) {
        bf16_t* pr = PB + (size_t)row * INP;
        const int c = lane * 4;
        { u32x2 w = *(const u32x2*)(pr + C_CKV + c); f32x4 v = {__uint_as_float(w.x << 16), __uint_as_float(w.x & 0xffff0000u), __uint_as_float(w.y << 16), __uint_as_float(w.y & 0xffff0000u)};
          const float rstd = rsqrtf(wave_sum(v.x * v.x + v.y * v.y + v.z * v.z + v.w * v.w) * (1.f / 256.f) + EPS);
          st4bf(pr + C_CKV + c, v * rstd * *(const f32x4*)(kvnw + c)); }
        { u32x2 w = *(const u32x2*)(pr + C_DQ + c); f32x4 v = {__uint_as_float(w.x << 16), __uint_as_float(w.x & 0xffff0000u), __uint_as_float(w.y << 16), __uint_as_float(w.y & 0xffff0000u)};
          const float rstd = rsqrtf(wave_sum(v.x * v.x + v.y * v.y + v.z * v.z + v.w * v.w) * (1.f / 256.f) + EPS);
          st4bf(pr + C_DQ + c, v * rstd * *(const f32x4*)(qnw + c)); }
        { u32x2 w = *(const u32x2*)(pr + C_SV + c); f32x4 v = {__uint_as_float(w.x << 16), __uint_as_float(w.x & 0xffff0000u), __uint_as_float(w.y << 16), __uint_as_float(w.y & 0xffff0000u)};
          const float mu = wave_sum(v.x + v.y + v.z + v.w) * (1.f / 256.f);
          v = v - mu;
          const float rstd = rsqrtf(wave_sum(v.x * v.x + v.y * v.y + v.z * v.z + v.w * v.w) * (1.f / 256.f) + EPS);
          st4bf(pr + C_SV + c, v * rstd * *(const f32x4*)(snw + c) + *(const f32x4*)(snb + c)); }
        if (GLA_NAIVE) { const int o = lane * 4, isb = o >> 7, d = o & 127;
          const float* wg = isb ? wgb : wgf; const float* bg = isb ? bgb : bgf; const bf16_t* gg = pr + (isb ? C_GGB : C_GGF);
          f32x4 z = *(const f32x4*)(bg + d);
#pragma unroll
          for (int r = 0; r < 16; ++r) z += *(const f32x4*)(wg + r * 128 + d) * bf2f(gg[r]);
          *(f32x4*)(LG + (size_t)row * 256 + o) = (f32x4){log_sigmoid_f(z.x), log_sigmoid_f(z.y), log_sigmoid_f(z.z), log_sigmoid_f(z.w)} * (1.f / 16.f); }
    }
}

__device__ __forceinline__ void phase_sgu_naive(const Args& a, int l) {
    unsigned char* ws = a.ws;
    const bf16_t* PB = (const bf16_t*)(ws + WS_PB); bf16_t* Y = (bf16_t*)(ws + WS_HY);
    const float* Ws = a.in[I_SGW] + (size_t)l * 4 * 128 * 128; const float* bs = a.in[I_SGB] + l * 4 * 128;
    const int tid = KTID, i = tid >> 2, eg = (tid & 3) * 16;
    for (int unit = blockIdx.x; unit < (MT / 128) * 4; unit += KGRID) {
        const int cc = unit >> 2, h = unit & 3;
        float acc[16];
#pragma unroll
        for (int e = 0; e < 16; ++e) acc[e] = 0.f;
        const float* wrow = Ws + ((size_t)h * 128 + i) * 128;
        for (int j = 0; j < 128; ++j) {
            const float w = wrow[j];
            const bf16_t* vp = PB + (size_t)(cc * 128 + j) * INP + C_SV + h * 64 + eg;
            float f[8], g[8]; unpack8(*(const u32x4*)vp, f); unpack8(*(const u32x4*)(vp + 8), g);
#pragma unroll
            for (int e = 0; e < 8; ++e) { acc[e] += w * f[e]; acc[8 + e] += w * g[e]; }
        }
        const float bias = bs[h * 128 + i];
        const int row = cc * 128 + i;
        const bf16_t* up = PB + (size_t)row * INP + C_SU + h * 64 + eg;
        float f[8], g[8]; unpack8(*(const u32x4*)up, f); unpack8(*(const u32x4*)(up + 8), g);
        bf16_t* yp = Y + (size_t)row * DM + h * 64 + eg;
        u32x4 o0, o1;
        o0.x = pk2(f[0] * (acc[0] + bias), f[1] * (acc[1] + bias)); o0.y = pk2(f[2] * (acc[2] + bias), f[3] * (acc[3] + bias));
        o0.z = pk2(f[4] * (acc[4] + bias), f[5] * (acc[5] + bias)); o0.w = pk2(f[6] * (acc[6] + bias), f[7] * (acc[7] + bias));
        o1.x = pk2(g[0] * (acc[8] + bias), g[1] * (acc[9] + bias)); o1.y = pk2(g[2] * (acc[10] + bias), g[3] * (acc[11] + bias));
        o1.z = pk2(g[4] * (acc[12] + bias), g[5] * (acc[13] + bias)); o1.w = pk2(g[6] * (acc[14] + bias), g[7] * (acc[15] + bias));
        *(u32x4*)yp = o0; *(u32x4*)(yp + 8) = o1;
    }
}

__device__ __forceinline__ void phase_gla_naive(const Args& a, int l) {
    unsigned char* ws = a.ws;
    const bf16_t* PB = (const bf16_t*)(ws + WS_PB); bf16_t* Y = (bf16_t*)(ws + WS_HY);
    const float* LG = (const float*)(ws + WS_LG); float* OB = (float*)(ws + WS_OB);
    const float* gnw = a.in[I_GNW] + l * 64;
    if (blockIdx.x >= 8 || KTID >= 64) return;
    const int b = blockIdx.x >> 2, h = blockIdx.x & 3, e = KTID;
    const float gw_e = gnw[e];
    for (int dir = 1; dir >= 0; --dir) {
        float S[32];
#pragma unroll
        for (int d = 0; d < 32; ++d) S[d] = 0.f;
        for (int tau = 0; tau < NKEY; ++tau) {
            int row;
            if (dir == 0) row = tau < NC ? ML + b * NC + tau : b * NL + (tau - NC);
            else row = tau < NC ? ML + b * NC + (NC - 1 - tau) : b * NL + (NL - 1 - (tau - NC));
            const bf16_t* pr = PB + (size_t)row * INP;
            const float* lg = LG + (size_t)row * 256 + dir * 128 + h * 32;
            const float v = bf2f(pr[C_GV + h * 64 + e]);
            float o = 0.f;
#pragma unroll
            for (int d = 0; d < 32; ++d) {
                const float kk = bf2f(pr[C_GK + h * 32 + d]), qq = bf2f(pr[C_GQ + h * 32 + d]), al = expf(lg[d]);
                S[d] = al * S[d] + kk * v; o += qq * S[d];
            }
            o *= 0.17677669529663687f;
            if (dir == 1) OB[(size_t)row * 256 + h * 64 + e] = o;
            else {
                o += OB[(size_t)row * 256 + h * 64 + e];
                const float ms = wave_sum(o * o) * (1.f / 64.f);
                const float y = o * rsqrtf(ms + EPS) * gw_e * bf2f(pr[C_GR + h * 64 + e]);
                Y[(size_t)row * DM + 256 + h * 64 + e] = (bf16_t)f2bf(y);
            }
        }
    }
}

typedef short bf16x8 __attribute__((ext_vector_type(8)));
typedef float f32x16 __attribute__((ext_vector_type(16)));
typedef float f32x2_t __attribute__((ext_vector_type(2)));
typedef __bf16 bf16x2_t __attribute__((ext_vector_type(2)));
__device__ __forceinline__ unsigned cvtpk(float lo, float hi) { f32x2_t v = {lo, hi}; bf16x2_t b = __builtin_convertvector(v, bf16x2_t); return __builtin_bit_cast(unsigned, b); }
__device__ __forceinline__ int crow(int r, int hi) { return (r & 3) + 8 * (r >> 2) + 4 * hi; }
constexpr int GLA_WLDS = 17920, GLA_NB = 132;
constexpr size_t WS_BC = WS_LG, WS_GL = WS_OB, WS_GD = 1 * MiB + 512 * 1024;
static_assert((size_t)2112 * 2048 * 4 <= WS_END - WS_OB && WS_GD + (size_t)2112 * 32 * 4 <= WS_WIN && WS_ROPE + 16384 <= WS_GD && WS_WSB + 262144 <= WS_WUKV && WS_WUQ + (size_t)2 * 768 * 256 * 2 <= WS_WSB, "gla ws");
__device__ __forceinline__ int gla_row0(int b, int beta) { return beta < 4 ? ML + b * NC + beta * 64 : b * NL + (beta - 4) * 64; }
#define LDS_FENCE() do { asm volatile("s_waitcnt lgkmcnt(0)" ::: "memory"); __builtin_amdgcn_sched_barrier(0); } while (0)
__device__ __forceinline__ void gla_stage_vt(const bf16_t* pv, LAS bf16_t* VT, int lane) {
#pragma unroll
    for (int c8 = 0; c8 < 8; ++c8) { const u32x4 w = *(const u32x4*)(pv + c8 * 8);
        VT[(c8 * 8 + 0) * 64 + lane] = (bf16_t)(w.x & 0xffffu); VT[(c8 * 8 + 1) * 64 + lane] = (bf16_t)(w.x >> 16);
        VT[(c8 * 8 + 2) * 64 + lane] = (bf16_t)(w.y & 0xffffu); VT[(c8 * 8 + 3) * 64 + lane] = (bf16_t)(w.y >> 16);
        VT[(c8 * 8 + 4) * 64 + lane] = (bf16_t)(w.z & 0xffffu); VT[(c8 * 8 + 5) * 64 + lane] = (bf16_t)(w.z >> 16);
        VT[(c8 * 8 + 6) * 64 + lane] = (bf16_t)(w.w & 0xffffu); VT[(c8 * 8 + 7) * 64 + lane] = (bf16_t)(w.w >> 16); }
}
__device__ __forceinline__ void load32bf(const bf16_t* p, float* f) {
    unpack8(*(const u32x4*)(p), f); unpack8(*(const u32x4*)(p + 8), f + 8); unpack8(*(const u32x4*)(p + 16), f + 16); unpack8(*(const u32x4*)(p + 24), f + 24);
}
__device__ __forceinline__ void phase_gla_local(const Args& a, int l, LAS unsigned char* lds) {
    unsigned char* ws = a.ws;
    const bf16_t* PB = (const bf16_t*)(ws + WS_PB); float* BC = (float*)(ws + WS_BC); float* GL = (float*)(ws + WS_GL); float* GD = (float*)(ws + WS_GD);
    const int lane = klane(), wave = kwave(), gw = blockIdx.x * NWAVES + wave, ngw = KGRID * NWAVES;
    const int r32 = lane & 31, hi = lane >> 5;
    LAS bf16_t* KT = (LAS bf16_t*)(lds + wave * GLA_WLDS); LAS bf16_t* VT = KT + 32 * 64;
    for (int task = gw; task < 16 * GLA_NB; task += ngw) {
        const int beta = task % GLA_NB, t2 = task / GLA_NB, dir = t2 & 1, h = (t2 >> 1) & 3, b = t2 >> 3;
        const int row = gla_row0(b, beta) + lane; const bf16_t* pr = PB + (size_t)row * INP;
        LDS_FENCE();
        gla_stage_vt(pr + C_GV + h * 64, VT, lane);
        float c[32];
        {
          const float* wg = (dir ? a.in[I_GWB] : a.in[I_GWF]) + l * 16 * 128 + h * 32; const float* bg = (dir ? a.in[I_GBB] : a.in[I_GBF]) + l * 128 + h * 32;
          LAS float* WGL = (LAS float*)(VT + 64 * 64); LAS float* BGL = WGL + 16 * 32;
          { const int r = lane >> 2, d0 = (lane & 3) * 8;
            *(LAS f32x4*)(WGL + r * 32 + d0) = *(const f32x4*)(wg + r * 128 + d0); *(LAS f32x4*)(WGL + r * 32 + d0 + 4) = *(const f32x4*)(wg + r * 128 + d0 + 4);
            if (lane < 32) BGL[lane] = bg[lane]; }
          float gg[16]; unpack8(*(const u32x4*)(pr + (dir ? C_GGB : C_GGF)), gg); unpack8(*(const u32x4*)(pr + (dir ? C_GGB : C_GGF) + 8), gg + 8);
          LDS_FENCE();
#pragma unroll
          for (int d = 0; d < 32; d += 4) { f32x4 z = *(const LAS f32x4*)(BGL + d);
#pragma unroll
              for (int r = 0; r < 16; ++r) z += *(const LAS f32x4*)(WGL + r * 32 + d) * gg[r];
              c[d] = log_sigmoid_fast(z.x) * (1.f / 16.f); c[d + 1] = log_sigmoid_fast(z.y) * (1.f / 16.f); c[d + 2] = log_sigmoid_fast(z.z) * (1.f / 16.f); c[d + 3] = log_sigmoid_fast(z.w) * (1.f / 16.f); } }
        if (dir == 0) {
#pragma unroll
            for (int d = 0; d < 32; ++d) { float v = c[d];
#pragma unroll
                for (int off = 1; off < 64; off <<= 1) { const float t = __shfl_up(v, off); if (lane >= off) v += t; }
                c[d] = v; }
        } else {
#pragma unroll
            for (int d = 0; d < 32; ++d) { float v = c[d];
#pragma unroll
                for (int off = 1; off < 64; off <<= 1) { const float t = __shfl_down(v, off); if (lane + off < 64) v += t; }
                c[d] = v; }
        }
        { float* bc = BC + (size_t)row * 256 + dir * 128 + h * 32;
#pragma unroll
          for (int d = 0; d < 32; d += 4) *(f32x4*)(bc + d) = (f32x4){c[d], c[d + 1], c[d + 2], c[d + 3]}; }
        float kk[32]; load32bf(pr + C_GK + h * 32, kk);
        const int tl = dir ? 0 : 63;
#pragma unroll
        for (int d = 0; d < 32; ++d) { const float T = __shfl(c[d], tl);
            KT[d * 64 + lane] = (bf16_t)(cvtpk(kk[d] * __expf(T - c[d]), 0.f) & 0xffffu);
            if (lane == 0) GD[(size_t)task * 32 + d] = __expf(T); }
        LDS_FENCE();
        f32x16 acc0 = {}, acc1 = {};
#pragma unroll
        for (int s = 0; s < 4; ++s) {
            const bf16x8 af = *(const LAS bf16x8*)(KT + r32 * 64 + 16 * s + 8 * hi);
            const bf16x8 b0 = *(const LAS bf16x8*)(VT + r32 * 64 + 16 * s + 8 * hi), b1 = *(const LAS bf16x8*)(VT + (32 + r32) * 64 + 16 * s + 8 * hi);
            acc0 = __builtin_amdgcn_mfma_f32_32x32x16_bf16(af, b0, acc0, 0, 0, 0); acc1 = __builtin_amdgcn_mfma_f32_32x32x16_bf16(af, b1, acc1, 0, 0, 0);
        }
        float* gl = GL + (size_t)task * 2048;
#pragma unroll
        for (int r = 0; r < 16; ++r) { gl[crow(r, hi) * 64 + r32] = acc0[r]; gl[crow(r, hi) * 64 + 32 + r32] = acc1[r]; }
    }
}
__device__ __forceinline__ void phase_gla_scan(const Args& a) {
    unsigned char* ws = a.ws; float* GL = (float*)(ws + WS_GL); const float* GD = (const float*)(ws + WS_GD);
    const int idx = ((int)blockIdx.x - (KGRID - 64)) * NTHR + KTID;
    if (idx < 0 || idx >= 16 * 2048) return;
    const int seq = idx >> 11, de = idx & 2047, d = de >> 6, dir = seq & 1;
    float S = 0.f;
    for (int c0 = 0; c0 < GLA_NB; c0 += 12) {
        float Lv[12], Dv[12];
#pragma unroll
        for (int u = 0; u < 12; ++u) { const int c = c0 + u, beta = dir ? (c < 4 ? 3 - c : 135 - c) : c; const size_t slot = (size_t)seq * GLA_NB + beta;
            Lv[u] = GL[slot * 2048 + de]; Dv[u] = GD[slot * 32 + d]; }
#pragma unroll
        for (int u = 0; u < 12; ++u) { const int c = c0 + u, beta = dir ? (c < 4 ? 3 - c : 135 - c) : c; const size_t slot = (size_t)seq * GLA_NB + beta;
            GL[slot * 2048 + de] = S; S = Dv[u] * S + Lv[u]; }
    }
}
template <int DIR> __device__ __forceinline__ void gla_dir(const bf16_t* pr, const float* bc, const float* sin, int h, LAS bf16_t* QS, LAS bf16_t* KS, const LAS bf16_t* VT, int lane,
                                                            f32x16& o00, f32x16& o01, f32x16& o10, f32x16& o11) {
    const int r32 = lane & 31, hi = lane >> 5;
    {
        float c[32], q[32], k[32];
#pragma unroll
        for (int d = 0; d < 32; d += 4) { const f32x4 v = *(const f32x4*)(bc + d); c[d] = v.x; c[d + 1] = v.y; c[d + 2] = v.z; c[d + 3] = v.w; }
        load32bf(pr + C_GQ + h * 32, q); load32bf(pr + C_GK + h * 32, k);
#pragma unroll
        for (int d = 0; d < 32; d += 8) {
            u32x4 wq, wk; float eq[8], ek[8];
#pragma unroll
            for (int i = 0; i < 8; ++i) { eq[i] = q[d + i] * __expf(c[d + i]) * 0.17677669529663687f; ek[i] = k[d + i] * __expf(-c[d + i]); }
            wq.x = cvtpk(eq[0], eq[1]); wq.y = cvtpk(eq[2], eq[3]); wq.z = cvtpk(eq[4], eq[5]); wq.w = cvtpk(eq[6], eq[7]);
            wk.x = cvtpk(ek[0], ek[1]); wk.y = cvtpk(ek[2], ek[3]); wk.z = cvtpk(ek[4], ek[5]); wk.w = cvtpk(ek[6], ek[7]);
            *(LAS u32x4*)(QS + lane * 32 + d) = wq; *(LAS u32x4*)(KS + lane * 32 + d) = wk;
        }
    }
    LDS_FENCE();
    bf16x8 qf[2][2], kf[2][2];
#pragma unroll
    for (int t = 0; t < 2; ++t)
#pragma unroll
        for (int s = 0; s < 2; ++s) { qf[t][s] = *(const LAS bf16x8*)(QS + (32 * t + r32) * 32 + 16 * s + 8 * hi); kf[t][s] = *(const LAS bf16x8*)(KS + (32 * t + r32) * 32 + 16 * s + 8 * hi); }
    LDS_FENCE();
    {
        u32x4 w[4];
#pragma unroll
        for (int d = 0; d < 32; d += 8) {
            float sv[8];
#pragma unroll
            for (int i = 0; i < 8; ++i) sv[i] = sin[(d + i) * 64 + lane];
            w[d >> 3].x = cvtpk(sv[0], sv[1]); w[d >> 3].y = cvtpk(sv[2], sv[3]); w[d >> 3].z = cvtpk(sv[4], sv[5]); w[d >> 3].w = cvtpk(sv[6], sv[7]);
        }
#pragma unroll
        for (int i = 0; i < 4; ++i) *(LAS u32x4*)(QS + lane * 32 + 8 * i) = w[i];
    }
#define GLA_X(tj, ti) __builtin_amdgcn_mfma_f32_32x32x16_bf16(kf[tj][1], qf[ti][1], __builtin_amdgcn_mfma_f32_32x32x16_bf16(kf[tj][0], qf[ti][0], (f32x16){}, 0, 0, 0), 0, 0, 0)
#define GLA_MASK(X) do { _Pragma("unroll") for (int r = 0; r < 16; ++r) { const int jl = crow(r, hi); const bool keep = DIR == 0 ? (jl <= r32) : (jl >= r32); X[r] = keep ? X[r] : 0.f; } } while (0)
#define GLA_XA(X, s) __builtin_bit_cast(bf16x8, (u32x4){cvtpk(X[8 * (s) + 0], X[8 * (s) + 1]), cvtpk(X[8 * (s) + 2], X[8 * (s) + 3]), cvtpk(X[8 * (s) + 4], X[8 * (s) + 5]), cvtpk(X[8 * (s) + 6], X[8 * (s) + 7])})
#define GLA_VF(tj, s, te) __builtin_bit_cast(bf16x8, (u32x4){((const LAS u32x2*)(VT + (32 * (te) + r32) * 64 + 32 * (tj) + 16 * (s) + 4 * hi))->x, ((const LAS u32x2*)(VT + (32 * (te) + r32) * 64 + 32 * (tj) + 16 * (s) + 4 * hi))->y, \
                                                              ((const LAS u32x2*)(VT + (32 * (te) + r32) * 64 + 32 * (tj) + 16 * (s) + 8 + 4 * hi))->x, ((const LAS u32x2*)(VT + (32 * (te) + r32) * 64 + 32 * (tj) + 16 * (s) + 8 + 4 * hi))->y})
#define GLA_PV(X, tj, O0, O1) do { _Pragma("unroll") for (int s = 0; s < 2; ++s) { const bf16x8 xa = GLA_XA(X, s); \
        O0 = __builtin_amdgcn_mfma_f32_32x32x16_bf16(xa, GLA_VF(tj, s, 0), O0, 0, 0, 0); O1 = __builtin_amdgcn_mfma_f32_32x32x16_bf16(xa, GLA_VF(tj, s, 1), O1, 0, 0, 0); } } while (0)
    __builtin_amdgcn_sched_barrier(0);
    { f32x16 X = GLA_X(0, 0); GLA_MASK(X); GLA_PV(X, 0, o00, o01); }
    __builtin_amdgcn_sched_barrier(0);
    { f32x16 X = GLA_X(1, 1); GLA_MASK(X); GLA_PV(X, 1, o10, o11); }
    __builtin_amdgcn_sched_barrier(0);
    if (DIR == 0) { f32x16 X = GLA_X(0, 1); GLA_PV(X, 0, o10, o11); }
    else          { f32x16 X = GLA_X(1, 0); GLA_PV(X, 1, o00, o01); }
    LDS_FENCE();
#pragma unroll
    for (int s = 0; s < 2; ++s) {
        const bf16x8 s0 = *(const LAS bf16x8*)(QS + r32 * 32 + 16 * s + 8 * hi), s1 = *(const LAS bf16x8*)(QS + (32 + r32) * 32 + 16 * s + 8 * hi);
        o00 = __builtin_amdgcn_mfma_f32_32x32x16_bf16(qf[0][s], s0, o00, 0, 0, 0); o01 = __builtin_amdgcn_mfma_f32_32x32x16_bf16(qf[0][s], s1, o01, 0, 0, 0);
        o10 = __builtin_amdgcn_mfma_f32_32x32x16_bf16(qf[1][s], s0, o10, 0, 0, 0); o11 = __builtin_amdgcn_mfma_f32_32x32x16_bf16(qf[1][s], s1, o11, 0, 0, 0);
    }
    LDS_FENCE();
#undef GLA_X
#undef GLA_MASK
#undef GLA_XA
#undef GLA_VF
#undef GLA_PV
}
__device__ __forceinline__ void phase_gla_out(const Args& a, int l, LAS unsigned char* lds) {
    unsigned char* ws = a.ws;
    const bf16_t* PB = (const bf16_t*)(ws + WS_PB); const float* BC = (const float*)(ws + WS_BC); const float* GL = (const float*)(ws + WS_GL); bf16_t* Y = (bf16_t*)(ws + WS_HY);
    const float* gnw = a.in[I_GNW] + l * 64;
    const int lane = klane(), wave = kwave(), gw = blockIdx.x * NWAVES + wave, ngw = KGRID * NWAVES;
    const int r32 = lane & 31, hi = lane >> 5;
    LAS bf16_t* QS = (LAS bf16_t*)(lds + wave * GLA_WLDS); LAS bf16_t* KS = QS + 64 * 32; LAS bf16_t* VT = KS + 64 * 32; LAS float* OS = (LAS float*)(lds + wave * GLA_WLDS);
    for (int task = gw; task < 8 * GLA_NB; task += ngw) {
        const int beta = task % GLA_NB, bh = task / GLA_NB, h = bh & 3, b = bh >> 2;
        const int row = gla_row0(b, beta) + lane; const bf16_t* pr = PB + (size_t)row * INP;
        LDS_FENCE();
        gla_stage_vt(pr + C_GV + h * 64, VT, lane);
        f32x16 o00 = {}, o01 = {}, o10 = {}, o11 = {};
        gla_dir<0>(pr, BC + (size_t)row * 256 + h * 32, GL + ((size_t)(bh * 2 + 0) * GLA_NB + beta) * 2048, h, QS, KS, VT, lane, o00, o01, o10, o11);
        gla_dir<1>(pr, BC + (size_t)row * 256 + 128 + h * 32, GL + ((size_t)(bh * 2 + 1) * GLA_NB + beta) * 2048, h, QS, KS, VT, lane, o00, o01, o10, o11);
#pragma unroll
        for (int r = 0; r < 16; ++r) { const int i = crow(r, hi);
            OS[i * 65 + r32] = o00[r]; OS[i * 65 + 32 + r32] = o01[r]; OS[(32 + i) * 65 + r32] = o10[r]; OS[(32 + i) * 65 + 32 + r32] = o11[r]; }
        LDS_FENCE();
        float ss = 0.f;
#pragma unroll
        for (int e = 0; e < 64; ++e) { const float v = OS[lane * 65 + e]; ss += v * v; }
        const float rstd = rsqrtf(ss * (1.f / 64.f) + EPS);
        bf16_t* yp = Y + (size_t)row * DM + 256 + h * 64;
#pragma unroll
        for (int c8 = 0; c8 < 8; ++c8) { float rr[8]; unpack8(*(const u32x4*)(pr + C_GR + h * 64 + c8 * 8), rr);
            float y[8];
#pragma unroll
            for (int i = 0; i < 8; ++i) y[i] = OS[lane * 65 + c8 * 8 + i] * rstd * gnw[c8 * 8 + i] * rr[i];
            u32x4 w; w.x = cvtpk(y[0], y[1]); w.y = cvtpk(y[2], y[3]); w.z = cvtpk(y[4], y[5]); w.w = cvtpk(y[6], y[7]);
            *(u32x4*)(yp + c8 * 8) = w; }
    }
}

__device__ __forceinline__ void phase_sgu_mfma(const Args& a, int l, LAS unsigned char* lds) {
    unsigned char* ws = a.ws;
    const bf16_t* PB = (const bf16_t*)(ws + WS_PB); bf16_t* Y = (bf16_t*)(ws + WS_HY);
    const bf16_t* WSB = (const bf16_t*)(ws + WS_WSB) + (size_t)l * 4 * 128 * 128; const float* bs = a.in[I_SGB] + l * 4 * 128;
    const int lane = klane(), wave = kwave(), gw = blockIdx.x * NWAVES + wave, ngw = KGRID * NWAVES;
    const int r32 = lane & 31, hi = lane >> 5;
    LAS bf16_t* VT = (LAS bf16_t*)(lds + wave * GLA_WLDS);
    for (int task = gw; task < (MT / 128) * 4; task += ngw) {
        const int cc = task >> 2, h = task & 3;
        LDS_FENCE();
#pragma unroll
        for (int half = 0; half < 2; ++half) { const int j = lane + 64 * half; const bf16_t* pv = PB + (size_t)(cc * 128 + j) * INP + C_SV + h * 64;
#pragma unroll
            for (int c8 = 0; c8 < 8; ++c8) { const u32x4 w = *(const u32x4*)(pv + c8 * 8);
                VT[(c8 * 8 + 0) * 128 + j] = (bf16_t)(w.x & 0xffffu); VT[(c8 * 8 + 1) * 128 + j] = (bf16_t)(w.x >> 16);
                VT[(c8 * 8 + 2) * 128 + j] = (bf16_t)(w.y & 0xffffu); VT[(c8 * 8 + 3) * 128 + j] = (bf16_t)(w.y >> 16);
                VT[(c8 * 8 + 4) * 128 + j] = (bf16_t)(w.z & 0xffffu); VT[(c8 * 8 + 5) * 128 + j] = (bf16_t)(w.z >> 16);
                VT[(c8 * 8 + 6) * 128 + j] = (bf16_t)(w.w & 0xffffu); VT[(c8 * 8 + 7) * 128 + j] = (bf16_t)(w.w >> 16); } }
        LDS_FENCE();
#pragma unroll 1
        for (int ti = 0; ti < 4; ++ti) {
            f32x16 acc0 = {}, acc1 = {};
            const bf16_t* wrow = WSB + ((size_t)h * 128 + 32 * ti + r32) * 128 + 8 * hi;
#pragma unroll
            for (int s = 0; s < 8; ++s) {
                const bf16x8 bw = *(const bf16x8*)(wrow + 16 * s);
                const bf16x8 a0 = *(const LAS bf16x8*)(VT + r32 * 128 + 16 * s + 8 * hi), a1 = *(const LAS bf16x8*)(VT + (32 + r32) * 128 + 16 * s + 8 * hi);
                acc0 = __builtin_amdgcn_mfma_f32_32x32x16_bf16(a0, bw, acc0, 0, 0, 0); acc1 = __builtin_amdgcn_mfma_f32_32x32x16_bf16(a1, bw, acc1, 0, 0, 0);
            }
            const int i = 32 * ti + r32, row = cc * 128 + i; const float bias = bs[h * 128 + i];
            const bf16_t* up = PB + (size_t)row * INP + C_SU + h * 64 + 4 * hi; bf16_t* yp = Y + (size_t)row * DM + h * 64 + 4 * hi;
#pragma unroll
            for (int g = 0; g < 4; ++g) {
                { const u32x2 u = *(const u32x2*)(up + 8 * g); u32x2 o;
                  o.x = cvtpk(__uint_as_float(u.x << 16) * (acc0[4 * g + 0] + bias), __uint_as_float(u.x & 0xffff0000u) * (acc0[4 * g + 1] + bias));
                  o.y = cvtpk(__uint_as_float(u.y << 16) * (acc0[4 * g + 2] + bias), __uint_as_float(u.y & 0xffff0000u) * (acc0[4 * g + 3] + bias));
                  *(u32x2*)(yp + 8 * g) = o; }
                { const u32x2 u = *(const u32x2*)(up + 32 + 8 * g); u32x2 o;
                  o.x = cvtpk(__uint_as_float(u.x << 16) * (acc1[4 * g + 0] + bias), __uint_as_float(u.x & 0xffff0000u) * (acc1[4 * g + 1] + bias));
                  o.y = cvtpk(__uint_as_float(u.y << 16) * (acc1[4 * g + 2] + bias), __uint_as_float(u.y & 0xffff0000u) * (acc1[4 * g + 3] + bias));
                  *(u32x2*)(yp + 32 + 8 * g) = o; }
            }
        }
    }
}

__device__ __forceinline__ void phase_attn_naive(const Args& a, int l, LAS unsigned char* lds) {
    unsigned char* ws = a.ws;
    const bf16_t* QB = (const bf16_t*)(ws + WS_QB); const bf16_t* KVB = (const bf16_t*)(ws + WS_KVB); const bf16_t* PB = (const bf16_t*)(ws + WS_PB); bf16_t* Y = (bf16_t*)(ws + WS_HY);
    const float* ROPE = (const float*)(ws + WS_ROPE);
    LAS float* Qs = (LAS float*)lds;
    LAS float* Ks = Qs + 192 * 64;
    LAS float* Vs = Ks + 96 * 64;
    LAS float* Ps = Vs + 64 * 128;
    const int tid = KTID, ty = tid >> 4, tx = tid & 15;
    const int nunits = 1024 + (l == 0 ? 32 : 0);
    for (int unit = blockIdx.x; unit < nunits; unit += KGRID) {
        int bh, nkeys, orow0;
        if (unit < 1024) { bh = unit >> 7; const int qb = unit & 127; nkeys = NKEY; orow0 = (bh >> 2) * NL + qb * 64; }
        else { const int u = unit - 1024; bh = u >> 2; const int qb = u & 3; nkeys = NC; orow0 = ML + (bh >> 2) * NC + qb * 64; }
        const int h = bh & 3, b = bh >> 2;
        const bf16_t* Qp = QB + (size_t)orow0 * 768 + h * 192;
        __syncthreads();
        for (int idx = tid; idx < 64 * 24; idx += NTHR) { const int r = idx / 24, ch = idx % 24; float f[8]; unpack8(*(const u32x4*)(Qp + (size_t)r * 768 + ch * 8), f);
            if (ch >= 16 && unit < 1024) { const int t = (orow0 + r) & (NL - 1), jj = (ch - 16) * 8;
                const f32x4 r0 = rope4((f32x4){f[0], f[1], f[2], f[3]}, jj, t, ROPE), r1 = rope4((f32x4){f[4], f[5], f[6], f[7]}, jj + 4, t, ROPE);
                f[0] = r0.x; f[1] = r0.y; f[2] = r0.z; f[3] = r0.w; f[4] = r1.x; f[5] = r1.y; f[6] = r1.z; f[7] = r1.w; }
#pragma unroll
            for (int i = 0; i < 8; ++i) Qs[(ch * 8 + i) * 64 + r] = f[i]; }
        float m[2] = {-1e30f, -1e30f}, lsum[2] = {0.f, 0.f}, o[2][8];
#pragma unroll
        for (int r = 0; r < 2; ++r)
#pragma unroll
            for (int c = 0; c < 8; ++c) o[r][c] = 0.f;
        for (int k0 = 0; k0 < nkeys; k0 += 64) {
            const int krow0 = k0 < NC ? ML + b * NC + k0 : b * NL + (k0 - NC);
            float s[2][4];
#pragma unroll
            for (int r = 0; r < 2; ++r)
#pragma unroll
                for (int j = 0; j < 4; ++j) s[r][j] = 0.f;
            for (int dh = 0; dh < 2; ++dh) {
                __syncthreads();
                for (int idx = tid; idx < 64 * 12; idx += NTHR) { const int key = idx / 12, ch = idx % 12; float f[8];
                    const int dcol = dh * 96 + ch * 8;
                    unpack8(dcol < 128 ? *(const u32x4*)(KVB + (size_t)(krow0 + key) * 1024 + h * 256 + dcol) : *(const u32x4*)(PB + (size_t)(krow0 + key) * INP + C_KR + (dcol - 128)), f);
#pragma unroll
                    for (int i = 0; i < 8; ++i) Ks[(ch * 8 + i) * 64 + key] = f[i]; }
                if (dh == 0) {
                    for (int idx = tid; idx < 64 * 16; idx += NTHR) { const int key = idx >> 4, ch = idx & 15; float f[8];
                        unpack8(*(const u32x4*)(KVB + (size_t)(krow0 + key) * 1024 + h * 256 + 128 + ch * 8), f);
#pragma unroll
                        for (int i = 0; i < 8; ++i) Vs[key * 128 + ch * 8 + i] = f[i]; }
                }
                __syncthreads();
#pragma unroll 4
                for (int d = 0; d < 96; ++d) {
                    const float q0 = Qs[(dh * 96 + d) * 64 + 2 * ty], q1 = Qs[(dh * 96 + d) * 64 + 2 * ty + 1];
                    const f32x4 kv = *(const LAS f32x4*)(Ks + d * 64 + 4 * tx);
#pragma unroll
                    for (int j = 0; j < 4; ++j) { s[0][j] += q0 * kv[j]; s[1][j] += q1 * kv[j]; }
                }
            }
#pragma unroll
            for (int r = 0; r < 2; ++r) {
                float mx = fmaxf(fmaxf(s[r][0], s[r][1]), fmaxf(s[r][2], s[r][3]));
                mx = fmaxf(mx, __shfl_xor(mx, 1)); mx = fmaxf(mx, __shfl_xor(mx, 2)); mx = fmaxf(mx, __shfl_xor(mx, 4)); mx = fmaxf(mx, __shfl_xor(mx, 8));
                const float mn = fmaxf(m[r], mx), alpha = exp2f(m[r] - mn);
                float p[4], rs = 0.f;
#pragma unroll
                for (int j = 0; j < 4; ++j) { p[j] = exp2f(s[r][j] - mn); rs += p[j]; Ps[(2 * ty + r) * 65 + 4 * tx + j] = p[j]; }
                rs += __shfl_xor(rs, 1); rs += __shfl_xor(rs, 2); rs += __shfl_xor(rs, 4); rs += __shfl_xor(rs, 8);
                lsum[r] = lsum[r] * alpha + rs; m[r] = mn;
#pragma unroll
                for (int c = 0; c < 8; ++c) o[r][c] *= alpha;
            }
            __syncthreads();
#pragma unroll 4
            for (int j = 0; j < 64; ++j) {
                const float p0 = Ps[(2 * ty) * 65 + j], p1 = Ps[(2 * ty + 1) * 65 + j];
                const f32x4 v0 = *(const LAS f32x4*)(Vs + j * 128 + 8 * tx), v1 = *(const LAS f32x4*)(Vs + j * 128 + 8 * tx + 4);
#pragma unroll
                for (int c = 0; c < 4; ++c) { o[0][c] += p0 * v0[c]; o[0][4 + c] += p0 * v1[c]; o[1][c] += p1 * v0[c]; o[1][4 + c] += p1 * v1[c]; }
            }
        }
#pragma unroll
        for (int r = 0; r < 2; ++r) {
            const float il = 1.f / lsum[r];
            u32x4 w; w.x = pk2(o[r][0] * il, o[r][1] * il); w.y = pk2(o[r][2] * il, o[r][3] * il); w.z = pk2(o[r][4] * il, o[r][5] * il); w.w = pk2(o[r][6] * il, o[r][7] * il);
            *(u32x4*)(Y + (size_t)(orow0 + 2 * ty + r) * DM + 512 + h * 128 + 8 * tx) = w;
        }
    }
}

namespace att {
using s16x4 = __attribute__((ext_vector_type(4))) short;
constexpr int QBLK = 32, KVBLK = 64;
constexpr int SHM_V = KVBLK * 128 * 2, SHM_K = KVBLK * 192 * 2, SHM_SCR = 2 * SHM_V + 2 * SHM_K, SHM_QL = SHM_SCR + NWAVES * 64 * 4, SHM_ATTN = SHM_QL + NWAVES * ATT_NQL * 1024;
constexpr float THR2 = 11.5f;
#define KSWZ(row, colB) ((row) * 384 + ((colB) ^ ((((row) >> 1) & 7) << 4)))
#define SBAR() __builtin_amdgcn_sched_barrier(0)
__device__ __forceinline__ void partialSM(f32x16& p0, f32x16& p1, float& m_reg, float& mn, float& alpha) {
  float pmax = p0[0];
#pragma unroll
  for (int r = 1; r < 16; ++r) pmax = fmaxf(pmax, p0[r]);
#pragma unroll
  for (int r = 0; r < 16; ++r) pmax = fmaxf(pmax, p1[r]);
  { auto rr = __builtin_amdgcn_permlane32_swap(__float_as_uint(pmax), __float_as_uint(pmax), false, false);
    pmax = fmaxf(__uint_as_float(rr[0]), __uint_as_float(rr[1])); }
  if (__builtin_expect(__all(pmax - m_reg <= THR2), 1)) { mn = m_reg; alpha = 1.f; }
  else { mn = fmaxf(m_reg, pmax); alpha = __builtin_amdgcn_exp2f(m_reg - mn); m_reg = mn; }
#pragma unroll
  for (int r = 0; r < 16; ++r) p0[r] = p0[r] - mn;
#pragma unroll
  for (int r = 0; r < 16; ++r) p1[r] = p1[r] - mn;
#pragma unroll
  for (int r = 0; r < 16; ++r) p0[r] = __builtin_amdgcn_exp2f(p0[r]);
}
__device__ __forceinline__ void finishSM(f32x16& p0, f32x16& p1, float alpha, float& l_reg, bf16x8& pa0, bf16x8& pa1, bf16x8& pa2, bf16x8& pa3) {
#pragma unroll
  for (int r = 0; r < 16; ++r) p1[r] = __builtin_amdgcn_exp2f(p1[r]);
  float ps = 0;
#pragma unroll
  for (int r = 0; r < 16; ++r) ps += p0[r];
#pragma unroll
  for (int r = 0; r < 16; ++r) ps += p1[r];
  { auto rr = __builtin_amdgcn_permlane32_swap(__float_as_uint(ps), __float_as_uint(ps), false, false);
    ps = __uint_as_float(rr[0]) + __uint_as_float(rr[1]); }
  l_reg = l_reg * alpha + ps;
#define PK4(P, BASE, OUT) do { unsigned a0 = cvtpk(P[BASE + 0], P[BASE + 1]), a1 = cvtpk(P[BASE + 2], P[BASE + 3]);   \
    unsigned b0 = cvtpk(P[BASE + 4], P[BASE + 5]), b1 = cvtpk(P[BASE + 6], P[BASE + 7]);                              \
    auto r0 = __builtin_amdgcn_permlane32_swap(a0, b0, false, false); auto r1 = __builtin_amdgcn_permlane32_swap(a1, b1, false, false); \
    u32x4 w = {r0[0], r1[0], r0[1], r1[1]}; OUT = __builtin_bit_cast(bf16x8, w); } while (0)
  PK4(p0, 0, pa0); PK4(p0, 8, pa1); PK4(p1, 0, pa2); PK4(p1, 8, pa3);
#undef PK4
}
constexpr int NQR = 12 - ATT_NQL;
#define ATT_KRD(K0, K1, d0, KB) asm volatile("ds_read_b128 %0, %2 offset:%3\n\tds_read_b128 %1, %2 offset:%4" : "=&v"(K0), "=&v"(K1) : "v"(ka[(d0) & 3]), "i"((KB) + ((d0) >> 2) * 128), "i"((KB) + ((d0) >> 2) * 128 + 12288) : "memory")
#define ATT_QRD(Q, d0) asm volatile("ds_read_b128 %0, %1 offset:%2" : "=&v"(Q) : "v"(qla), "i"(((d0) - NQR) * 1024) : "memory")
template <int KB> __device__ __forceinline__ void qkt(f32x16& p0, f32x16& p1, const unsigned (&ka)[4], const bf16x8* qr, unsigned qla) {
  p0 = f32x16{}; p1 = f32x16{};
  bf16x8 kx0, kx1, ky0, ky1, qx, qy;
  ATT_KRD(kx0, kx1, 0, KB); if (0 >= NQR) ATT_QRD(qx, 0);
#pragma unroll
  for (int d0 = 0; d0 < 12; d0 += 2) {
    ATT_KRD(ky0, ky1, d0 + 1, KB); if (d0 + 1 >= NQR) ATT_QRD(qy, d0 + 1);
    if (d0 + 1 >= NQR) { if (d0 >= NQR) asm volatile("s_waitcnt lgkmcnt(3)" : "+v"(kx0), "+v"(kx1), "+v"(qx)); else asm volatile("s_waitcnt lgkmcnt(3)" : "+v"(kx0), "+v"(kx1)); }
    else asm volatile("s_waitcnt lgkmcnt(2)" : "+v"(kx0), "+v"(kx1));
    { const bf16x8 qf = d0 < NQR ? qr[d0 < NQR ? d0 : 0] : qx;
      p0 = __builtin_amdgcn_mfma_f32_32x32x16_bf16(kx0, qf, p0, 0, 0, 0); p1 = __builtin_amdgcn_mfma_f32_32x32x16_bf16(kx1, qf, p1, 0, 0, 0); }
    if (d0 + 2 < 12) { ATT_KRD(kx0, kx1, d0 + 2, KB); if (d0 + 2 >= NQR) ATT_QRD(qx, d0 + 2);
      if (d0 + 2 >= NQR) { if (d0 + 1 >= NQR) asm volatile("s_waitcnt lgkmcnt(3)" : "+v"(ky0), "+v"(ky1), "+v"(qy)); else asm volatile("s_waitcnt lgkmcnt(3)" : "+v"(ky0), "+v"(ky1)); }
      else asm volatile("s_waitcnt lgkmcnt(2)" : "+v"(ky0), "+v"(ky1)); }
    else { if (d0 + 1 >= NQR) asm volatile("s_waitcnt lgkmcnt(0)" : "+v"(ky0), "+v"(ky1), "+v"(qy)); else asm volatile("s_waitcnt lgkmcnt(0)" : "+v"(ky0), "+v"(ky1)); }
    { const bf16x8 qf = d0 + 1 < NQR ? qr[d0 + 1 < NQR ? d0 + 1 : 0] : qy;
      p0 = __builtin_amdgcn_mfma_f32_32x32x16_bf16(ky0, qf, p0, 0, 0, 0); p1 = __builtin_amdgcn_mfma_f32_32x32x16_bf16(ky1, qf, p1, 0, 0, 0); }
  }
}
__device__ __forceinline__ int v_st(int k, int c) { const int kk = (k & ~0xC) | ((k & 4) << 1) | ((k & 8) >> 1); return ((kk >> 3) * 4 + (c >> 5)) * 512 + ((kk & 7) * 32 + (c & 31)) * 2; }
__device__ __forceinline__ int v_rd_base(int lane) { return ((lane & 3) << 3) | (((lane >> 2) & 3) << 6) | (((lane >> 4) & 1) << 5) | (((lane >> 5) & 1) << 8); }
constexpr int v_rd_off(int d0, int ks, int half) { return d0 * 512 + ks * 4096 + half * 2048; }
template <int OFF> __device__ __forceinline__ s16x4 tr_read(int vb) {
  s16x4 r; asm volatile("ds_read_b64_tr_b16 %0, %1 offset:%2" : "=&v"(r) : "v"(vb), "i"(OFF) : "memory"); return r;
}
template <int D0> __device__ __forceinline__ void pv_one(f32x16& od, int vb, bf16x8 pa0, bf16x8 pa1, bf16x8 pa2, bf16x8 pa3) {
  const s16x4 l0 = tr_read<v_rd_off(D0, 0, 0)>(vb), h0 = tr_read<v_rd_off(D0, 0, 1)>(vb), l1 = tr_read<v_rd_off(D0, 1, 0)>(vb), h1 = tr_read<v_rd_off(D0, 1, 1)>(vb);
  const s16x4 l2 = tr_read<v_rd_off(D0, 2, 0)>(vb), h2 = tr_read<v_rd_off(D0, 2, 1)>(vb), l3 = tr_read<v_rd_off(D0, 3, 0)>(vb), h3 = tr_read<v_rd_off(D0, 3, 1)>(vb);
  asm volatile("s_waitcnt lgkmcnt(0)" ::: "memory"); SBAR();
#define PK(L, H) (bf16x8){L[0], L[1], L[2], L[3], H[0], H[1], H[2], H[3]}
  od = __builtin_amdgcn_mfma_f32_32x32x16_bf16(pa0, PK(l0, h0), od, 0, 0, 0);
  od = __builtin_amdgcn_mfma_f32_32x32x16_bf16(pa1, PK(l1, h1), od, 0, 0, 0);
  od = __builtin_amdgcn_mfma_f32_32x32x16_bf16(pa2, PK(l2, h2), od, 0, 0, 0);
  od = __builtin_amdgcn_mfma_f32_32x32x16_bf16(pa3, PK(l3, h3), od, 0, 0, 0);
#undef PK
}
__device__ __forceinline__ void pv_d0(f32x16* o, int vb, bf16x8 pa0, bf16x8 pa1, bf16x8 pa2, bf16x8 pa3) {
  pv_one<0>(o[0], vb, pa0, pa1, pa2, pa3); pv_one<1>(o[1], vb, pa0, pa1, pa2, pa3); pv_one<2>(o[2], vb, pa0, pa1, pa2, pa3); pv_one<3>(o[3], vb, pa0, pa1, pa2, pa3);
}
template <int ABL> __device__ __forceinline__ void unit(const bf16_t* __restrict__ QB, const bf16_t* __restrict__ KVB, const bf16_t* __restrict__ PB, const float* __restrict__ ROPE, bf16_t* __restrict__ Y,
                                     int qrow0, int b, int h, int nkeys, bool ropeq, LAS unsigned char* lds) {
  const int wid = kwave(), lane = klane(), tid = wid * 64 + lane, r32 = lane & 31, hi = lane >> 5;
  LAS unsigned char* V_lds = lds; LAS unsigned char* K_lds = lds + 2 * SHM_V;
  LAS float* wsc = (LAS float*)(lds + SHM_SCR) + wid * 64; LAS float* li_l = wsc; LAS float* al_l = wsc + 32;
  LAS unsigned char* qlw = lds + SHM_QL + wid * (ATT_NQL * 1024); const LAS unsigned char* ql = qlw + lane * 16;
  float m_reg = -1e30f, l_reg = 0; f32x16 o[4] = {}; bf16x8 qr[NQR];
  {
    const int qrow = qrow0 + wid * QBLK + r32;
    const bf16_t* Qw = QB + (size_t)qrow * 768 + h * 192 + hi * 8;
#pragma unroll
    for (int d0 = 0; d0 < 12; ++d0) {
      u32x4 w = *(const u32x4*)(Qw + d0 * 16);
      if (d0 >= 8 && ropeq) { float f[8]; unpack8(w, f); const int t = qrow & (NL - 1), jj = (d0 - 8) * 16 + hi * 8;
        const f32x4 r0 = rope4((f32x4){f[0], f[1], f[2], f[3]}, jj, t, ROPE), r1 = rope4((f32x4){f[4], f[5], f[6], f[7]}, jj + 4, t, ROPE);
        w.x = cvtpk(r0.x, r0.y); w.y = cvtpk(r0.z, r0.w); w.z = cvtpk(r1.x, r1.y); w.w = cvtpk(r1.z, r1.w); }
      if (d0 < NQR) qr[d0 < NQR ? d0 : 0] = __builtin_bit_cast(bf16x8, w); else *(LAS u32x4*)(qlw + (d0 - NQR) * 1024 + lane * 16) = w;
    }
  }
  const int sr = tid >> 4, sc = (tid & 15) * 8, vst0 = v_st(sr, sc), vst1 = v_st(32 + sr, sc);
  const int krw = tid >> 3, kcg = tid & 7;
  const int kw0 = KSWZ(krw, kcg * 16), kw1 = KSWZ(krw, (kcg + 8) * 16), kw2 = KSWZ(krw, (kcg + 16) * 16);
  const int vb0 = (int)(uintptr_t)V_lds + v_rd_base(lane);
  unsigned ka[4];
#pragma unroll
  for (int c = 0; c < 4; ++c) ka[c] = (unsigned)(uintptr_t)K_lds + r32 * 384 + (((c << 5) | (hi << 4)) ^ (((r32 >> 1) & 7) << 4));
  const unsigned qla = (unsigned)(uintptr_t)ql;
  u32x4 sv0, sv1, sk0, sk1, sk2;
#define KROW(k0) ((k0) < NC ? ML + b * NC + (k0) : b * NL + ((k0) - NC))
  const int gv0 = sr * 1024 + h * 256 + 128 + sc, gv1 = gv0 + 32 * 1024, gk0 = krw * 1024 + h * 256 + kcg * 8, gk1 = gk0 + 64, gk2 = krw * INP + C_KR + kcg * 8;
#define KLOAD(k0) do { const int kr_ = __builtin_amdgcn_readfirstlane(KROW(k0)); const bf16_t* kvb_ = KVB + (size_t)kr_ * 1024; const bf16_t* pb_ = PB + (size_t)kr_ * INP; \
    sk0 = *(const u32x4*)(kvb_ + gk0); sk1 = *(const u32x4*)(kvb_ + gk1); sk2 = *(const u32x4*)(pb_ + gk2); } while (0)
#define VLOAD(k0) do { const int kr_ = __builtin_amdgcn_readfirstlane(KROW(k0)); const bf16_t* kvb_ = KVB + (size_t)kr_ * 1024; \
    sv0 = *(const u32x4*)(kvb_ + gv0); sv1 = *(const u32x4*)(kvb_ + gv1); } while (0)
#define KWRITE(bf) do { *(LAS u32x4*)(K_lds + (bf) * SHM_K + kw0) = sk0; *(LAS u32x4*)(K_lds + (bf) * SHM_K + kw1) = sk1; *(LAS u32x4*)(K_lds + (bf) * SHM_K + kw2) = sk2; } while (0)
#define VWRITE(bf) do { *(LAS u32x4*)(V_lds + (bf) * SHM_V + vst0) = sv0; *(LAS u32x4*)(V_lds + (bf) * SHM_V + vst1) = sv1; } while (0)
#define RESC(a) do { if (__any((a) < 1.f)) { if (hi == 0) al_l[r32] = (a); asm volatile("s_waitcnt lgkmcnt(0)" ::: "memory"); \
    _Pragma("unroll") for (int d = 0; d < 4; ++d) _Pragma("unroll") for (int r = 0; r < 16; ++r) o[d][r] *= al_l[crow(r, hi)]; } } while (0)
  f32x16 pA0, pA1, pB0, pB1; float mnA, mnB, alA, alB; bf16x8 pa0, pa1, pa2, pa3; const int NT = nkeys / KVBLK;
#define QKT0(P0, P1) do { if constexpr (ABL == 2) { P0 = f32x16{}; P1 = f32x16{}; asm volatile("" : "+v"(P0), "+v"(P1)); } else qkt<0>(P0, P1, ka, qr, qla); } while (0)
#define QKT1(P0, P1) do { if constexpr (ABL == 2) { P0 = f32x16{}; P1 = f32x16{}; asm volatile("" : "+v"(P0), "+v"(P1)); } else qkt<SHM_K>(P0, P1, ka, qr, qla); } while (0)
#define PV(VB) do { if constexpr (ABL == 3) { asm volatile("" : "+v"(o[0]), "+v"(o[1]), "+v"(o[2]), "+v"(o[3]) : "v"(pa0), "v"(pa1), "v"(pa2), "v"(pa3)); } else pv_d0(o, VB, pa0, pa1, pa2, pa3); } while (0)
#define PSM(P0, P1, MN, AL) do { if constexpr (ABL == 4) { MN = 0.f; AL = 1.f; asm volatile("" : "+v"(P0), "+v"(P1)); } else partialSM(P0, P1, m_reg, MN, AL); } while (0)
#define FSM(P0, P1, AL) do { if constexpr (ABL == 4) { u32x4 w0_ = {__float_as_uint(P0[0]), __float_as_uint(P0[1]), __float_as_uint(P0[2]), __float_as_uint(P0[3])}, w1_ = {__float_as_uint(P1[0]), __float_as_uint(P1[1]), __float_as_uint(P1[2]), __float_as_uint(P1[3])}; \
      pa0 = __builtin_bit_cast(bf16x8, w0_); pa1 = __builtin_bit_cast(bf16x8, w1_); pa2 = pa0; pa3 = pa1; l_reg += AL; } else finishSM(P0, P1, AL, l_reg, pa0, pa1, pa2, pa3); } while (0)
  KLOAD(0); KWRITE(0); __syncthreads();
  if (wid >= 4) __syncthreads();
  SBAR(); KLOAD(KVBLK); SBAR(); QKT0(pA0, pA1); SBAR(); KWRITE(1); __syncthreads();
  SBAR(); VLOAD(0); SBAR(); PSM(pA0, pA1, mnA, alA); SBAR(); VWRITE(0); __syncthreads();
  for (int j = 1; j + 1 < NT; j += 2) {
    SBAR(); if constexpr (ABL != 1) KLOAD((j + 1) * KVBLK); SBAR(); QKT1(pB0, pB1); FSM(pA0, pA1, alA); SBAR(); if constexpr (ABL != 1) KWRITE(0); __syncthreads();
    SBAR(); if constexpr (ABL != 1) VLOAD(j * KVBLK); SBAR(); PV(vb0); PSM(pB0, pB1, mnB, alB); RESC(alB); SBAR(); if constexpr (ABL != 1) VWRITE(1); __syncthreads();
    SBAR(); if constexpr (ABL != 1) KLOAD((j + 2) * KVBLK); SBAR(); QKT0(pA0, pA1); FSM(pB0, pB1, alB); SBAR(); if constexpr (ABL != 1) KWRITE(1); __syncthreads();
    SBAR(); if constexpr (ABL != 1) VLOAD((j + 1) * KVBLK); SBAR(); PV(vb0 + SHM_V); PSM(pA0, pA1, mnA, alA); RESC(alA); SBAR(); if constexpr (ABL != 1) VWRITE(0); __syncthreads();
  }
  SBAR(); QKT1(pB0, pB1); FSM(pA0, pA1, alA); SBAR(); __syncthreads();
  SBAR(); VLOAD((NT - 1) * KVBLK); SBAR(); PV(vb0); PSM(pB0, pB1, mnB, alB); RESC(alB); SBAR(); VWRITE(1); __syncthreads();
  if (wid < 4) __syncthreads();
  FSM(pB0, pB1, alB); SBAR();
  PV(vb0 + SHM_V);
#undef QKT0
#undef QKT1
#undef PV
#undef PSM
#undef FSM
  if (hi == 0) li_l[r32] = l_reg; asm volatile("s_waitcnt lgkmcnt(0)" ::: "memory");
  float rli[16];
#pragma unroll
  for (int r = 0; r < 16; ++r) rli[r] = __builtin_amdgcn_rcpf(li_l[crow(r, hi)]);
  bf16_t* Ow = Y + (size_t)(qrow0 + wid * QBLK) * DM + 512 + h * 128;
#pragma unroll
  for (int r = 0; r < 16; ++r) { const int orow = crow(r, hi);
#pragma unroll
    for (int d0 = 0; d0 < 4; ++d0) { const float val = o[d0][r] * rli[r]; if constexpr (ABL == 0) Ow[(size_t)orow * DM + d0 * 32 + r32] = (bf16_t)(cvtpk(val, 0.f) & 0xffffu); else asm volatile("" :: "v"(val)); } }
#undef KROW
#undef KLOAD
#undef VLOAD
#undef KWRITE
#undef VWRITE
#undef RESC
}
#undef KSWZ
#undef SBAR
}
template <int ABL> __device__ __forceinline__ void phase_attn_mfma(const Args& a, int l, LAS unsigned char* lds) {
    unsigned char* ws = a.ws;
    const bf16_t* QB = (const bf16_t*)(ws + WS_QB); const bf16_t* KVB = (const bf16_t*)(ws + WS_KVB); const bf16_t* PB = (const bf16_t*)(ws + WS_PB); bf16_t* Y = (bf16_t*)(ws + WS_HY);
    const float* ROPE = (const float*)(ws + WS_ROPE);
    const int nunits = 256 + (l == 0 ? 8 : 0);
    for (int u = blockIdx.x; u < nunits; u += KGRID) {
        __syncthreads();
        if (u < 256) { const int bh = u & 7, qb = u >> 3, b = bh >> 2, h = bh & 3; att::unit<ABL>(QB, KVB, PB, ROPE, Y, b * NL + qb * 256, b, h, NKEY, true, lds); }
        else { const int bh = u - 256, b = bh >> 2, h = bh & 3; att::unit<ABL>(QB, KVB, PB, ROPE, Y, ML + b * NC, b, h, NC, false, lds); }
    }
}

namespace pg8 {
#define PG8_LAS __attribute__((address_space(3)))
typedef unsigned short bf16_t;
typedef short bf16x8 __attribute__((ext_vector_type(8)));
typedef float f32x4 __attribute__((ext_vector_type(4)));
typedef unsigned u32x4 __attribute__((ext_vector_type(4)));
constexpr int BM = 256, BK = 64, HALF = 128, HTB = HALF * BK * 2  , STAGE_BYTES = 8 * HTB, NXCD = 8, WGM = 8;

__host__ __device__ __forceinline__ int lds_byte(int r, int c) { const int st = (r >> 4) * 2 + (c >> 5), rr = r & 15, cc = c & 31, ob = rr * 64 + cc * 2; return st * 1024 + (ob ^ (((ob >> 9) & 1) << 5)); }
__host__ __device__ __forceinline__ void stage_rc(int b, int& R, int& C) { const int st = b / 1024, sb = b % 1024, swz = sb ^ (((sb >> 9) & 1) << 5); R = (st >> 1) * 16 + swz / 64; C = (st & 1) * 32 + (swz % 64) / 2; }
__host__ __device__ __forceinline__ int perm32(int rho) { const int n = rho >> 4, i = rho & 15; return 8 * (i >> 2) + 4 * n + (i & 3); }

struct Unit { int pm, pn; };
struct Gemm { const bf16_t* A; int lda; const bf16_t* Bt; int M, N, K; };

struct StaticOrder {
    int nM, nN, nwg, G, c;
    __host__ __device__ void init(int M, int N, int G_, int c_) { nM = M / BM; nN = N / BM; nwg = nM * nN; G = G_; c = c_; }
    __host__ __device__ bool next(int i, Unit& u) const {
        const long L = (long)i * G + c; if (L >= nwg) return false;
        int wgid = (int)L; { const int q = nwg / NXCD, r = nwg % NXCD, xcd = wgid % NXCD, off = wgid / NXCD; wgid = (xcd < r ? xcd * (q + 1) : r * (q + 1) + (xcd - r) * q) + off; }
        const int nig = WGM * nN, gid = wgid / nig, fm = gid * WGM, gsz = (nM - fm) < WGM ? (nM - fm) : WGM;
        u.pm = fm + ((wgid % nig) % gsz); u.pn = (wgid % nig) / gsz; return true;
    }
    __device__ __forceinline__ void a_ready(const Unit&) const {}
    __device__ __forceinline__ void done(const Unit&) const {}
};
template <class Epi, class Sched, bool ALIGN_EPI = false, bool SP2 = false>
__device__ __forceinline__ void gemm_phase(PG8_LAS unsigned char* lds, const Gemm g, const Sched& S, const Epi& E) {
    const int wid = kwave(), lane = klane(), tid = wid * 64 + lane, wr = wid >> 2, wc = wid & 3, fr = lane & 15, fq = lane >> 4;
    const int K = g.K, nt = K / BK;
    unsigned voffA[2], voffB[2];
#pragma unroll
    for (int i = 0; i < 2; ++i) { int R, C; stage_rc(tid * 16 + i * 8192, R, C); const int Rb = Epi::PERM ? ((R & ~31) + perm32(R & 31)) : R;
        voffA[i] = (unsigned)(R * g.lda + C) * 2u; voffB[i] = (unsigned)(Rb * K + C) * 2u; }
    const size_t kstep = (size_t)(BK * 2);
    const size_t hstepA = (size_t)HALF * g.lda * 2, hstepB = (size_t)HALF * K * 2;
    const size_t tstepA = 2 * hstepA, tstepB = 2 * hstepB;
    const unsigned ldsw = (unsigned)wid * 1024u;
    const int aoff = lds_byte(wr * 64 + fr, fq * 8), boff = lds_byte(wc * 32 + fr, fq * 8);
#define PG8_SA(b, h) (((b) * 2 + (h)) * HTB)
#define PG8_SB(b, h) ((4 + (b) * 2 + (h)) * HTB)
#define PG8_STAGE(bufoff, gbase, voff) do { _Pragma("unroll") for (int _i = 0; _i < 2; ++_i) \
        __builtin_amdgcn_global_load_lds((const unsigned*)((const char*)(gbase) + (voff)[_i]), (PG8_LAS unsigned*)(lds + (bufoff) + ldsw + _i * 8192), 16, 0, 0); } while (0)
#define PG8_LDA(dst, b, h) do { _Pragma("unroll") for (int m = 0; m < 4; ++m) _Pragma("unroll") for (int k = 0; k < 2; ++k) dst[m][k] = *(const PG8_LAS bf16x8*)(lds + PG8_SA(b, h) + aoff + m * 2048 + k * 1024); } while (0)
#define PG8_LDB(dst, b, h) do { _Pragma("unroll") for (int n = 0; n < 2; ++n) _Pragma("unroll") for (int k = 0; k < 2; ++k) dst[n][k] = *(const PG8_LAS bf16x8*)(lds + PG8_SB(b, h) + boff + n * 2048 + k * 1024); } while (0)
#define PG8_MMA(ai, bj, At, Bt) do { __builtin_amdgcn_s_setprio(1); _Pragma("unroll") for (int m = 0; m < 4; ++m) _Pragma("unroll") for (int n = 0; n < 2; ++n) _Pragma("unroll") for (int k = 0; k < 2; ++k) \
        acc[ai][bj][m][n] = __builtin_amdgcn_mfma_f32_16x16x32_bf16(Bt[n][k], At[m][k], acc[ai][bj][m][n], 0, 0, 0); __builtin_amdgcn_s_setprio(0); } while (0)
#define PG8_WAIT_V(n) asm volatile("s_waitcnt vmcnt(" #n ")" ::: "memory")
#define PG8_WAIT_L(n) asm volatile("s_waitcnt lgkmcnt(" #n ")" ::: "memory")
#define PG8_BAR __builtin_amdgcn_s_barrier()
#define PG8_SCHED __builtin_amdgcn_sched_barrier(0)
    Unit cur, nxt; int ui = 0;
    if (!S.next(0, cur)) return;
    f32x4 acc[2][2][4][2];
#pragma unroll
    for (int a = 0; a < 2; ++a)
#pragma unroll
        for (int b = 0; b < 2; ++b)
#pragma unroll
            for (int m = 0; m < 4; ++m)
#pragma unroll
                for (int n = 0; n < 2; ++n) acc[a][b][m][n] = (f32x4){0.f, 0.f, 0.f, 0.f};
    bf16x8 At[4][2], B0[2][2], B1[2][2];
    const char* cA = (const char*)g.A + (size_t)cur.pm * tstepA; const char* cB = (const char*)g.Bt + (size_t)cur.pn * tstepB;
    S.a_ready(cur);
    if constexpr (SP2) {
        PG8_STAGE(PG8_SB(0, 0), cB, voffB); PG8_STAGE(PG8_SB(0, 1), cB + hstepB, voffB); PG8_STAGE(PG8_SA(0, 0), cA, voffA); PG8_STAGE(PG8_SA(0, 1), cA + hstepA, voffA);
        if (wr == 1) PG8_BAR;
        PG8_WAIT_V(2); PG8_BAR;
        PG8_STAGE(PG8_SB(1, 0), cB + kstep, voffB); PG8_STAGE(PG8_SA(1, 0), cA + kstep, voffA); PG8_STAGE(PG8_SB(1, 1), cB + hstepB + kstep, voffB);
        PG8_WAIT_V(6); PG8_BAR;
    } else {
        PG8_STAGE(PG8_SB(0, 0), cB, voffB); PG8_STAGE(PG8_SA(0, 0), cA, voffA); PG8_STAGE(PG8_SB(0, 1), cB + hstepB, voffB); PG8_STAGE(PG8_SA(0, 1), cA + hstepA, voffA);
        if (wr == 1) PG8_BAR;
        PG8_WAIT_V(4); PG8_BAR;
        PG8_STAGE(PG8_SB(1, 0), cB + kstep, voffB); PG8_STAGE(PG8_SA(1, 0), cA + kstep, voffA); PG8_STAGE(PG8_SB(1, 1), cB + hstepB + kstep, voffB);
        PG8_WAIT_V(6); PG8_BAR;
    }
    for (;;) {
        const bool has_next = S.next(ui + 1, nxt);
        const char* nA = has_next ? (const char*)g.A + (size_t)nxt.pm * tstepA : cA; const char* nB = has_next ? (const char*)g.Bt + (size_t)nxt.pn * tstepB : cB;
#pragma nounroll
        for (int t = 0; t < nt; t += 2) {
            const bool last = (t == nt - 2);
            const char* a1 = cA + (size_t)(t + 1) * kstep;
            const char* a2 = last ? nA : cA + (size_t)(t + 2) * kstep; const char* b2 = last ? nB : cB + (size_t)(t + 2) * kstep;
            const char* a3 = a2 + kstep; const char* b3 = b2 + kstep;
            if (last && has_next) S.a_ready(nxt);
            if constexpr (SP2) {
            PG8_LDB(B0, 0, 0); PG8_LDB(B1, 0, 1); PG8_SCHED; PG8_LDA(At, 0, 0); PG8_STAGE(PG8_SA(1, 1), a1 + hstepA, voffA);
            PG8_WAIT_V(8); PG8_WAIT_L(0); PG8_BAR; PG8_MMA(0, 0, At, B0); PG8_MMA(0, 1, At, B1); PG8_BAR; PG8_SCHED;
            PG8_LDA(At, 0, 1); PG8_STAGE(PG8_SB(0, 0), b2, voffB); PG8_STAGE(PG8_SB(0, 1), b2 + hstepB, voffB); PG8_STAGE(PG8_SA(0, 0), a2, voffA);
            PG8_WAIT_V(8); PG8_WAIT_L(0); PG8_BAR; PG8_MMA(1, 0, At, B0); PG8_MMA(1, 1, At, B1); PG8_BAR; PG8_SCHED;
            PG8_LDB(B0, 1, 0); PG8_LDB(B1, 1, 1); PG8_SCHED; PG8_LDA(At, 1, 0); PG8_STAGE(PG8_SA(0, 1), a2 + hstepA, voffA);
            PG8_WAIT_V(8); PG8_WAIT_L(0); PG8_BAR; PG8_MMA(0, 0, At, B0); PG8_MMA(0, 1, At, B1); PG8_BAR; PG8_SCHED;
            PG8_LDA(At, 1, 1); PG8_STAGE(PG8_SB(1, 0), b3, voffB); PG8_STAGE(PG8_SB(1, 1), b3 + hstepB, voffB); PG8_STAGE(PG8_SA(1, 0), a3, voffA);
            PG8_WAIT_V(8); PG8_WAIT_L(0); PG8_BAR; PG8_MMA(1, 0, At, B0); PG8_MMA(1, 1, At, B1); PG8_BAR; PG8_SCHED;
            } else {
            PG8_LDB(B0, 0, 0); PG8_SCHED; PG8_LDA(At, 0, 0); PG8_STAGE(PG8_SA(1, 1), a1 + hstepA, voffA);
            PG8_WAIT_L(8); PG8_BAR; PG8_WAIT_L(0); PG8_MMA(0, 0, At, B0); PG8_BAR; PG8_SCHED;
            PG8_LDB(B1, 0, 1); PG8_STAGE(PG8_SB(0, 0), b2, voffB);
            PG8_BAR; PG8_WAIT_L(0); PG8_MMA(0, 1, At, B1); PG8_BAR;
            PG8_LDA(At, 0, 1); PG8_STAGE(PG8_SA(0, 0), a2, voffA);
            PG8_BAR; PG8_WAIT_L(0); PG8_MMA(1, 0, At, B0); PG8_BAR; PG8_SCHED;
            PG8_STAGE(PG8_SB(0, 1), b2 + hstepB, voffB);
            PG8_WAIT_V(6); PG8_BAR; PG8_MMA(1, 1, At, B1); PG8_BAR;
            PG8_LDB(B0, 1, 0); PG8_SCHED; PG8_LDA(At, 1, 0); PG8_STAGE(PG8_SA(0, 1), a2 + hstepA, voffA);
            PG8_WAIT_L(8); PG8_BAR; PG8_WAIT_L(0); PG8_MMA(0, 0, At, B0); PG8_BAR; PG8_SCHED;
            PG8_LDB(B1, 1, 1); PG8_STAGE(PG8_SB(1, 0), b3, voffB);
            PG8_BAR; PG8_WAIT_L(0); PG8_MMA(0, 1, At, B1); PG8_BAR;
            PG8_LDA(At, 1, 1); PG8_STAGE(PG8_SA(1, 0), a3, voffA);
            PG8_BAR; PG8_WAIT_L(0); PG8_MMA(1, 0, At, B0); PG8_BAR; PG8_SCHED;
            PG8_STAGE(PG8_SB(1, 1), b3 + hstepB, voffB);
            PG8_WAIT_V(6); PG8_BAR; PG8_MMA(1, 1, At, B1); PG8_BAR;
            }
        }
        if constexpr (ALIGN_EPI) { if (wr == 0) PG8_BAR; }
        if constexpr (!Epi::AFTER_DRAIN) { E(acc, cur, wr, wc, fr, fq); S.done(cur); }
        if (!has_next) break;
#pragma unroll
        for (int a = 0; a < 2; ++a)
#pragma unroll
            for (int b = 0; b < 2; ++b)
#pragma unroll
                for (int m = 0; m < 4; ++m)
#pragma unroll
                    for (int n = 0; n < 2; ++n) acc[a][b][m][n] = (f32x4){0.f, 0.f, 0.f, 0.f};
        cur = nxt; cA = nA; cB = nB; ++ui;
        if constexpr (ALIGN_EPI) { if (wr == 1) PG8_BAR; }
    }
    PG8_WAIT_V(0);
    if constexpr (!ALIGN_EPI) { if (wr == 0) PG8_BAR; }
    PG8_BAR;
    if constexpr (Epi::AFTER_DRAIN) { E.fused(acc, cur, wr, wc, fr, fq, lds, wid, lane); S.done(cur); }
#undef PG8_SA
#undef PG8_SB
#undef PG8_STAGE
#undef PG8_LDA
#undef PG8_LDB
#undef PG8_MMA
#undef PG8_WAIT_V
#undef PG8_WAIT_L
#undef PG8_BAR
#undef PG8_SCHED
}
}

template <class F> struct EpiAdapt {
    static constexpr bool PERM = false, AFTER_DRAIN = false;
    F f;
    __device__ __forceinline__ void operator()(const pg8::f32x4 (&acc)[2][2][4][2], const pg8::Unit& u, int wr, int wc, int fr, int fq) const {
#pragma unroll
        for (int ai = 0; ai < 2; ++ai)
#pragma unroll
            for (int m = 0; m < 4; ++m) { const int row = u.pm * 256 + ai * 128 + wr * 64 + m * 16 + fr;
#pragma unroll
                for (int bj = 0; bj < 2; ++bj)
#pragma unroll
                    for (int n = 0; n < 2; ++n) f(row, u.pn * 256 + bj * 128 + wc * 32 + n * 16 + 4 * fq, acc[ai][bj][m][n]); }
    }
};
template <class F> struct EpiAdapt8 {
    static constexpr bool PERM = true, AFTER_DRAIN = false;
    F f;
    __device__ __forceinline__ void operator()(const pg8::f32x4 (&acc)[2][2][4][2], const pg8::Unit& u, int wr, int wc, int fr, int fq) const {
#pragma unroll
        for (int ai = 0; ai < 2; ++ai)
#pragma unroll
            for (int m = 0; m < 4; ++m) { const int row = u.pm * 256 + ai * 128 + wr * 64 + m * 16 + fr;
#pragma unroll
                for (int bj = 0; bj < 2; ++bj) f.op8(row, u.pn * 256 + bj * 128 + wc * 32 + 8 * fq, acc[ai][bj][m][0], acc[ai][bj][m][1]); }
    }
};
template <class F> __device__ __forceinline__ void gemm_mfma8(const bf16_t* A, int lda, const bf16_t* Bt, int M, int N, int K, const F& f, LAS unsigned char* lds) {
    pg8::Gemm g{A, lda, Bt, M, N, K}; pg8::StaticOrder S; S.init(M, N, KGRID, (int)blockIdx.x);
    EpiAdapt8<F> E{f};
    pg8::gemm_phase<EpiAdapt8<F>, pg8::StaticOrder, true, true>(lds, g, S, E);
}
template <class F> __device__ __forceinline__ void gemm_mfma(const bf16_t* A, int lda, const bf16_t* Bt, int M, int N, int K, const F& f, LAS unsigned char* lds) {
    pg8::Gemm g{A, lda, Bt, M, N, K}; pg8::StaticOrder S; S.init(M, N, KGRID, (int)blockIdx.x);
    EpiAdapt<F> E{f};
    pg8::gemm_phase<EpiAdapt<F>, pg8::StaticOrder, true, true>(lds, g, S, E);
}


#ifndef GEMM_MASK
#define GEMM_MASK 63
#endif
template <int BIT, class F> __device__ __forceinline__ void gemm_sel(const bf16_t* A, int lda, const bf16_t* Bt, int M, int N, int K, const F& f, LAS unsigned char* lds) {
    if constexpr ((GEMM_MASK >> BIT) & 1) gemm_mfma(A, lda, Bt, M, N, K, f, lds); else gemm_naive(A, lda, Bt, M, N, K, f, lds);
}

template <class F> __device__ __forceinline__ void gemm_ctx_small(const bf16_t* A, int lda, const bf16_t* Bt, int N, int K, const F& f, LAS unsigned char* lds) {
    const int lane = klane(), wave = kwave(), r32 = lane & 31, hi = lane >> 5;
    const int nct = N / 64, ntasks = 8 * nct, G = KGRID;
    const int KS = K >= 512 ? 8 : K / 64, kslice = K / KS;
    LAS float* red = (LAS float*)lds;
    for (int task = blockIdx.x; task < ntasks; task += G) {
        const int rt = task / nct, ct = task % nct, row0 = ML + rt * 64, col0 = ct * 64;
        f32x16 acc[2][2];
#pragma unroll
        for (int c = 0; c < 2; ++c) { acc[c][0] = f32x16{}; acc[c][1] = f32x16{}; }
        if (wave < KS) {
            const bf16_t* ap0 = A + (size_t)(row0 + r32) * lda + wave * kslice + 8 * hi; const bf16_t* ap1 = ap0 + (size_t)32 * lda;
            const bf16_t* bp0 = Bt + (size_t)(col0 + r32) * K + wave * kslice + 8 * hi; const bf16_t* bp1 = bp0 + (size_t)32 * K;
            bf16x8 av[4][2], bv[4][2];
#define CTX_LOAD(k0) do { _Pragma("unroll") for (int s = 0; s < 4; ++s) { av[s][0] = *(const bf16x8*)(ap0 + (k0) + 16 * s); av[s][1] = *(const bf16x8*)(ap1 + (k0) + 16 * s); \
                bv[s][0] = *(const bf16x8*)(bp0 + (k0) + 16 * s); bv[s][1] = *(const bf16x8*)(bp1 + (k0) + 16 * s); } } while (0)
            CTX_LOAD(0);
#pragma unroll 1
            for (int k0 = 0; k0 < kslice; k0 += 64) {
                bf16x8 ac[4][2], bc[4][2];
#pragma unroll
                for (int s = 0; s < 4; ++s) { ac[s][0] = av[s][0]; ac[s][1] = av[s][1]; bc[s][0] = bv[s][0]; bc[s][1] = bv[s][1]; }
                if (k0 + 64 < kslice) CTX_LOAD(k0 + 64);
#pragma unroll
                for (int s = 0; s < 4; ++s)
#pragma unroll
                    for (int c = 0; c < 2; ++c) { acc[c][0] = __builtin_amdgcn_mfma_f32_32x32x16_bf16(bc[s][c], ac[s][0], acc[c][0], 0, 0, 0); acc[c][1] = __builtin_amdgcn_mfma_f32_32x32x16_bf16(bc[s][c], ac[s][1], acc[c][1], 0, 0, 0); }
            }
#undef CTX_LOAD
        }
        __syncthreads();
        if (wave < KS) {
#pragma unroll
            for (int c = 0; c < 2; ++c)
#pragma unroll
                for (int t = 0; t < 2; ++t)
#pragma unroll
                    for (int r = 0; r < 16; ++r) red[(wave * 64 + (c * 2 + t) * 16 + r) * 64 + lane] = acc[c][t][r];
        }
        __syncthreads();
#pragma unroll
        for (int q = 0; q < 2; ++q) {
            const int grp = wave * 2 + q, c = grp >> 3, t = (grp >> 2) & 1, g = grp & 3;
            f32x4 v = {0.f, 0.f, 0.f, 0.f};
            for (int w = 0; w < KS; ++w) {
                const LAS float* p = red + (w * 64 + (c * 2 + t) * 16 + 4 * g) * 64 + lane;
                v.x += p[0]; v.y += p[64]; v.z += p[128]; v.w += p[192];
            }
            f(row0 + 32 * t + r32, col0 + 32 * c + 8 * g + 4 * hi, v);
        }
    }
    __syncthreads();
}

__device__ __forceinline__ void phase_final(const Args& a) {
    const float* fw = a.in[I_FNW];
    const int lane = klane(), gw = blockIdx.x * NWAVES + kwave(), ngw = KGRID * NWAVES;
    for (int row = gw; row < ML; row += ngw) {
        float* p = a.out + (size_t)row * DM;
        f32x4 v[4]; float ss = 0.f;
#pragma unroll
        for (int j = 0; j < 4; ++j) { v[j] = *(const f32x4*)(p + lane * 4 + 256 * j); ss += v[j].x * v[j].x + v[j].y * v[j].y + v[j].z * v[j].z + v[j].w * v[j].w; }
        const float rstd = rsqrtf(wave_sum(ss) * (1.f / DM) + EPS);
#pragma unroll
        for (int j = 0; j < 4; ++j) *(f32x4*)(p + lane * 4 + 256 * j) = v[j] * rstd * *(const f32x4*)(fw + lane * 4 + 256 * j);
    }
}

constexpr int NPHASE = 20;
#define PH_BEGIN(k) if (lo <= (k) && (k) < hi) { const Args& a = get_args(); unsigned char* ws = a.ws; (void)ws;
#define PH_END(k) if (MK_ONE_LAUNCH && (k) + 1 < hi) xcd_barrier(bar); }
template <int L> __device__ __forceinline__ void layer_phases(LAS unsigned char* lds, const XcdBarrier& bar, const int lo, const int hi) {
    constexpr int P = 1 + 9 * L;
#define MODL ((const float*)(ws + WS_MOD) + (size_t)L * 3 * 6144)
#define ROPET ((const float*)(ws + WS_ROPE))
#define HYB ((bf16_t*)(ws + WS_HY))
#define PBB ((bf16_t*)(ws + WS_PB))
#define XCB ((float*)(ws + WS_XC))
#define XL_IN ((L == 0) ? a.in[I_X] : (const float*)a.out)
#define XC_IN ((L == 0) ? a.in[I_CTX] : (const float*)XCB)
    PH_BEGIN(P + 0) phase_norm_mod(XL_IN, XC_IN, a.in[I_N1W] + L * DM, MODL, 0, 1024, HYB, MT); PH_END(P + 0)
    PH_BEGIN(P + 1) for (int rep = 0; rep < REP_INP; ++rep) { if (rep) xcd_barrier(bar); EpiInProj E{PBB, ROPET}; const bf16_t* W = (const bf16_t*)(ws + WS_WIN) + (size_t)L * INP * DM;
        gemm_mfma8(HYB, DM, W, ML, INP, DM, E, lds); gemm_ctx_small(HYB, DM, W, INP, DM, E, lds); } PH_END(P + 1)
    PH_BEGIN(P + 2) phase_post(a, L); phase_gla_local(a, L, lds); PH_END(P + 2)
    PH_BEGIN(P + 3) for (int rep = 0; rep < REP_UP; ++rep) { if (rep) xcd_barrier(bar);
        { EpiUQ E1{(bf16_t*)(ws + WS_QB)}; const bf16_t* W = (const bf16_t*)(ws + WS_WUQ) + (size_t)L * 768 * 256; gemm_mfma8(PBB + C_DQ, INP, W, ML, 768, 256, E1, lds); if (L == 0) gemm_ctx_small(PBB + C_DQ, INP, W, 768, 256, E1, lds); }
        { EpiUKV E2{(bf16_t*)(ws + WS_KVB)}; const bf16_t* W = (const bf16_t*)(ws + WS_WUKV) + (size_t)L * 1024 * 256; gemm_mfma8(PBB + C_CKV, INP, W, ML, 1024, 256, E2, lds); gemm_ctx_small(PBB + C_CKV, INP, W, 1024, 256, E2, lds); }
        if (rep == 0) phase_gla_scan(a);
        phase_sgu_mfma(a, L, lds);
    } PH_END(P + 3)
    PH_BEGIN(P + 4) { phase_gla_out(a, L, lds); phase_attn_mfma<0>(a, L, lds); if (REP_ATTN == 2) { xcd_barrier(bar); phase_attn_mfma<ATT_ABL>(a, L, lds); } } PH_END(P + 4)
    PH_BEGIN(P + 5) for (int rep = 0; rep < (L == 0 ? REP_OUT : 1); ++rep) { if (rep) xcd_barrier(bar); EpiResid E{XL_IN, XC_IN, a.out, XCB, MODL, 2048}; const bf16_t* W = (const bf16_t*)(ws + WS_WOUT) + (size_t)L * DM * DM;
        gemm_sel<3>(HYB, DM, W, ML, DM, DM, E, lds); if (L == 0) gemm_ctx_small(HYB, DM, W, DM, DM, E, lds); } PH_END(P + 5)
    PH_BEGIN(P + 6) phase_norm_mod(a.out, XCB, a.in[I_N2W] + L * DM, MODL, 3072, 4096, HYB, L == 0 ? MT : ML); PH_END(P + 6)
    PH_BEGIN(P + 7) { EpiFF1 E{(bf16_t*)(ws + WS_A)}; const bf16_t* W = (const bf16_t*)(ws + WS_WFF1) + (size_t)L * FF * DM;
        gemm_mfma8(HYB, DM, W, ML, FF, DM, E, lds); if (L == 0) gemm_ctx_small(HYB, DM, W, FF, DM, E, lds);
        if (REP_FF1 == 2) { xcd_barrier(bar); EpiNull EN; gemm_mfma8(HYB, DM, W, ML, FF, DM, EN, lds); }
        if (REP_FF1 == 3) { xcd_barrier(bar); gemm_mfma8(HYB, DM, W, ML, FF, DM, E, lds); } } PH_END(P + 7)
    PH_BEGIN(P + 8) { EpiResid E{a.out, XCB, a.out, XCB, MODL, 5120}; const bf16_t* W = (const bf16_t*)(ws + WS_WFF2) + (size_t)L * DM * FF;
        gemm_sel<5>((const bf16_t*)(ws + WS_A), FF, W, ML, DM, FF, E, lds); if (L == 0) gemm_ctx_small((const bf16_t*)(ws + WS_A), FF, W, DM, FF, E, lds); } PH_END(P + 8)
}
__global__ void __launch_bounds__(NTHR, 2) mega(Args a_kernarg_only) {
    extern __shared__ __attribute__((aligned(16))) unsigned char lds_raw[];
    LAS unsigned char* lds = (LAS unsigned char*)lds_raw;
    volatile LAS unsigned* MISC = (volatile LAS unsigned*)(lds + LDS_CTL_OFF);
    { const int t0 = __builtin_amdgcn_workitem_id_x();
      if (t0 < 64) MISC[t0] = 0u;
      if ((t0 & 63) == 0) { const unsigned id = (unsigned)__builtin_amdgcn_s_getreg((5 << 11) | 4) & 63u; MISC[64 + id] = (unsigned)(t0 >> 6); } }
    __syncthreads();
    XcdBarrier bar; bar.bar = (unsigned*)(get_args().ws + WS_CTL); bar.x = 0; bar.st = nullptr;
    if (MK_ONE_LAUNCH) bar = xcd_barrier_post((unsigned*)(get_args().ws + WS_CTL), MISC + 8);
    const int lo = MK_ONE_LAUNCH ? 0 : get_args().ph_lo, hi = MK_ONE_LAUNCH ? NPHASE : get_args().ph_hi;
    PH_BEGIN(0) phase_prep(a, lds); PH_END(0)
    layer_phases<0>(lds, bar, lo, hi);
    layer_phases<1>(lds, bar, lo, hi);
    PH_BEGIN(NPHASE - 1) phase_final(a); PH_END(NPHASE - 1)
}

extern "C" void kernel_launch(void* const* d_in, const int* in_sizes, int n_in, void* d_out, int out_size, void* d_ws, size_t ws_size, hipStream_t stream) {
    static int grid = 0;
    if (grid == 0) {
        if (n_in != 26 || in_sizes[0] != ML * DM || out_size != ML * DM || ws_size < WS_END) { fprintf(stderr, "kernel_launch: unexpected shapes (n_in %d, in0 %d, out %d, ws %zu)\n", n_in, n_in > 0 ? in_sizes[0] : -1, out_size, ws_size); grid = -1; return; }
        int dev = 0, cus = 0;
        if (hipGetDevice(&dev) != hipSuccess || hipDeviceGetAttribute(&cus, hipDeviceAttributeMultiprocessorCount, dev) != hipSuccess) { grid = -1; return; }
        if (hipFuncSetAttribute((const void*)mega, hipFuncAttributeMaxDynamicSharedMemorySize, LDS_BYTES) != hipSuccess) { fprintf(stderr, "kernel_launch: hipFuncSetAttribute failed\n"); grid = -1; return; }
        int per_cu = 0;
        if (hipOccupancyMaxActiveBlocksPerMultiprocessor(&per_cu, (const void*)mega, NTHR, LDS_BYTES) != hipSuccess || per_cu < 1) fprintf(stderr, "kernel_launch: occupancy query says %d\n", per_cu);
        (void)hipGetLastError();
        grid = cus;
    }
    if (grid < 0) return;
    (void)hipMemsetAsync((char*)d_ws + WS_CTL, 0, CTL_ZERO_BYTES, stream);
    Args a{};
    for (int i = 0; i < 26; ++i) a.in[i] = (const float*)d_in[i];
    a.out = (float*)d_out; a.ws = (unsigned char*)d_ws; a.grid = grid;
    if (MK_ONE_LAUNCH) { a.ph_lo = 0; a.ph_hi = NPHASE; hipLaunchKernelGGL(mega, dim3(grid), dim3(NTHR), LDS_BYTES, stream, a); }
    else for (int ph = 0; ph < NPHASE; ++ph) { a.ph_lo = ph; a.ph_hi = ph + 1; hipLaunchKernelGGL(mega, dim3(grid), dim3(NTHR), LDS_BYTES, stream, a); }
}
```

```cpp
#include <hip/hip_runtime.h>
#include <cstdio>
#include <cstdint>

#ifndef REP_FF1
#define REP_FF1 1
#endif
#ifndef REP_INP
#define REP_INP 1
#endif
#ifndef REP_GLAL
#define REP_GLAL 1
#endif
#ifndef REP_UP
#define REP_UP 1
#endif
#ifndef REP_OUT
#define REP_OUT 1
#endif
#ifndef ATT_ABL
#define ATT_ABL 5
#endif
#ifndef REP_PREP
#define REP_PREP 1
#endif
#ifndef REP_SGU
#define REP_SGU 1
#endif
#ifndef REP_ATTN
#define REP_ATTN 1
#endif
#ifndef REP_GLA
#define REP_GLA 1
#endif
#ifndef REP_NORM
#define REP_NORM 1
#endif
#ifndef ATT_NQL
#define ATT_NQL 6
#endif
#ifndef ATTN_NAIVE
#define ATTN_NAIVE 0
#endif
#ifndef GLA_NAIVE
#define GLA_NAIVE 0
#endif
#ifndef MK_ONE_LAUNCH
#define MK_ONE_LAUNCH 1
#endif

#define GAS __attribute__((address_space(1)))
#define LAS __attribute__((address_space(3)))
typedef unsigned short bf16_t;
typedef float f32x4 __attribute__((ext_vector_type(4)));
typedef unsigned u32x4 __attribute__((ext_vector_type(4)));
typedef unsigned u32x2 __attribute__((ext_vector_type(2)));

constexpr int DM = 1024, NB = 2, NL = 8192, NC = 256, ML = NB * NL, MC = NB * NC, MT = ML + MC;
constexpr int FF = 4096, INP = 2048, IN_COLS = 1888, NKEY = NC + NL;
constexpr float EPS = 1e-6f;
constexpr float QSCALE = 0.07216878364870322f * 1.4426950408889634f;
constexpr int NWAVES = 8, NTHR = 512;
constexpr int C_CKV = 0, C_DQ = 256, C_SU = 512, C_SV = 768, C_GV = 1024, C_GR = 1280, C_GK = 1536, C_GQ = 1664, C_KR = 1792, C_GGF = 1856, C_GGB = 1872;

constexpr size_t MiB = 1u << 20;
constexpr size_t WS_CTL = 0, CTL_ZERO_BYTES = 65536;
constexpr size_t WS_MOD = 1 * MiB;
constexpr size_t WS_ROPE = 1 * MiB + 256 * 1024;
constexpr size_t WS_WSB = 14 * MiB + 768 * 1024;
constexpr size_t WS_WIN = 2 * MiB;
constexpr size_t WS_WOUT = 10 * MiB;
constexpr size_t WS_WUQ = 14 * MiB;
constexpr size_t WS_WUKV = 15 * MiB;
constexpr size_t WS_WFF1 = 16 * MiB;
constexpr size_t WS_WFF2 = 32 * MiB;
constexpr size_t WS_XC = 48 * MiB;
constexpr size_t WS_HY = 50 * MiB;
constexpr size_t WS_PB = 83 * MiB;
constexpr size_t WS_QB = 149 * MiB;
constexpr size_t WS_KVB = 174 * MiB;
constexpr size_t WS_LG = 216 * MiB;
constexpr size_t WS_OB = 233 * MiB;
constexpr size_t WS_A = 83 * MiB;
constexpr size_t WS_END = 250 * MiB;
static_assert(WS_A + (size_t)MT * FF * 2 <= WS_LG, "ffn hidden overlay");
static_assert(WS_PB + (size_t)MT * INP * 2 <= WS_QB && WS_QB + (size_t)MT * 768 * 2 <= WS_KVB && WS_KVB + (size_t)MT * 1024 * 2 <= WS_LG, "ws map");
static_assert(WS_LG + (size_t)MT * 256 * 4 <= WS_OB && WS_OB + (size_t)MT * 256 * 4 <= WS_END, "ws map 2");

constexpr int LDS_BYTES = 147456;

struct Args { const float* in[26]; float* out; unsigned char* ws; int ph_lo, ph_hi, grid, pad; };
enum { I_X = 0, I_C, I_CTX, I_CCTX, I_WMOD, I_BMOD, I_N1W, I_WIN, I_WOUT, I_SGNW, I_SGNB, I_SGW, I_SGB, I_GWF, I_GBF, I_GWB, I_GBB, I_GNW, I_QNW, I_WUQ, I_KVNW, I_WUKV, I_N2W, I_WFF1, I_WFF2, I_FNW };

typedef __attribute__((address_space(4))) const Args* KArgsPtr;
__device__ __forceinline__ const Args& get_args() { KArgsPtr p = (KArgsPtr)__builtin_amdgcn_kernarg_segment_ptr(); asm volatile("" : "+s"(p)); return *(const Args*)p; }
constexpr int LDS_CTL_OFF = LDS_BYTES - 512;
__device__ __forceinline__ int klane() { int l; asm volatile("v_mbcnt_lo_u32_b32 %0, -1, 0\n\tv_mbcnt_hi_u32_b32 %0, -1, %0" : "=v"(l)); return l; }
__device__ __forceinline__ int kwave() { const unsigned id = (unsigned)__builtin_amdgcn_s_getreg((5 << 11) | 4) & 63u;
    return __builtin_amdgcn_readfirstlane((int)((volatile LAS unsigned*)(uintptr_t)(LDS_CTL_OFF + 256))[id]); }
#define KTID (kwave() * 64 + klane())
#define KGRID (get_args().grid)
__device__ __forceinline__ float bf2f(bf16_t v) { return __uint_as_float(((unsigned)v) << 16); }
__device__ __forceinline__ unsigned f2bf(float f) { unsigned u = __float_as_uint(f); return (u + 0x7fffu + ((u >> 16) & 1u)) >> 16; }
__device__ __forceinline__ unsigned pk2(float lo, float hi) { return f2bf(lo) | (f2bf(hi) << 16); }
#define DPP_F(v, ctrl, rmask) __builtin_bit_cast(float, __builtin_amdgcn_update_dpp(0, __builtin_bit_cast(int, (v)), (ctrl), (rmask), 0xf, true))
__device__ __forceinline__ float wave_prefix_sum(float v) {
    v += DPP_F(v, 0x111, 0xf); v += DPP_F(v, 0x112, 0xf); v += DPP_F(v, 0x114, 0xf); v += DPP_F(v, 0x118, 0xf);
    v += DPP_F(v, 0x142, 0xa); v += DPP_F(v, 0x143, 0xc);
    return v;
}
__device__ __forceinline__ float wave_sum(float v) {
    return __builtin_bit_cast(float, __builtin_amdgcn_readlane(__builtin_bit_cast(int, wave_prefix_sum(v)), 63));
}
__device__ __forceinline__ float gelu_tanh(float x) { const float u = 1.5957691216057308f * (x + 0.044715f * x * x * x); return x / (1.f + __expf(-u)); }
__device__ __forceinline__ float silu_f(float x) { return x / (1.f + __expf(-x)); }
__device__ __forceinline__ float log_sigmoid_f(float z) { return fminf(z, 0.f) - log1pf(expf(-fabsf(z))); }
__device__ __forceinline__ float log_sigmoid_fast(float z) { return fminf(z, 0.f) - __logf(1.f + __expf(-fabsf(z))); }
__device__ __forceinline__ void unpack8(u32x4 w, float* f) {
    f[0] = __uint_as_float(w.x << 16); f[1] = __uint_as_float(w.x & 0xffff0000u); f[2] = __uint_as_float(w.y << 16); f[3] = __uint_as_float(w.y & 0xffff0000u);
    f[4] = __uint_as_float(w.z << 16); f[5] = __uint_as_float(w.z & 0xffff0000u); f[6] = __uint_as_float(w.w << 16); f[7] = __uint_as_float(w.w & 0xffff0000u);
}

#define XB_TMO      128
#define XB_XCNT(j)  (256  + 64 * (j))
#define XB_XSUB(j)  (1280 + 64 * (j))
#define XB_XGEN(j)  (2304 + 64 * (j))
#define XB_TOP      3328
#define XB_TOPGEN   3392
#define XCD_BAR_WORDS 3456
#define XB_SPIN_CAP (1u << 22)
__device__ __forceinline__ unsigned xb_ld(unsigned* p)              { return __hip_atomic_load(p, __ATOMIC_RELAXED, __HIP_MEMORY_SCOPE_AGENT); }
__device__ __forceinline__ unsigned xb_add(unsigned* p, unsigned v) { return __hip_atomic_fetch_add(p, v, __ATOMIC_RELAXED, __HIP_MEMORY_SCOPE_AGENT); }
__device__ __forceinline__ unsigned xb_xcc_id() { return (unsigned)__builtin_amdgcn_s_getreg((3 << 11) | 20) & 0xFu; }
#define XB_SPIN(cond, bar) do { unsigned _sp = 0; while (cond) { __builtin_amdgcn_s_sleep(1); \
    if ((++_sp & 255u) == 0u) { if (xb_ld(&(bar)[XB_TMO])) break; if (_sp > XB_SPIN_CAP) { atomicAdd(&(bar)[XB_TMO], 1u); break; } } } } while (0)
struct XcdBarrier { unsigned* bar; unsigned x; volatile LAS unsigned* st; };
__device__ __forceinline__ XcdBarrier xcd_barrier_post(unsigned* bar, volatile LAS unsigned* st) {
    XcdBarrier b; b.bar = bar; b.x = xb_xcc_id(); b.st = st;
    if (KTID == 0) (void)xb_add(&bar[XB_XCNT(b.x)], 1u);
    return b;
}
__device__ __forceinline__ void xcd_barrier_complete(unsigned* bar, unsigned x, unsigned& nloc, unsigned& nx) {
    const unsigned G = (unsigned)KGRID;
    unsigned sum, cnt, mine, sp = 0u;
    for (;;) {
        sum = 0u; cnt = 0u; mine = 0u;
#pragma unroll
        for (unsigned j = 0; j < 16; ++j) { const unsigned c = xb_ld(&bar[XB_XCNT(j)]); sum += c; cnt += (c > 0u) ? 1u : 0u; mine = (j == x) ? c : mine; }
        if (sum == G) break;
        __builtin_amdgcn_s_sleep(1);
        if ((++sp & 255u) == 0u) { if (xb_ld(&bar[XB_TMO])) break; if (sp > XB_SPIN_CAP) { atomicAdd(&bar[XB_TMO], 1u); break; } }
    }
    nloc = mine > 0u ? mine : 1u; nx = cnt > 0u ? cnt : 1u;
}
__device__ __forceinline__ void xcd_barrier(const XcdBarrier& b) {
    asm volatile("s_waitcnt vmcnt(0)" ::: "memory");
    __syncthreads();
    if (KTID == 0) {
        unsigned* bar = b.bar;
        __builtin_amdgcn_s_waitcnt(0);
        unsigned nloc = b.st[0], nx = b.st[1];
        if (nloc == 0u) { xcd_barrier_complete(bar, b.x, nloc, nx); b.st[0] = nloc; b.st[1] = nx; }
        const unsigned old = xb_add(&bar[XB_XSUB(b.x)], 1u);
        const unsigned gen = old / nloc;
        if (old + 1u == (gen + 1u) * nloc) {
            __builtin_amdgcn_fence(__ATOMIC_RELEASE, "agent");
            asm volatile("s_waitcnt vmcnt(0)" ::: "memory");
            const unsigned og = xb_add(&bar[XB_TOP], 1u);
            const unsigned tg = og / nx;
            if (og + 1u == (tg + 1u) * nx) xb_add(&bar[XB_TOPGEN], 1u);
            else XB_SPIN(xb_ld(&bar[XB_TOPGEN]) == tg, bar);
            __builtin_amdgcn_fence(__ATOMIC_ACQUIRE, "agent");
            xb_add(&bar[XB_XGEN(b.x)], 1u);
            asm volatile("s_waitcnt vmcnt(0)" ::: "memory");
        } else {
            XB_SPIN(xb_ld(&bar[XB_XGEN(b.x)]) == gen, bar);
            __builtin_amdgcn_fence(__ATOMIC_ACQUIRE, "agent");
            asm volatile("s_waitcnt vmcnt(0)" ::: "memory");
        }
    }
    __syncthreads();
}

__device__ __forceinline__ int rope_unperm(int jj) { return (jj < 32) ? ((jj >> 1) + 16 * (jj & 1)) : (32 + ((jj - 32) >> 1) + 16 * (jj & 1)); }
__device__ __forceinline__ int map_in(int n) {
    if (n < 256) return 416 + n;
    if (n < 512) return 1632 + (n - 256);
    if (n < 768) return 736 + (n - 512);
    if (n < 1024) return 992 + (n - 768);
    if (n < 1280) return 128 + (n - 1024);
    if (n < 1536) return 1376 + (n - 1280);
    if (n < 1664) return n - 1536;
    if (n < 1792) return 1248 + (n - 1664);
    if (n < 1856) return 672 + rope_unperm(n - 1792);
    if (n < 1872) return 384 + (n - 1856);
    if (n < 1888) return 400 + (n - 1872);
    return -1;
}
__device__ __forceinline__ int map_uq(int n) { const int h = n / 192, j = n % 192; return (j < 128) ? n : (h * 192 + 128 + rope_unperm(j - 128)); }
template <int MODE> __device__ __forceinline__ void transpose_w(const float* W, int K, int Nsrc, bf16_t* Wt, int Npad, int gtid, int gthreads) {
    const int total = Npad * (K / 8);
    for (int idx = gtid; idx < total; idx += gthreads) {
        const int n = idx % Npad, kc = idx / Npad;
        const int src = (MODE == 0) ? n : (MODE == 1 ? map_in(n) : map_uq(n));
        float f[8];
#pragma unroll
        for (int i = 0; i < 8; ++i) f[i] = (src >= 0) ? W[(size_t)(kc * 8 + i) * Nsrc + src] : 0.f;
        u32x4 o; o.x = pk2(f[0], f[1]); o.y = pk2(f[2], f[3]); o.z = pk2(f[4], f[5]); o.w = pk2(f[6], f[7]);
        *(u32x4*)(Wt + (size_t)n * K + kc * 8) = o;
    }
}
template <int MODE> __device__ __forceinline__ void transpose_item(const float* W, int K, int Nsrc, bf16_t* Wt, int Npad, LAS float* scr, int item, int lane) {
    const int nblk = Npad / 32, kb = item / nblk, nb = item % nblk, k0 = 64 * kb, n0 = 32 * nb;
    const int nn = n0 + (lane & 31), src = (MODE == 0) ? nn : (MODE == 1 ? map_in(nn) : map_uq(nn));
    float tv[32];
#pragma unroll
    for (int i = 0; i < 32; ++i) { const int kk = 2 * i + (lane >> 5); tv[i] = (src >= 0) ? W[(size_t)(k0 + kk) * Nsrc + src] : 0.f; }
#pragma unroll
    for (int i = 0; i < 32; ++i) { const int kk = 2 * i + (lane >> 5); scr[kk * 33 + (lane & 31)] = tv[i]; }
    asm volatile("s_waitcnt lgkmcnt(0)" ::: "memory");
    const int c = lane & 7;
#pragma unroll
    for (int j = 0; j < 4; ++j) { const int n = (lane >> 3) + 8 * j; const LAS float* s = scr + (8 * c) * 33 + n;
        u32x4 o; o.x = pk2(s[0 * 33], s[1 * 33]); o.y = pk2(s[2 * 33], s[3 * 33]); o.z = pk2(s[4 * 33], s[5 * 33]); o.w = pk2(s[6 * 33], s[7 * 33]);
        *(u32x4*)(Wt + (size_t)(n0 + n) * K + k0 + 8 * c) = o; }
    asm volatile("s_waitcnt lgkmcnt(0)" ::: "memory");
}
__device__ __forceinline__ void phase_prep(const Args& a, LAS unsigned char* lds) {
    unsigned char* ws = a.ws;
    const int tid = KTID, gtid = blockIdx.x * NTHR + tid, gthreads = KGRID * NTHR;
    {
        const int wave = kwave(), lane = klane(), gw = wave * KGRID + (int)blockIdx.x, ngw = KGRID * NWAVES    ;
        LAS float* scr = (LAS float*)(lds + 8192 + wave * 8704);
        for (int it = gw; it < 2 * 5856; it += ngw) {
            const int l = it / 5856; int r = it % 5856;
            if (r < 1024) { transpose_item<1>(a.in[I_WIN] + (size_t)l * DM * IN_COLS, DM, IN_COLS, (bf16_t*)(ws + WS_WIN) + (size_t)l * INP * DM, INP, scr, r, lane); continue; } r -= 1024;
            if (r < 512) { transpose_item<0>(a.in[I_WOUT] + (size_t)l * DM * DM, DM, DM, (bf16_t*)(ws + WS_WOUT) + (size_t)l * DM * DM, DM, scr, r, lane); continue; } r -= 512;
            if (r < 96) { transpose_item<2>(a.in[I_WUQ] + (size_t)l * 256 * 768, 256, 768, (bf16_t*)(ws + WS_WUQ) + (size_t)l * 768 * 256, 768, scr, r, lane); continue; } r -= 96;
            if (r < 128) { transpose_item<0>(a.in[I_WUKV] + (size_t)l * 256 * 1024, 256, 1024, (bf16_t*)(ws + WS_WUKV) + (size_t)l * 1024 * 256, 1024, scr, r, lane); continue; } r -= 128;
            if (r < 2048) { transpose_item<0>(a.in[I_WFF1] + (size_t)l * DM * FF, DM, FF, (bf16_t*)(ws + WS_WFF1) + (size_t)l * FF * DM, FF, scr, r, lane); continue; } r -= 2048;
            transpose_item<0>(a.in[I_WFF2] + (size_t)l * FF * DM, FF, DM, (bf16_t*)(ws + WS_WFF2) + (size_t)l * DM * FF, DM, scr, r, lane);
        }
    }
    for (int idx = gtid; idx < 2 * 4 * 128 * 128 / 4; idx += gthreads) { const f32x4 v = *(const f32x4*)(a.in[I_SGW] + (size_t)idx * 4); u32x2 o; o.x = pk2(v.x, v.y); o.y = pk2(v.z, v.w); *(u32x2*)((bf16_t*)(ws + WS_WSB) + (size_t)idx * 4) = o; }
    { const int ridx = ((int)blockIdx.x - (KGRID - 4)) * NTHR + tid;
      if (ridx >= 0 && ridx < 128 * 16) {
        const int p = ridx >> 4, i = ridx & 15;
        const float freq = powf(10000.0f, -(float)i * 2.0f / 32.0f);
        const float ang = (float)p * freq;
        float sn, cs; sincosf(ang, &sn, &cs);
        float* R = (float*)(ws + WS_ROPE);
        R[ridx * 2 + 0] = cs; R[ridx * 2 + 1] = sn;
      } }
    {
        LAS float* red = (LAS float*)lds;
        LAS float* sil = (LAS float*)(lds + 80 * 1024);
        const int wave = kwave(), lane = klane();
        if ((int)blockIdx.x < 2 * 96) {
            for (int i = tid; i < 3 * DM; i += NTHR) { const float v = i < 2 * DM ? a.in[I_C][i] : a.in[I_CCTX][i - 2 * DM]; sil[i] = silu_f(v); }
        }
        __syncthreads();
        for (int item = blockIdx.x; item < 2 * 96; item += KGRID) {
            const int l = item / 96, j = (item % 96) * 64 + lane;
            const float* W = a.in[I_WMOD] + (size_t)l * DM * 6144 + (size_t)(wave * 128) * 6144 + j;
            float s0 = 0.f, s1 = 0.f, s2 = 0.f;
#pragma unroll 16
            for (int kk = 0; kk < 128; ++kk) {
                const float w = W[(size_t)kk * 6144];
                const int k2 = wave * 128 + kk;
                s0 += sil[k2] * w; s1 += sil[DM + k2] * w; s2 += sil[2 * DM + k2] * w;
            }
            red[(wave * 3 + 0) * 64 + lane] = s0; red[(wave * 3 + 1) * 64 + lane] = s1; red[(wave * 3 + 2) * 64 + lane] = s2;
            __syncthreads();
            if (tid < 192) {
                const int r = tid >> 6; float s = 0.f;
#pragma unroll
                for (int w = 0; w < 8; ++w) s += red[(w * 3 + r) * 64 + lane];
                ((float*)(ws + WS_MOD))[(size_t)(l * 3 + r) * 6144 + j] = s + a.in[I_BMOD][l * 6144 + j];
            }
            __syncthreads();
        }
    }
}

__device__ __forceinline__ void phase_norm_mod(const float* xl, const float* xc, const float* nw, const float* mod, int sh_off, int sc_off, bf16_t* H, int nrows) {
    const int lane = klane(), gw = blockIdx.x * NWAVES + kwave(), ngw = KGRID * NWAVES;
    for (int row = gw; row < nrows; row += ngw) {
        const float* src = row < ML ? xl + (size_t)row * DM : xc + (size_t)(row - ML) * DM;
        const float* m = mod + (row < ML ? row / NL : 2) * 6144;
        f32x4 v[4]; float ss = 0.f;
#pragma unroll
        for (int j = 0; j < 4; ++j) { v[j] = *(const f32x4*)(src + lane * 4 + 256 * j); ss += v[j].x * v[j].x + v[j].y * v[j].y + v[j].z * v[j].z + v[j].w * v[j].w; }
        const float rstd = rsqrtf(wave_sum(ss) * (1.f / DM) + EPS);
#pragma unroll
        for (int j = 0; j < 4; ++j) {
            const int c = lane * 4 + 256 * j;
            const f32x4 w = *(const f32x4*)(nw + c), sc = *(const f32x4*)(m + sc_off + c), sh = *(const f32x4*)(m + sh_off + c);
            const f32x4 o = (v[j] * rstd * w) * (sc + 1.f) + sh;
            u32x2 pk; pk.x = pk2(o.x, o.y); pk.y = pk2(o.z, o.w);
            *(u32x2*)(H + (size_t)row * DM + c) = pk;
        }
    }
}

template <class Epi> __device__ __forceinline__ void gemm_naive(const bf16_t* A, int lda, const bf16_t* Bt, int M, int N, int K, const Epi& E, LAS unsigned char* lds) {
    LAS float* As = (LAS float*)lds;
    LAS float* Bs = As + 32 * 132;
    const int tid = KTID, ty = tid >> 4, tx = tid & 15;
    const int ntm = M / 128, ntn = N / 64, ntiles = ntm * ntn;
    for (int tile = blockIdx.x; tile < ntiles; tile += KGRID) {
        const int tm = tile / ntn, tn = tile % ntn, row0 = tm * 128, col0 = tn * 64;
        float acc[4][4];
#pragma unroll
        for (int i = 0; i < 4; ++i)
#pragma unroll
            for (int j = 0; j < 4; ++j) acc[i][j] = 0.f;
        for (int k0 = 0; k0 < K; k0 += 32) {
            {
                const int r = tid >> 2, kc = (tid & 3) * 8; float f[8];
                unpack8(*(const u32x4*)(A + (size_t)(row0 + r) * lda + k0 + kc), f);
#pragma unroll
                for (int i = 0; i < 8; ++i) As[(kc + i) * 132 + r] = f[i];
                if (tid < 256) {
                    unpack8(*(const u32x4*)(Bt + (size_t)(col0 + r) * K + k0 + kc), f);
#pragma unroll
                    for (int i = 0; i < 8; ++i) Bs[(kc + i) * 68 + r] = f[i];
                }
            }
            __syncthreads();
#pragma unroll 8
            for (int k = 0; k < 32; ++k) {
                const f32x4 av = *(const LAS f32x4*)(As + k * 132 + ty * 4), bv = *(const LAS f32x4*)(Bs + k * 68 + tx * 4);
#pragma unroll
                for (int i = 0; i < 4; ++i)
#pragma unroll
                    for (int j = 0; j < 4; ++j) acc[i][j] += av[i] * bv[j];
            }
            __syncthreads();
        }
#pragma unroll
        for (int i = 0; i < 4; ++i) E(row0 + ty * 4 + i, col0 + tx * 4, (f32x4){acc[i][0], acc[i][1], acc[i][2], acc[i][3]});
    }
}

__device__ __forceinline__ void st4bf(bf16_t* p, f32x4 v) { u32x2 pk; pk.x = pk2(v.x, v.y); pk.y = pk2(v.z, v.w); *(u32x2*)p = pk; }
__device__ __forceinline__ f32x4 rope4(f32x4 v, int jj, int t, const float* R) {
    const int pos = (jj < 32) ? (t >> 6) : (t & 63), i0 = ((jj & 31) >> 1);
    const f32x4 cs = *(const f32x4*)(R + (pos * 16 + i0) * 2);
    return (f32x4){v.x * cs.x - v.y * cs.y, v.x * cs.y + v.y * cs.x, v.z * cs.z - v.w * cs.w, v.z * cs.w + v.w * cs.z};
}
__device__ __forceinline__ void st8bf(bf16_t* p, f32x4 a, f32x4 b) { u32x4 pk; pk.x = pk2(a.x, a.y); pk.y = pk2(a.z, a.w); pk.z = pk2(b.x, b.y); pk.w = pk2(b.z, b.w); *(u32x4*)p = pk; }
struct EpiInProj { bf16_t* PB; const float* R;
    __device__ __forceinline__ f32x4 xf(int row, int col, f32x4 v) const {
        const int tile = col >> 8;
        if (tile == 2 || tile == 3) { v = (f32x4){gelu_tanh(v.x), gelu_tanh(v.y), gelu_tanh(v.z), gelu_tanh(v.w)}; }
        else if (tile == 5) { v = (f32x4){silu_f(v.x), silu_f(v.y), silu_f(v.z), silu_f(v.w)}; }
        else if (tile == 7) { const int cc = col - C_KR; if (cc < 64 && row < ML) v = rope4(v, cc, row & (NL - 1), R); }
        return v; }
    __device__ __forceinline__ void operator()(int row, int col, f32x4 v) const { st4bf(PB + (size_t)row * INP + col, xf(row, col, v)); }
    __device__ __forceinline__ void op8(int row, int col, f32x4 v0, f32x4 v1) const { st8bf(PB + (size_t)row * INP + col, xf(row, col, v0), xf(row, col + 4, v1)); } };
struct EpiUQ { bf16_t* QB;
    __device__ __forceinline__ void operator()(int row, int col, f32x4 v) const { st4bf(QB + (size_t)row * 768 + col, v * QSCALE); }
    __device__ __forceinline__ void op8(int row, int col, f32x4 v0, f32x4 v1) const { st8bf(QB + (size_t)row * 768 + col, v0 * QSCALE, v1 * QSCALE); } };
struct EpiUKV { bf16_t* KVB;
    __device__ __forceinline__ void operator()(int row, int col, f32x4 v) const { st4bf(KVB + (size_t)row * 1024 + col, v); }
    __device__ __forceinline__ void op8(int row, int col, f32x4 v0, f32x4 v1) const { st8bf(KVB + (size_t)row * 1024 + col, v0, v1); } };
struct EpiResid { const float* xin_l; const float* xin_c; float* xout_l; float* xout_c; const float* mod; int g_off;
    __device__ __forceinline__ void operator()(int row, int col, f32x4 v) const {
        if (row < ML) { const f32x4 g = *(const f32x4*)(mod + (row >> 13) * 6144 + g_off + col), xi = *(const f32x4*)(xin_l + (size_t)row * DM + col);
            *(f32x4*)(xout_l + (size_t)row * DM + col) = xi + g * v;
        } else { const int rc = row - ML; const f32x4 g = *(const f32x4*)(mod + 2 * 6144 + g_off + col), xi = *(const f32x4*)(xin_c + (size_t)rc * DM + col);
            *(f32x4*)(xout_c + (size_t)rc * DM + col) = xi + g * v; }
    }
    __device__ __forceinline__ void op8(int row, int col, f32x4 v0, f32x4 v1) const {
        const float* gp; const float* xi; float* xo;
        if (row < ML) { gp = mod + (row >> 13) * 6144 + g_off + col; xi = xin_l + (size_t)row * DM + col; xo = xout_l + (size_t)row * DM + col; }
        else { const int rc = row - ML; gp = mod + 2 * 6144 + g_off + col; xi = xin_c + (size_t)rc * DM + col; xo = xout_c + (size_t)rc * DM + col; }
        const f32x4 g0 = *(const f32x4*)gp, g1 = *(const f32x4*)(gp + 4), x0 = *(const f32x4*)xi, x1 = *(const f32x4*)(xi + 4);
        *(f32x4*)xo = x0 + g0 * v0; *(f32x4*)(xo + 4) = x1 + g1 * v1;
    } };
struct EpiNull {
    __device__ __forceinline__ void operator()(int row, int col, f32x4 v) const { asm volatile("" :: "v"(v)); }
    __device__ __forceinline__ void op8(int row, int col, f32x4 v0, f32x4 v1) const { asm volatile("" :: "v"(v0), "v"(v1)); } };
struct EpiFF1 { bf16_t* Ah;
    __device__ __forceinline__ void operator()(int row, int col, f32x4 v) const {
        f32x4 r = (f32x4){fmaxf(v.x, 0.f), fmaxf(v.y, 0.f), fmaxf(v.z, 0.f), fmaxf(v.w, 0.f)};
        st4bf(Ah + (size_t)row * FF + col, r * r);
    }
    __device__ __forceinline__ void op8(int row, int col, f32x4 v0, f32x4 v1) const {
        f32x4 r0 = (f32x4){fmaxf(v0.x, 0.f), fmaxf(v0.y, 0.f), fmaxf(v0.z, 0.f), fmaxf(v0.w, 0.f)}, r1 = (f32x4){fmaxf(v1.x, 0.f), fmaxf(v1.y, 0.f), fmaxf(v1.z, 0.f), fmaxf(v1.w, 0.f)};
        st8bf(Ah + (size_t)row * FF + col, r0 * r0, r1 * r1);
    } };

__device__ __forceinline__ void phase_post(const Args& a, int l) {
    unsigned char* ws = a.ws;
    bf16_t* PB = (bf16_t*)(ws + WS_PB); float* LG = (float*)(ws + WS_LG);
    const float* kvnw = a.in[I_KVNW] + l * 256; const float* qnw = a.in[I_QNW] + l * 256;
    const float* snw = a.in[I_SGNW] + l * 256; const float* snb = a.in[I_SGNB] + l * 256;
    const float* wgf = a.in[I_GWF] + l * 16 * 128; const float* bgf = a.in[I_GBF] + l * 128;
    const float* wgb = a.in[I_GWB] + l * 16 * 128; const float* bgb = a.in[I_GBB] + l * 128;
    const int lane = klane(), gw = blockIdx.x * NWAVES + kwave(), ngw = KGRID * NWAVES;
    for (int row = gw; row < MT; row += ngw) {
        bf16_t* pr = PB + (size_t)row * INP;
        const int c = lane * 4;
        { u32x2 w = *(const u32x2*)(pr + C_CKV + c); f32x4 v = {__uint_as_float(w.x << 16), __uint_as_float(w.x & 0xffff0000u), __uint_as_float(w.y << 16), __uint_as_float(w.y & 0xffff0000u)};
          const float rstd = rsqrtf(wave_sum(v.x * v.x + v.y * v.y + v.z * v.z + v.w * v.w) * (1.f / 256.f) + EPS);
          st4bf(pr + C_CKV + c, v * rstd * *(const f32x4*)(kvnw + c)); }
        { u32x2 w = *(const u32x2*)(pr + C_DQ + c); f32x4 v = {__uint_as_float(w.x << 16), __uint_as_float(w.x & 0xffff0000u), __uint_as_float(w.y << 16), __uint_as_float(w.y & 0xffff0000u)};
          const float rstd = rsqrtf(wave_sum(v.x * v.x + v.y * v.y + v.z * v.z + v.w * v.w) * (1.f / 256.f) + EPS);
          st4bf(pr + C_DQ + c, v * rstd * *(const f32x4*)(qnw + c)); }
        { u32x2 w = *(const u32x2*)(pr + C_SV + c); f32x4 v = {__uint_as_float(w.x << 16), __uint_as_float(w.x & 0xffff0000u), __uint_as_float(w.y << 16), __uint_as_float(w.y & 0xffff0000u)};
          const float mu = wave_sum(v.x + v.y + v.z + v.w) * (1.f / 256.f);
          v = v - mu;
          const float rstd = rsqrtf(wave_sum(v.x * v.x + v.y * v.y + v.z * v.z + v.w * v.w) * (1.f / 256.f) + EPS);
          st4bf(pr + C_SV + c, v * rstd * *(const f32x4*)(snw + c) + *(const f32x4*)(snb + c)); }
        if (GLA_NAIVE) { const int o = lane * 4, isb = o >> 7, d = o & 127;
          const float* wg = isb ? wgb : wgf; const float* bg = isb ? bgb : bgf; const bf16_t* gg = pr + (isb ? C_GGB : C_GGF);
          f32x4 z = *(const f32x4*)(bg + d);
#pragma unroll
          for (int r = 0; r < 16; ++r) z += *(const f32x4*)(wg + r * 128 + d) * bf2f(gg[r]);
          *(f32x4*)(LG + (size_t)row * 256 + o) = (f32x4){log_sigmoid_f(z.x), log_sigmoid_f(z.y), log_sigmoid_f(z.z), log_sigmoid_f(z.w)} * (1.f / 16.f); }
    }
}

__device__ __forceinline__ void phase_sgu_naive(const Args& a, int l) {
    unsigned char* ws = a.ws;
    const bf16_t* PB = (const bf16_t*)(ws + WS_PB); bf16_t* Y = (bf16_t*)(ws + WS_HY);
    const float* Ws = a.in[I_SGW] + (size_t)l * 4 * 128 * 128; const float* bs = a.in[I_SGB] + l * 4 * 128;
    const int tid = KTID, i = tid >> 2, eg = (tid & 3) * 16;
    for (int unit = blockIdx.x; unit < (MT / 128) * 4; unit += KGRID) {
        const int cc = unit >> 2, h = unit & 3;
        float acc[16];
#pragma unroll
        for (int e = 0; e < 16; ++e) acc[e] = 0.f;
        const float* wrow = Ws + ((size_t)h * 128 + i) * 128;
        for (int j = 0; j < 128; ++j) {
            const float w = wrow[j];
            const bf16_t* vp = PB + (size_t)(cc * 128 + j) * INP + C_SV + h * 64 + eg;
            float f[8], g[8]; unpack8(*(const u32x4*)vp, f); unpack8(*(const u32x4*)(vp + 8), g);
#pragma unroll
            for (int e = 0; e < 8; ++e) { acc[e] += w * f[e]; acc[8 + e] += w * g[e]; }
        }
        const float bias = bs[h * 128 + i];
        const int row = cc * 128 + i;
        const bf16_t* up = PB + (size_t)row * INP + C_SU + h * 64 + eg;
        float f[8], g[8]; unpack8(*(const u32x4*)up, f); unpack8(*(const u32x4*)(up + 8), g);
        bf16_t* yp = Y + (size_t)row * DM + h * 64 + eg;
        u32x4 o0, o1;
        o0.x = pk2(f[0] * (acc[0] + bias), f[1] * (acc[1] + bias)); o0.y = pk2(f[2] * (acc[2] + bias), f[3] * (acc[3] + bias));
        o0.z = pk2(f[4] * (acc[4] + bias), f[5] * (acc[5] + bias)); o0.w = pk2(f[6] * (acc[6] + bias), f[7] * (acc[7] + bias));
        o1.x = pk2(g[0] * (acc[8] + bias), g[1] * (acc[9] + bias)); o1.y = pk2(g[2] * (acc[10] + bias), g[3] * (acc[11] + bias));
        o1.z = pk2(g[4] * (acc[12] + bias), g[5] * (acc[13] + bias)); o1.w = pk2(g[6] * (acc[14] + bias), g[7] * (acc[15] + bias));
        *(u32x4*)yp = o0; *(u32x4*)(yp + 8) = o1;
    }
}

__device__ __forceinline__ void phase_gla_naive(const Args& a, int l) {
    unsigned char* ws = a.ws;
    const bf16_t* PB = (const bf16_t*)(ws + WS_PB); bf16_t* Y = (bf16_t*)(ws + WS_HY);
    const float* LG = (const float*)(ws + WS_LG); float* OB = (float*)(ws + WS_OB);
    const float* gnw = a.in[I_GNW] + l * 64;
    if (blockIdx.x >= 8 || KTID >= 64) return;
    const int b = blockIdx.x >> 2, h = blockIdx.x & 3, e = KTID;
    const float gw_e = gnw[e];
    for (int dir = 1; dir >= 0; --dir) {
        float S[32];
#pragma unroll
        for (int d = 0; d < 32; ++d) S[d] = 0.f;
        for (int tau = 0; tau < NKEY; ++tau) {
            int row;
            if (dir == 0) row = tau < NC ? ML + b * NC + tau : b * NL + (tau - NC);
            else row = tau < NC ? ML + b * NC + (NC - 1 - tau) : b * NL + (NL - 1 - (tau - NC));
            const bf16_t* pr = PB + (size_t)row * INP;
            const float* lg = LG + (size_t)row * 256 + dir * 128 + h * 32;
            const float v = bf2f(pr[C_GV + h * 64 + e]);
            float o = 0.f;
#pragma unroll
            for (int d = 0; d < 32; ++d) {
                const float kk = bf2f(pr[C_GK + h * 32 + d]), qq = bf2f(pr[C_GQ + h * 32 + d]), al = expf(lg[d]);
                S[d] = al * S[d] + kk * v; o += qq * S[d];
            }
            o *= 0.17677669529663687f;
            if (dir == 1) OB[(size_t)row * 256 + h * 64 + e] = o;
            else {
                o += OB[(size_t)row * 256 + h * 64 + e];
                const float ms = wave_sum(o * o) * (1.f / 64.f);
                const float y = o * rsqrtf(ms + EPS) * gw_e * bf2f(pr[C_GR + h * 64 + e]);
                Y[(size_t)row * DM + 256 + h * 64 + e] = (bf16_t)f2bf(y);
            }
        }
    }
}

typedef short bf16x8 __attribute__((ext_vector_type(8)));
typedef float f32x16 __attribute__((ext_vector_type(16)));
typedef float f32x2_t __attribute__((ext_vector_type(2)));
typedef __bf16 bf16x2_t __attribute__((ext_vector_type(2)));
__device__ __forceinline__ unsigned cvtpk(float lo, float hi) { f32x2_t v = {lo, hi}; bf16x2_t b = __builtin_convertvector(v, bf16x2_t); return __builtin_bit_cast(unsigned, b); }
__device__ __forceinline__ int crow(int r, int hi) { return (r & 3) + 8 * (r >> 2) + 4 * hi; }
constexpr int GLA_WLDS = 17920, GLA_NB = 132;
constexpr size_t WS_BC = WS_LG, WS_GL = WS_OB, WS_GD = 1 * MiB + 512 * 1024;
static_assert((size_t)2112 * 2048 * 4 <= WS_END - WS_OB && WS_GD + (size_t)2112 * 32 * 4 <= WS_WIN && WS_ROPE + 16384 <= WS_GD && WS_WSB + 262144 <= WS_WUKV && WS_WUQ + (size_t)2 * 768 * 256 * 2 <= WS_WSB, "gla ws");
__device__ __forceinline__ int gla_row0(int b, int beta) { return beta < 4 ? ML + b * NC + beta * 64 : b * NL + (beta - 4) * 64; }
#define LDS_FENCE() do { asm volatile("s_waitcnt lgkmcnt(0)" ::: "memory"); __builtin_amdgcn_sched_barrier(0); } while (0)
__device__ __forceinline__ void gla_stage_vt(const bf16_t* pv, LAS bf16_t* VT, int lane) {
#pragma unroll
    for (int c8 = 0; c8 < 8; ++c8) { const u32x4 w = *(const u32x4*)(pv + c8 * 8);
        VT[(c8 * 8 + 0) * 64 + lane] = (bf16_t)(w.x & 0xffffu); VT[(c8 * 8 + 1) * 64 + lane] = (bf16_t)(w.x >> 16);
        VT[(c8 * 8 + 2) * 64 + lane] = (bf16_t)(w.y & 0xffffu); VT[(c8 * 8 + 3) * 64 + lane] = (bf16_t)(w.y >> 16);
        VT[(c8 * 8 + 4) * 64 + lane] = (bf16_t)(w.z & 0xffffu); VT[(c8 * 8 + 5) * 64 + lane] = (bf16_t)(w.z >> 16);
        VT[(c8 * 8 + 6) * 64 + lane] = (bf16_t)(w.w & 0xffffu); VT[(c8 * 8 + 7) * 64 + lane] = (bf16_t)(w.w >> 16); }
}
__device__ __forceinline__ void load32bf(const bf16_t* p, float* f) {
    unpack8(*(const u32x4*)(p), f); unpack8(*(const u32x4*)(p + 8), f + 8); unpack8(*(const u32x4*)(p + 16), f + 16); unpack8(*(const u32x4*)(p + 24), f + 24);
}
__device__ __forceinline__ void phase_gla_local(const Args& a, int l, LAS unsigned char* lds) {
    unsigned char* ws = a.ws;
    const bf16_t* PB = (const bf16_t*)(ws + WS_PB); float* BC = (float*)(ws + WS_BC); float* GL = (float*)(ws + WS_GL); float* GD = (float*)(ws + WS_GD);
    const int lane = klane(), wave = kwave(), gw = wave * KGRID + (int)blockIdx.x, ngw = KGRID * NWAVES    ;
    const int r32 = lane & 31, hi = lane >> 5;
    LAS bf16_t* KT = (LAS bf16_t*)(lds + wave * GLA_WLDS); LAS bf16_t* VT = KT + 32 * 64;
    for (int task = gw; task < 16 * GLA_NB; task += ngw) {
        const int beta = task % GLA_NB, t2 = task / GLA_NB, dir = t2 & 1, h = (t2 >> 1) & 3, b = t2 >> 3;
        const int row = gla_row0(b, beta) + lane; const bf16_t* pr = PB + (size_t)row * INP;
        LDS_FENCE();
        gla_stage_vt(pr + C_GV + h * 64, VT, lane);
        float c[32];
        {
          const float* wg = (dir ? a.in[I_GWB] : a.in[I_GWF]) + l * 16 * 128 + h * 32; const float* bg = (dir ? a.in[I_GBB] : a.in[I_GBF]) + l * 128 + h * 32;
          LAS float* WGL = (LAS float*)(VT + 64 * 64); LAS float* BGL = WGL + 16 * 32;
          { const int r = lane >> 2, d0 = (lane & 3) * 8;
            *(LAS f32x4*)(WGL + r * 32 + d0) = *(const f32x4*)(wg + r * 128 + d0); *(LAS f32x4*)(WGL + r * 32 + d0 + 4) = *(const f32x4*)(wg + r * 128 + d0 + 4);
            if (lane < 32) BGL[lane] = bg[lane]; }
          float gg[16]; unpack8(*(const u32x4*)(pr + (dir ? C_GGB : C_GGF)), gg); unpack8(*(const u32x4*)(pr + (dir ? C_GGB : C_GGF) + 8), gg + 8);
          LDS_FENCE();
#pragma unroll
          for (int d = 0; d < 32; d += 4) { f32x4 z = *(const LAS f32x4*)(BGL + d);
#pragma unroll
              for (int r = 0; r < 16; ++r) z += *(const LAS f32x4*)(WGL + r * 32 + d) * gg[r];
              c[d] = log_sigmoid_fast(z.x) * (1.f / 16.f); c[d + 1] = log_sigmoid_fast(z.y) * (1.f / 16.f); c[d + 2] = log_sigmoid_fast(z.z) * (1.f / 16.f); c[d + 3] = log_sigmoid_fast(z.w) * (1.f / 16.f); } }
        float kk[32]; load32bf(pr + C_GK + h * 32, kk);
#pragma unroll
        for (int d = 0; d < 32; ++d) {
            const float g = c[d], p = wave_prefix_sum(g);
            const float T = __builtin_bit_cast(float, __builtin_amdgcn_readlane(__builtin_bit_cast(int, p), 63));
            const float cc = dir ? (T - p + g) : p;
            c[d] = cc;
            KT[d * 64 + lane] = (bf16_t)(cvtpk(kk[d] * __expf(T - cc), 0.f) & 0xffffu);
            kk[d] = __expf(T);
        }
        if (lane == 0) { float* gd = GD + (size_t)task * 32;
#pragma unroll
            for (int d = 0; d < 32; d += 4) *(f32x4*)(gd + d) = (f32x4){kk[d], kk[d + 1], kk[d + 2], kk[d + 3]}; }
        { float* bc = BC + (size_t)row * 256 + dir * 128 + h * 32;
#pragma unroll
          for (int d = 0; d < 32; d += 4) *(f32x4*)(bc + d) = (f32x4){c[d], c[d + 1], c[d + 2], c[d + 3]}; }
        LDS_FENCE();
        f32x16 acc0 = {}, acc1 = {};
#pragma unroll
        for (int s = 0; s < 4; ++s) {
            const bf16x8 af = *(const LAS bf16x8*)(KT + r32 * 64 + 16 * s + 8 * hi);
            const bf16x8 b0 = *(const LAS bf16x8*)(VT + r32 * 64 + 16 * s + 8 * hi), b1 = *(const LAS bf16x8*)(VT + (32 + r32) * 64 + 16 * s + 8 * hi);
            acc0 = __builtin_amdgcn_mfma_f32_32x32x16_bf16(af, b0, acc0, 0, 0, 0); acc1 = __builtin_amdgcn_mfma_f32_32x32x16_bf16(af, b1, acc1, 0, 0, 0);
        }
        float* gl = GL + (size_t)task * 2048;
#pragma unroll
        for (int r = 0; r < 16; ++r) { gl[crow(r, hi) * 64 + r32] = acc0[r]; gl[crow(r, hi) * 64 + 32 + r32] = acc1[r]; }
    }
}
__device__ __forceinline__ void phase_gla_scan(const Args& a) {
    unsigned char* ws = a.ws; float* GL = (float*)(ws + WS_GL); const float* GD = (const float*)(ws + WS_GD);
    const int idx = ((int)blockIdx.x - (KGRID - 64)) * NTHR + KTID;
    if (idx < 0 || idx >= 16 * 2048) return;
    const int seq = idx >> 11, de = idx & 2047, d = de >> 6, dir = seq & 1;
    float S = 0.f;
    for (int c0 = 0; c0 < GLA_NB; c0 += 12) {
        float Lv[12], Dv[12];
#pragma unroll
        for (int u = 0; u < 12; ++u) { const int c = c0 + u, beta = dir ? (c < 4 ? 3 - c : 135 - c) : c; const size_t slot = (size_t)seq * GLA_NB + beta;
            Lv[u] = GL[slot * 2048 + de]; Dv[u] = GD[slot * 32 + d]; }
#pragma unroll
        for (int u = 0; u < 12; ++u) { const int c = c0 + u, beta = dir ? (c < 4 ? 3 - c : 135 - c) : c; const size_t slot = (size_t)seq * GLA_NB + beta;
            GL[slot * 2048 + de] = S; S = Dv[u] * S + Lv[u]; }
    }
}
template <int DIR> __device__ __forceinline__ void gla_dir(const bf16_t* pr, const float* bc, const float* sin, int h, LAS bf16_t* QS, LAS bf16_t* KS, const LAS bf16_t* VT, int lane,
                                                            f32x16& o00, f32x16& o01, f32x16& o10, f32x16& o11) {
    const int r32 = lane & 31, hi = lane >> 5;
    {
        float c[32], q[32], k[32];
#pragma unroll
        for (int d = 0; d < 32; d += 4) { const f32x4 v = *(const f32x4*)(bc + d); c[d] = v.x; c[d + 1] = v.y; c[d + 2] = v.z; c[d + 3] = v.w; }
        load32bf(pr + C_GQ + h * 32, q); load32bf(pr + C_GK + h * 32, k);
#pragma unroll
        for (int d = 0; d < 32; d += 8) {
            u32x4 wq, wk; float eq[8], ek[8];
#pragma unroll
            for (int i = 0; i < 8; ++i) { eq[i] = q[d + i] * __expf(c[d + i]) * 0.17677669529663687f; ek[i] = k[d + i] * __expf(-c[d + i]); }
            wq.x = cvtpk(eq[0], eq[1]); wq.y = cvtpk(eq[2], eq[3]); wq.z = cvtpk(eq[4], eq[5]); wq.w = cvtpk(eq[6], eq[7]);
            wk.x = cvtpk(ek[0], ek[1]); wk.y = cvtpk(ek[2], ek[3]); wk.z = cvtpk(ek[4], ek[5]); wk.w = cvtpk(ek[6], ek[7]);
            *(LAS u32x4*)(QS + lane * 32 + d) = wq; *(LAS u32x4*)(KS + lane * 32 + d) = wk;
        }
    }
    LDS_FENCE();
    bf16x8 qf[2][2], kf[2][2];
#pragma unroll
    for (int t = 0; t < 2; ++t)
#pragma unroll
        for (int s = 0; s < 2; ++s) { qf[t][s] = *(const LAS bf16x8*)(QS + (32 * t + r32) * 32 + 16 * s + 8 * hi); kf[t][s] = *(const LAS bf16x8*)(KS + (32 * t + r32) * 32 + 16 * s + 8 * hi); }
    LDS_FENCE();
    {
        u32x4 w[4];
#pragma unroll
        for (int d = 0; d < 32; d += 8) {
            float sv[8];
#pragma unroll
            for (int i = 0; i < 8; ++i) sv[i] = sin[(d + i) * 64 + lane];
            w[d >> 3].x = cvtpk(sv[0], sv[1]); w[d >> 3].y = cvtpk(sv[2], sv[3]); w[d >> 3].z = cvtpk(sv[4], sv[5]); w[d >> 3].w = cvtpk(sv[6], sv[7]);
        }
#pragma unroll
        for (int i = 0; i < 4; ++i) *(LAS u32x4*)(QS + lane * 32 + 8 * i) = w[i];
    }
#define GLA_X(tj, ti) __builtin_amdgcn_mfma_f32_32x32x16_bf16(kf[tj][1], qf[ti][1], __builtin_amdgcn_mfma_f32_32x32x16_bf16(kf[tj][0], qf[ti][0], (f32x16){}, 0, 0, 0), 0, 0, 0)
#define GLA_MASK(X) do { _Pragma("unroll") for (int r = 0; r < 16; ++r) { const int jl = crow(r, hi); const bool keep = DIR == 0 ? (jl <= r32) : (jl >= r32); X[r] = keep ? X[r] : 0.f; } } while (0)
#define GLA_XA(X, s) __builtin_bit_cast(bf16x8, (u32x4){cvtpk(X[8 * (s) + 0], X[8 * (s) + 1]), cvtpk(X[8 * (s) + 2], X[8 * (s) + 3]), cvtpk(X[8 * (s) + 4], X[8 * (s) + 5]), cvtpk(X[8 * (s) + 6], X[8 * (s) + 7])})
#define GLA_VF(tj, s, te) __builtin_bit_cast(bf16x8, (u32x4){((const LAS u32x2*)(VT + (32 * (te) + r32) * 64 + 32 * (tj) + 16 * (s) + 4 * hi))->x, ((const LAS u32x2*)(VT + (32 * (te) + r32) * 64 + 32 * (tj) + 16 * (s) + 4 * hi))->y, \
                                                              ((const LAS u32x2*)(VT + (32 * (te) + r32) * 64 + 32 * (tj) + 16 * (s) + 8 + 4 * hi))->x, ((const LAS u32x2*)(VT + (32 * (te) + r32) * 64 + 32 * (tj) + 16 * (s) + 8 + 4 * hi))->y})
#define GLA_PV(X, tj, O0, O1) do { _Pragma("unroll") for (int s = 0; s < 2; ++s) { const bf16x8 xa = GLA_XA(X, s); \
        O0 = __builtin_amdgcn_mfma_f32_32x32x16_bf16(xa, GLA_VF(tj, s, 0), O0, 0, 0, 0); O1 = __builtin_amdgcn_mfma_f32_32x32x16_bf16(xa, GLA_VF(tj, s, 1), O1, 0, 0, 0); } } while (0)
    __builtin_amdgcn_sched_barrier(0);
    { f32x16 X = GLA_X(0, 0); GLA_MASK(X); GLA_PV(X, 0, o00, o01); }
    __builtin_amdgcn_sched_barrier(0);
    { f32x16 X = GLA_X(1, 1); GLA_MASK(X); GLA_PV(X, 1, o10, o11); }
    __builtin_amdgcn_sched_barrier(0);
    if (DIR == 0) { f32x16 X = GLA_X(0, 1); GLA_PV(X, 0, o10, o11); }
    else          { f32x16 X = GLA_X(1, 0); GLA_PV(X, 1, o00, o01); }
    LDS_FENCE();
#pragma unroll
    for (int s = 0; s < 2; ++s) {
        const bf16x8 s0 = *(const LAS bf16x8*)(QS + r32 * 32 + 16 * s + 8 * hi), s1 = *(const LAS bf16x8*)(QS + (32 + r32) * 32 + 16 * s + 8 * hi);
        o00 = __builtin_amdgcn_mfma_f32_32x32x16_bf16(qf[0][s], s0, o00, 0, 0, 0); o01 = __builtin_amdgcn_mfma_f32_32x32x16_bf16(qf[0][s], s1, o01, 0, 0, 0);
        o10 = __builtin_amdgcn_mfma_f32_32x32x16_bf16(qf[1][s], s0, o10, 0, 0, 0); o11 = __builtin_amdgcn_mfma_f32_32x32x16_bf16(qf[1][s], s1, o11, 0, 0, 0);
    }
    LDS_FENCE();
#undef GLA_X
#undef GLA_MASK
#undef GLA_XA
#undef GLA_VF
#undef GLA_PV
}
__device__ __forceinline__ void phase_gla_out(const Args& a, int l, LAS unsigned char* lds) {
    unsigned char* ws = a.ws;
    const bf16_t* PB = (const bf16_t*)(ws + WS_PB); const float* BC = (const float*)(ws + WS_BC); const float* GL = (const float*)(ws + WS_GL); bf16_t* Y = (bf16_t*)(ws + WS_HY);
    const float* gnw = a.in[I_GNW] + l * 64;
    const int lane = klane(), wave = kwave(), gw = wave * KGRID + (int)blockIdx.x, ngw = KGRID * NWAVES    ;
    const int r32 = lane & 31, hi = lane >> 5;
    LAS bf16_t* QS = (LAS bf16_t*)(lds + wave * GLA_WLDS); LAS bf16_t* KS = QS + 64 * 32; LAS bf16_t* VT = KS + 64 * 32; LAS float* OS = (LAS float*)(lds + wave * GLA_WLDS);
    for (int task = gw; task < 8 * GLA_NB; task += ngw) {
        const int beta = task % GLA_NB, bh = task / GLA_NB, h = bh & 3, b = bh >> 2;
        const int row = gla_row0(b, beta) + lane; const bf16_t* pr = PB + (size_t)row * INP;
        LDS_FENCE();
        gla_stage_vt(pr + C_GV + h * 64, VT, lane);
        f32x16 o00 = {}, o01 = {}, o10 = {}, o11 = {};
        gla_dir<0>(pr, BC + (size_t)row * 256 + h * 32, GL + ((size_t)(bh * 2 + 0) * GLA_NB + beta) * 2048, h, QS, KS, VT, lane, o00, o01, o10, o11);
        gla_dir<1>(pr, BC + (size_t)row * 256 + 128 + h * 32, GL + ((size_t)(bh * 2 + 1) * GLA_NB + beta) * 2048, h, QS, KS, VT, lane, o00, o01, o10, o11);
#pragma unroll
        for (int r = 0; r < 16; ++r) { const int i = crow(r, hi);
            OS[i * 65 + r32] = o00[r]; OS[i * 65 + 32 + r32] = o01[r]; OS[(32 + i) * 65 + r32] = o10[r]; OS[(32 + i) * 65 + 32 + r32] = o11[r]; }
        LDS_FENCE();
        float ss = 0.f;
#pragma unroll
        for (int e = 0; e < 64; ++e) { const float v = OS[lane * 65 + e]; ss += v * v; }
        const float rstd = rsqrtf(ss * (1.f / 64.f) + EPS);
        bf16_t* yp = Y + (size_t)row * DM + 256 + h * 64;
#pragma unroll
        for (int c8 = 0; c8 < 8; ++c8) { float rr[8]; unpack8(*(const u32x4*)(pr + C_GR + h * 64 + c8 * 8), rr);
            float y[8];
#pragma unroll
            for (int i = 0; i < 8; ++i) y[i] = OS[lane * 65 + c8 * 8 + i] * rstd * gnw[c8 * 8 + i] * rr[i];
            u32x4 w; w.x = cvtpk(y[0], y[1]); w.y = cvtpk(y[2], y[3]); w.z = cvtpk(y[4], y[5]); w.w = cvtpk(y[6], y[7]);
            *(u32x4*)(yp + c8 * 8) = w; }
    }
}

__device__ __forceinline__ void phase_sgu_mfma(const Args& a, int l, LAS unsigned char* lds) {
    unsigned char* ws = a.ws;
    const bf16_t* PB = (const bf16_t*)(ws + WS_PB); bf16_t* Y = (bf16_t*)(ws + WS_HY);
    const bf16_t* WSB = (const bf16_t*)(ws + WS_WSB) + (size_t)l * 4 * 128 * 128; const float* bs = a.in[I_SGB] + l * 4 * 128;
    const int lane = klane(), wave = kwave(), gw = wave * KGRID + (int)blockIdx.x, ngw = KGRID * NWAVES    ;
    const int r32 = lane & 31, hi = lane >> 5;
    LAS bf16_t* VT = (LAS bf16_t*)(lds + wave * GLA_WLDS);
    for (int task = gw; task < (MT / 128) * 4; task += ngw) {
        const int cc = task >> 2, h = task & 3;
        LDS_FENCE();
#pragma unroll
        for (int half = 0; half < 2; ++half) { const int j = lane + 64 * half; const bf16_t* pv = PB + (size_t)(cc * 128 + j) * INP + C_SV + h * 64;
#pragma unroll
            for (int c8 = 0; c8 < 8; ++c8) { const u32x4 w = *(const u32x4*)(pv + c8 * 8);
                VT[(c8 * 8 + 0) * 128 + j] = (bf16_t)(w.x & 0xffffu); VT[(c8 * 8 + 1) * 128 + j] = (bf16_t)(w.x >> 16);
                VT[(c8 * 8 + 2) * 128 + j] = (bf16_t)(w.y & 0xffffu); VT[(c8 * 8 + 3) * 128 + j] = (bf16_t)(w.y >> 16);
                VT[(c8 * 8 + 4) * 128 + j] = (bf16_t)(w.z & 0xffffu); VT[(c8 * 8 + 5) * 128 + j] = (bf16_t)(w.z >> 16);
                VT[(c8 * 8 + 6) * 128 + j] = (bf16_t)(w.w & 0xffffu); VT[(c8 * 8 + 7) * 128 + j] = (bf16_t)(w.w >> 16); } }
        LDS_FENCE();
#pragma unroll 1
        for (int ti = 0; ti < 4; ++ti) {
            f32x16 acc0 = {}, acc1 = {};
            const bf16_t* wrow = WSB + ((size_t)h * 128 + 32 * ti + r32) * 128 + 8 * hi;
#pragma unroll
            for (int s = 0; s < 8; ++s) {
                const bf16x8 bw = *(const bf16x8*)(wrow + 16 * s);
                const bf16x8 a0 = *(const LAS bf16x8*)(VT + r32 * 128 + 16 * s + 8 * hi), a1 = *(const LAS bf16x8*)(VT + (32 + r32) * 128 + 16 * s + 8 * hi);
                acc0 = __builtin_amdgcn_mfma_f32_32x32x16_bf16(a0, bw, acc0, 0, 0, 0); acc1 = __builtin_amdgcn_mfma_f32_32x32x16_bf16(a1, bw, acc1, 0, 0, 0);
            }
            const int i = 32 * ti + r32, row = cc * 128 + i; const float bias = bs[h * 128 + i];
            const bf16_t* up = PB + (size_t)row * INP + C_SU + h * 64 + 4 * hi; bf16_t* yp = Y + (size_t)row * DM + h * 64 + 4 * hi;
#pragma unroll
            for (int g = 0; g < 4; ++g) {
                { const u32x2 u = *(const u32x2*)(up + 8 * g); u32x2 o;
                  o.x = cvtpk(__uint_as_float(u.x << 16) * (acc0[4 * g + 0] + bias), __uint_as_float(u.x & 0xffff0000u) * (acc0[4 * g + 1] + bias));
                  o.y = cvtpk(__uint_as_float(u.y << 16) * (acc0[4 * g + 2] + bias), __uint_as_float(u.y & 0xffff0000u) * (acc0[4 * g + 3] + bias));
                  *(u32x2*)(yp + 8 * g) = o; }
                { const u32x2 u = *(const u32x2*)(up + 32 + 8 * g); u32x2 o;
                  o.x = cvtpk(__uint_as_float(u.x << 16) * (acc1[4 * g + 0] + bias), __uint_as_float(u.x & 0xffff0000u) * (acc1[4 * g + 1] + bias));
                  o.y = cvtpk(__uint_as_float(u.y << 16) * (acc1[4 * g + 2] + bias), __uint_as_float(u.y & 0xffff0000u) * (acc1[4 * g + 3] + bias));
                  *(u32x2*)(yp + 32 + 8 * g) = o; }
            }
        }
    }
}

__device__ __forceinline__ void phase_attn_naive(const Args& a, int l, LAS unsigned char* lds) {
    unsigned char* ws = a.ws;
    const bf16_t* QB = (const bf16_t*)(ws + WS_QB); const bf16_t* KVB = (const bf16_t*)(ws + WS_KVB); const bf16_t* PB = (const bf16_t*)(ws + WS_PB); bf16_t* Y = (bf16_t*)(ws + WS_HY);
    const float* ROPE = (const float*)(ws + WS_ROPE);
    LAS float* Qs = (LAS float*)lds;
    LAS float* Ks = Qs + 192 * 64;
    LAS float* Vs = Ks + 96 * 64;
    LAS float* Ps = Vs + 64 * 128;
    const int tid = KTID, ty = tid >> 4, tx = tid & 15;
    const int nunits = 1024 + (l == 0 ? 32 : 0);
    for (int unit = blockIdx.x; unit < nunits; unit += KGRID) {
        int bh, nkeys, orow0;
        if (unit < 1024) { bh = unit >> 7; const int qb = unit & 127; nkeys = NKEY; orow0 = (bh >> 2) * NL + qb * 64; }
        else { const int u = unit - 1024; bh = u >> 2; const int qb = u & 3; nkeys = NC; orow0 = ML + (bh >> 2) * NC + qb * 64; }
        const int h = bh & 3, b = bh >> 2;
        const bf16_t* Qp = QB + (size_t)orow0 * 768 + h * 192;
        __syncthreads();
        for (int idx = tid; idx < 64 * 24; idx += NTHR) { const int r = idx / 24, ch = idx % 24; float f[8]; unpack8(*(const u32x4*)(Qp + (size_t)r * 768 + ch * 8), f);
            if (ch >= 16 && unit < 1024) { const int t = (orow0 + r) & (NL - 1), jj = (ch - 16) * 8;
                const f32x4 r0 = rope4((f32x4){f[0], f[1], f[2], f[3]}, jj, t, ROPE), r1 = rope4((f32x4){f[4], f[5], f[6], f[7]}, jj + 4, t, ROPE);
                f[0] = r0.x; f[1] = r0.y; f[2] = r0.z; f[3] = r0.w; f[4] = r1.x; f[5] = r1.y; f[6] = r1.z; f[7] = r1.w; }
#pragma unroll
            for (int i = 0; i < 8; ++i) Qs[(ch * 8 + i) * 64 + r] = f[i]; }
        float m[2] = {-1e30f, -1e30f}, lsum[2] = {0.f, 0.f}, o[2][8];
#pragma unroll
        for (int r = 0; r < 2; ++r)
#pragma unroll
            for (int c = 0; c < 8; ++c) o[r][c] = 0.f;
        for (int k0 = 0; k0 < nkeys; k0 += 64) {
            const int krow0 = k0 < NC ? ML + b * NC + k0 : b * NL + (k0 - NC);
            float s[2][4];
#pragma unroll
            for (int r = 0; r < 2; ++r)
#pragma unroll
                for (int j = 0; j < 4; ++j) s[r][j] = 0.f;
            for (int dh = 0; dh < 2; ++dh) {
                __syncthreads();
                for (int idx = tid; idx < 64 * 12; idx += NTHR) { const int key = idx / 12, ch = idx % 12; float f[8];
                    const int dcol = dh * 96 + ch * 8;
                    unpack8(dcol < 128 ? *(const u32x4*)(KVB + (size_t)(krow0 + key) * 1024 + h * 256 + dcol) : *(const u32x4*)(PB + (size_t)(krow0 + key) * INP + C_KR + (dcol - 128)), f);
#pragma unroll
                    for (int i = 0; i < 8; ++i) Ks[(ch * 8 + i) * 64 + key] = f[i]; }
                if (dh == 0) {
                    for (int idx = tid; idx < 64 * 16; idx += NTHR) { const int key = idx >> 4, ch = idx & 15; float f[8];
                        unpack8(*(const u32x4*)(KVB + (size_t)(krow0 + key) * 1024 + h * 256 + 128 + ch * 8), f);
#pragma unroll
                        for (int i = 0; i < 8; ++i) Vs[key * 128 + ch * 8 + i] = f[i]; }
                }
                __syncthreads();
#pragma unroll 4
                for (int d = 0; d < 96; ++d) {
                    const float q0 = Qs[(dh * 96 + d) * 64 + 2 * ty], q1 = Qs[(dh * 96 + d) * 64 + 2 * ty + 1];
                    const f32x4 kv = *(const LAS f32x4*)(Ks + d * 64 + 4 * tx);
#pragma unroll
                    for (int j = 0; j < 4; ++j) { s[0][j] += q0 * kv[j]; s[1][j] += q1 * kv[j]; }
                }
            }
#pragma unroll
            for (int r = 0; r < 2; ++r) {
                float mx = fmaxf(fmaxf(s[r][0], s[r][1]), fmaxf(s[r][2], s[r][3]));
                mx = fmaxf(mx, __shfl_xor(mx, 1)); mx = fmaxf(mx, __shfl_xor(mx, 2)); mx = fmaxf(mx, __shfl_xor(mx, 4)); mx = fmaxf(mx, __shfl_xor(mx, 8));
                const float mn = fmaxf(m[r], mx), alpha = exp2f(m[r] - mn);
                float p[4], rs = 0.f;
#pragma unroll
                for (int j = 0; j < 4; ++j) { p[j] = exp2f(s[r][j] - mn); rs += p[j]; Ps[(2 * ty + r) * 65 + 4 * tx + j] = p[j]; }
                rs += __shfl_xor(rs, 1); rs += __shfl_xor(rs, 2); rs += __shfl_xor(rs, 4); rs += __shfl_xor(rs, 8);
                lsum[r] = lsum[r] * alpha + rs; m[r] = mn;
#pragma unroll
                for (int c = 0; c < 8; ++c) o[r][c] *= alpha;
            }
            __syncthreads();
#pragma unroll 4
            for (int j = 0; j < 64; ++j) {
                const float p0 = Ps[(2 * ty) * 65 + j], p1 = Ps[(2 * ty + 1) * 65 + j];
                const f32x4 v0 = *(const LAS f32x4*)(Vs + j * 128 + 8 * tx), v1 = *(const LAS f32x4*)(Vs + j * 128 + 8 * tx + 4);
#pragma unroll
                for (int c = 0; c < 4; ++c) { o[0][c] += p0 * v0[c]; o[0][4 + c] += p0 * v1[c]; o[1][c] += p1 * v0[c]; o[1][4 + c] += p1 * v1[c]; }
            }
        }
#pragma unroll
        for (int r = 0; r < 2; ++r) {
            const float il = 1.f / lsum[r];
            u32x4 w; w.x = pk2(o[r][0] * il, o[r][1] * il); w.y = pk2(o[r][2] * il, o[r][3] * il); w.z = pk2(o[r][4] * il, o[r][5] * il); w.w = pk2(o[r][6] * il, o[r][7] * il);
            *(u32x4*)(Y + (size_t)(orow0 + 2 * ty + r) * DM + 512 + h * 128 + 8 * tx) = w;
        }
    }
}

namespace att {
using s16x4 = __attribute__((ext_vector_type(4))) short;
constexpr int QBLK = 32, KVBLK = 64;
constexpr int SHM_V = KVBLK * 128 * 2, SHM_K = KVBLK * 192 * 2, SHM_SCR = 2 * SHM_V + 2 * SHM_K, SHM_QL = SHM_SCR + NWAVES * 64 * 4, SHM_ATTN = SHM_QL + NWAVES * ATT_NQL * 1024;
constexpr float THR2 = 11.5f;
#define KSWZ(row, colB) ((row) * 384 + ((colB) ^ ((((row) >> 1) & 7) << 4)))
#define SBAR() __builtin_amdgcn_sched_barrier(0)
__device__ __forceinline__ void partialSM(f32x16& p0, f32x16& p1, float& m_reg, float& mn, float& alpha) {
  float pmax = p0[0];
#pragma unroll
  for (int r = 1; r < 16; ++r) pmax = fmaxf(pmax, p0[r]);
#pragma unroll
  for (int r = 0; r < 16; ++r) pmax = fmaxf(pmax, p1[r]);
  { auto rr = __builtin_amdgcn_permlane32_swap(__float_as_uint(pmax), __float_as_uint(pmax), false, false);
    pmax = fmaxf(__uint_as_float(rr[0]), __uint_as_float(rr[1])); }
  if (__builtin_expect(__all(pmax - m_reg <= THR2), 1)) { mn = m_reg; alpha = 1.f; }
  else { mn = fmaxf(m_reg, pmax); alpha = __builtin_amdgcn_exp2f(m_reg - mn); m_reg = mn; }
#pragma unroll
  for (int r = 0; r < 16; ++r) p0[r] = p0[r] - mn;
#pragma unroll
  for (int r = 0; r < 16; ++r) p1[r] = p1[r] - mn;
#pragma unroll
  for (int r = 0; r < 16; ++r) p0[r] = __builtin_amdgcn_exp2f(p0[r]);
}
__device__ __forceinline__ void finishSM(f32x16& p0, f32x16& p1, float alpha, float& l_reg, bf16x8& pa0, bf16x8& pa1, bf16x8& pa2, bf16x8& pa3) {
#pragma unroll
  for (int r = 0; r < 16; ++r) p1[r] = __builtin_amdgcn_exp2f(p1[r]);
  float ps = 0;
#pragma unroll
  for (int r = 0; r < 16; ++r) ps += p0[r];
#pragma unroll
  for (int r = 0; r < 16; ++r) ps += p1[r];
  { auto rr = __builtin_amdgcn_permlane32_swap(__float_as_uint(ps), __float_as_uint(ps), false, false);
    ps = __uint_as_float(rr[0]) + __uint_as_float(rr[1]); }
  l_reg = l_reg * alpha + ps;
#define PK4(P, BASE, OUT) do { unsigned a0 = cvtpk(P[BASE + 0], P[BASE + 1]), a1 = cvtpk(P[BASE + 2], P[BASE + 3]);   \
    unsigned b0 = cvtpk(P[BASE + 4], P[BASE + 5]), b1 = cvtpk(P[BASE + 6], P[BASE + 7]);                              \
    auto r0 = __builtin_amdgcn_permlane32_swap(a0, b0, false, false); auto r1 = __builtin_amdgcn_permlane32_swap(a1, b1, false, false); \
    u32x4 w = {r0[0], r1[0], r0[1], r1[1]}; OUT = __builtin_bit_cast(bf16x8, w); } while (0)
  PK4(p0, 0, pa0); PK4(p0, 8, pa1); PK4(p1, 0, pa2); PK4(p1, 8, pa3);
#undef PK4
}
constexpr int NQR = 12 - ATT_NQL;
#define ATT_KRD(K0, K1, d0, KB) asm volatile("ds_read_b128 %0, %2 offset:%3\n\tds_read_b128 %1, %2 offset:%4" : "=&v"(K0), "=&v"(K1) : "v"(ka[(d0) & 3]), "i"((KB) + ((d0) >> 2) * 128), "i"((KB) + ((d0) >> 2) * 128 + 12288) : "memory")
#define ATT_QRD(Q, d0) asm volatile("ds_read_b128 %0, %1 offset:%2" : "=&v"(Q) : "v"(qla), "i"(((d0) - NQR) * 1024) : "memory")
template <int KB> __device__ __forceinline__ void qkt(f32x16& p0, f32x16& p1, const unsigned (&ka)[4], const bf16x8* qr, unsigned qla) {
  p0 = f32x16{}; p1 = f32x16{};
  bf16x8 kx0, kx1, ky0, ky1, qx, qy;
  ATT_KRD(kx0, kx1, 0, KB); if (0 >= NQR) ATT_QRD(qx, 0);
#pragma unroll
  for (int d0 = 0; d0 < 12; d0 += 2) {
    ATT_KRD(ky0, ky1, d0 + 1, KB); if (d0 + 1 >= NQR) ATT_QRD(qy, d0 + 1);
    if (d0 + 1 >= NQR) { if (d0 >= NQR) asm volatile("s_waitcnt lgkmcnt(3)" : "+v"(kx0), "+v"(kx1), "+v"(qx)); else asm volatile("s_waitcnt lgkmcnt(3)" : "+v"(kx0), "+v"(kx1)); }
    else asm volatile("s_waitcnt lgkmcnt(2)" : "+v"(kx0), "+v"(kx1));
    { const bf16x8 qf = d0 < NQR ? qr[d0 < NQR ? d0 : 0] : qx;
      p0 = __builtin_amdgcn_mfma_f32_32x32x16_bf16(kx0, qf, p0, 0, 0, 0); p1 = __builtin_amdgcn_mfma_f32_32x32x16_bf16(kx1, qf, p1, 0, 0, 0); }
    if (d0 + 2 < 12) { ATT_KRD(kx0, kx1, d0 + 2, KB); if (d0 + 2 >= NQR) ATT_QRD(qx, d0 + 2);
      if (d0 + 2 >= NQR) { if (d0 + 1 >= NQR) asm volatile("s_waitcnt lgkmcnt(3)" : "+v"(ky0), "+v"(ky1), "+v"(qy)); else asm volatile("s_waitcnt lgkmcnt(3)" : "+v"(ky0), "+v"(ky1)); }
      else asm volatile("s_waitcnt lgkmcnt(2)" : "+v"(ky0), "+v"(ky1)); }
    else { if (d0 + 1 >= NQR) asm volatile("s_waitcnt lgkmcnt(0)" : "+v"(ky0), "+v"(ky1), "+v"(qy)); else asm volatile("s_waitcnt lgkmcnt(0)" : "+v"(ky0), "+v"(ky1)); }
    { const bf16x8 qf = d0 + 1 < NQR ? qr[d0 + 1 < NQR ? d0 + 1 : 0] : qy;
      p0 = __builtin_amdgcn_mfma_f32_32x32x16_bf16(ky0, qf, p0, 0, 0, 0); p1 = __builtin_amdgcn_mfma_f32_32x32x16_bf16(ky1, qf, p1, 0, 0, 0); }
  }
}
__device__ __forceinline__ int v_st(int k, int c) { const int kk = (k & ~0xC) | ((k & 4) << 1) | ((k & 8) >> 1); return ((kk >> 3) * 4 + (c >> 5)) * 512 + ((kk & 7) * 32 + (c & 31)) * 2; }
__device__ __forceinline__ int v_rd_base(int lane) { return ((lane & 3) << 3) | (((lane >> 2) & 3) << 6) | (((lane >> 4) & 1) << 5) | (((lane >> 5) & 1) << 8); }
constexpr int v_rd_off(int d0, int ks, int half) { return d0 * 512 + ks * 4096 + half * 2048; }
template <int OFF> __device__ __forceinline__ s16x4 tr_read(int vb) {
  s16x4 r; asm volatile("ds_read_b64_tr_b16 %0, %1 offset:%2" : "=&v"(r) : "v"(vb), "i"(OFF) : "memory"); return r;
}
template <int D0> __device__ __forceinline__ void pv_one(f32x16& od, int vb, bf16x8 pa0, bf16x8 pa1, bf16x8 pa2, bf16x8 pa3) {
  const s16x4 l0 = tr_read<v_rd_off(D0, 0, 0)>(vb), h0 = tr_read<v_rd_off(D0, 0, 1)>(vb), l1 = tr_read<v_rd_off(D0, 1, 0)>(vb), h1 = tr_read<v_rd_off(D0, 1, 1)>(vb);
  const s16x4 l2 = tr_read<v_rd_off(D0, 2, 0)>(vb), h2 = tr_read<v_rd_off(D0, 2, 1)>(vb), l3 = tr_read<v_rd_off(D0, 3, 0)>(vb), h3 = tr_read<v_rd_off(D0, 3, 1)>(vb);
  asm volatile("s_waitcnt lgkmcnt(0)" ::: "memory"); SBAR();
#define PK(L, H) (bf16x8){L[0], L[1], L[2], L[3], H[0], H[1], H[2], H[3]}
  od = __builtin_amdgcn_mfma_f32_32x32x16_bf16(pa0, PK(l0, h0), od, 0, 0, 0);
  od = __builtin_amdgcn_mfma_f32_32x32x16_bf16(pa1, PK(l1, h1), od, 0, 0, 0);
  od = __builtin_amdgcn_mfma_f32_32x32x16_bf16(pa2, PK(l2, h2), od, 0, 0, 0);
  od = __builtin_amdgcn_mfma_f32_32x32x16_bf16(pa3, PK(l3, h3), od, 0, 0, 0);
#undef PK
}
__device__ __forceinline__ void pv_d0(f32x16* o, int vb, bf16x8 pa0, bf16x8 pa1, bf16x8 pa2, bf16x8 pa3) {
  pv_one<0>(o[0], vb, pa0, pa1, pa2, pa3); pv_one<1>(o[1], vb, pa0, pa1, pa2, pa3); pv_one<2>(o[2], vb, pa0, pa1, pa2, pa3); pv_one<3>(o[3], vb, pa0, pa1, pa2, pa3);
}
template <int ABL> __device__ __forceinline__ void unit(const bf16_t* __restrict__ QB, const bf16_t* __restrict__ KVB, const bf16_t* __restrict__ PB, const float* __restrict__ ROPE, bf16_t* __restrict__ Y,
                                     int qrow0, int b, int h, int nkeys, bool ropeq, LAS unsigned char* lds) {
  const int wid = kwave(), lane = klane(), tid = wid * 64 + lane, r32 = lane & 31, hi = lane >> 5;
  LAS unsigned char* V_lds = lds; LAS unsigned char* K_lds = lds + 2 * SHM_V;
  LAS float* wsc = (LAS float*)(lds + SHM_SCR) + wid * 64; LAS float* li_l = wsc; LAS float* al_l = wsc + 32;
  LAS unsigned char* qlw = lds + SHM_QL + wid * (ATT_NQL * 1024); const LAS unsigned char* ql = qlw + lane * 16;
  float m_reg = -1e30f, l_reg = 0; f32x16 o[4] = {}; bf16x8 qr[NQR];
  {
    const int qrow = qrow0 + wid * QBLK + r32;
    const bf16_t* Qw = QB + (size_t)qrow * 768 + h * 192 + hi * 8;
#pragma unroll
    for (int d0 = 0; d0 < 12; ++d0) {
      u32x4 w = *(const u32x4*)(Qw + d0 * 16);
      if (d0 >= 8 && ropeq) { float f[8]; unpack8(w, f); const int t = qrow & (NL - 1), jj = (d0 - 8) * 16 + hi * 8;
        const f32x4 r0 = rope4((f32x4){f[0], f[1], f[2], f[3]}, jj, t, ROPE), r1 = rope4((f32x4){f[4], f[5], f[6], f[7]}, jj + 4, t, ROPE);
        w.x = cvtpk(r0.x, r0.y); w.y = cvtpk(r0.z, r0.w); w.z = cvtpk(r1.x, r1.y); w.w = cvtpk(r1.z, r1.w); }
      if (d0 < NQR) qr[d0 < NQR ? d0 : 0] = __builtin_bit_cast(bf16x8, w); else *(LAS u32x4*)(qlw + (d0 - NQR) * 1024 + lane * 16) = w;
    }
  }
  const int sr = tid >> 4, sc = (tid & 15) * 8, vst0 = v_st(sr, sc), vst1 = v_st(32 + sr, sc);
  const int krw = tid >> 3, kcg = tid & 7;
  const int kw0 = KSWZ(krw, kcg * 16), kw1 = KSWZ(krw, (kcg + 8) * 16), kw2 = KSWZ(krw, (kcg + 16) * 16);
  const int vb0 = (int)(uintptr_t)V_lds + v_rd_base(lane);
  unsigned ka[4];
#pragma unroll
  for (int c = 0; c < 4; ++c) ka[c] = (unsigned)(uintptr_t)K_lds + r32 * 384 + (((c << 5) | (hi << 4)) ^ (((r32 >> 1) & 7) << 4));
  const unsigned qla = (unsigned)(uintptr_t)ql;
  u32x4 sv0, sv1, sk0, sk1, sk2;
#define KROW(k0) ((k0) < NC ? ML + b * NC + (k0) : b * NL + ((k0) - NC))
  const int gv0 = sr * 1024 + h * 256 + 128 + sc, gv1 = gv0 + 32 * 1024, gk0 = krw * 1024 + h * 256 + kcg * 8, gk1 = gk0 + 64, gk2 = krw * INP + C_KR + kcg * 8;
#define KLOAD(k0) do { const int kr_ = __builtin_amdgcn_readfirstlane(KROW(k0)); const bf16_t* kvb_ = KVB + (size_t)kr_ * 1024; const bf16_t* pb_ = PB + (size_t)kr_ * INP; \
    sk0 = *(const u32x4*)(kvb_ + gk0); sk1 = *(const u32x4*)(kvb_ + gk1); sk2 = *(const u32x4*)(pb_ + gk2); } while (0)
#define VLOAD(k0) do { const int kr_ = __builtin_amdgcn_readfirstlane(KROW(k0)); const bf16_t* kvb_ = KVB + (size_t)kr_ * 1024; \
    sv0 = *(const u32x4*)(kvb_ + gv0); sv1 = *(const u32x4*)(kvb_ + gv1); } while (0)
#define KWRITE(bf) do { *(LAS u32x4*)(K_lds + (bf) * SHM_K + kw0) = sk0; *(LAS u32x4*)(K_lds + (bf) * SHM_K + kw1) = sk1; *(LAS u32x4*)(K_lds + (bf) * SHM_K + kw2) = sk2; } while (0)
#define VWRITE(bf) do { *(LAS u32x4*)(V_lds + (bf) * SHM_V + vst0) = sv0; *(LAS u32x4*)(V_lds + (bf) * SHM_V + vst1) = sv1; } while (0)
#define RESC(a) do { if (__any((a) < 1.f)) { if (hi == 0) al_l[r32] = (a); asm volatile("s_waitcnt lgkmcnt(0)" ::: "memory"); \
    _Pragma("unroll") for (int d = 0; d < 4; ++d) _Pragma("unroll") for (int r = 0; r < 16; ++r) o[d][r] *= al_l[crow(r, hi)]; } } while (0)
  f32x16 pA0, pA1, pB0, pB1; float mnA, mnB, alA, alB; bf16x8 pa0, pa1, pa2, pa3; const int NT = nkeys / KVBLK;
#define QKT0(P0, P1) do { if constexpr (ABL == 2) { P0 = f32x16{}; P1 = f32x16{}; asm volatile("" : "+v"(P0), "+v"(P1)); } else qkt<0>(P0, P1, ka, qr, qla); } while (0)
#define QKT1(P0, P1) do { if constexpr (ABL == 2) { P0 = f32x16{}; P1 = f32x16{}; asm volatile("" : "+v"(P0), "+v"(P1)); } else qkt<SHM_K>(P0, P1, ka, qr, qla); } while (0)
#define PV(VB) do { if constexpr (ABL == 3) { asm volatile("" : "+v"(o[0]), "+v"(o[1]), "+v"(o[2]), "+v"(o[3]) : "v"(pa0), "v"(pa1), "v"(pa2), "v"(pa3)); } else pv_d0(o, VB, pa0, pa1, pa2, pa3); } while (0)
#define PSM(P0, P1, MN, AL) do { if constexpr (ABL == 4) { MN = 0.f; AL = 1.f; asm volatile("" : "+v"(P0), "+v"(P1)); } else partialSM(P0, P1, m_reg, MN, AL); } while (0)
#define FSM(P0, P1, AL) do { if constexpr (ABL == 4) { u32x4 w0_ = {__float_as_uint(P0[0]), __float_as_uint(P0[1]), __float_as_uint(P0[2]), __float_as_uint(P0[3])}, w1_ = {__float_as_uint(P1[0]), __float_as_uint(P1[1]), __float_as_uint(P1[2]), __float_as_uint(P1[3])}; \
      pa0 = __builtin_bit_cast(bf16x8, w0_); pa1 = __builtin_bit_cast(bf16x8, w1_); pa2 = pa0; pa3 = pa1; l_reg += AL; } else finishSM(P0, P1, AL, l_reg, pa0, pa1, pa2, pa3); } while (0)
  KLOAD(0); KWRITE(0); __syncthreads();
  if (wid >= 4) __syncthreads();
  SBAR(); KLOAD(KVBLK); SBAR(); QKT0(pA0, pA1); SBAR(); KWRITE(1); __syncthreads();
  SBAR(); VLOAD(0); SBAR(); PSM(pA0, pA1, mnA, alA); SBAR(); VWRITE(0); __syncthreads();
  for (int j = 1; j + 1 < NT; j += 2) {
    SBAR(); if constexpr (ABL != 1) KLOAD((j + 1) * KVBLK); SBAR(); QKT1(pB0, pB1); FSM(pA0, pA1, alA); SBAR(); if constexpr (ABL != 1) KWRITE(0); __syncthreads();
    SBAR(); if constexpr (ABL != 1) VLOAD(j * KVBLK); SBAR(); PV(vb0); PSM(pB0, pB1, mnB, alB); RESC(alB); SBAR(); if constexpr (ABL != 1) VWRITE(1); __syncthreads();
    SBAR(); if constexpr (ABL != 1) KLOAD((j + 2) * KVBLK); SBAR(); QKT0(pA0, pA1); FSM(pB0, pB1, alB); SBAR(); if constexpr (ABL != 1) KWRITE(1); __syncthreads();
    SBAR(); if constexpr (ABL != 1) VLOAD((j + 1) * KVBLK); SBAR(); PV(vb0 + SHM_V); PSM(pA0, pA1, mnA, alA); RESC(alA); SBAR(); if constexpr (ABL != 1) VWRITE(0); __syncthreads();
  }
  SBAR(); QKT1(pB0, pB1); FSM(pA0, pA1, alA); SBAR(); __syncthreads();
  SBAR(); VLOAD((NT - 1) * KVBLK); SBAR(); PV(vb0); PSM(pB0, pB1, mnB, alB); RESC(alB); SBAR(); VWRITE(1); __syncthreads();
  if (wid < 4) __syncthreads();
  FSM(pB0, pB1, alB); SBAR();
  PV(vb0 + SHM_V);
#undef QKT0
#undef QKT1
#undef PV
#undef PSM
#undef FSM
  if (hi == 0) li_l[r32] = l_reg; asm volatile("s_waitcnt lgkmcnt(0)" ::: "memory");
  float rli[16];
#pragma unroll
  for (int r = 0; r < 16; ++r) rli[r] = __builtin_amdgcn_rcpf(li_l[crow(r, hi)]);
  bf16_t* Ow = Y + (size_t)(qrow0 + wid * QBLK) * DM + 512 + h * 128;
#pragma unroll
  for (int r = 0; r < 16; ++r) { const int orow = crow(r, hi);
#pragma unroll
    for (int d0 = 0; d0 < 4; ++d0) { const float val = o[d0][r] * rli[r]; if constexpr (ABL == 0) Ow[(size_t)orow * DM + d0 * 32 + r32] = (bf16_t)(cvtpk(val, 0.f) & 0xffffu); else asm volatile("" :: "v"(val)); } }
#undef KROW
#undef KLOAD
#undef VLOAD
#undef KWRITE
#undef VWRITE
#undef RESC
}
#undef KSWZ
#undef SBAR
}
template <int ABL> __device__ __forceinline__ void phase_attn_mfma(const Args& a, int l, LAS unsigned char* lds) {
    unsigned char* ws = a.ws;
    const bf16_t* QB = (const bf16_t*)(ws + WS_QB); const bf16_t* KVB = (const bf16_t*)(ws + WS_KVB); const bf16_t* PB = (const bf16_t*)(ws + WS_PB); bf16_t* Y = (bf16_t*)(ws + WS_HY);
    const float* ROPE = (const float*)(ws + WS_ROPE);
    const int nunits = 256 + (l == 0 ? 8 : 0);
    for (int u = blockIdx.x; u < nunits; u += KGRID) {
        __syncthreads();
        if (u < 256) { const int bh = u & 7, qb = u >> 3, b = bh >> 2, h = bh & 3; att::unit<ABL>(QB, KVB, PB, ROPE, Y, b * NL + qb * 256, b, h, NKEY, true, lds); }
        else { const int bh = u - 256, b = bh >> 2, h = bh & 3; att::unit<ABL>(QB, KVB, PB, ROPE, Y, ML + b * NC, b, h, NC, false, lds); }
    }
}

namespace pg8 {
#define PG8_LAS __attribute__((address_space(3)))
typedef unsigned short bf16_t;
typedef short bf16x8 __attribute__((ext_vector_type(8)));
typedef float f32x4 __attribute__((ext_vector_type(4)));
typedef unsigned u32x4 __attribute__((ext_vector_type(4)));
constexpr int BM = 256, BK = 64, HALF = 128, HTB = HALF * BK * 2  , STAGE_BYTES = 8 * HTB, NXCD = 8, WGM = 8;

__host__ __device__ __forceinline__ int lds_byte(int r, int c) { const int st = (r >> 4) * 2 + (c >> 5), rr = r & 15, cc = c & 31, ob = rr * 64 + cc * 2; return st * 1024 + (ob ^ (((ob >> 9) & 1) << 5)); }
__host__ __device__ __forceinline__ void stage_rc(int b, int& R, int& C) { const int st = b / 1024, sb = b % 1024, swz = sb ^ (((sb >> 9) & 1) << 5); R = (st >> 1) * 16 + swz / 64; C = (st & 1) * 32 + (swz % 64) / 2; }
__host__ __device__ __forceinline__ int perm32(int rho) { const int n = rho >> 4, i = rho & 15; return 8 * (i >> 2) + 4 * n + (i & 3); }

struct Unit { int pm, pn; };
struct Gemm { const bf16_t* A; int lda; const bf16_t* Bt; int M, N, K; };

struct StaticOrder {
    int nM, nN, nwg, G, c;
    __host__ __device__ void init(int M, int N, int G_, int c_) { nM = M / BM; nN = N / BM; nwg = nM * nN; G = G_; c = c_; }
    __host__ __device__ bool next(int i, Unit& u) const {
        const long L = (long)i * G + c; if (L >= nwg) return false;
        int wgid = (int)L; { const int q = nwg / NXCD, r = nwg % NXCD, xcd = wgid % NXCD, off = wgid / NXCD; wgid = (xcd < r ? xcd * (q + 1) : r * (q + 1) + (xcd - r) * q) + off; }
        const int nig = WGM * nN, gid = wgid / nig, fm = gid * WGM, gsz = (nM - fm) < WGM ? (nM - fm) : WGM;
        u.pm = fm + ((wgid % nig) % gsz); u.pn = (wgid % nig) / gsz; return true;
    }
    __device__ __forceinline__ void a_ready(const Unit&) const {}
    __device__ __forceinline__ void done(const Unit&) const {}
};
template <class Epi, class Sched, bool ALIGN_EPI = false, bool SP2 = false>
__device__ __forceinline__ void gemm_phase(PG8_LAS unsigned char* lds, const Gemm g, const Sched& S, const Epi& E) {
    const int wid = kwave(), lane = klane(), tid = wid * 64 + lane, wr = wid >> 2, wc = wid & 3, fr = lane & 15, fq = lane >> 4;
    const int K = g.K, nt = K / BK;
    unsigned voffA[2], voffB[2];
#pragma unroll
    for (int i = 0; i < 2; ++i) { int R, C; stage_rc(tid * 16 + i * 8192, R, C); const int Rb = Epi::PERM ? ((R & ~31) + perm32(R & 31)) : R;
        voffA[i] = (unsigned)(R * g.lda + C) * 2u; voffB[i] = (unsigned)(Rb * K + C) * 2u; }
    const size_t kstep = (size_t)(BK * 2);
    const size_t hstepA = (size_t)HALF * g.lda * 2, hstepB = (size_t)HALF * K * 2;
    const size_t tstepA = 2 * hstepA, tstepB = 2 * hstepB;
    const unsigned ldsw = (unsigned)wid * 1024u;
    const int aoff = lds_byte(wr * 64 + fr, fq * 8), boff = lds_byte(wc * 32 + fr, fq * 8);
#define PG8_SA(b, h) (((b) * 2 + (h)) * HTB)
#define PG8_SB(b, h) ((4 + (b) * 2 + (h)) * HTB)
#define PG8_STAGE(bufoff, gbase, voff) do { _Pragma("unroll") for (int _i = 0; _i < 2; ++_i) \
        __builtin_amdgcn_global_load_lds((const unsigned*)((const char*)(gbase) + (voff)[_i]), (PG8_LAS unsigned*)(lds + (bufoff) + ldsw + _i * 8192), 16, 0, 0); } while (0)
#define PG8_LDA(dst, b, h) do { _Pragma("unroll") for (int m = 0; m < 4; ++m) _Pragma("unroll") for (int k = 0; k < 2; ++k) dst[m][k] = *(const PG8_LAS bf16x8*)(lds + PG8_SA(b, h) + aoff + m * 2048 + k * 1024); } while (0)
#define PG8_LDB(dst, b, h) do { _Pragma("unroll") for (int n = 0; n < 2; ++n) _Pragma("unroll") for (int k = 0; k < 2; ++k) dst[n][k] = *(const PG8_LAS bf16x8*)(lds + PG8_SB(b, h) + boff + n * 2048 + k * 1024); } while (0)
#define PG8_MMA(ai, bj, At, Bt) do { __builtin_amdgcn_s_setprio(1); _Pragma("unroll") for (int m = 0; m < 4; ++m) _Pragma("unroll") for (int n = 0; n < 2; ++n) _Pragma("unroll") for (int k = 0; k < 2; ++k) \
        acc[ai][bj][m][n] = __builtin_amdgcn_mfma_f32_16x16x32_bf16(Bt[n][k], At[m][k], acc[ai][bj][m][n], 0, 0, 0); __builtin_amdgcn_s_setprio(0); } while (0)
#define PG8_WAIT_V(n) asm volatile("s_waitcnt vmcnt(" #n ")" ::: "memory")
#define PG8_WAIT_L(n) asm volatile("s_waitcnt lgkmcnt(" #n ")" ::: "memory")
#define PG8_BAR __builtin_amdgcn_s_barrier()
#define PG8_SCHED __builtin_amdgcn_sched_barrier(0)
    Unit cur, nxt; int ui = 0;
    if (!S.next(0, cur)) return;
    f32x4 acc[2][2][4][2];
#pragma unroll
    for (int a = 0; a < 2; ++a)
#pragma unroll
        for (int b = 0; b < 2; ++b)
#pragma unroll
            for (int m = 0; m < 4; ++m)
#pragma unroll
                for (int n = 0; n < 2; ++n) acc[a][b][m][n] = (f32x4){0.f, 0.f, 0.f, 0.f};
    bf16x8 At[4][2], B0[2][2], B1[2][2];
    const char* cA = (const char*)g.A + (size_t)cur.pm * tstepA; const char* cB = (const char*)g.Bt + (size_t)cur.pn * tstepB;
    S.a_ready(cur);
    if constexpr (SP2) {
        PG8_STAGE(PG8_SB(0, 0), cB, voffB); PG8_STAGE(PG8_SB(0, 1), cB + hstepB, voffB); PG8_STAGE(PG8_SA(0, 0), cA, voffA); PG8_STAGE(PG8_SA(0, 1), cA + hstepA, voffA);
        if (wr == 1) PG8_BAR;
        PG8_WAIT_V(2); PG8_BAR;
        PG8_STAGE(PG8_SB(1, 0), cB + kstep, voffB); PG8_STAGE(PG8_SA(1, 0), cA + kstep, voffA); PG8_STAGE(PG8_SB(1, 1), cB + hstepB + kstep, voffB);
        PG8_WAIT_V(6); PG8_BAR;
    } else {
        PG8_STAGE(PG8_SB(0, 0), cB, voffB); PG8_STAGE(PG8_SA(0, 0), cA, voffA); PG8_STAGE(PG8_SB(0, 1), cB + hstepB, voffB); PG8_STAGE(PG8_SA(0, 1), cA + hstepA, voffA);
        if (wr == 1) PG8_BAR;
        PG8_WAIT_V(4); PG8_BAR;
        PG8_STAGE(PG8_SB(1, 0), cB + kstep, voffB); PG8_STAGE(PG8_SA(1, 0), cA + kstep, voffA); PG8_STAGE(PG8_SB(1, 1), cB + hstepB + kstep, voffB);
        PG8_WAIT_V(6); PG8_BAR;
    }
    for (;;) {
        const bool has_next = S.next(ui + 1, nxt);
        const char* nA = has_next ? (const char*)g.A + (size_t)nxt.pm * tstepA : cA; const char* nB = has_next ? (const char*)g.Bt + (size_t)nxt.pn * tstepB : cB;
#pragma nounroll
        for (int t = 0; t < nt; t += 2) {
            const bool last = (t == nt - 2);
            const char* a1 = cA + (size_t)(t + 1) * kstep;
            const char* a2 = last ? nA : cA + (size_t)(t + 2) * kstep; const char* b2 = last ? nB : cB + (size_t)(t + 2) * kstep;
            const char* a3 = a2 + kstep; const char* b3 = b2 + kstep;
            if (last && has_next) S.a_ready(nxt);
            if constexpr (SP2) {
            PG8_LDB(B0, 0, 0); PG8_LDB(B1, 0, 1); PG8_SCHED; PG8_LDA(At, 0, 0); PG8_STAGE(PG8_SA(1, 1), a1 + hstepA, voffA);
            PG8_WAIT_V(8); PG8_WAIT_L(0); PG8_BAR; PG8_MMA(0, 0, At, B0); PG8_MMA(0, 1, At, B1); PG8_BAR; PG8_SCHED;
            PG8_LDA(At, 0, 1); PG8_STAGE(PG8_SB(0, 0), b2, voffB); PG8_STAGE(PG8_SB(0, 1), b2 + hstepB, voffB); PG8_STAGE(PG8_SA(0, 0), a2, voffA);
            PG8_WAIT_V(8); PG8_WAIT_L(0); PG8_BAR; PG8_MMA(1, 0, At, B0); PG8_MMA(1, 1, At, B1); PG8_BAR; PG8_SCHED;
            PG8_LDB(B0, 1, 0); PG8_LDB(B1, 1, 1); PG8_SCHED; PG8_LDA(At, 1, 0); PG8_STAGE(PG8_SA(0, 1), a2 + hstepA, voffA);
            PG8_WAIT_V(8); PG8_WAIT_L(0); PG8_BAR; PG8_MMA(0, 0, At, B0); PG8_MMA(0, 1, At, B1); PG8_BAR; PG8_SCHED;
            PG8_LDA(At, 1, 1); PG8_STAGE(PG8_SB(1, 0), b3, voffB); PG8_STAGE(PG8_SB(1, 1), b3 + hstepB, voffB); PG8_STAGE(PG8_SA(1, 0), a3, voffA);
            PG8_WAIT_V(8); PG8_WAIT_L(0); PG8_BAR; PG8_MMA(1, 0, At, B0); PG8_MMA(1, 1, At, B1); PG8_BAR; PG8_SCHED;
            } else {
            PG8_LDB(B0, 0, 0); PG8_SCHED; PG8_LDA(At, 0, 0); PG8_STAGE(PG8_SA(1, 1), a1 + hstepA, voffA);
            PG8_WAIT_L(8); PG8_BAR; PG8_WAIT_L(0); PG8_MMA(0, 0, At, B0); PG8_BAR; PG8_SCHED;
            PG8_LDB(B1, 0, 1); PG8_STAGE(PG8_SB(0, 0), b2, voffB);
            PG8_BAR; PG8_WAIT_L(0); PG8_MMA(0, 1, At, B1); PG8_BAR;
            PG8_LDA(At, 0, 1); PG8_STAGE(PG8_SA(0, 0), a2, voffA);
            PG8_BAR; PG8_WAIT_L(0); PG8_MMA(1, 0, At, B0); PG8_BAR; PG8_SCHED;
            PG8_STAGE(PG8_SB(0, 1), b2 + hstepB, voffB);
            PG8_WAIT_V(6); PG8_BAR; PG8_MMA(1, 1, At, B1); PG8_BAR;
            PG8_LDB(B0, 1, 0); PG8_SCHED; PG8_LDA(At, 1, 0); PG8_STAGE(PG8_SA(0, 1), a2 + hstepA, voffA);
            PG8_WAIT_L(8); PG8_BAR; PG8_WAIT_L(0); PG8_MMA(0, 0, At, B0); PG8_BAR; PG8_SCHED;
            PG8_LDB(B1, 1, 1); PG8_STAGE(PG8_SB(1, 0), b3, voffB);
            PG8_BAR; PG8_WAIT_L(0); PG8_MMA(0, 1, At, B1); PG8_BAR;
            PG8_LDA(At, 1, 1); PG8_STAGE(PG8_SA(1, 0), a3, voffA);
            PG8_BAR; PG8_WAIT_L(0); PG8_MMA(1, 0, At, B0); PG8_BAR; PG8_SCHED;
            PG8_STAGE(PG8_SB(1, 1), b3 + hstepB, voffB);
            PG8_WAIT_V(6); PG8_BAR; PG8_MMA(1, 1, At, B1); PG8_BAR;
            }
        }
        if constexpr (ALIGN_EPI) { if (wr == 0) PG8_BAR; }
        if constexpr (!Epi::AFTER_DRAIN) { E(acc, cur, wr, wc, fr, fq); S.done(cur); }
        if (!has_next) break;
#pragma unroll
        for (int a = 0; a < 2; ++a)
#pragma unroll
            for (int b = 0; b < 2; ++b)
#pragma unroll
                for (int m = 0; m < 4; ++m)
#pragma unroll
                    for (int n = 0; n < 2; ++n) acc[a][b][m][n] = (f32x4){0.f, 0.f, 0.f, 0.f};
        cur = nxt; cA = nA; cB = nB; ++ui;
        if constexpr (ALIGN_EPI) { if (wr == 1) PG8_BAR; }
    }
    PG8_WAIT_V(0);
    if constexpr (!ALIGN_EPI) { if (wr == 0) PG8_BAR; }
    PG8_BAR;
    if constexpr (Epi::AFTER_DRAIN) { E.fused(acc, cur, wr, wc, fr, fq, lds, wid, lane); S.done(cur); }
#undef PG8_SA
#undef PG8_SB
#undef PG8_STAGE
#undef PG8_LDA
#undef PG8_LDB
#undef PG8_MMA
#undef PG8_WAIT_V
#undef PG8_WAIT_L
#undef PG8_BAR
#undef PG8_SCHED
}
}

template <class F> struct EpiAdapt {
    static constexpr bool PERM = false, AFTER_DRAIN = false;
    F f;
    __device__ __forceinline__ void operator()(const pg8::f32x4 (&acc)[2][2][4][2], const pg8::Unit& u, int wr, int wc, int fr, int fq) const {
#pragma unroll
        for (int ai = 0; ai < 2; ++ai)
#pragma unroll
            for (int m = 0; m < 4; ++m) { const int row = u.pm * 256 + ai * 128 + wr * 64 + m * 16 + fr;
#pragma unroll
                for (int bj = 0; bj < 2; ++bj)
#pragma unroll
                    for (int n = 0; n < 2; ++n) f(row, u.pn * 256 + bj * 128 + wc * 32 + n * 16 + 4 * fq, acc[ai][bj][m][n]); }
    }
};
template <class F> struct EpiAdapt8 {
    static constexpr bool PERM = true, AFTER_DRAIN = false;
    F f;
    __device__ __forceinline__ void operator()(const pg8::f32x4 (&acc)[2][2][4][2], const pg8::Unit& u, int wr, int wc, int fr, int fq) const {
#pragma unroll
        for (int ai = 0; ai < 2; ++ai)
#pragma unroll
            for (int m = 0; m < 4; ++m) { const int row = u.pm * 256 + ai * 128 + wr * 64 + m * 16 + fr;
#pragma unroll
                for (int bj = 0; bj < 2; ++bj) f.op8(row, u.pn * 256 + bj * 128 + wc * 32 + 8 * fq, acc[ai][bj][m][0], acc[ai][bj][m][1]); }
    }
};
template <class F> __device__ __forceinline__ void gemm_mfma8(const bf16_t* A, int lda, const bf16_t* Bt, int M, int N, int K, const F& f, LAS unsigned char* lds) {
    pg8::Gemm g{A, lda, Bt, M, N, K}; pg8::StaticOrder S; S.init(M, N, KGRID, (int)blockIdx.x);
    EpiAdapt8<F> E{f};
    pg8::gemm_phase<EpiAdapt8<F>, pg8::StaticOrder, true, true>(lds, g, S, E);
}
template <class F> __device__ __forceinline__ void gemm_mfma(const bf16_t* A, int lda, const bf16_t* Bt, int M, int N, int K, const F& f, LAS unsigned char* lds) {
    pg8::Gemm g{A, lda, Bt, M, N, K}; pg8::StaticOrder S; S.init(M, N, KGRID, (int)blockIdx.x);
    EpiAdapt<F> E{f};
    pg8::gemm_phase<EpiAdapt<F>, pg8::StaticOrder, true, true>(lds, g, S, E);
}


#ifndef GEMM_MASK
#define GEMM_MASK 63
#endif
template <int BIT, class F> __device__ __forceinline__ void gemm_sel(const bf16_t* A, int lda, const bf16_t* Bt, int M, int N, int K, const F& f, LAS unsigned char* lds) {
    if constexpr ((GEMM_MASK >> BIT) & 1) gemm_mfma(A, lda, Bt, M, N, K, f, lds); else gemm_naive(A, lda, Bt, M, N, K, f, lds);
}

template <class F> __device__ __forceinline__ void gemm_ctx_small(const bf16_t* A, int lda, const bf16_t* Bt, int N, int K, const F& f, LAS unsigned char* lds) {
    const int lane = klane(), wave = kwave(), r32 = lane & 31, hi = lane >> 5;
    const int nct = N / 64, ntasks = 8 * nct, G = KGRID;
    const int KS = K >= 512 ? 8 : K / 64, kslice = K / KS;
    LAS float* red = (LAS float*)lds;
    for (int task = blockIdx.x; task < ntasks; task += G) {
        const int rt = task / nct, ct = task % nct, row0 = ML + rt * 64, col0 = ct * 64;
        f32x16 acc[2][2];
#pragma unroll
        for (int c = 0; c < 2; ++c) { acc[c][0] = f32x16{}; acc[c][1] = f32x16{}; }
        if (wave < KS) {
            const bf16_t* ap0 = A + (size_t)(row0 + r32) * lda + wave * kslice + 8 * hi; const bf16_t* ap1 = ap0 + (size_t)32 * lda;
            const bf16_t* bp0 = Bt + (size_t)(col0 + r32) * K + wave * kslice + 8 * hi; const bf16_t* bp1 = bp0 + (size_t)32 * K;
            bf16x8 av[4][2], bv[4][2];
#define CTX_LOAD(k0) do { _Pragma("unroll") for (int s = 0; s < 4; ++s) { av[s][0] = *(const bf16x8*)(ap0 + (k0) + 16 * s); av[s][1] = *(const bf16x8*)(ap1 + (k0) + 16 * s); \
                bv[s][0] = *(const bf16x8*)(bp0 + (k0) + 16 * s); bv[s][1] = *(const bf16x8*)(bp1 + (k0) + 16 * s); } } while (0)
            CTX_LOAD(0);
#pragma unroll 1
            for (int k0 = 0; k0 < kslice; k0 += 64) {
                bf16x8 ac[4][2], bc[4][2];
#pragma unroll
                for (int s = 0; s < 4; ++s) { ac[s][0] = av[s][0]; ac[s][1] = av[s][1]; bc[s][0] = bv[s][0]; bc[s][1] = bv[s][1]; }
                if (k0 + 64 < kslice) CTX_LOAD(k0 + 64);
#pragma unroll
                for (int s = 0; s < 4; ++s)
#pragma unroll
                    for (int c = 0; c < 2; ++c) { acc[c][0] = __builtin_amdgcn_mfma_f32_32x32x16_bf16(bc[s][c], ac[s][0], acc[c][0], 0, 0, 0); acc[c][1] = __builtin_amdgcn_mfma_f32_32x32x16_bf16(bc[s][c], ac[s][1], acc[c][1], 0, 0, 0); }
            }
#undef CTX_LOAD
        }
        __syncthreads();
        if (wave < KS) {
#pragma unroll
            for (int c = 0; c < 2; ++c)
#pragma unroll
                for (int t = 0; t < 2; ++t)
#pragma unroll
                    for (int r = 0; r < 16; ++r) red[(wave * 64 + (c * 2 + t) * 16 + r) * 64 + lane] = acc[c][t][r];
        }
        __syncthreads();
#pragma unroll
        for (int q = 0; q < 2; ++q) {
            const int grp = wave * 2 + q, c = grp >> 3, t = (grp >> 2) & 1, g = grp & 3;
            f32x4 v = {0.f, 0.f, 0.f, 0.f};
            for (int w = 0; w < KS; ++w) {
                const LAS float* p = red + (w * 64 + (c * 2 + t) * 16 + 4 * g) * 64 + lane;
                v.x += p[0]; v.y += p[64]; v.z += p[128]; v.w += p[192];
            }
            f(row0 + 32 * t + r32, col0 + 32 * c + 8 * g + 4 * hi, v);
        }
    }
    __syncthreads();
}

__device__ __forceinline__ void phase_final(const Args& a) {
    const float* fw = a.in[I_FNW];
    const int lane = klane(), gw = blockIdx.x * NWAVES + kwave(), ngw = KGRID * NWAVES;
    for (int row = gw; row < ML; row += ngw) {
        float* p = a.out + (size_t)row * DM;
        f32x4 v[4]; float ss = 0.f;
#pragma unroll
        for (int j = 0; j < 4; ++j) { v[j] = *(const f32x4*)(p + lane * 4 + 256 * j); ss += v[j].x * v[j].x + v[j].y * v[j].y + v[j].z * v[j].z + v[j].w * v[j].w; }
        const float rstd = rsqrtf(wave_sum(ss) * (1.f / DM) + EPS);
#pragma unroll
        for (int j = 0; j < 4; ++j) *(f32x4*)(p + lane * 4 + 256 * j) = v[j] * rstd * *(const f32x4*)(fw + lane * 4 + 256 * j);
    }
}

constexpr int NPHASE = 20;
#define PH_BEGIN(k) if (lo <= (k) && (k) < hi) { const Args& a = get_args(); unsigned char* ws = a.ws; (void)ws;
#ifndef XBAR
#define XBAR 0
#endif
#define PH_END(k) if (MK_ONE_LAUNCH && (k) + 1 < hi) { xcd_barrier(bar); for (int xb_ = 0; xb_ < XBAR; ++xb_) xcd_barrier(bar); } }
template <int L> __device__ __forceinline__ void layer_phases(LAS unsigned char* lds, const XcdBarrier& bar, const int lo, const int hi) {
    constexpr int P = 1 + 9 * L;
#define MODL ((const float*)(ws + WS_MOD) + (size_t)L * 3 * 6144)
#define ROPET ((const float*)(ws + WS_ROPE))
#define HYB ((bf16_t*)(ws + WS_HY))
#define PBB ((bf16_t*)(ws + WS_PB))
#define XCB ((float*)(ws + WS_XC))
#define XL_IN ((L == 0) ? a.in[I_X] : (const float*)a.out)
#define XC_IN ((L == 0) ? a.in[I_CTX] : (const float*)XCB)
    PH_BEGIN(P + 0) phase_norm_mod(XL_IN, XC_IN, a.in[I_N1W] + L * DM, MODL, 0, 1024, HYB, MT); PH_END(P + 0)
    PH_BEGIN(P + 1) for (int rep = 0; rep < REP_INP; ++rep) { if (rep) xcd_barrier(bar); EpiInProj E{PBB, ROPET}; const bf16_t* W = (const bf16_t*)(ws + WS_WIN) + (size_t)L * INP * DM;
        gemm_mfma8(HYB, DM, W, ML, INP, DM, E, lds); gemm_ctx_small(HYB, DM, W, INP, DM, E, lds); } PH_END(P + 1)
    PH_BEGIN(P + 2) phase_post(a, L); for (int rep = 0; rep < REP_GLAL; ++rep) { if (rep) xcd_barrier(bar); phase_gla_local(a, L, lds); } PH_END(P + 2)
    PH_BEGIN(P + 3) for (int rep = 0; rep < REP_UP; ++rep) { if (rep) xcd_barrier(bar);
        { EpiUQ E1{(bf16_t*)(ws + WS_QB)}; const bf16_t* W = (const bf16_t*)(ws + WS_WUQ) + (size_t)L * 768 * 256; gemm_mfma8(PBB + C_DQ, INP, W, ML, 768, 256, E1, lds); if (L == 0) gemm_ctx_small(PBB + C_DQ, INP, W, 768, 256, E1, lds); }
        { EpiUKV E2{(bf16_t*)(ws + WS_KVB)}; const bf16_t* W = (const bf16_t*)(ws + WS_WUKV) + (size_t)L * 1024 * 256; gemm_mfma8(PBB + C_CKV, INP, W, ML, 1024, 256, E2, lds); gemm_ctx_small(PBB + C_CKV, INP, W, 1024, 256, E2, lds); }
        if (rep == 0) phase_gla_scan(a);
        phase_sgu_mfma(a, L, lds);
    } PH_END(P + 3)
    PH_BEGIN(P + 4) { for (int rep = 0; rep < REP_GLA; ++rep) { if (rep) xcd_barrier(bar); phase_gla_out(a, L, lds); } phase_attn_mfma<0>(a, L, lds); if (REP_ATTN == 2) { xcd_barrier(bar); phase_attn_mfma<ATT_ABL>(a, L, lds); } } PH_END(P + 4)
    PH_BEGIN(P + 5) for (int rep = 0; rep < (L == 0 ? REP_OUT : 1); ++rep) { if (rep) xcd_barrier(bar); EpiResid E{XL_IN, XC_IN, a.out, XCB, MODL, 2048}; const bf16_t* W = (const bf16_t*)(ws + WS_WOUT) + (size_t)L * DM * DM;
        gemm_mfma8(HYB, DM, W, ML, DM, DM, E, lds); if (L == 0) gemm_ctx_small(HYB, DM, W, DM, DM, E, lds); } PH_END(P + 5)
    PH_BEGIN(P + 6) phase_norm_mod(a.out, XCB, a.in[I_N2W] + L * DM, MODL, 3072, 4096, HYB, L == 0 ? MT : ML); PH_END(P + 6)
    PH_BEGIN(P + 7) { EpiFF1 E{(bf16_t*)(ws + WS_A)}; const bf16_t* W = (const bf16_t*)(ws + WS_WFF1) + (size_t)L * FF * DM;
        gemm_mfma8(HYB, DM, W, ML, FF, DM, E, lds); if (L == 0) gemm_ctx_small(HYB, DM, W, FF, DM, E, lds);
        if (REP_FF1 == 2) { xcd_barrier(bar); EpiNull EN; gemm_mfma8(HYB, DM, W, ML, FF, DM, EN, lds); }
        if (REP_FF1 == 3) { xcd_barrier(bar); gemm_mfma8(HYB, DM, W, ML, FF, DM, E, lds); } } PH_END(P + 7)
    PH_BEGIN(P + 8) { EpiResid E{a.out, XCB, a.out, XCB, MODL, 5120}; const bf16_t* W = (const bf16_t*)(ws + WS_WFF2) + (size_t)L * DM * FF;
        gemm_mfma8((const bf16_t*)(ws + WS_A), FF, W, ML, DM, FF, E, lds); if (L == 0) gemm_ctx_small((const bf16_t*)(ws + WS_A), FF, W, DM, FF, E, lds); } PH_END(P + 8)
}
__global__ void __launch_bounds__(NTHR, 2) mega(Args a_kernarg_only) {
    extern __shared__ __attribute__((aligned(16))) unsigned char lds_raw[];
    LAS unsigned char* lds = (LAS unsigned char*)lds_raw;
    volatile LAS unsigned* MISC = (volatile LAS unsigned*)(lds + LDS_CTL_OFF);
    { const int t0 = __builtin_amdgcn_workitem_id_x();
      if (t0 < 64) MISC[t0] = 0u;
      if ((t0 & 63) == 0) { const unsigned id = (unsigned)__builtin_amdgcn_s_getreg((5 << 11) | 4) & 63u; MISC[64 + id] = (unsigned)(t0 >> 6); } }
    __syncthreads();
    XcdBarrier bar; bar.bar = (unsigned*)(get_args().ws + WS_CTL); bar.x = 0; bar.st = nullptr;
    if (MK_ONE_LAUNCH) bar = xcd_barrier_post((unsigned*)(get_args().ws + WS_CTL), MISC + 8);
    const int lo = MK_ONE_LAUNCH ? 0 : get_args().ph_lo, hi = MK_ONE_LAUNCH ? NPHASE : get_args().ph_hi;
    PH_BEGIN(0) phase_prep(a, lds); PH_END(0)
    layer_phases<0>(lds, bar, lo, hi);
    layer_phases<1>(lds, bar, lo, hi);
    PH_BEGIN(NPHASE - 1) phase_final(a); PH_END(NPHASE - 1)
}

extern "C" void kernel_launch(void* const* d_in, const int* in_sizes, int n_in, void* d_out, int out_size, void* d_ws, size_t ws_size, hipStream_t stream) {
    static int grid = 0;
    if (grid == 0) {
        if (n_in != 26 || in_sizes[0] != ML * DM || out_size != ML * DM || ws_size < WS_END) { fprintf(stderr, "kernel_launch: unexpected shapes (n_in %d, in0 %d, out %d, ws %zu)\n", n_in, n_in > 0 ? in_sizes[0] : -1, out_size, ws_size); grid = -1; return; }
        int dev = 0, cus = 0;
        if (hipGetDevice(&dev) != hipSuccess || hipDeviceGetAttribute(&cus, hipDeviceAttributeMultiprocessorCount, dev) != hipSuccess) { grid = -1; return; }
        if (hipFuncSetAttribute((const void*)mega, hipFuncAttributeMaxDynamicSharedMemorySize, LDS_BYTES) != hipSuccess) { fprintf(stderr, "kernel_launch: hipFuncSetAttribute failed\n"); grid = -1; return; }
        int per_cu = 0;
        if (hipOccupancyMaxActiveBlocksPerMultiprocessor(&per_cu, (const void*)mega, NTHR, LDS_BYTES) != hipSuccess || per_cu < 1) fprintf(stderr, "kernel_launch: occupancy query says %d\n", per_cu);
        (void)hipGetLastError();
        grid = cus;
    }
    if (grid < 0) return;
    (void)hipMemsetAsync((char*)d_ws + WS_CTL, 0, CTL_ZERO_BYTES, stream);
    Args a{};
    for (int i = 0; i < 26; ++i) a.in[i] = (const float*)d_in[i];
    a.out = (float*)d_out; a.ws = (unsigned char*)d_ws; a.grid = grid;
    if (MK_ONE_LAUNCH) { a.ph_lo = 0; a.ph_hi = NPHASE; hipLaunchKernelGGL(mega, dim3(grid), dim3(NTHR), LDS_BYTES, stream, a); }
    else for (int ph = 0; ph < NPHASE; ++ph) { a.ph_lo = ph; a.ph_hi = ph + 1; hipLaunchKernelGGL(mega, dim3(grid), dim3(NTHR), LDS_BYTES, stream, a); }
}
```

```cpp
#include <hip/hip_runtime.h>
#include <cstdio>
#include <cstdint>

#ifndef REP_FF1
#define REP_FF1 1
#endif
#ifndef REP_INP
#define REP_INP 1
#endif
#ifndef REP_GLAL
#define REP_GLAL 1
#endif
#ifndef REP_UP
#define REP_UP 1
#endif
#ifndef REP_OUT
#define REP_OUT 1
#endif
#ifndef ATT_ABL
#define ATT_ABL 5
#endif
#ifndef REP_PREP
#define REP_PREP 1
#endif
#ifndef REP_SGU
#define REP_SGU 1
#endif
#ifndef REP_ATTN
#define REP_ATTN 1
#endif
#ifndef REP_GLA
#define REP_GLA 1
#endif
#ifndef REP_NORM
#define REP_NORM 1
#endif
#ifndef ATT_NQL
#define ATT_NQL 6
#endif
#ifndef ATTN_NAIVE
#define ATTN_NAIVE 0
#endif
#ifndef GLA_NAIVE
#define GLA_NAIVE 0
#endif
#ifndef MK_ONE_LAUNCH
#define MK_ONE_LAUNCH 1
#endif

#define GAS __attribute__((address_space(1)))
#define LAS __attribute__((address_space(3)))
typedef unsigned short bf16_t;
typedef float f32x4 __attribute__((ext_vector_type(4)));
typedef unsigned u32x4 __attribute__((ext_vector_type(4)));
typedef unsigned u32x2 __attribute__((ext_vector_type(2)));

constexpr int DM = 1024, NB = 2, NL = 8192, NC = 256, ML = NB * NL, MC = NB * NC, MT = ML + MC;
constexpr int FF = 4096, INP = 2048, IN_COLS = 1888, NKEY = NC + NL;
constexpr float EPS = 1e-6f;
constexpr float QSCALE = 0.07216878364870322f * 1.4426950408889634f;
constexpr int NWAVES = 8, NTHR = 512;
constexpr int C_CKV = 0, C_DQ = 256, C_SU = 512, C_SV = 768, C_GV = 1024, C_GR = 1280, C_GK = 1536, C_GQ = 1664, C_KR = 1792, C_GGF = 1856, C_GGB = 1872;

constexpr size_t MiB = 1u << 20;
constexpr size_t WS_CTL = 0, CTL_ZERO_BYTES = 65536;
constexpr size_t WS_MOD = 1 * MiB;
constexpr size_t WS_ROPE = 1 * MiB + 256 * 1024;
constexpr size_t WS_WSB = 14 * MiB + 768 * 1024;
constexpr size_t WS_WIN = 2 * MiB;
constexpr size_t WS_WOUT = 10 * MiB;
constexpr size_t WS_WUQ = 14 * MiB;
constexpr size_t WS_WUKV = 15 * MiB;
constexpr size_t WS_WFF1 = 16 * MiB;
constexpr size_t WS_WFF2 = 32 * MiB;
constexpr size_t WS_XC = 48 * MiB;
constexpr size_t WS_HY = 50 * MiB;
constexpr size_t WS_PB = 83 * MiB;
constexpr size_t WS_QB = 149 * MiB;
constexpr size_t WS_KVB = 174 * MiB;
constexpr size_t WS_LG = 216 * MiB;
constexpr size_t WS_OB = 233 * MiB;
constexpr size_t WS_A = 83 * MiB;
constexpr size_t WS_END = 250 * MiB;
static_assert(WS_A + (size_t)MT * FF * 2 <= WS_LG, "ffn hidden overlay");
static_assert(WS_PB + (size_t)MT * INP * 2 <= WS_QB && WS_QB + (size_t)MT * 768 * 2 <= WS_KVB && WS_KVB + (size_t)MT * 1024 * 2 <= WS_LG, "ws map");
static_assert(WS_LG + (size_t)MT * 256 * 4 <= WS_OB && WS_OB + (size_t)MT * 256 * 4 <= WS_END, "ws map 2");

constexpr int LDS_BYTES = 147456;

struct Args { const float* in[26]; float* out; unsigned char* ws; int ph_lo, ph_hi, grid, pad; };
enum { I_X = 0, I_C, I_CTX, I_CCTX, I_WMOD, I_BMOD, I_N1W, I_WIN, I_WOUT, I_SGNW, I_SGNB, I_SGW, I_SGB, I_GWF, I_GBF, I_GWB, I_GBB, I_GNW, I_QNW, I_WUQ, I_KVNW, I_WUKV, I_N2W, I_WFF1, I_WFF2, I_FNW };

typedef __attribute__((address_space(4))) const Args* KArgsPtr;
__device__ __forceinline__ const Args& get_args() { KArgsPtr p = (KArgsPtr)__builtin_amdgcn_kernarg_segment_ptr(); asm volatile("" : "+s"(p)); return *(const Args*)p; }
constexpr int LDS_CTL_OFF = LDS_BYTES - 512;
__device__ __forceinline__ int klane() { int l; asm volatile("v_mbcnt_lo_u32_b32 %0, -1, 0\n\tv_mbcnt_hi_u32_b32 %0, -1, %0" : "=v"(l)); return l; }
__device__ __forceinline__ int kwave() { const unsigned id = (unsigned)__builtin_amdgcn_s_getreg((5 << 11) | 4) & 63u;
    return __builtin_amdgcn_readfirstlane((int)((volatile LAS unsigned*)(uintptr_t)(LDS_CTL_OFF + 256))[id]); }
#define KTID (kwave() * 64 + klane())
#define KGRID (get_args().grid)
__device__ __forceinline__ float bf2f(bf16_t v) { return __uint_as_float(((unsigned)v) << 16); }
__device__ __forceinline__ unsigned f2bf(float f) { unsigned u = __float_as_uint(f); return (u + 0x7fffu + ((u >> 16) & 1u)) >> 16; }
__device__ __forceinline__ unsigned pk2(float lo, float hi) { return f2bf(lo) | (f2bf(hi) << 16); }
#define DPP_F(v, ctrl, rmask) __builtin_bit_cast(float, __builtin_amdgcn_update_dpp(0, __builtin_bit_cast(int, (v)), (ctrl), (rmask), 0xf, true))
__device__ __forceinline__ float wave_prefix_sum(float v) {
    v += DPP_F(v, 0x111, 0xf); v += DPP_F(v, 0x112, 0xf); v += DPP_F(v, 0x114, 0xf); v += DPP_F(v, 0x118, 0xf);
    v += DPP_F(v, 0x142, 0xa); v += DPP_F(v, 0x143, 0xc);
    return v;
}
__device__ __forceinline__ float wave_sum(float v) {
    return __builtin_bit_cast(float, __builtin_amdgcn_readlane(__builtin_bit_cast(int, wave_prefix_sum(v)), 63));
}
__device__ __forceinline__ float gelu_tanh(float x) { const float u = 1.5957691216057308f * (x + 0.044715f * x * x * x); return x / (1.f + __expf(-u)); }
__device__ __forceinline__ float silu_f(float x) { return x / (1.f + __expf(-x)); }
__device__ __forceinline__ float log_sigmoid_f(float z) { return fminf(z, 0.f) - log1pf(expf(-fabsf(z))); }
__device__ __forceinline__ float log_sigmoid_fast(float z) { return fminf(z, 0.f) - __logf(1.f + __expf(-fabsf(z))); }
__device__ __forceinline__ void unpack8(u32x4 w, float* f) {
    f[0] = __uint_as_float(w.x << 16); f[1] = __uint_as_float(w.x & 0xffff0000u); f[2] = __uint_as_float(w.y << 16); f[3] = __uint_as_float(w.y & 0xffff0000u);
    f[4] = __uint_as_float(w.z << 16); f[5] = __uint_as_float(w.z & 0xffff0000u); f[6] = __uint_as_float(w.w << 16); f[7] = __uint_as_float(w.w & 0xffff0000u);
}

#define XB_TMO      128
#define XB_XCNT(j)  (256  + 64 * (j))
#define XB_XSUB(j)  (1280 + 64 * (j))
#define XB_XGEN(j)  (2304 + 64 * (j))
#define XB_TOP      3328
#define XB_TOPGEN   3392
#define XCD_BAR_WORDS 3456
#define XB_SPIN_CAP (1u << 22)
__device__ __forceinline__ unsigned xb_ld(unsigned* p)              { return __hip_atomic_load(p, __ATOMIC_RELAXED, __HIP_MEMORY_SCOPE_AGENT); }
__device__ __forceinline__ unsigned xb_add(unsigned* p, unsigned v) { return __hip_atomic_fetch_add(p, v, __ATOMIC_RELAXED, __HIP_MEMORY_SCOPE_AGENT); }
__device__ __forceinline__ unsigned xb_xcc_id() { return (unsigned)__builtin_amdgcn_s_getreg((3 << 11) | 20) & 0xFu; }
#define XB_SPIN(cond, bar) do { unsigned _sp = 0; while (cond) { __builtin_amdgcn_s_sleep(1); \
    if ((++_sp & 255u) == 0u) { if (xb_ld(&(bar)[XB_TMO])) break; if (_sp > XB_SPIN_CAP) { atomicAdd(&(bar)[XB_TMO], 1u); break; } } } } while (0)
struct XcdBarrier { unsigned* bar; unsigned x; volatile LAS unsigned* st; };
__device__ __forceinline__ XcdBarrier xcd_barrier_post(unsigned* bar, volatile LAS unsigned* st) {
    XcdBarrier b; b.bar = bar; b.x = xb_xcc_id(); b.st = st;
    if (KTID == 0) (void)xb_add(&bar[XB_XCNT(b.x)], 1u);
    return b;
}
__device__ __forceinline__ void xcd_barrier_complete(unsigned* bar, unsigned x, unsigned& nloc, unsigned& nx) {
    const unsigned G = (unsigned)KGRID;
    unsigned sum, cnt, mine, sp = 0u;
    for (;;) {
        sum = 0u; cnt = 0u; mine = 0u;
#pragma unroll
        for (unsigned j = 0; j < 16; ++j) { const unsigned c = xb_ld(&bar[XB_XCNT(j)]); sum += c; cnt += (c > 0u) ? 1u : 0u; mine = (j == x) ? c : mine; }
        if (sum == G) break;
        __builtin_amdgcn_s_sleep(1);
        if ((++sp & 255u) == 0u) { if (xb_ld(&bar[XB_TMO])) break; if (sp > XB_SPIN_CAP) { atomicAdd(&bar[XB_TMO], 1u); break; } }
    }
    nloc = mine > 0u ? mine : 1u; nx = cnt > 0u ? cnt : 1u;
}
__device__ __forceinline__ void xcd_barrier(const XcdBarrier& b) {
    asm volatile("s_waitcnt vmcnt(0)" ::: "memory");
    __syncthreads();
    if (KTID == 0) {
        unsigned* bar = b.bar;
        __builtin_amdgcn_s_waitcnt(0);
        unsigned nloc = b.st[0], nx = b.st[1];
        if (nloc == 0u) { xcd_barrier_complete(bar, b.x, nloc, nx); b.st[0] = nloc; b.st[1] = nx; }
        const unsigned old = xb_add(&bar[XB_XSUB(b.x)], 1u);
        const unsigned gen = old / nloc;
        if (old + 1u == (gen + 1u) * nloc) {
            __builtin_amdgcn_fence(__ATOMIC_RELEASE, "agent");
            asm volatile("s_waitcnt vmcnt(0)" ::: "memory");
            const unsigned og = xb_add(&bar[XB_TOP], 1u);
            const unsigned tg = og / nx;
            if (og + 1u == (tg + 1u) * nx) xb_add(&bar[XB_TOPGEN], 1u);
            else XB_SPIN(xb_ld(&bar[XB_TOPGEN]) == tg, bar);
            __builtin_amdgcn_fence(__ATOMIC_ACQUIRE, "agent");
            xb_add(&bar[XB_XGEN(b.x)], 1u);
            asm volatile("s_waitcnt vmcnt(0)" ::: "memory");
        } else {
            XB_SPIN(xb_ld(&bar[XB_XGEN(b.x)]) == gen, bar);
            __builtin_amdgcn_fence(__ATOMIC_ACQUIRE, "agent");
            asm volatile("s_waitcnt vmcnt(0)" ::: "memory");
        }
    }
    __syncthreads();
}

__device__ __forceinline__ int rope_unperm(int jj) { return (jj < 32) ? ((jj >> 1) + 16 * (jj & 1)) : (32 + ((jj - 32) >> 1) + 16 * (jj & 1)); }
__device__ __forceinline__ int map_in(int n) {
    if (n < 256) return 416 + n;
    if (n < 512) return 1632 + (n - 256);
    if (n < 768) return 736 + (n - 512);
    if (n < 1024) return 992 + (n - 768);
    if (n < 1280) return 128 + (n - 1024);
    if (n < 1536) return 1376 + (n - 1280);
    if (n < 1664) return n - 1536;
    if (n < 1792) return 1248 + (n - 1664);
    if (n < 1856) return 672 + rope_unperm(n - 1792);
    if (n < 1872) return 384 + (n - 1856);
    if (n < 1888) return 400 + (n - 1872);
    return -1;
}
__device__ __forceinline__ int map_uq(int n) { const int h = n / 192, j = n % 192; return (j < 128) ? n : (h * 192 + 128 + rope_unperm(j - 128)); }
template <int MODE> __device__ __forceinline__ void transpose_w(const float* W, int K, int Nsrc, bf16_t* Wt, int Npad, int gtid, int gthreads) {
    const int total = Npad * (K / 8);
    for (int idx = gtid; idx < total; idx += gthreads) {
        const int n = idx % Npad, kc = idx / Npad;
        const int src = (MODE == 0) ? n : (MODE == 1 ? map_in(n) : map_uq(n));
        float f[8];
#pragma unroll
        for (int i = 0; i < 8; ++i) f[i] = (src >= 0) ? W[(size_t)(kc * 8 + i) * Nsrc + src] : 0.f;
        u32x4 o; o.x = pk2(f[0], f[1]); o.y = pk2(f[2], f[3]); o.z = pk2(f[4], f[5]); o.w = pk2(f[6], f[7]);
        *(u32x4*)(Wt + (size_t)n * K + kc * 8) = o;
    }
}
template <int MODE> __device__ __forceinline__ void transpose_item(const float* W, int K, int Nsrc, bf16_t* Wt, int Npad, LAS float* scr, int item, int lane) {
    const int nblk = Npad / 32, kb = item / nblk, nb = item % nblk, k0 = 64 * kb, n0 = 32 * nb;
    const int nn = n0 + (lane & 31), src = (MODE == 0) ? nn : (MODE == 1 ? map_in(nn) : map_uq(nn));
    float tv[32];
#pragma unroll
    for (int i = 0; i < 32; ++i) { const int kk = 2 * i + (lane >> 5); tv[i] = (src >= 0) ? W[(size_t)(k0 + kk) * Nsrc + src] : 0.f; }
#pragma unroll
    for (int i = 0; i < 32; ++i) { const int kk = 2 * i + (lane >> 5); scr[kk * 33 + (lane & 31)] = tv[i]; }
    asm volatile("s_waitcnt lgkmcnt(0)" ::: "memory");
    const int c = lane & 7;
#pragma unroll
    for (int j = 0; j < 4; ++j) { const int n = (lane >> 3) + 8 * j; const LAS float* s = scr + (8 * c) * 33 + n;
        u32x4 o; o.x = pk2(s[0 * 33], s[1 * 33]); o.y = pk2(s[2 * 33], s[3 * 33]); o.z = pk2(s[4 * 33], s[5 * 33]); o.w = pk2(s[6 * 33], s[7 * 33]);
        *(u32x4*)(Wt + (size_t)(n0 + n) * K + k0 + 8 * c) = o; }
    asm volatile("s_waitcnt lgkmcnt(0)" ::: "memory");
}
__device__ __forceinline__ void phase_prep(const Args& a, LAS unsigned char* lds) {
    unsigned char* ws = a.ws;
    const int tid = KTID, gtid = blockIdx.x * NTHR + tid, gthreads = KGRID * NTHR;
    {
        const int wave = kwave(), lane = klane(), gw = wave * KGRID + (int)blockIdx.x, ngw = KGRID * NWAVES    ;
        LAS float* scr = (LAS float*)(lds + 8192 + wave * 8704);
        for (int it = gw; it < 2 * 5856; it += ngw) {
            const int l = it / 5856; int r = it % 5856;
            if (r < 1024) { transpose_item<1>(a.in[I_WIN] + (size_t)l * DM * IN_COLS, DM, IN_COLS, (bf16_t*)(ws + WS_WIN) + (size_t)l * INP * DM, INP, scr, r, lane); continue; } r -= 1024;
            if (r < 512) { transpose_item<0>(a.in[I_WOUT] + (size_t)l * DM * DM, DM, DM, (bf16_t*)(ws + WS_WOUT) + (size_t)l * DM * DM, DM, scr, r, lane); continue; } r -= 512;
            if (r < 96) { transpose_item<2>(a.in[I_WUQ] + (size_t)l * 256 * 768, 256, 768, (bf16_t*)(ws + WS_WUQ) + (size_t)l * 768 * 256, 768, scr, r, lane); continue; } r -= 96;
            if (r < 128) { transpose_item<0>(a.in[I_WUKV] + (size_t)l * 256 * 1024, 256, 1024, (bf16_t*)(ws + WS_WUKV) + (size_t)l * 1024 * 256, 1024, scr, r, lane); continue; } r -= 128;
            if (r < 2048) { transpose_item<0>(a.in[I_WFF1] + (size_t)l * DM * FF, DM, FF, (bf16_t*)(ws + WS_WFF1) + (size_t)l * FF * DM, FF, scr, r, lane); continue; } r -= 2048;
            transpose_item<0>(a.in[I_WFF2] + (size_t)l * FF * DM, FF, DM, (bf16_t*)(ws + WS_WFF2) + (size_t)l * DM * FF, DM, scr, r, lane);
        }
    }
    for (int idx = gtid; idx < 2 * 4 * 128 * 128 / 4; idx += gthreads) { const f32x4 v = *(const f32x4*)(a.in[I_SGW] + (size_t)idx * 4); u32x2 o; o.x = pk2(v.x, v.y); o.y = pk2(v.z, v.w); *(u32x2*)((bf16_t*)(ws + WS_WSB) + (size_t)idx * 4) = o; }
    { const int ridx = ((int)blockIdx.x - (KGRID - 4)) * NTHR + tid;
      if (ridx >= 0 && ridx < 128 * 16) {
        const int p = ridx >> 4, i = ridx & 15;
        const float freq = powf(10000.0f, -(float)i * 2.0f / 32.0f);
        const float ang = (float)p * freq;
        float sn, cs; sincosf(ang, &sn, &cs);
        float* R = (float*)(ws + WS_ROPE);
        R[ridx * 2 + 0] = cs; R[ridx * 2 + 1] = sn;
      } }
    {
        LAS float* red = (LAS float*)lds;
        LAS float* sil = (LAS float*)(lds + 80 * 1024);
        const int wave = kwave(), lane = klane();
        if ((int)blockIdx.x < 2 * 96) {
            for (int i = tid; i < 3 * DM; i += NTHR) { const float v = i < 2 * DM ? a.in[I_C][i] : a.in[I_CCTX][i - 2 * DM]; sil[i] = silu_f(v); }
        }
        __syncthreads();
        for (int item = blockIdx.x; item < 2 * 96; item += KGRID) {
            const int l = item / 96, j = (item % 96) * 64 + lane;
            const float* W = a.in[I_WMOD] + (size_t)l * DM * 6144 + (size_t)(wave * 128) * 6144 + j;
            float s0 = 0.f, s1 = 0.f, s2 = 0.f;
#pragma unroll 16
            for (int kk = 0; kk < 128; ++kk) {
                const float w = W[(size_t)kk * 6144];
                const int k2 = wave * 128 + kk;
                s0 += sil[k2] * w; s1 += sil[DM + k2] * w; s2 += sil[2 * DM + k2] * w;
            }
            red[(wave * 3 + 0) * 64 + lane] = s0; red[(wave * 3 + 1) * 64 + lane] = s1; red[(wave * 3 + 2) * 64 + lane] = s2;
            __syncthreads();
            if (tid < 192) {
                const int r = tid >> 6; float s = 0.f;
#pragma unroll
                for (int w = 0; w < 8; ++w) s += red[(w * 3 + r) * 64 + lane];
                ((float*)(ws + WS_MOD))[(size_t)(l * 3 + r) * 6144 + j] = s + a.in[I_BMOD][l * 6144 + j];
            }
            __syncthreads();
        }
    }
}

__device__ __forceinline__ void phase_norm_mod(const float* xl, const float* xc, const float* nw, const float* mod, int sh_off, int sc_off, bf16_t* H, int nrows) {
    const int lane = klane(), gw = blockIdx.x * NWAVES + kwave(), ngw = KGRID * NWAVES;
    for (int row = gw; row < nrows; row += ngw) {
        const float* src = row < ML ? xl + (size_t)row * DM : xc + (size_t)(row - ML) * DM;
        const float* m = mod + (row < ML ? row / NL : 2) * 6144;
        f32x4 v[4]; float ss = 0.f;
#pragma unroll
        for (int j = 0; j < 4; ++j) { v[j] = *(const f32x4*)(src + lane * 4 + 256 * j); ss += v[j].x * v[j].x + v[j].y * v[j].y + v[j].z * v[j].z + v[j].w * v[j].w; }
        const float rstd = rsqrtf(wave_sum(ss) * (1.f / DM) + EPS);
#pragma unroll
        for (int j = 0; j < 4; ++j) {
            const int c = lane * 4 + 256 * j;
            const f32x4 w = *(const f32x4*)(nw + c), sc = *(const f32x4*)(m + sc_off + c), sh = *(const f32x4*)(m + sh_off + c);
            const f32x4 o = (v[j] * rstd * w) * (sc + 1.f) + sh;
            u32x2 pk; pk.x = pk2(o.x, o.y); pk.y = pk2(o.z, o.w);
            *(u32x2*)(H + (size_t)row * DM + c) = pk;
        }
    }
}

template <class Epi> __device__ __forceinline__ void gemm_naive(const bf16_t* A, int lda, const bf16_t* Bt, int M, int N, int K, const Epi& E, LAS unsigned char* lds) {
    LAS float* As = (LAS float*)lds;
    LAS float* Bs = As + 32 * 132;
    const int tid = KTID, ty = tid >> 4, tx = tid & 15;
    const int ntm = M / 128, ntn = N / 64, ntiles = ntm * ntn;
    for (int tile = blockIdx.x; tile < ntiles; tile += KGRID) {
        const int tm = tile / ntn, tn = tile % ntn, row0 = tm * 128, col0 = tn * 64;
        float acc[4][4];
#pragma unroll
        for (int i = 0; i < 4; ++i)
#pragma unroll
            for (int j = 0; j < 4; ++j) acc[i][j] = 0.f;
        for (int k0 = 0; k0 < K; k0 += 32) {
            {
                const int r = tid >> 2, kc = (tid & 3) * 8; float f[8];
                unpack8(*(const u32x4*)(A + (size_t)(row0 + r) * lda + k0 + kc), f);
#pragma unroll
                for (int i = 0; i < 8; ++i) As[(kc + i) * 132 + r] = f[i];
                if (tid < 256) {
                    unpack8(*(const u32x4*)(Bt + (size_t)(col0 + r) * K + k0 + kc), f);
#pragma unroll
                    for (int i = 0; i < 8; ++i) Bs[(kc + i) * 68 + r] = f[i];
                }
            }
            __syncthreads();
#pragma unroll 8
            for (int k = 0; k < 32; ++k) {
                const f32x4 av = *(const LAS f32x4*)(As + k * 132 + ty * 4), bv = *(const LAS f32x4*)(Bs + k * 68 + tx * 4);
#pragma unroll
                for (int i = 0; i < 4; ++i)
#pragma unroll
                    for (int j = 0; j < 4; ++j) acc[i][j] += av[i] * bv[j];
            }
            __syncthreads();
        }
#pragma unroll
        for (int i = 0; i < 4; ++i) E(row0 + ty * 4 + i, col0 + tx * 4, (f32x4){acc[i][0], acc[i][1], acc[i][2], acc[i][3]});
    }
}

__device__ __forceinline__ void st4bf(bf16_t* p, f32x4 v) { u32x2 pk; pk.x = pk2(v.x, v.y); pk.y = pk2(v.z, v.w); *(u32x2*)p = pk; }
__device__ __forceinline__ f32x4 rope4(f32x4 v, int jj, int t, const float* R) {
    const int pos = (jj < 32) ? (t >> 6) : (t & 63), i0 = ((jj & 31) >> 1);
    const f32x4 cs = *(const f32x4*)(R + (pos * 16 + i0) * 2);
    return (f32x4){v.x * cs.x - v.y * cs.y, v.x * cs.y + v.y * cs.x, v.z * cs.z - v.w * cs.w, v.z * cs.w + v.w * cs.z};
}
__device__ __forceinline__ void st8bf(bf16_t* p, f32x4 a, f32x4 b) { u32x4 pk; pk.x = pk2(a.x, a.y); pk.y = pk2(a.z, a.w); pk.z = pk2(b.x, b.y); pk.w = pk2(b.z, b.w); *(u32x4*)p = pk; }
struct EpiInProj { bf16_t* PB; const float* R;
    __device__ __forceinline__ f32x4 xf(int row, int col, f32x4 v) const {
        const int tile = col >> 8;
        if (tile == 2 || tile == 3) { v = (f32x4){gelu_tanh(v.x), gelu_tanh(v.y), gelu_tanh(v.z), gelu_tanh(v.w)}; }
        else if (tile == 5) { v = (f32x4){silu_f(v.x), silu_f(v.y), silu_f(v.z), silu_f(v.w)}; }
        else if (tile == 7) { const int cc = col - C_KR; if (cc < 64 && row < ML) v = rope4(v, cc, row & (NL - 1), R); }
        return v; }
    __device__ __forceinline__ void operator()(int row, int col, f32x4 v) const { st4bf(PB + (size_t)row * INP + col, xf(row, col, v)); }
    __device__ __forceinline__ void op8(int row, int col, f32x4 v0, f32x4 v1) const { st8bf(PB + (size_t)row * INP + col, xf(row, col, v0), xf(row, col + 4, v1)); } };
struct EpiUQ { bf16_t* QB;
    __device__ __forceinline__ void operator()(int row, int col, f32x4 v) const { st4bf(QB + (size_t)row * 768 + col, v * QSCALE); }
    __device__ __forceinline__ void op8(int row, int col, f32x4 v0, f32x4 v1) const { st8bf(QB + (size_t)row * 768 + col, v0 * QSCALE, v1 * QSCALE); } };
struct EpiUKV { bf16_t* KVB;
    __device__ __forceinline__ void operator()(int row, int col, f32x4 v) const { st4bf(KVB + (size_t)row * 1024 + col, v); }
    __device__ __forceinline__ void op8(int row, int col, f32x4 v0, f32x4 v1) const { st8bf(KVB + (size_t)row * 1024 + col, v0, v1); } };
struct EpiResid { const float* xin_l; const float* xin_c; float* xout_l; float* xout_c; const float* mod; int g_off;
    __device__ __forceinline__ void operator()(int row, int col, f32x4 v) const {
        if (row < ML) { const f32x4 g = *(const f32x4*)(mod + (row >> 13) * 6144 + g_off + col), xi = *(const f32x4*)(xin_l + (size_t)row * DM + col);
            *(f32x4*)(xout_l + (size_t)row * DM + col) = xi + g * v;
        } else { const int rc = row - ML; const f32x4 g = *(const f32x4*)(mod + 2 * 6144 + g_off + col), xi = *(const f32x4*)(xin_c + (size_t)rc * DM + col);
            *(f32x4*)(xout_c + (size_t)rc * DM + col) = xi + g * v; }
    }
    __device__ __forceinline__ void op8(int row, int col, f32x4 v0, f32x4 v1) const {
        const float* gp; const float* xi; float* xo;
        if (row < ML) { gp = mod + (row >> 13) * 6144 + g_off + col; xi = xin_l + (size_t)row * DM + col; xo = xout_l + (size_t)row * DM + col; }
        else { const int rc = row - ML; gp = mod + 2 * 6144 + g_off + col; xi = xin_c + (size_t)rc * DM + col; xo = xout_c + (size_t)rc * DM + col; }
        const f32x4 g0 = *(const f32x4*)gp, g1 = *(const f32x4*)(gp + 4), x0 = *(const f32x4*)xi, x1 = *(const f32x4*)(xi + 4);
        *(f32x4*)xo = x0 + g0 * v0; *(f32x4*)(xo + 4) = x1 + g1 * v1;
    } };
struct EpiNull {
    __device__ __forceinline__ void operator()(int row, int col, f32x4 v) const { asm volatile("" :: "v"(v)); }
    __device__ __forceinline__ void op8(int row, int col, f32x4 v0, f32x4 v1) const { asm volatile("" :: "v"(v0), "v"(v1)); } };
struct EpiFF1 { bf16_t* Ah;
    __device__ __forceinline__ void operator()(int row, int col, f32x4 v) const {
        f32x4 r = (f32x4){fmaxf(v.x, 0.f), fmaxf(v.y, 0.f), fmaxf(v.z, 0.f), fmaxf(v.w, 0.f)};
        st4bf(Ah + (size_t)row * FF + col, r * r);
    }
    __device__ __forceinline__ void op8(int row, int col, f32x4 v0, f32x4 v1) const {
        f32x4 r0 = (f32x4){fmaxf(v0.x, 0.f), fmaxf(v0.y, 0.f), fmaxf(v0.z, 0.f), fmaxf(v0.w, 0.f)}, r1 = (f32x4){fmaxf(v1.x, 0.f), fmaxf(v1.y, 0.f), fmaxf(v1.z, 0.f), fmaxf(v1.w, 0.f)};
        st8bf(Ah + (size_t)row * FF + col, r0 * r0, r1 * r1);
    } };

__device__ __forceinline__ void phase_post(const Args& a, int l) {
    unsigned char* ws = a.ws;
    bf16_t* PB = (bf16_t*)(ws + WS_PB); float* LG = (float*)(ws + WS_LG);
    const float* kvnw = a.in[I_KVNW] + l * 256; const float* qnw = a.in[I_QNW] + l * 256;
    const float* snw = a.in[I_SGNW] + l * 256; const float* snb = a.in[I_SGNB] + l * 256;
    const float* wgf = a.in[I_GWF] + l * 16 * 128; const float* bgf = a.in[I_GBF] + l * 128;
    const float* wgb = a.in[I_GWB] + l * 16 * 128; const float* bgb = a.in[I_GBB] + l * 128;
    const int lane = klane(), gw = blockIdx.x * NWAVES + kwave(), ngw = KGRID * NWAVES;
    for (int row = gw; row < MT; row += ngw) {
        bf16_t* pr = PB + (size_t)row * INP;
        const int c = lane * 4;
        { u32x2 w = *(const u32x2*)(pr + C_CKV + c); f32x4 v = {__uint_as_float(w.x << 16), __uint_as_float(w.x & 0xffff0000u), __uint_as_float(w.y << 16), __uint_as_float(w.y & 0xffff0000u)};
          const float rstd = rsqrtf(wave_sum(v.x * v.x + v.y * v.y + v.z * v.z + v.w * v.w) * (1.f / 256.f) + EPS);
          st4bf(pr + C_CKV + c, v * rstd * *(const f32x4*)(kvnw + c)); }
        { u32x2 w = *(const u32x2*)(pr + C_DQ + c); f32x4 v = {__uint_as_float(w.x << 16), __uint_as_float(w.x & 0xffff0000u), __uint_as_float(w.y << 16), __uint_as_float(w.y & 0xffff0000u)};
          const float rstd = rsqrtf(wave_sum(v.x * v.x + v.y * v.y + v.z * v.z + v.w * v.w) * (1.f / 256.f) + EPS);
          st4bf(pr + C_DQ + c, v * rstd * *(const f32x4*)(qnw + c)); }
        { u32x2 w = *(const u32x2*)(pr + C_SV + c); f32x4 v = {__uint_as_float(w.x << 16), __uint_as_float(w.x & 0xffff0000u), __uint_as_float(w.y << 16), __uint_as_float(w.y & 0xffff0000u)};
          const float mu = wave_sum(v.x + v.y + v.z + v.w) * (1.f / 256.f);
          v = v - mu;
          const float rstd = rsqrtf(wave_sum(v.x * v.x + v.y * v.y + v.z * v.z + v.w * v.w) * (1.f / 256.f) + EPS);
          st4bf(pr + C_SV + c, v * rstd * *(const f32x4*)(snw + c) + *(const f32x4*)(snb + c)); }
        if (GLA_NAIVE) { const int o = lane * 4, isb = o >> 7, d = o & 127;
          const float* wg = isb ? wgb : wgf; const float* bg = isb ? bgb : bgf; const bf16_t* gg = pr + (isb ? C_GGB : C_GGF);
          f32x4 z = *(const f32x4*)(bg + d);
#pragma unroll
          for (int r = 0; r < 16; ++r) z += *(const f32x4*)(wg + r * 128 + d) * bf2f(gg[r]);
          *(f32x4*)(LG + (size_t)row * 256 + o) = (f32x4){log_sigmoid_f(z.x), log_sigmoid_f(z.y), log_sigmoid_f(z.z), log_sigmoid_f(z.w)} * (1.f / 16.f); }
    }
}

__device__ __forceinline__ void phase_sgu_naive(const Args& a, int l) {
    unsigned char* ws = a.ws;
    const bf16_t* PB = (const bf16_t*)(ws + WS_PB); bf16_t* Y = (bf16_t*)(ws + WS_HY);
    const float* Ws = a.in[I_SGW] + (size_t)l * 4 * 128 * 128; const float* bs = a.in[I_SGB] + l * 4 * 128;
    const int tid = KTID, i = tid >> 2, eg = (tid & 3) * 16;
    for (int unit = blockIdx.x; unit < (MT / 128) * 4; unit += KGRID) {
        const int cc = unit >> 2, h = unit & 3;
        float acc[16];
#pragma unroll
        for (int e = 0; e < 16; ++e) acc[e] = 0.f;
        const float* wrow = Ws + ((size_t)h * 128 + i) * 128;
        for (int j = 0; j < 128; ++j) {
            const float w = wrow[j];
            const bf16_t* vp = PB + (size_t)(cc * 128 + j) * INP + C_SV + h * 64 + eg;
            float f[8], g[8]; unpack8(*(const u32x4*)vp, f); unpack8(*(const u32x4*)(vp + 8), g);
#pragma unroll
            for (int e = 0; e < 8; ++e) { acc[e] += w * f[e]; acc[8 + e] += w * g[e]; }
        }
        const float bias = bs[h * 128 + i];
        const int row = cc * 128 + i;
        const bf16_t* up = PB + (size_t)row * INP + C_SU + h * 64 + eg;
        float f[8], g[8]; unpack8(*(const u32x4*)up, f); unpack8(*(const u32x4*)(up + 8), g);
        bf16_t* yp = Y + (size_t)row * DM + h * 64 + eg;
        u32x4 o0, o1;
        o0.x = pk2(f[0] * (acc[0] + bias), f[1] * (acc[1] + bias)); o0.y = pk2(f[2] * (acc[2] + bias), f[3] * (acc[3] + bias));
        o0.z = pk2(f[4] * (acc[4] + bias), f[5] * (acc[5] + bias)); o0.w = pk2(f[6] * (acc[6] + bias), f[7] * (acc[7] + bias));
        o1.x = pk2(g[0] * (acc[8] + bias), g[1] * (acc[9] + bias)); o1.y = pk2(g[2] * (acc[10] + bias), g[3] * (acc[11] + bias));
        o1.z = pk2(g[4] * (acc[12] + bias), g[5] * (acc[13] + bias)); o1.w = pk2(g[6] * (acc[14] + bias), g[7] * (acc[15] + bias));
        *(u32x4*)yp = o0; *(u32x4*)(yp + 8) = o1;
    }
}

__device__ __forceinline__ void phase_gla_naive(const Args& a, int l) {
    unsigned char* ws = a.ws;
    const bf16_t* PB = (const bf16_t*)(ws + WS_PB); bf16_t* Y = (bf16_t*)(ws + WS_HY);
    const float* LG = (const float*)(ws + WS_LG); float* OB = (float*)(ws + WS_OB);
    const float* gnw = a.in[I_GNW] + l * 64;
    if (blockIdx.x >= 8 || KTID >= 64) return;
    const int b = blockIdx.x >> 2, h = blockIdx.x & 3, e = KTID;
    const float gw_e = gnw[e];
    for (int dir = 1; dir >= 0; --dir) {
        float S[32];
#pragma unroll
        for (int d = 0; d < 32; ++d) S[d] = 0.f;
        for (int tau = 0; tau < NKEY; ++tau) {
            int row;
            if (dir == 0) row = tau < NC ? ML + b * NC + tau : b * NL + (tau - NC);
            else row = tau < NC ? ML + b * NC + (NC - 1 - tau) : b * NL + (NL - 1 - (tau - NC));
            const bf16_t* pr = PB + (size_t)row * INP;
            const float* lg = LG + (size_t)row * 256 + dir * 128 + h * 32;
            const float v = bf2f(pr[C_GV + h * 64 + e]);
            float o = 0.f;
#pragma unroll
            for (int d = 0; d < 32; ++d) {
                const float kk = bf2f(pr[C_GK + h * 32 + d]), qq = bf2f(pr[C_GQ + h * 32 + d]), al = expf(lg[d]);
                S[d] = al * S[d] + kk * v; o += qq * S[d];
            }
            o *= 0.17677669529663687f;
            if (dir == 1) OB[(size_t)row * 256 + h * 64 + e] = o;
            else {
                o += OB[(size_t)row * 256 + h * 64 + e];
                const float ms = wave_sum(o * o) * (1.f / 64.f);
                const float y = o * rsqrtf(ms + EPS) * gw_e * bf2f(pr[C_GR + h * 64 + e]);
                Y[(size_t)row * DM + 256 + h * 64 + e] = (bf16_t)f2bf(y);
            }
        }
    }
}

typedef short bf16x8 __attribute__((ext_vector_type(8)));
typedef float f32x16 __attribute__((ext_vector_type(16)));
typedef float f32x2_t __attribute__((ext_vector_type(2)));
typedef __bf16 bf16x2_t __attribute__((ext_vector_type(2)));
__device__ __forceinline__ unsigned cvtpk(float lo, float hi) { f32x2_t v = {lo, hi}; bf16x2_t b = __builtin_convertvector(v, bf16x2_t); return __builtin_bit_cast(unsigned, b); }
__device__ __forceinline__ int crow(int r, int hi) { return (r & 3) + 8 * (r >> 2) + 4 * hi; }
constexpr int GLA_WLDS = 17920, GLA_NB = 132;
constexpr size_t WS_BC = WS_LG, WS_GL = WS_OB, WS_GD = 1 * MiB + 512 * 1024;
static_assert((size_t)2112 * 2048 * 4 <= WS_END - WS_OB && WS_GD + (size_t)2112 * 32 * 4 <= WS_WIN && WS_ROPE + 16384 <= WS_GD && WS_WSB + 262144 <= WS_WUKV && WS_WUQ + (size_t)2 * 768 * 256 * 2 <= WS_WSB, "gla ws");
__device__ __forceinline__ int gla_row0(int b, int beta) { return beta < 4 ? ML + b * NC + beta * 64 : b * NL + (beta - 4) * 64; }
#define LDS_FENCE() do { asm volatile("s_waitcnt lgkmcnt(0)" ::: "memory"); __builtin_amdgcn_sched_barrier(0); } while (0)
__device__ __forceinline__ void gla_stage_vt(const bf16_t* pv, LAS bf16_t* VT, int lane) {
#pragma unroll
    for (int c8 = 0; c8 < 8; ++c8) { const u32x4 w = *(const u32x4*)(pv + c8 * 8);
        VT[(c8 * 8 + 0) * 64 + lane] = (bf16_t)(w.x & 0xffffu); VT[(c8 * 8 + 1) * 64 + lane] = (bf16_t)(w.x >> 16);
        VT[(c8 * 8 + 2) * 64 + lane] = (bf16_t)(w.y & 0xffffu); VT[(c8 * 8 + 3) * 64 + lane] = (bf16_t)(w.y >> 16);
        VT[(c8 * 8 + 4) * 64 + lane] = (bf16_t)(w.z & 0xffffu); VT[(c8 * 8 + 5) * 64 + lane] = (bf16_t)(w.z >> 16);
        VT[(c8 * 8 + 6) * 64 + lane] = (bf16_t)(w.w & 0xffffu); VT[(c8 * 8 + 7) * 64 + lane] = (bf16_t)(w.w >> 16); }
}
__device__ __forceinline__ void load32bf(const bf16_t* p, float* f) {
    unpack8(*(const u32x4*)(p), f); unpack8(*(const u32x4*)(p + 8), f + 8); unpack8(*(const u32x4*)(p + 16), f + 16); unpack8(*(const u32x4*)(p + 24), f + 24);
}
__device__ __forceinline__ void phase_gla_local(const Args& a, int l, LAS unsigned char* lds) {
    unsigned char* ws = a.ws;
    const bf16_t* PB = (const bf16_t*)(ws + WS_PB); float* BC = (float*)(ws + WS_BC); float* GL = (float*)(ws + WS_GL); float* GD = (float*)(ws + WS_GD);
    const int lane = klane(), wave = kwave(), gw = wave * KGRID + (int)blockIdx.x, ngw = KGRID * NWAVES    ;
    const int r32 = lane & 31, hi = lane >> 5;
    LAS bf16_t* KT = (LAS bf16_t*)(lds + wave * GLA_WLDS); LAS bf16_t* VT = KT + 32 * 64;
    for (int task = gw; task < 16 * GLA_NB; task += ngw) {
        const int beta = task % GLA_NB, t2 = task / GLA_NB, dir = t2 & 1, h = (t2 >> 1) & 3, b = t2 >> 3;
        const int row = gla_row0(b, beta) + lane; const bf16_t* pr = PB + (size_t)row * INP;
        LDS_FENCE();
        gla_stage_vt(pr + C_GV + h * 64, VT, lane);
        float c[32];
        {
          const float* wg = (dir ? a.in[I_GWB] : a.in[I_GWF]) + l * 16 * 128 + h * 32; const float* bg = (dir ? a.in[I_GBB] : a.in[I_GBF]) + l * 128 + h * 32;
          LAS float* WGL = (LAS float*)(VT + 64 * 64); LAS float* BGL = WGL + 16 * 32;
          { const int r = lane >> 2, d0 = (lane & 3) * 8;
            *(LAS f32x4*)(WGL + r * 32 + d0) = *(const f32x4*)(wg + r * 128 + d0); *(LAS f32x4*)(WGL + r * 32 + d0 + 4) = *(const f32x4*)(wg + r * 128 + d0 + 4);
            if (lane < 32) BGL[lane] = bg[lane]; }
          float gg[16]; unpack8(*(const u32x4*)(pr + (dir ? C_GGB : C_GGF)), gg); unpack8(*(const u32x4*)(pr + (dir ? C_GGB : C_GGF) + 8), gg + 8);
          LDS_FENCE();
#pragma unroll
          for (int d = 0; d < 32; d += 4) { f32x4 z = *(const LAS f32x4*)(BGL + d);
#pragma unroll
              for (int r = 0; r < 16; ++r) z += *(const LAS f32x4*)(WGL + r * 32 + d) * gg[r];
              c[d] = log_sigmoid_fast(z.x) * (1.f / 16.f); c[d + 1] = log_sigmoid_fast(z.y) * (1.f / 16.f); c[d + 2] = log_sigmoid_fast(z.z) * (1.f / 16.f); c[d + 3] = log_sigmoid_fast(z.w) * (1.f / 16.f); } }
        float kk[32]; load32bf(pr + C_GK + h * 32, kk);
#pragma unroll
        for (int d = 0; d < 32; ++d) {
            const float g = c[d], p = wave_prefix_sum(g);
            const float T = __builtin_bit_cast(float, __builtin_amdgcn_readlane(__builtin_bit_cast(int, p), 63));
            const float cc = dir ? (T - p + g) : p;
            c[d] = cc;
            KT[d * 64 + lane] = (bf16_t)(cvtpk(kk[d] * __expf(T - cc), 0.f) & 0xffffu);
            kk[d] = __expf(T);
        }
        if (lane == 0) { float* gd = GD + (size_t)task * 32;
#pragma unroll
            for (int d = 0; d < 32; d += 4) *(f32x4*)(gd + d) = (f32x4){kk[d], kk[d + 1], kk[d + 2], kk[d + 3]}; }
        { float* bc = BC + (size_t)row * 256 + dir * 128 + h * 32;
#pragma unroll
          for (int d = 0; d < 32; d += 4) *(f32x4*)(bc + d) = (f32x4){c[d], c[d + 1], c[d + 2], c[d + 3]}; }
        LDS_FENCE();
        f32x16 acc0 = {}, acc1 = {};
#pragma unroll
        for (int s = 0; s < 4; ++s) {
            const bf16x8 af = *(const LAS bf16x8*)(KT + r32 * 64 + 16 * s + 8 * hi);
            const bf16x8 b0 = *(const LAS bf16x8*)(VT + r32 * 64 + 16 * s + 8 * hi), b1 = *(const LAS bf16x8*)(VT + (32 + r32) * 64 + 16 * s + 8 * hi);
            acc0 = __builtin_amdgcn_mfma_f32_32x32x16_bf16(af, b0, acc0, 0, 0, 0); acc1 = __builtin_amdgcn_mfma_f32_32x32x16_bf16(af, b1, acc1, 0, 0, 0);
        }
        float* gl = GL + (size_t)task * 2048;
#pragma unroll
        for (int r = 0; r < 16; ++r) { gl[crow(r, hi) * 64 + r32] = acc0[r]; gl[crow(r, hi) * 64 + 32 + r32] = acc1[r]; }
    }
}
__device__ __forceinline__ void phase_gla_scan(const Args& a) {
    unsigned char* ws = a.ws; float* GL = (float*)(ws + WS_GL); const float* GD = (const float*)(ws + WS_GD);
    const int idx = ((int)blockIdx.x - (KGRID - 64)) * NTHR + KTID;
    if (idx < 0 || idx >= 16 * 2048) return;
    const int seq = idx >> 11, de = idx & 2047, d = de >> 6, dir = seq & 1;
    float S = 0.f;
    for (int c0 = 0; c0 < GLA_NB; c0 += 12) {
        float Lv[12], Dv[12];
#pragma unroll
        for (int u = 0; u < 12; ++u) { const int c = c0 + u, beta = dir ? (c < 4 ? 3 - c : 135 - c) : c; const size_t slot = (size_t)seq * GLA_NB + beta;
            Lv[u] = GL[slot * 2048 + de]; Dv[u] = GD[slot * 32 + d]; }
#pragma unroll
        for (int u = 0; u < 12; ++u) { const int c = c0 + u, beta = dir ? (c < 4 ? 3 - c : 135 - c) : c; const size_t slot = (size_t)seq * GLA_NB + beta;
            GL[slot * 2048 + de] = S; S = Dv[u] * S + Lv[u]; }
    }
}
template <int DIR> __device__ __forceinline__ void gla_dir(const bf16_t* pr, const float* bc, const float* sin, int h, LAS bf16_t* QS, LAS bf16_t* KS, const LAS bf16_t* VT, int lane,
                                                            f32x16& o00, f32x16& o01, f32x16& o10, f32x16& o11) {
    const int r32 = lane & 31, hi = lane >> 5;
    {
        float c[32], q[32], k[32];
#pragma unroll
        for (int d = 0; d < 32; d += 4) { const f32x4 v = *(const f32x4*)(bc + d); c[d] = v.x; c[d + 1] = v.y; c[d + 2] = v.z; c[d + 3] = v.w; }
        load32bf(pr + C_GQ + h * 32, q); load32bf(pr + C_GK + h * 32, k);
#pragma unroll
        for (int d = 0; d < 32; d += 8) {
            u32x4 wq, wk; float eq[8], ek[8];
#pragma unroll
            for (int i = 0; i < 8; ++i) { eq[i] = q[d + i] * __expf(c[d + i]) * 0.17677669529663687f; ek[i] = k[d + i] * __expf(-c[d + i]); }
            wq.x = cvtpk(eq[0], eq[1]); wq.y = cvtpk(eq[2], eq[3]); wq.z = cvtpk(eq[4], eq[5]); wq.w = cvtpk(eq[6], eq[7]);
            wk.x = cvtpk(ek[0], ek[1]); wk.y = cvtpk(ek[2], ek[3]); wk.z = cvtpk(ek[4], ek[5]); wk.w = cvtpk(ek[6], ek[7]);
            *(LAS u32x4*)(QS + lane * 32 + d) = wq; *(LAS u32x4*)(KS + lane * 32 + d) = wk;
        }
    }
    LDS_FENCE();
    bf16x8 qf[2][2], kf[2][2];
#pragma unroll
    for (int t = 0; t < 2; ++t)
#pragma unroll
        for (int s = 0; s < 2; ++s) { qf[t][s] = *(const LAS bf16x8*)(QS + (32 * t + r32) * 32 + 16 * s + 8 * hi); kf[t][s] = *(const LAS bf16x8*)(KS + (32 * t + r32) * 32 + 16 * s + 8 * hi); }
    LDS_FENCE();
    {
        u32x4 w[4];
#pragma unroll
        for (int d = 0; d < 32; d += 8) {
            float sv[8];
#pragma unroll
            for (int i = 0; i < 8; ++i) sv[i] = sin[(d + i) * 64 + lane];
            w[d >> 3].x = cvtpk(sv[0], sv[1]); w[d >> 3].y = cvtpk(sv[2], sv[3]); w[d >> 3].z = cvtpk(sv[4], sv[5]); w[d >> 3].w = cvtpk(sv[6], sv[7]);
        }
#pragma unroll
        for (int i = 0; i < 4; ++i) *(LAS u32x4*)(QS + lane * 32 + 8 * i) = w[i];
    }
#define GLA_X(tj, ti) __builtin_amdgcn_mfma_f32_32x32x16_bf16(kf[tj][1], qf[ti][1], __builtin_amdgcn_mfma_f32_32x32x16_bf16(kf[tj][0], qf[ti][0], (f32x16){}, 0, 0, 0), 0, 0, 0)
#define GLA_MASK(X) do { _Pragma("unroll") for (int r = 0; r < 16; ++r) { const int jl = crow(r, hi); const bool keep = DIR == 0 ? (jl <= r32) : (jl >= r32); X[r] = keep ? X[r] : 0.f; } } while (0)
#define GLA_XA(X, s) __builtin_bit_cast(bf16x8, (u32x4){cvtpk(X[8 * (s) + 0], X[8 * (s) + 1]), cvtpk(X[8 * (s) + 2], X[8 * (s) + 3]), cvtpk(X[8 * (s) + 4], X[8 * (s) + 5]), cvtpk(X[8 * (s) + 6], X[8 * (s) + 7])})
#define GLA_VF(tj, s, te) __builtin_bit_cast(bf16x8, (u32x4){((const LAS u32x2*)(VT + (32 * (te) + r32) * 64 + 32 * (tj) + 16 * (s) + 4 * hi))->x, ((const LAS u32x2*)(VT + (32 * (te) + r32) * 64 + 32 * (tj) + 16 * (s) + 4 * hi))->y, \
                                                              ((const LAS u32x2*)(VT + (32 * (te) + r32) * 64 + 32 * (tj) + 16 * (s) + 8 + 4 * hi))->x, ((const LAS u32x2*)(VT + (32 * (te) + r32) * 64 + 32 * (tj) + 16 * (s) + 8 + 4 * hi))->y})
#define GLA_PV(X, tj, O0, O1) do { _Pragma("unroll") for (int s = 0; s < 2; ++s) { const bf16x8 xa = GLA_XA(X, s); \
        O0 = __builtin_amdgcn_mfma_f32_32x32x16_bf16(xa, GLA_VF(tj, s, 0), O0, 0, 0, 0); O1 = __builtin_amdgcn_mfma_f32_32x32x16_bf16(xa, GLA_VF(tj, s, 1), O1, 0, 0, 0); } } while (0)
    __builtin_amdgcn_sched_barrier(0);
    { f32x16 X = GLA_X(0, 0); GLA_MASK(X); GLA_PV(X, 0, o00, o01); }
    __builtin_amdgcn_sched_barrier(0);
    { f32x16 X = GLA_X(1, 1); GLA_MASK(X); GLA_PV(X, 1, o10, o11); }
    __builtin_amdgcn_sched_barrier(0);
    if (DIR == 0) { f32x16 X = GLA_X(0, 1); GLA_PV(X, 0, o10, o11); }
    else          { f32x16 X = GLA_X(1, 0); GLA_PV(X, 1, o00, o01); }
    LDS_FENCE();
#pragma unroll
    for (int s = 0; s < 2; ++s) {
        const bf16x8 s0 = *(const LAS bf16x8*)(QS + r32 * 32 + 16 * s + 8 * hi), s1 = *(const LAS bf16x8*)(QS + (32 + r32) * 32 + 16 * s + 8 * hi);
        o00 = __builtin_amdgcn_mfma_f32_32x32x16_bf16(qf[0][s], s0, o00, 0, 0, 0); o01 = __builtin_amdgcn_mfma_f32_32x32x16_bf16(qf[0][s], s1, o01, 0, 0, 0);
        o10 = __builtin_amdgcn_mfma_f32_32x32x16_bf16(qf[1][s], s0, o10, 0, 0, 0); o11 = __builtin_amdgcn_mfma_f32_32x32x16_bf16(qf[1][s], s1, o11, 0, 0, 0);
    }
    LDS_FENCE();
#undef GLA_X
#undef GLA_MASK
#undef GLA_XA
#undef GLA_VF
#undef GLA_PV
}
__device__ __forceinline__ void phase_gla_out(const Args& a, int l, LAS unsigned char* lds, const int w0, const int nw) {
    unsigned char* ws = a.ws;
    const bf16_t* PB = (const bf16_t*)(ws + WS_PB); const float* BC = (const float*)(ws + WS_BC); const float* GL = (const float*)(ws + WS_GL); bf16_t* Y = (bf16_t*)(ws + WS_HY);
    const float* gnw = a.in[I_GNW] + l * 64;
    const int lane = klane(), wave = kwave(), gw = wave * KGRID + (int)blockIdx.x, ngw = KGRID * NWAVES    ;
    const int r32 = lane & 31, hi = lane >> 5;
    LAS bf16_t* QS = (LAS bf16_t*)(lds + wave * GLA_WLDS); LAS bf16_t* KS = QS + 64 * 32; LAS bf16_t* VT = KS + 64 * 32; LAS float* OS = (LAS float*)(lds + wave * GLA_WLDS);
    for (int task = (wave - w0) * KGRID + (int)blockIdx.x; wave >= w0 && wave < w0 + nw && task < 8 * GLA_NB; task += nw * KGRID) {
        const int beta = task % GLA_NB, bh = task / GLA_NB, h = bh & 3, b = bh >> 2;
        const int row = gla_row0(b, beta) + lane; const bf16_t* pr = PB + (size_t)row * INP;
        LDS_FENCE();
        gla_stage_vt(pr + C_GV + h * 64, VT, lane);
        f32x16 o00 = {}, o01 = {}, o10 = {}, o11 = {};
        gla_dir<0>(pr, BC + (size_t)row * 256 + h * 32, GL + ((size_t)(bh * 2 + 0) * GLA_NB + beta) * 2048, h, QS, KS, VT, lane, o00, o01, o10, o11);
        gla_dir<1>(pr, BC + (size_t)row * 256 + 128 + h * 32, GL + ((size_t)(bh * 2 + 1) * GLA_NB + beta) * 2048, h, QS, KS, VT, lane, o00, o01, o10, o11);
#pragma unroll
        for (int r = 0; r < 16; ++r) { const int i = crow(r, hi);
            OS[i * 65 + r32] = o00[r]; OS[i * 65 + 32 + r32] = o01[r]; OS[(32 + i) * 65 + r32] = o10[r]; OS[(32 + i) * 65 + 32 + r32] = o11[r]; }
        LDS_FENCE();
        float ss = 0.f;
#pragma unroll
        for (int e = 0; e < 64; ++e) { const float v = OS[lane * 65 + e]; ss += v * v; }
        const float rstd = rsqrtf(ss * (1.f / 64.f) + EPS);
        bf16_t* yp = Y + (size_t)row * DM + 256 + h * 64;
#pragma unroll
        for (int c8 = 0; c8 < 8; ++c8) { float rr[8]; unpack8(*(const u32x4*)(pr + C_GR + h * 64 + c8 * 8), rr);
            float y[8];
#pragma unroll
            for (int i = 0; i < 8; ++i) y[i] = OS[lane * 65 + c8 * 8 + i] * rstd * gnw[c8 * 8 + i] * rr[i];
            u32x4 w; w.x = cvtpk(y[0], y[1]); w.y = cvtpk(y[2], y[3]); w.z = cvtpk(y[4], y[5]); w.w = cvtpk(y[6], y[7]);
            *(u32x4*)(yp + c8 * 8) = w; }
    }
}

__device__ __forceinline__ void phase_sgu_mfma(const Args& a, int l, LAS unsigned char* lds, const int w0, const int nw) {
    unsigned char* ws = a.ws;
    const bf16_t* PB = (const bf16_t*)(ws + WS_PB); bf16_t* Y = (bf16_t*)(ws + WS_HY);
    const bf16_t* WSB = (const bf16_t*)(ws + WS_WSB) + (size_t)l * 4 * 128 * 128; const float* bs = a.in[I_SGB] + l * 4 * 128;
    const int lane = klane(), wave = kwave(), gw = wave * KGRID + (int)blockIdx.x, ngw = KGRID * NWAVES    ;
    const int r32 = lane & 31, hi = lane >> 5;
    LAS bf16_t* VT = (LAS bf16_t*)(lds + wave * GLA_WLDS);
    for (int task = (wave - w0) * KGRID + (int)blockIdx.x; wave >= w0 && wave < w0 + nw && task < (MT / 128) * 4; task += nw * KGRID) {
        const int cc = task >> 2, h = task & 3;
        LDS_FENCE();
#pragma unroll
        for (int half = 0; half < 2; ++half) { const int j = lane + 64 * half; const bf16_t* pv = PB + (size_t)(cc * 128 + j) * INP + C_SV + h * 64;
#pragma unroll
            for (int c8 = 0; c8 < 8; ++c8) { const u32x4 w = *(const u32x4*)(pv + c8 * 8);
                VT[(c8 * 8 + 0) * 128 + j] = (bf16_t)(w.x & 0xffffu); VT[(c8 * 8 + 1) * 128 + j] = (bf16_t)(w.x >> 16);
                VT[(c8 * 8 + 2) * 128 + j] = (bf16_t)(w.y & 0xffffu); VT[(c8 * 8 + 3) * 128 + j] = (bf16_t)(w.y >> 16);
                VT[(c8 * 8 + 4) * 128 + j] = (bf16_t)(w.z & 0xffffu); VT[(c8 * 8 + 5) * 128 + j] = (bf16_t)(w.z >> 16);
                VT[(c8 * 8 + 6) * 128 + j] = (bf16_t)(w.w & 0xffffu); VT[(c8 * 8 + 7) * 128 + j] = (bf16_t)(w.w >> 16); } }
        LDS_FENCE();
#pragma unroll 1
        for (int ti = 0; ti < 4; ++ti) {
            f32x16 acc0 = {}, acc1 = {};
            const bf16_t* wrow = WSB + ((size_t)h * 128 + 32 * ti + r32) * 128 + 8 * hi;
#pragma unroll
            for (int s = 0; s < 8; ++s) {
                const bf16x8 bw = *(const bf16x8*)(wrow + 16 * s);
                const bf16x8 a0 = *(const LAS bf16x8*)(VT + r32 * 128 + 16 * s + 8 * hi), a1 = *(const LAS bf16x8*)(VT + (32 + r32) * 128 + 16 * s + 8 * hi);
                acc0 = __builtin_amdgcn_mfma_f32_32x32x16_bf16(a0, bw, acc0, 0, 0, 0); acc1 = __builtin_amdgcn_mfma_f32_32x32x16_bf16(a1, bw, acc1, 0, 0, 0);
            }
            const int i = 32 * ti + r32, row = cc * 128 + i; const float bias = bs[h * 128 + i];
            const bf16_t* up = PB + (size_t)row * INP + C_SU + h * 64 + 4 * hi; bf16_t* yp = Y + (size_t)row * DM + h * 64 + 4 * hi;
#pragma unroll
            for (int g = 0; g < 4; ++g) {
                { const u32x2 u = *(const u32x2*)(up + 8 * g); u32x2 o;
                  o.x = cvtpk(__uint_as_float(u.x << 16) * (acc0[4 * g + 0] + bias), __uint_as_float(u.x & 0xffff0000u) * (acc0[4 * g + 1] + bias));
                  o.y = cvtpk(__uint_as_float(u.y << 16) * (acc0[4 * g + 2] + bias), __uint_as_float(u.y & 0xffff0000u) * (acc0[4 * g + 3] + bias));
                  *(u32x2*)(yp + 8 * g) = o; }
                { const u32x2 u = *(const u32x2*)(up + 32 + 8 * g); u32x2 o;
                  o.x = cvtpk(__uint_as_float(u.x << 16) * (acc1[4 * g + 0] + bias), __uint_as_float(u.x & 0xffff0000u) * (acc1[4 * g + 1] + bias));
                  o.y = cvtpk(__uint_as_float(u.y << 16) * (acc1[4 * g + 2] + bias), __uint_as_float(u.y & 0xffff0000u) * (acc1[4 * g + 3] + bias));
                  *(u32x2*)(yp + 32 + 8 * g) = o; }
            }
        }
    }
}

__device__ __forceinline__ void phase_attn_naive(const Args& a, int l, LAS unsigned char* lds) {
    unsigned char* ws = a.ws;
    const bf16_t* QB = (const bf16_t*)(ws + WS_QB); const bf16_t* KVB = (const bf16_t*)(ws + WS_KVB); const bf16_t* PB = (const bf16_t*)(ws + WS_PB); bf16_t* Y = (bf16_t*)(ws + WS_HY);
    const float* ROPE = (const float*)(ws + WS_ROPE);
    LAS float* Qs = (LAS float*)lds;
    LAS float* Ks = Qs + 192 * 64;
    LAS float* Vs = Ks + 96 * 64;
    LAS float* Ps = Vs + 64 * 128;
    const int tid = KTID, ty = tid >> 4, tx = tid & 15;
    const int nunits = 1024 + (l == 0 ? 32 : 0);
    for (int unit = blockIdx.x; unit < nunits; unit += KGRID) {
        int bh, nkeys, orow0;
        if (unit < 1024) { bh = unit >> 7; const int qb = unit & 127; nkeys = NKEY; orow0 = (bh >> 2) * NL + qb * 64; }
        else { const int u = unit - 1024; bh = u >> 2; const int qb = u & 3; nkeys = NC; orow0 = ML + (bh >> 2) * NC + qb * 64; }
        const int h = bh & 3, b = bh >> 2;
        const bf16_t* Qp = QB + (size_t)orow0 * 768 + h * 192;
        __syncthreads();
        for (int idx = tid; idx < 64 * 24; idx += NTHR) { const int r = idx / 24, ch = idx % 24; float f[8]; unpack8(*(const u32x4*)(Qp + (size_t)r * 768 + ch * 8), f);
            if (ch >= 16 && unit < 1024) { const int t = (orow0 + r) & (NL - 1), jj = (ch - 16) * 8;
                const f32x4 r0 = rope4((f32x4){f[0], f[1], f[2], f[3]}, jj, t, ROPE), r1 = rope4((f32x4){f[4], f[5], f[6], f[7]}, jj + 4, t, ROPE);
                f[0] = r0.x; f[1] = r0.y; f[2] = r0.z; f[3] = r0.w; f[4] = r1.x; f[5] = r1.y; f[6] = r1.z; f[7] = r1.w; }
#pragma unroll
            for (int i = 0; i < 8; ++i) Qs[(ch * 8 + i) * 64 + r] = f[i]; }
        float m[2] = {-1e30f, -1e30f}, lsum[2] = {0.f, 0.f}, o[2][8];
#pragma unroll
        for (int r = 0; r < 2; ++r)
#pragma unroll
            for (int c = 0; c < 8; ++c) o[r][c] = 0.f;
        for (int k0 = 0; k0 < nkeys; k0 += 64) {
            const int krow0 = k0 < NC ? ML + b * NC + k0 : b * NL + (k0 - NC);
            float s[2][4];
#pragma unroll
            for (int r = 0; r < 2; ++r)
#pragma unroll
                for (int j = 0; j < 4; ++j) s[r][j] = 0.f;
            for (int dh = 0; dh < 2; ++dh) {
                __syncthreads();
                for (int idx = tid; idx < 64 * 12; idx += NTHR) { const int key = idx / 12, ch = idx % 12; float f[8];
                    const int dcol = dh * 96 + ch * 8;
                    unpack8(dcol < 128 ? *(const u32x4*)(KVB + (size_t)(krow0 + key) * 1024 + h * 256 + dcol) : *(const u32x4*)(PB + (size_t)(krow0 + key) * INP + C_KR + (dcol - 128)), f);
#pragma unroll
                    for (int i = 0; i < 8; ++i) Ks[(ch * 8 + i) * 64 + key] = f[i]; }
                if (dh == 0) {
                    for (int idx = tid; idx < 64 * 16; idx += NTHR) { const int key = idx >> 4, ch = idx & 15; float f[8];
                        unpack8(*(const u32x4*)(KVB + (size_t)(krow0 + key) * 1024 + h * 256 + 128 + ch * 8), f);
#pragma unroll
                        for (int i = 0; i < 8; ++i) Vs[key * 128 + ch * 8 + i] = f[i]; }
                }
                __syncthreads();
#pragma unroll 4
                for (int d = 0; d < 96; ++d) {
                    const float q0 = Qs[(dh * 96 + d) * 64 + 2 * ty], q1 = Qs[(dh * 96 + d) * 64 + 2 * ty + 1];
                    const f32x4 kv = *(const LAS f32x4*)(Ks + d * 64 + 4 * tx);
#pragma unroll
                    for (int j = 0; j < 4; ++j) { s[0][j] += q0 * kv[j]; s[1][j] += q1 * kv[j]; }
                }
            }
#pragma unroll
            for (int r = 0; r < 2; ++r) {
                float mx = fmaxf(fmaxf(s[r][0], s[r][1]), fmaxf(s[r][2], s[r][3]));
                mx = fmaxf(mx, __shfl_xor(mx, 1)); mx = fmaxf(mx, __shfl_xor(mx, 2)); mx = fmaxf(mx, __shfl_xor(mx, 4)); mx = fmaxf(mx, __shfl_xor(mx, 8));
                const float mn = fmaxf(m[r], mx), alpha = exp2f(m[r] - mn);
                float p[4], rs = 0.f;
#pragma unroll
                for (int j = 0; j < 4; ++j) { p[j] = exp2f(s[r][j] - mn); rs += p[j]; Ps[(2 * ty + r) * 65 + 4 * tx + j] = p[j]; }
                rs += __shfl_xor(rs, 1); rs += __shfl_xor(rs, 2); rs += __shfl_xor(rs, 4); rs += __shfl_xor(rs, 8);
                lsum[r] = lsum[r] * alpha + rs; m[r] = mn;
#pragma unroll
                for (int c = 0; c < 8; ++c) o[r][c] *= alpha;
            }
            __syncthreads();
#pragma unroll 4
            for (int j = 0; j < 64; ++j) {
                const float p0 = Ps[(2 * ty) * 65 + j], p1 = Ps[(2 * ty + 1) * 65 + j];
                const f32x4 v0 = *(const LAS f32x4*)(Vs + j * 128 + 8 * tx), v1 = *(const LAS f32x4*)(Vs + j * 128 + 8 * tx + 4);
#pragma unroll
                for (int c = 0; c < 4; ++c) { o[0][c] += p0 * v0[c]; o[0][4 + c] += p0 * v1[c]; o[1][c] += p1 * v0[c]; o[1][4 + c] += p1 * v1[c]; }
            }
        }
#pragma unroll
        for (int r = 0; r < 2; ++r) {
            const float il = 1.f / lsum[r];
            u32x4 w; w.x = pk2(o[r][0] * il, o[r][1] * il); w.y = pk2(o[r][2] * il, o[r][3] * il); w.z = pk2(o[r][4] * il, o[r][5] * il); w.w = pk2(o[r][6] * il, o[r][7] * il);
            *(u32x4*)(Y + (size_t)(orow0 + 2 * ty + r) * DM + 512 + h * 128 + 8 * tx) = w;
        }
    }
}

namespace att {
using s16x4 = __attribute__((ext_vector_type(4))) short;
constexpr int QBLK = 32, KVBLK = 64;
constexpr int SHM_V = KVBLK * 128 * 2, SHM_K = KVBLK * 192 * 2, SHM_SCR = 2 * SHM_V + 2 * SHM_K, SHM_QL = SHM_SCR + NWAVES * 64 * 4, SHM_ATTN = SHM_QL + NWAVES * ATT_NQL * 1024;
constexpr float THR2 = 11.5f;
#define KSWZ(row, colB) ((row) * 384 + ((colB) ^ ((((row) >> 1) & 7) << 4)))
#define SBAR() __builtin_amdgcn_sched_barrier(0)
__device__ __forceinline__ void partialSM(f32x16& p0, f32x16& p1, float& m_reg, float& mn, float& alpha) {
  float pmax = p0[0];
#pragma unroll
  for (int r = 1; r < 16; ++r) pmax = fmaxf(pmax, p0[r]);
#pragma unroll
  for (int r = 0; r < 16; ++r) pmax = fmaxf(pmax, p1[r]);
  { auto rr = __builtin_amdgcn_permlane32_swap(__float_as_uint(pmax), __float_as_uint(pmax), false, false);
    pmax = fmaxf(__uint_as_float(rr[0]), __uint_as_float(rr[1])); }
  if (__builtin_expect(__all(pmax - m_reg <= THR2), 1)) { mn = m_reg; alpha = 1.f; }
  else { mn = fmaxf(m_reg, pmax); alpha = __builtin_amdgcn_exp2f(m_reg - mn); m_reg = mn; }
#pragma unroll
  for (int r = 0; r < 16; ++r) p0[r] = p0[r] - mn;
#pragma unroll
  for (int r = 0; r < 16; ++r) p1[r] = p1[r] - mn;
#pragma unroll
  for (int r = 0; r < 16; ++r) p0[r] = __builtin_amdgcn_exp2f(p0[r]);
}
__device__ __forceinline__ void finishSM(f32x16& p0, f32x16& p1, float alpha, float& l_reg, bf16x8& pa0, bf16x8& pa1, bf16x8& pa2, bf16x8& pa3) {
#pragma unroll
  for (int r = 0; r < 16; ++r) p1[r] = __builtin_amdgcn_exp2f(p1[r]);
  float ps = 0;
#pragma unroll
  for (int r = 0; r < 16; ++r) ps += p0[r];
#pragma unroll
  for (int r = 0; r < 16; ++r) ps += p1[r];
  { auto rr = __builtin_amdgcn_permlane32_swap(__float_as_uint(ps), __float_as_uint(ps), false, false);
    ps = __uint_as_float(rr[0]) + __uint_as_float(rr[1]); }
  l_reg = l_reg * alpha + ps;
#define PK4(P, BASE, OUT) do { unsigned a0 = cvtpk(P[BASE + 0], P[BASE + 1]), a1 = cvtpk(P[BASE + 2], P[BASE + 3]);   \
    unsigned b0 = cvtpk(P[BASE + 4], P[BASE + 5]), b1 = cvtpk(P[BASE + 6], P[BASE + 7]);                              \
    auto r0 = __builtin_amdgcn_permlane32_swap(a0, b0, false, false); auto r1 = __builtin_amdgcn_permlane32_swap(a1, b1, false, false); \
    u32x4 w = {r0[0], r1[0], r0[1], r1[1]}; OUT = __builtin_bit_cast(bf16x8, w); } while (0)
  PK4(p0, 0, pa0); PK4(p0, 8, pa1); PK4(p1, 0, pa2); PK4(p1, 8, pa3);
#undef PK4
}
constexpr int NQR = 12 - ATT_NQL;
#define ATT_KRD(K0, K1, d0, KB) asm volatile("ds_read_b128 %0, %2 offset:%3\n\tds_read_b128 %1, %2 offset:%4" : "=&v"(K0), "=&v"(K1) : "v"(ka[(d0) & 3]), "i"((KB) + ((d0) >> 2) * 128), "i"((KB) + ((d0) >> 2) * 128 + 12288) : "memory")
#define ATT_QRD(Q, d0) asm volatile("ds_read_b128 %0, %1 offset:%2" : "=&v"(Q) : "v"(qla), "i"(((d0) - NQR) * 1024) : "memory")
template <int KB> __device__ __forceinline__ void qkt(f32x16& p0, f32x16& p1, const unsigned (&ka)[4], const bf16x8* qr, unsigned qla) {
  p0 = f32x16{}; p1 = f32x16{};
  bf16x8 kx0, kx1, ky0, ky1, qx, qy;
  ATT_KRD(kx0, kx1, 0, KB); if (0 >= NQR) ATT_QRD(qx, 0);
#pragma unroll
  for (int d0 = 0; d0 < 12; d0 += 2) {
    ATT_KRD(ky0, ky1, d0 + 1, KB); if (d0 + 1 >= NQR) ATT_QRD(qy, d0 + 1);
    if (d0 + 1 >= NQR) { if (d0 >= NQR) asm volatile("s_waitcnt lgkmcnt(3)" : "+v"(kx0), "+v"(kx1), "+v"(qx)); else asm volatile("s_waitcnt lgkmcnt(3)" : "+v"(kx0), "+v"(kx1)); }
    else asm volatile("s_waitcnt lgkmcnt(2)" : "+v"(kx0), "+v"(kx1));
    { const bf16x8 qf = d0 < NQR ? qr[d0 < NQR ? d0 : 0] : qx;
      p0 = __builtin_amdgcn_mfma_f32_32x32x16_bf16(kx0, qf, p0, 0, 0, 0); p1 = __builtin_amdgcn_mfma_f32_32x32x16_bf16(kx1, qf, p1, 0, 0, 0); }
    if (d0 + 2 < 12) { ATT_KRD(kx0, kx1, d0 + 2, KB); if (d0 + 2 >= NQR) ATT_QRD(qx, d0 + 2);
      if (d0 + 2 >= NQR) { if (d0 + 1 >= NQR) asm volatile("s_waitcnt lgkmcnt(3)" : "+v"(ky0), "+v"(ky1), "+v"(qy)); else asm volatile("s_waitcnt lgkmcnt(3)" : "+v"(ky0), "+v"(ky1)); }
      else asm volatile("s_waitcnt lgkmcnt(2)" : "+v"(ky0), "+v"(ky1)); }
    else { if (d0 + 1 >= NQR) asm volatile("s_waitcnt lgkmcnt(0)" : "+v"(ky0), "+v"(ky1), "+v"(qy)); else asm volatile("s_waitcnt lgkmcnt(0)" : "+v"(ky0), "+v"(ky1)); }
    { const bf16x8 qf = d0 + 1 < NQR ? qr[d0 + 1 < NQR ? d0 + 1 : 0] : qy;
      p0 = __builtin_amdgcn_mfma_f32_32x32x16_bf16(ky0, qf, p0, 0, 0, 0); p1 = __builtin_amdgcn_mfma_f32_32x32x16_bf16(ky1, qf, p1, 0, 0, 0); }
  }
}
__device__ __forceinline__ int v_st(int k, int c) { const int kk = (k & ~0xC) | ((k & 4) << 1) | ((k & 8) >> 1); return ((kk >> 3) * 4 + (c >> 5)) * 512 + ((kk & 7) * 32 + (c & 31)) * 2; }
__device__ __forceinline__ int v_rd_base(int lane) { return ((lane & 3) << 3) | (((lane >> 2) & 3) << 6) | (((lane >> 4) & 1) << 5) | (((lane >> 5) & 1) << 8); }
constexpr int v_rd_off(int d0, int ks, int half) { return d0 * 512 + ks * 4096 + half * 2048; }
template <int OFF> __device__ __forceinline__ s16x4 tr_read(int vb) {
  s16x4 r; asm volatile("ds_read_b64_tr_b16 %0, %1 offset:%2" : "=&v"(r) : "v"(vb), "i"(OFF) : "memory"); return r;
}
template <int D0> __device__ __forceinline__ void pv_one(f32x16& od, int vb, bf16x8 pa0, bf16x8 pa1, bf16x8 pa2, bf16x8 pa3) {
  const s16x4 l0 = tr_read<v_rd_off(D0, 0, 0)>(vb), h0 = tr_read<v_rd_off(D0, 0, 1)>(vb), l1 = tr_read<v_rd_off(D0, 1, 0)>(vb), h1 = tr_read<v_rd_off(D0, 1, 1)>(vb);
  const s16x4 l2 = tr_read<v_rd_off(D0, 2, 0)>(vb), h2 = tr_read<v_rd_off(D0, 2, 1)>(vb), l3 = tr_read<v_rd_off(D0, 3, 0)>(vb), h3 = tr_read<v_rd_off(D0, 3, 1)>(vb);
  asm volatile("s_waitcnt lgkmcnt(0)" ::: "memory"); SBAR();
#define PK(L, H) (bf16x8){L[0], L[1], L[2], L[3], H[0], H[1], H[2], H[3]}
  od = __builtin_amdgcn_mfma_f32_32x32x16_bf16(pa0, PK(l0, h0), od, 0, 0, 0);
  od = __builtin_amdgcn_mfma_f32_32x32x16_bf16(pa1, PK(l1, h1), od, 0, 0, 0);
  od = __builtin_amdgcn_mfma_f32_32x32x16_bf16(pa2, PK(l2, h2), od, 0, 0, 0);
  od = __builtin_amdgcn_mfma_f32_32x32x16_bf16(pa3, PK(l3, h3), od, 0, 0, 0);
#undef PK
}
__device__ __forceinline__ void pv_d0(f32x16* o, int vb, bf16x8 pa0, bf16x8 pa1, bf16x8 pa2, bf16x8 pa3) {
  pv_one<0>(o[0], vb, pa0, pa1, pa2, pa3); pv_one<1>(o[1], vb, pa0, pa1, pa2, pa3); pv_one<2>(o[2], vb, pa0, pa1, pa2, pa3); pv_one<3>(o[3], vb, pa0, pa1, pa2, pa3);
}
template <int ABL> __device__ __forceinline__ void unit(const bf16_t* __restrict__ QB, const bf16_t* __restrict__ KVB, const bf16_t* __restrict__ PB, const float* __restrict__ ROPE, bf16_t* __restrict__ Y,
                                     int qrow0, int b, int h, int nkeys, bool ropeq, LAS unsigned char* lds) {
  const int wid = kwave(), lane = klane(), tid = wid * 64 + lane, r32 = lane & 31, hi = lane >> 5;
  LAS unsigned char* V_lds = lds; LAS unsigned char* K_lds = lds + 2 * SHM_V;
  LAS float* wsc = (LAS float*)(lds + SHM_SCR) + wid * 64; LAS float* li_l = wsc; LAS float* al_l = wsc + 32;
  LAS unsigned char* qlw = lds + SHM_QL + wid * (ATT_NQL * 1024); const LAS unsigned char* ql = qlw + lane * 16;
  float m_reg = -1e30f, l_reg = 0; f32x16 o[4] = {}; bf16x8 qr[NQR];
  {
    const int qrow = qrow0 + wid * QBLK + r32;
    const bf16_t* Qw = QB + (size_t)qrow * 768 + h * 192 + hi * 8;
#pragma unroll
    for (int d0 = 0; d0 < 12; ++d0) {
      u32x4 w = *(const u32x4*)(Qw + d0 * 16);
      if (d0 >= 8 && ropeq) { float f[8]; unpack8(w, f); const int t = qrow & (NL - 1), jj = (d0 - 8) * 16 + hi * 8;
        const f32x4 r0 = rope4((f32x4){f[0], f[1], f[2], f[3]}, jj, t, ROPE), r1 = rope4((f32x4){f[4], f[5], f[6], f[7]}, jj + 4, t, ROPE);
        w.x = cvtpk(r0.x, r0.y); w.y = cvtpk(r0.z, r0.w); w.z = cvtpk(r1.x, r1.y); w.w = cvtpk(r1.z, r1.w); }
      if (d0 < NQR) qr[d0 < NQR ? d0 : 0] = __builtin_bit_cast(bf16x8, w); else *(LAS u32x4*)(qlw + (d0 - NQR) * 1024 + lane * 16) = w;
    }
  }
  const int sr = tid >> 4, sc = (tid & 15) * 8, vst0 = v_st(sr, sc), vst1 = v_st(32 + sr, sc);
  const int krw = tid >> 3, kcg = tid & 7;
  const int kw0 = KSWZ(krw, kcg * 16), kw1 = KSWZ(krw, (kcg + 8) * 16), kw2 = KSWZ(krw, (kcg + 16) * 16);
  const int vb0 = (int)(uintptr_t)V_lds + v_rd_base(lane);
  unsigned ka[4];
#pragma unroll
  for (int c = 0; c < 4; ++c) ka[c] = (unsigned)(uintptr_t)K_lds + r32 * 384 + (((c << 5) | (hi << 4)) ^ (((r32 >> 1) & 7) << 4));
  const unsigned qla = (unsigned)(uintptr_t)ql;
  u32x4 sv0, sv1, sk0, sk1, sk2;
#define KROW(k0) ((k0) < NC ? ML + b * NC + (k0) : b * NL + ((k0) - NC))
  const int gv0 = sr * 1024 + h * 256 + 128 + sc, gv1 = gv0 + 32 * 1024, gk0 = krw * 1024 + h * 256 + kcg * 8, gk1 = gk0 + 64, gk2 = krw * INP + C_KR + kcg * 8;
#define KLOAD(k0) do { const int kr_ = __builtin_amdgcn_readfirstlane(KROW(k0)); const bf16_t* kvb_ = KVB + (size_t)kr_ * 1024; const bf16_t* pb_ = PB + (size_t)kr_ * INP; \
    sk0 = *(const u32x4*)(kvb_ + gk0); sk1 = *(const u32x4*)(kvb_ + gk1); sk2 = *(const u32x4*)(pb_ + gk2); } while (0)
#define VLOAD(k0) do { const int kr_ = __builtin_amdgcn_readfirstlane(KROW(k0)); const bf16_t* kvb_ = KVB + (size_t)kr_ * 1024; \
    sv0 = *(const u32x4*)(kvb_ + gv0); sv1 = *(const u32x4*)(kvb_ + gv1); } while (0)
#define KWRITE(bf) do { *(LAS u32x4*)(K_lds + (bf) * SHM_K + kw0) = sk0; *(LAS u32x4*)(K_lds + (bf) * SHM_K + kw1) = sk1; *(LAS u32x4*)(K_lds + (bf) * SHM_K + kw2) = sk2; } while (0)
#define VWRITE(bf) do { *(LAS u32x4*)(V_lds + (bf) * SHM_V + vst0) = sv0; *(LAS u32x4*)(V_lds + (bf) * SHM_V + vst1) = sv1; } while (0)
#define RESC(a) do { if (__any((a) < 1.f)) { if (hi == 0) al_l[r32] = (a); asm volatile("s_waitcnt lgkmcnt(0)" ::: "memory"); \
    _Pragma("unroll") for (int d = 0; d < 4; ++d) _Pragma("unroll") for (int r = 0; r < 16; ++r) o[d][r] *= al_l[crow(r, hi)]; } } while (0)
  f32x16 pA0, pA1, pB0, pB1; float mnA, mnB, alA, alB; bf16x8 pa0, pa1, pa2, pa3; const int NT = nkeys / KVBLK;
#define QKT0(P0, P1) do { if constexpr (ABL == 2) { P0 = f32x16{}; P1 = f32x16{}; asm volatile("" : "+v"(P0), "+v"(P1)); } else qkt<0>(P0, P1, ka, qr, qla); } while (0)
#define QKT1(P0, P1) do { if constexpr (ABL == 2) { P0 = f32x16{}; P1 = f32x16{}; asm volatile("" : "+v"(P0), "+v"(P1)); } else qkt<SHM_K>(P0, P1, ka, qr, qla); } while (0)
#define PV(VB) do { if constexpr (ABL == 3) { asm volatile("" : "+v"(o[0]), "+v"(o[1]), "+v"(o[2]), "+v"(o[3]) : "v"(pa0), "v"(pa1), "v"(pa2), "v"(pa3)); } else pv_d0(o, VB, pa0, pa1, pa2, pa3); } while (0)
#define PSM(P0, P1, MN, AL) do { if constexpr (ABL == 4) { MN = 0.f; AL = 1.f; asm volatile("" : "+v"(P0), "+v"(P1)); } else partialSM(P0, P1, m_reg, MN, AL); } while (0)
#define FSM(P0, P1, AL) do { if constexpr (ABL == 4) { u32x4 w0_ = {__float_as_uint(P0[0]), __float_as_uint(P0[1]), __float_as_uint(P0[2]), __float_as_uint(P0[3])}, w1_ = {__float_as_uint(P1[0]), __float_as_uint(P1[1]), __float_as_uint(P1[2]), __float_as_uint(P1[3])}; \
      pa0 = __builtin_bit_cast(bf16x8, w0_); pa1 = __builtin_bit_cast(bf16x8, w1_); pa2 = pa0; pa3 = pa1; l_reg += AL; } else finishSM(P0, P1, AL, l_reg, pa0, pa1, pa2, pa3); } while (0)
  KLOAD(0); KWRITE(0); __syncthreads();
  if (wid >= 4) __syncthreads();
  SBAR(); KLOAD(KVBLK); SBAR(); QKT0(pA0, pA1); SBAR(); KWRITE(1); __syncthreads();
  SBAR(); VLOAD(0); SBAR(); PSM(pA0, pA1, mnA, alA); SBAR(); VWRITE(0); __syncthreads();
  for (int j = 1; j + 1 < NT; j += 2) {
    SBAR(); if constexpr (ABL != 1) KLOAD((j + 1) * KVBLK); SBAR(); QKT1(pB0, pB1); FSM(pA0, pA1, alA); SBAR(); if constexpr (ABL != 1) KWRITE(0); __syncthreads();
    SBAR(); if constexpr (ABL != 1) VLOAD(j * KVBLK); SBAR(); PV(vb0); PSM(pB0, pB1, mnB, alB); RESC(alB); SBAR(); if constexpr (ABL != 1) VWRITE(1); __syncthreads();
    SBAR(); if constexpr (ABL != 1) KLOAD((j + 2) * KVBLK); SBAR(); QKT0(pA0, pA1); FSM(pB0, pB1, alB); SBAR(); if constexpr (ABL != 1) KWRITE(1); __syncthreads();
    SBAR(); if constexpr (ABL != 1) VLOAD((j + 1) * KVBLK); SBAR(); PV(vb0 + SHM_V); PSM(pA0, pA1, mnA, alA); RESC(alA); SBAR(); if constexpr (ABL != 1) VWRITE(0); __syncthreads();
  }
  SBAR(); QKT1(pB0, pB1); FSM(pA0, pA1, alA); SBAR(); __syncthreads();
  SBAR(); VLOAD((NT - 1) * KVBLK); SBAR(); PV(vb0); PSM(pB0, pB1, mnB, alB); RESC(alB); SBAR(); VWRITE(1); __syncthreads();
  if (wid < 4) __syncthreads();
  FSM(pB0, pB1, alB); SBAR();
  PV(vb0 + SHM_V);
#undef QKT0
#undef QKT1
#undef PV
#undef PSM
#undef FSM
  if (hi == 0) li_l[r32] = l_reg; asm volatile("s_waitcnt lgkmcnt(0)" ::: "memory");
  float rli[16];
#pragma unroll
  for (int r = 0; r < 16; ++r) rli[r] = __builtin_amdgcn_rcpf(li_l[crow(r, hi)]);
  bf16_t* Ow = Y + (size_t)(qrow0 + wid * QBLK) * DM + 512 + h * 128;
#pragma unroll
  for (int r = 0; r < 16; ++r) { const int orow = crow(r, hi);
#pragma unroll
    for (int d0 = 0; d0 < 4; ++d0) { const float val = o[d0][r] * rli[r]; if constexpr (ABL == 0) Ow[(size_t)orow * DM + d0 * 32 + r32] = (bf16_t)(cvtpk(val, 0.f) & 0xffffu); else asm volatile("" :: "v"(val)); } }
#undef KROW
#undef KLOAD
#undef VLOAD
#undef KWRITE
#undef VWRITE
#undef RESC
}
#undef KSWZ
#undef SBAR
}
template <int ABL> __device__ __forceinline__ void phase_attn_mfma(const Args& a, int l, LAS unsigned char* lds) {
    unsigned char* ws = a.ws;
    const bf16_t* QB = (const bf16_t*)(ws + WS_QB); const bf16_t* KVB = (const bf16_t*)(ws + WS_KVB); const bf16_t* PB = (const bf16_t*)(ws + WS_PB); bf16_t* Y = (bf16_t*)(ws + WS_HY);
    const float* ROPE = (const float*)(ws + WS_ROPE);
    const int nunits = 256 + (l == 0 ? 8 : 0);
    for (int u = blockIdx.x; u < nunits; u += KGRID) {
        __syncthreads();
        if (u < 256) { const int bh = u & 7, qb = u >> 3, b = bh >> 2, h = bh & 3; att::unit<ABL>(QB, KVB, PB, ROPE, Y, b * NL + qb * 256, b, h, NKEY, true, lds); }
        else { const int bh = u - 256, b = bh >> 2, h = bh & 3; att::unit<ABL>(QB, KVB, PB, ROPE, Y, ML + b * NC, b, h, NC, false, lds); }
    }
}

namespace pg8 {
#define PG8_LAS __attribute__((address_space(3)))
typedef unsigned short bf16_t;
typedef short bf16x8 __attribute__((ext_vector_type(8)));
typedef float f32x4 __attribute__((ext_vector_type(4)));
typedef unsigned u32x4 __attribute__((ext_vector_type(4)));
constexpr int BM = 256, BK = 64, HALF = 128, HTB = HALF * BK * 2  , STAGE_BYTES = 8 * HTB, NXCD = 8, WGM = 8;

__host__ __device__ __forceinline__ int lds_byte(int r, int c) { const int st = (r >> 4) * 2 + (c >> 5), rr = r & 15, cc = c & 31, ob = rr * 64 + cc * 2; return st * 1024 + (ob ^ (((ob >> 9) & 1) << 5)); }
__host__ __device__ __forceinline__ void stage_rc(int b, int& R, int& C) { const int st = b / 1024, sb = b % 1024, swz = sb ^ (((sb >> 9) & 1) << 5); R = (st >> 1) * 16 + swz / 64; C = (st & 1) * 32 + (swz % 64) / 2; }
__host__ __device__ __forceinline__ int perm32(int rho) { const int n = rho >> 4, i = rho & 15; return 8 * (i >> 2) + 4 * n + (i & 3); }

struct Unit { int pm, pn; };
struct Gemm { const bf16_t* A; int lda; const bf16_t* Bt; int M, N, K; };

struct StaticOrder {
    int nM, nN, nwg, G, c;
    __host__ __device__ void init(int M, int N, int G_, int c_) { nM = M / BM; nN = N / BM; nwg = nM * nN; G = G_; c = c_; }
    __host__ __device__ bool next(int i, Unit& u) const {
        const long L = (long)i * G + c; if (L >= nwg) return false;
        int wgid = (int)L; { const int q = nwg / NXCD, r = nwg % NXCD, xcd = wgid % NXCD, off = wgid / NXCD; wgid = (xcd < r ? xcd * (q + 1) : r * (q + 1) + (xcd - r) * q) + off; }
        const int nig = WGM * nN, gid = wgid / nig, fm = gid * WGM, gsz = (nM - fm) < WGM ? (nM - fm) : WGM;
        u.pm = fm + ((wgid % nig) % gsz); u.pn = (wgid % nig) / gsz; return true;
    }
    __device__ __forceinline__ void a_ready(const Unit&) const {}
    __device__ __forceinline__ void done(const Unit&) const {}
};
template <class Epi, class Sched, bool ALIGN_EPI = false, bool SP2 = false>
__device__ __forceinline__ void gemm_phase(PG8_LAS unsigned char* lds, const Gemm g, const Sched& S, const Epi& E) {
    const int wid = kwave(), lane = klane(), tid = wid * 64 + lane, wr = wid >> 2, wc = wid & 3, fr = lane & 15, fq = lane >> 4;
    const int K = g.K, nt = K / BK;
    unsigned voffA[2], voffB[2];
#pragma unroll
    for (int i = 0; i < 2; ++i) { int R, C; stage_rc(tid * 16 + i * 8192, R, C); const int Rb = Epi::PERM ? ((R & ~31) + perm32(R & 31)) : R;
        voffA[i] = (unsigned)(R * g.lda + C) * 2u; voffB[i] = (unsigned)(Rb * K + C) * 2u; }
    const size_t kstep = (size_t)(BK * 2);
    const size_t hstepA = (size_t)HALF * g.lda * 2, hstepB = (size_t)HALF * K * 2;
    const size_t tstepA = 2 * hstepA, tstepB = 2 * hstepB;
    const unsigned ldsw = (unsigned)wid * 1024u;
    const int aoff = lds_byte(wr * 64 + fr, fq * 8), boff = lds_byte(wc * 32 + fr, fq * 8);
#define PG8_SA(b, h) (((b) * 2 + (h)) * HTB)
#define PG8_SB(b, h) ((4 + (b) * 2 + (h)) * HTB)
#define PG8_STAGE(bufoff, gbase, voff) do { _Pragma("unroll") for (int _i = 0; _i < 2; ++_i) \
        __builtin_amdgcn_global_load_lds((const unsigned*)((const char*)(gbase) + (voff)[_i]), (PG8_LAS unsigned*)(lds + (bufoff) + ldsw + _i * 8192), 16, 0, 0); } while (0)
#define PG8_LDA(dst, b, h) do { _Pragma("unroll") for (int m = 0; m < 4; ++m) _Pragma("unroll") for (int k = 0; k < 2; ++k) dst[m][k] = *(const PG8_LAS bf16x8*)(lds + PG8_SA(b, h) + aoff + m * 2048 + k * 1024); } while (0)
#define PG8_LDB(dst, b, h) do { _Pragma("unroll") for (int n = 0; n < 2; ++n) _Pragma("unroll") for (int k = 0; k < 2; ++k) dst[n][k] = *(const PG8_LAS bf16x8*)(lds + PG8_SB(b, h) + boff + n * 2048 + k * 1024); } while (0)
#define PG8_MMA(ai, bj, At, Bt) do { __builtin_amdgcn_s_setprio(1); _Pragma("unroll") for (int m = 0; m < 4; ++m) _Pragma("unroll") for (int n = 0; n < 2; ++n) _Pragma("unroll") for (int k = 0; k < 2; ++k) \
        acc[ai][bj][m][n] = __builtin_amdgcn_mfma_f32_16x16x32_bf16(Bt[n][k], At[m][k], acc[ai][bj][m][n], 0, 0, 0); __builtin_amdgcn_s_setprio(0); } while (0)
#define PG8_WAIT_V(n) asm volatile("s_waitcnt vmcnt(" #n ")" ::: "memory")
#define PG8_WAIT_L(n) asm volatile("s_waitcnt lgkmcnt(" #n ")" ::: "memory")
#define PG8_BAR __builtin_amdgcn_s_barrier()
#define PG8_SCHED __builtin_amdgcn_sched_barrier(0)
    Unit cur, nxt; int ui = 0;
    if (!S.next(0, cur)) return;
    f32x4 acc[2][2][4][2];
#pragma unroll
    for (int a = 0; a < 2; ++a)
#pragma unroll
        for (int b = 0; b < 2; ++b)
#pragma unroll
            for (int m = 0; m < 4; ++m)
#pragma unroll
                for (int n = 0; n < 2; ++n) acc[a][b][m][n] = (f32x4){0.f, 0.f, 0.f, 0.f};
    bf16x8 At[4][2], B0[2][2], B1[2][2];
    const char* cA = (const char*)g.A + (size_t)cur.pm * tstepA; const char* cB = (const char*)g.Bt + (size_t)cur.pn * tstepB;
    S.a_ready(cur);
    if constexpr (SP2) {
        PG8_STAGE(PG8_SB(0, 0), cB, voffB); PG8_STAGE(PG8_SB(0, 1), cB + hstepB, voffB); PG8_STAGE(PG8_SA(0, 0), cA, voffA); PG8_STAGE(PG8_SA(0, 1), cA + hstepA, voffA);
        if (wr == 1) PG8_BAR;
        PG8_WAIT_V(2); PG8_BAR;
        PG8_STAGE(PG8_SB(1, 0), cB + kstep, voffB); PG8_STAGE(PG8_SA(1, 0), cA + kstep, voffA); PG8_STAGE(PG8_SB(1, 1), cB + hstepB + kstep, voffB);
        PG8_WAIT_V(6); PG8_BAR;
    } else {
        PG8_STAGE(PG8_SB(0, 0), cB, voffB); PG8_STAGE(PG8_SA(0, 0), cA, voffA); PG8_STAGE(PG8_SB(0, 1), cB + hstepB, voffB); PG8_STAGE(PG8_SA(0, 1), cA + hstepA, voffA);
        if (wr == 1) PG8_BAR;
        PG8_WAIT_V(4); PG8_BAR;
        PG8_STAGE(PG8_SB(1, 0), cB + kstep, voffB); PG8_STAGE(PG8_SA(1, 0), cA + kstep, voffA); PG8_STAGE(PG8_SB(1, 1), cB + hstepB + kstep, voffB);
        PG8_WAIT_V(6); PG8_BAR;
    }
    for (;;) {
        const bool has_next = S.next(ui + 1, nxt);
        const char* nA = has_next ? (const char*)g.A + (size_t)nxt.pm * tstepA : cA; const char* nB = has_next ? (const char*)g.Bt + (size_t)nxt.pn * tstepB : cB;
#pragma nounroll
        for (int t = 0; t < nt; t += 2) {
            const bool last = (t == nt - 2);
            const char* a1 = cA + (size_t)(t + 1) * kstep;
            const char* a2 = last ? nA : cA + (size_t)(t + 2) * kstep; const char* b2 = last ? nB : cB + (size_t)(t + 2) * kstep;
            const char* a3 = a2 + kstep; const char* b3 = b2 + kstep;
            if (last && has_next) S.a_ready(nxt);
            if constexpr (SP2) {
            PG8_LDB(B0, 0, 0); PG8_LDB(B1, 0, 1); PG8_SCHED; PG8_LDA(At, 0, 0); PG8_STAGE(PG8_SA(1, 1), a1 + hstepA, voffA);
            PG8_WAIT_V(8); PG8_WAIT_L(0); PG8_BAR; PG8_MMA(0, 0, At, B0); PG8_MMA(0, 1, At, B1); PG8_BAR; PG8_SCHED;
            PG8_LDA(At, 0, 1); PG8_STAGE(PG8_SB(0, 0), b2, voffB); PG8_STAGE(PG8_SB(0, 1), b2 + hstepB, voffB); PG8_STAGE(PG8_SA(0, 0), a2, voffA);
            PG8_WAIT_V(8); PG8_WAIT_L(0); PG8_BAR; PG8_MMA(1, 0, At, B0); PG8_MMA(1, 1, At, B1); PG8_BAR; PG8_SCHED;
            PG8_LDB(B0, 1, 0); PG8_LDB(B1, 1, 1); PG8_SCHED; PG8_LDA(At, 1, 0); PG8_STAGE(PG8_SA(0, 1), a2 + hstepA, voffA);
            PG8_WAIT_V(8); PG8_WAIT_L(0); PG8_BAR; PG8_MMA(0, 0, At, B0); PG8_MMA(0, 1, At, B1); PG8_BAR; PG8_SCHED;
            PG8_LDA(At, 1, 1); PG8_STAGE(PG8_SB(1, 0), b3, voffB); PG8_STAGE(PG8_SB(1, 1), b3 + hstepB, voffB); PG8_STAGE(PG8_SA(1, 0), a3, voffA);
            PG8_WAIT_V(8); PG8_WAIT_L(0); PG8_BAR; PG8_MMA(1, 0, At, B0); PG8_MMA(1, 1, At, B1); PG8_BAR; PG8_SCHED;
            } else {
            PG8_LDB(B0, 0, 0); PG8_SCHED; PG8_LDA(At, 0, 0); PG8_STAGE(PG8_SA(1, 1), a1 + hstepA, voffA);
            PG8_WAIT_L(8); PG8_BAR; PG8_WAIT_L(0); PG8_MMA(0, 0, At, B0); PG8_BAR; PG8_SCHED;
            PG8_LDB(B1, 0, 1); PG8_STAGE(PG8_SB(0, 0), b2, voffB);
            PG8_BAR; PG8_WAIT_L(0); PG8_MMA(0, 1, At, B1); PG8_BAR;
            PG8_LDA(At, 0, 1); PG8_STAGE(PG8_SA(0, 0), a2, voffA);
            PG8_BAR; PG8_WAIT_L(0); PG8_MMA(1, 0, At, B0); PG8_BAR; PG8_SCHED;
            PG8_STAGE(PG8_SB(0, 1), b2 + hstepB, voffB);
            PG8_WAIT_V(6); PG8_BAR; PG8_MMA(1, 1, At, B1); PG8_BAR;
            PG8_LDB(B0, 1, 0); PG8_SCHED; PG8_LDA(At, 1, 0); PG8_STAGE(PG8_SA(0, 1), a2 + hstepA, voffA);
            PG8_WAIT_L(8); PG8_BAR; PG8_WAIT_L(0); PG8_MMA(0, 0, At, B0); PG8_BAR; PG8_SCHED;
            PG8_LDB(B1, 1, 1); PG8_STAGE(PG8_SB(1, 0), b3, voffB);
            PG8_BAR; PG8_WAIT_L(0); PG8_MMA(0, 1, At, B1); PG8_BAR;
            PG8_LDA(At, 1, 1); PG8_STAGE(PG8_SA(1, 0), a3, voffA);
            PG8_BAR; PG8_WAIT_L(0); PG8_MMA(1, 0, At, B0); PG8_BAR; PG8_SCHED;
            PG8_STAGE(PG8_SB(1, 1), b3 + hstepB, voffB);
            PG8_WAIT_V(6); PG8_BAR; PG8_MMA(1, 1, At, B1); PG8_BAR;
            }
        }
        if constexpr (ALIGN_EPI) { if (wr == 0) PG8_BAR; }
        if constexpr (!Epi::AFTER_DRAIN) { E(acc, cur, wr, wc, fr, fq); S.done(cur); }
        if (!has_next) break;
#pragma unroll
        for (int a = 0; a < 2; ++a)
#pragma unroll
            for (int b = 0; b < 2; ++b)
#pragma unroll
                for (int m = 0; m < 4; ++m)
#pragma unroll
                    for (int n = 0; n < 2; ++n) acc[a][b][m][n] = (f32x4){0.f, 0.f, 0.f, 0.f};
        cur = nxt; cA = nA; cB = nB; ++ui;
        if constexpr (ALIGN_EPI) { if (wr == 1) PG8_BAR; }
    }
    PG8_WAIT_V(0);
    if constexpr (!ALIGN_EPI) { if (wr == 0) PG8_BAR; }
    PG8_BAR;
    if constexpr (Epi::AFTER_DRAIN) { E.fused(acc, cur, wr, wc, fr, fq, lds, wid, lane); S.done(cur); }
#undef PG8_SA
#undef PG8_SB
#undef PG8_STAGE
#undef PG8_LDA
#undef PG8_LDB
#undef PG8_MMA
#undef PG8_WAIT_V
#undef PG8_WAIT_L
#undef PG8_BAR
#undef PG8_SCHED
}
}

template <class F> struct EpiAdapt {
    static constexpr bool PERM = false, AFTER_DRAIN = false;
    F f;
    __device__ __forceinline__ void operator()(const pg8::f32x4 (&acc)[2][2][4][2], const pg8::Unit& u, int wr, int wc, int fr, int fq) const {
#pragma unroll
        for (int ai = 0; ai < 2; ++ai)
#pragma unroll
            for (int m = 0; m < 4; ++m) { const int row = u.pm * 256 + ai * 128 + wr * 64 + m * 16 + fr;
#pragma unroll
                for (int bj = 0; bj < 2; ++bj)
#pragma unroll
                    for (int n = 0; n < 2; ++n) f(row, u.pn * 256 + bj * 128 + wc * 32 + n * 16 + 4 * fq, acc[ai][bj][m][n]); }
    }
};
template <class F> struct EpiAdapt8 {
    static constexpr bool PERM = true, AFTER_DRAIN = false;
    F f;
    __device__ __forceinline__ void operator()(const pg8::f32x4 (&acc)[2][2][4][2], const pg8::Unit& u, int wr, int wc, int fr, int fq) const {
#pragma unroll
        for (int ai = 0; ai < 2; ++ai)
#pragma unroll
            for (int m = 0; m < 4; ++m) { const int row = u.pm * 256 + ai * 128 + wr * 64 + m * 16 + fr;
#pragma unroll
                for (int bj = 0; bj < 2; ++bj) f.op8(row, u.pn * 256 + bj * 128 + wc * 32 + 8 * fq, acc[ai][bj][m][0], acc[ai][bj][m][1]); }
    }
};
template <class F> __device__ __forceinline__ void gemm_mfma8(const bf16_t* A, int lda, const bf16_t* Bt, int M, int N, int K, const F& f, LAS unsigned char* lds) {
    pg8::Gemm g{A, lda, Bt, M, N, K}; pg8::StaticOrder S; S.init(M, N, KGRID, (int)blockIdx.x);
    EpiAdapt8<F> E{f};
    pg8::gemm_phase<EpiAdapt8<F>, pg8::StaticOrder, true, true>(lds, g, S, E);
}
template <class F> __device__ __forceinline__ void gemm_mfma(const bf16_t* A, int lda, const bf16_t* Bt, int M, int N, int K, const F& f, LAS unsigned char* lds) {
    pg8::Gemm g{A, lda, Bt, M, N, K}; pg8::StaticOrder S; S.init(M, N, KGRID, (int)blockIdx.x);
    EpiAdapt<F> E{f};
    pg8::gemm_phase<EpiAdapt<F>, pg8::StaticOrder, true, true>(lds, g, S, E);
}


#ifndef GEMM_MASK
#define GEMM_MASK 63
#endif
template <int BIT, class F> __device__ __forceinline__ void gemm_sel(const bf16_t* A, int lda, const bf16_t* Bt, int M, int N, int K, const F& f, LAS unsigned char* lds) {
    if constexpr ((GEMM_MASK >> BIT) & 1) gemm_mfma(A, lda, Bt, M, N, K, f, lds); else gemm_naive(A, lda, Bt, M, N, K, f, lds);
}

template <class F> __device__ __forceinline__ void gemm_ctx_small(const bf16_t* A, int lda, const bf16_t* Bt, int N, int K, const F& f, LAS unsigned char* lds) {
    const int lane = klane(), wave = kwave(), r32 = lane & 31, hi = lane >> 5;
    const int nct = N / 64, ntasks = 8 * nct, G = KGRID;
    const int KS = K >= 512 ? 8 : K / 64, kslice = K / KS;
    LAS float* red = (LAS float*)lds;
    for (int task = blockIdx.x; task < ntasks; task += G) {
        const int rt = task / nct, ct = task % nct, row0 = ML + rt * 64, col0 = ct * 64;
        f32x16 acc[2][2];
#pragma unroll
        for (int c = 0; c < 2; ++c) { acc[c][0] = f32x16{}; acc[c][1] = f32x16{}; }
        if (wave < KS) {
            const bf16_t* ap0 = A + (size_t)(row0 + r32) * lda + wave * kslice + 8 * hi; const bf16_t* ap1 = ap0 + (size_t)32 * lda;
            const bf16_t* bp0 = Bt + (size_t)(col0 + r32) * K + wave * kslice + 8 * hi; const bf16_t* bp1 = bp0 + (size_t)32 * K;
            bf16x8 av[4][2], bv[4][2];
#define CTX_LOAD(k0) do { _Pragma("unroll") for (int s = 0; s < 4; ++s) { av[s][0] = *(const bf16x8*)(ap0 + (k0) + 16 * s); av[s][1] = *(const bf16x8*)(ap1 + (k0) + 16 * s); \
                bv[s][0] = *(const bf16x8*)(bp0 + (k0) + 16 * s); bv[s][1] = *(const bf16x8*)(bp1 + (k0) + 16 * s); } } while (0)
            CTX_LOAD(0);
#pragma unroll 1
            for (int k0 = 0; k0 < kslice; k0 += 64) {
                bf16x8 ac[4][2], bc[4][2];
#pragma unroll
                for (int s = 0; s < 4; ++s) { ac[s][0] = av[s][0]; ac[s][1] = av[s][1]; bc[s][0] = bv[s][0]; bc[s][1] = bv[s][1]; }
                if (k0 + 64 < kslice) CTX_LOAD(k0 + 64);
#pragma unroll
                for (int s = 0; s < 4; ++s)
#pragma unroll
                    for (int c = 0; c < 2; ++c) { acc[c][0] = __builtin_amdgcn_mfma_f32_32x32x16_bf16(bc[s][c], ac[s][0], acc[c][0], 0, 0, 0); acc[c][1] = __builtin_amdgcn_mfma_f32_32x32x16_bf16(bc[s][c], ac[s][1], acc[c][1], 0, 0, 0); }
            }
#undef CTX_LOAD
        }
        __syncthreads();
        if (wave < KS) {
#pragma unroll
            for (int c = 0; c < 2; ++c)
#pragma unroll
                for (int t = 0; t < 2; ++t)
#pragma unroll
                    for (int r = 0; r < 16; ++r) red[(wave * 64 + (c * 2 + t) * 16 + r) * 64 + lane] = acc[c][t][r];
        }
        __syncthreads();
#pragma unroll
        for (int q = 0; q < 2; ++q) {
            const int grp = wave * 2 + q, c = grp >> 3, t = (grp >> 2) & 1, g = grp & 3;
            f32x4 v = {0.f, 0.f, 0.f, 0.f};
            for (int w = 0; w < KS; ++w) {
                const LAS float* p = red + (w * 64 + (c * 2 + t) * 16 + 4 * g) * 64 + lane;
                v.x += p[0]; v.y += p[64]; v.z += p[128]; v.w += p[192];
            }
            f(row0 + 32 * t + r32, col0 + 32 * c + 8 * g + 4 * hi, v);
        }
    }
    __syncthreads();
}

__device__ __forceinline__ void phase_final(const Args& a) {
    const float* fw = a.in[I_FNW];
    const int lane = klane(), gw = blockIdx.x * NWAVES + kwave(), ngw = KGRID * NWAVES;
    for (int row = gw; row < ML; row += ngw) {
        float* p = a.out + (size_t)row * DM;
        f32x4 v[4]; float ss = 0.f;
#pragma unroll
        for (int j = 0; j < 4; ++j) { v[j] = *(const f32x4*)(p + lane * 4 + 256 * j); ss += v[j].x * v[j].x + v[j].y * v[j].y + v[j].z * v[j].z + v[j].w * v[j].w; }
        const float rstd = rsqrtf(wave_sum(ss) * (1.f / DM) + EPS);
#pragma unroll
        for (int j = 0; j < 4; ++j) *(f32x4*)(p + lane * 4 + 256 * j) = v[j] * rstd * *(const f32x4*)(fw + lane * 4 + 256 * j);
    }
}

constexpr int NPHASE = 20;
#define PH_BEGIN(k) if (lo <= (k) && (k) < hi) { const Args& a = get_args(); unsigned char* ws = a.ws; (void)ws;
#ifndef XBAR
#define XBAR 0
#endif
#define PH_END(k) if (MK_ONE_LAUNCH && (k) + 1 < hi) { xcd_barrier(bar); for (int xb_ = 0; xb_ < XBAR; ++xb_) xcd_barrier(bar); } }
template <int L> __device__ __forceinline__ void layer_phases(LAS unsigned char* lds, const XcdBarrier& bar, const int lo, const int hi) {
    constexpr int P = 1 + 9 * L;
#define MODL ((const float*)(ws + WS_MOD) + (size_t)L * 3 * 6144)
#define ROPET ((const float*)(ws + WS_ROPE))
#define HYB ((bf16_t*)(ws + WS_HY))
#define PBB ((bf16_t*)(ws + WS_PB))
#define XCB ((float*)(ws + WS_XC))
#define XL_IN ((L == 0) ? a.in[I_X] : (const float*)a.out)
#define XC_IN ((L == 0) ? a.in[I_CTX] : (const float*)XCB)
    PH_BEGIN(P + 0) phase_norm_mod(XL_IN, XC_IN, a.in[I_N1W] + L * DM, MODL, 0, 1024, HYB, MT); PH_END(P + 0)
    PH_BEGIN(P + 1) for (int rep = 0; rep < REP_INP; ++rep) { if (rep) xcd_barrier(bar); EpiInProj E{PBB, ROPET}; const bf16_t* W = (const bf16_t*)(ws + WS_WIN) + (size_t)L * INP * DM;
        gemm_mfma8(HYB, DM, W, ML, INP, DM, E, lds); gemm_ctx_small(HYB, DM, W, INP, DM, E, lds); } PH_END(P + 1)
    PH_BEGIN(P + 2) phase_post(a, L); for (int rep = 0; rep < REP_GLAL; ++rep) { if (rep) xcd_barrier(bar); phase_gla_local(a, L, lds); } PH_END(P + 2)
    PH_BEGIN(P + 3) for (int rep = 0; rep < REP_UP; ++rep) { if (rep) xcd_barrier(bar);
        { EpiUQ E1{(bf16_t*)(ws + WS_QB)}; const bf16_t* W = (const bf16_t*)(ws + WS_WUQ) + (size_t)L * 768 * 256; gemm_mfma8(PBB + C_DQ, INP, W, ML, 768, 256, E1, lds); if (L == 0) gemm_ctx_small(PBB + C_DQ, INP, W, 768, 256, E1, lds); }
        { EpiUKV E2{(bf16_t*)(ws + WS_KVB)}; const bf16_t* W = (const bf16_t*)(ws + WS_WUKV) + (size_t)L * 1024 * 256; gemm_mfma8(PBB + C_CKV, INP, W, ML, 1024, 256, E2, lds); gemm_ctx_small(PBB + C_CKV, INP, W, 1024, 256, E2, lds); }
        if (rep == 0) phase_gla_scan(a);
    } PH_END(P + 3)
    PH_BEGIN(P + 4) { phase_gla_out(a, L, lds, 0, 5); phase_sgu_mfma(a, L, lds, 5, 3); phase_attn_mfma<0>(a, L, lds); if (REP_ATTN == 2) { xcd_barrier(bar); phase_attn_mfma<ATT_ABL>(a, L, lds); } } PH_END(P + 4)
    PH_BEGIN(P + 5) for (int rep = 0; rep < (L == 0 ? REP_OUT : 1); ++rep) { if (rep) xcd_barrier(bar); EpiResid E{XL_IN, XC_IN, a.out, XCB, MODL, 2048}; const bf16_t* W = (const bf16_t*)(ws + WS_WOUT) + (size_t)L * DM * DM;
        gemm_mfma8(HYB, DM, W, ML, DM, DM, E, lds); if (L == 0) gemm_ctx_small(HYB, DM, W, DM, DM, E, lds); } PH_END(P + 5)
    PH_BEGIN(P + 6) phase_norm_mod(a.out, XCB, a.in[I_N2W] + L * DM, MODL, 3072, 4096, HYB, L == 0 ? MT : ML); PH_END(P + 6)
    PH_BEGIN(P + 7) { EpiFF1 E{(bf16_t*)(ws + WS_A)}; const bf16_t* W = (const bf16_t*)(ws + WS_WFF1) + (size_t)L * FF * DM;
        gemm_mfma8(HYB, DM, W, ML, FF, DM, E, lds); if (L == 0) gemm_ctx_small(HYB, DM, W, FF, DM, E, lds);
        if (REP_FF1 == 2) { xcd_barrier(bar); EpiNull EN; gemm_mfma8(HYB, DM, W, ML, FF, DM, EN, lds); }
        if (REP_FF1 == 3) { xcd_barrier(bar); gemm_mfma8(HYB, DM, W, ML, FF, DM, E, lds); } } PH_END(P + 7)
    PH_BEGIN(P + 8) { EpiResid E{a.out, XCB, a.out, XCB, MODL, 5120}; const bf16_t* W = (const bf16_t*)(ws + WS_WFF2) + (size_t)L * DM * FF;
        gemm_mfma8((const bf16_t*)(ws + WS_A), FF, W, ML, DM, FF, E, lds); if (L == 0) gemm_ctx_small((const bf16_t*)(ws + WS_A), FF, W, DM, FF, E, lds); } PH_END(P + 8)
}
__global__ void __launch_bounds__(NTHR, 2) mega(Args a_kernarg_only) {
    extern __shared__ __attribute__((aligned(16))) unsigned char lds_raw[];
    LAS unsigned char* lds = (LAS unsigned char*)lds_raw;
    volatile LAS unsigned* MISC = (volatile LAS unsigned*)(lds + LDS_CTL_OFF);
    { const int t0 = __builtin_amdgcn_workitem_id_x();
      if (t0 < 64) MISC[t0] = 0u;
      if ((t0 & 63) == 0) { const unsigned id = (unsigned)__builtin_amdgcn_s_getreg((5 << 11) | 4) & 63u; MISC[64 + id] = (unsigned)(t0 >> 6); } }
    __syncthreads();
    XcdBarrier bar; bar.bar = (unsigned*)(get_args().ws + WS_CTL); bar.x = 0; bar.st = nullptr;
    if (MK_ONE_LAUNCH) bar = xcd_barrier_post((unsigned*)(get_args().ws + WS_CTL), MISC + 8);
    const int lo = MK_ONE_LAUNCH ? 0 : get_args().ph_lo, hi = MK_ONE_LAUNCH ? NPHASE : get_args().ph_hi;
    PH_BEGIN(0) phase_prep(a, lds); PH_END(0)
    layer_phases<0>(lds, bar, lo, hi);
    layer_phases<1>(lds, bar, lo, hi);
    PH_BEGIN(NPHASE - 1) phase_final(a); PH_END(NPHASE - 1)
}

extern "C" void kernel_launch(void* const* d_in, const int* in_sizes, int n_in, void* d_out, int out_size, void* d_ws, size_t ws_size, hipStream_t stream) {
    static int grid = 0;
    if (grid == 0) {
        if (n_in != 26 || in_sizes[0] != ML * DM || out_size != ML * DM || ws_size < WS_END) { fprintf(stderr, "kernel_launch: unexpected shapes (n_in %d, in0 %d, out %d, ws %zu)\n", n_in, n_in > 0 ? in_sizes[0] : -1, out_size, ws_size); grid = -1; return; }
        int dev = 0, cus = 0;
        if (hipGetDevice(&dev) != hipSuccess || hipDeviceGetAttribute(&cus, hipDeviceAttributeMultiprocessorCount, dev) != hipSuccess) { grid = -1; return; }
        if (hipFuncSetAttribute((const void*)mega, hipFuncAttributeMaxDynamicSharedMemorySize, LDS_BYTES) != hipSuccess) { fprintf(stderr, "kernel_launch: hipFuncSetAttribute failed\n"); grid = -1; return; }
        int per_cu = 0;
        if (hipOccupancyMaxActiveBlocksPerMultiprocessor(&per_cu, (const void*)mega, NTHR, LDS_BYTES) != hipSuccess || per_cu < 1) fprintf(stderr, "kernel_launch: occupancy query says %d\n", per_cu);
        (void)hipGetLastError();
        grid = cus;
    }
    if (grid < 0) return;
    (void)hipMemsetAsync((char*)d_ws + WS_CTL, 0, CTL_ZERO_BYTES, stream);
    Args a{};
    for (int i = 0; i < 26; ++i) a.in[i] = (const float*)d_in[i];
    a.out = (float*)d_out; a.ws = (unsigned char*)d_ws; a.grid = grid;
    if (MK_ONE_LAUNCH) { a.ph_lo = 0; a.ph_hi = NPHASE; hipLaunchKernelGGL(mega, dim3(grid), dim3(NTHR), LDS_BYTES, stream, a); }
    else for (int ph = 0; ph < NPHASE; ++ph) { a.ph_lo = ph; a.ph_hi = ph + 1; hipLaunchKernelGGL(mega, dim3(grid), dim3(NTHR), LDS_BYTES, stream, a); }
}
```

```cpp
#include <hip/hip_runtime.h>
#include <cstdio>
#include <cstdint>

#ifndef REP_FF1
#define REP_FF1 1
#endif
#ifndef REP_INP
#define REP_INP 1
#endif
#ifndef REP_GLAL
#define REP_GLAL 1
#endif
#ifndef REP_UP
#define REP_UP 1
#endif
#ifndef REP_OUT
#define REP_OUT 1
#endif
#ifndef ATT_ABL
#define ATT_ABL 5
#endif
#ifndef REP_PREP
#define REP_PREP 1
#endif
#ifndef REP_SGU
#define REP_SGU 1
#endif
#ifndef REP_ATTN
#define REP_ATTN 1
#endif
#ifndef REP_GLA
#define REP_GLA 1
#endif
#ifndef REP_NORM
#define REP_NORM 1
#endif
#ifndef ATT_NQL
#define ATT_NQL 6
#endif
#ifndef ATTN_NAIVE
#define ATTN_NAIVE 0
#endif
#ifndef GLA_NAIVE
#define GLA_NAIVE 0
#endif
#ifndef MK_ONE_LAUNCH
#define MK_ONE_LAUNCH 1
#endif

#define GAS __attribute__((address_space(1)))
#define LAS __attribute__((address_space(3)))
typedef unsigned short bf16_t;
typedef float f32x4 __attribute__((ext_vector_type(4)));
typedef unsigned u32x4 __attribute__((ext_vector_type(4)));
typedef unsigned u32x2 __attribute__((ext_vector_type(2)));

constexpr int DM = 1024, NB = 2, NL = 8192, NC = 256, ML = NB * NL, MC = NB * NC, MT = ML + MC;
constexpr int FF = 4096, INP = 2048, IN_COLS = 1888, NKEY = NC + NL;
constexpr float EPS = 1e-6f;
constexpr float QSCALE = 0.07216878364870322f * 1.4426950408889634f;
constexpr int NWAVES = 8, NTHR = 512;
constexpr int C_CKV = 0, C_DQ = 256, C_SU = 512, C_SV = 768, C_GV = 1024, C_GR = 1280, C_GK = 1536, C_GQ = 1664, C_KR = 1792, C_GGF = 1856, C_GGB = 1872;

constexpr size_t MiB = 1u << 20;
constexpr size_t WS_CTL = 0, CTL_ZERO_BYTES = 65536;
constexpr size_t WS_MOD = 1 * MiB;
constexpr size_t WS_ROPE = 1 * MiB + 256 * 1024;
constexpr size_t WS_WSB = 14 * MiB + 768 * 1024;
constexpr size_t WS_WIN = 2 * MiB;
constexpr size_t WS_WOUT = 10 * MiB;
constexpr size_t WS_WUQ = 14 * MiB;
constexpr size_t WS_WUKV = 15 * MiB;
constexpr size_t WS_WFF1 = 16 * MiB;
constexpr size_t WS_WFF2 = 32 * MiB;
constexpr size_t WS_XC = 48 * MiB;
constexpr size_t WS_HY = 50 * MiB;
constexpr size_t WS_PB = 83 * MiB;
constexpr size_t WS_QB = 149 * MiB;
constexpr size_t WS_KVB = 174 * MiB;
constexpr size_t WS_LG = 216 * MiB;
constexpr size_t WS_OB = 233 * MiB;
constexpr size_t WS_A = 83 * MiB;
constexpr size_t WS_END = 250 * MiB;
static_assert(WS_A + (size_t)MT * FF * 2 <= WS_LG, "ffn hidden overlay");
static_assert(WS_PB + (size_t)MT * INP * 2 <= WS_QB && WS_QB + (size_t)MT * 768 * 2 <= WS_KVB && WS_KVB + (size_t)MT * 1024 * 2 <= WS_LG, "ws map");
static_assert(WS_LG + (size_t)MT * 256 * 4 <= WS_OB && WS_OB + (size_t)MT * 256 * 4 <= WS_END, "ws map 2");

constexpr int LDS_BYTES = 147456;

struct Args { const float* in[26]; float* out; unsigned char* ws; int ph_lo, ph_hi, grid, pad; };
enum { I_X = 0, I_C, I_CTX, I_CCTX, I_WMOD, I_BMOD, I_N1W, I_WIN, I_WOUT, I_SGNW, I_SGNB, I_SGW, I_SGB, I_GWF, I_GBF, I_GWB, I_GBB, I_GNW, I_QNW, I_WUQ, I_KVNW, I_WUKV, I_N2W, I_WFF1, I_WFF2, I_FNW };

typedef __attribute__((address_space(4))) const Args* KArgsPtr;
__device__ __forceinline__ const Args& get_args() { KArgsPtr p = (KArgsPtr)__builtin_amdgcn_kernarg_segment_ptr(); asm volatile("" : "+s"(p)); return *(const Args*)p; }
constexpr int LDS_CTL_OFF = LDS_BYTES - 512;
__device__ __forceinline__ int klane() { int l; asm volatile("v_mbcnt_lo_u32_b32 %0, -1, 0\n\tv_mbcnt_hi_u32_b32 %0, -1, %0" : "=v"(l)); return l; }
__device__ __forceinline__ int kwave() { const unsigned id = (unsigned)__builtin_amdgcn_s_getreg((5 << 11) | 4) & 63u;
    return __builtin_amdgcn_readfirstlane((int)((volatile LAS unsigned*)(uintptr_t)(LDS_CTL_OFF + 256))[id]); }
#define KTID (kwave() * 64 + klane())
#define KGRID (get_args().grid)
__device__ __forceinline__ float bf2f(bf16_t v) { return __uint_as_float(((unsigned)v) << 16); }
__device__ __forceinline__ unsigned f2bf(float f) { unsigned u = __float_as_uint(f); return (u + 0x7fffu + ((u >> 16) & 1u)) >> 16; }
__device__ __forceinline__ unsigned pk2(float lo, float hi) { return f2bf(lo) | (f2bf(hi) << 16); }
#define DPP_F(v, ctrl, rmask) __builtin_bit_cast(float, __builtin_amdgcn_update_dpp(0, __builtin_bit_cast(int, (v)), (ctrl), (rmask), 0xf, true))
__device__ __forceinline__ float wave_prefix_sum(float v) {
    v += DPP_F(v, 0x111, 0xf); v += DPP_F(v, 0x112, 0xf); v += DPP_F(v, 0x114, 0xf); v += DPP_F(v, 0x118, 0xf);
    v += DPP_F(v, 0x142, 0xa); v += DPP_F(v, 0x143, 0xc);
    return v;
}
__device__ __forceinline__ float wave_sum(float v) {
    return __builtin_bit_cast(float, __builtin_amdgcn_readlane(__builtin_bit_cast(int, wave_prefix_sum(v)), 63));
}
__device__ __forceinline__ float gelu_tanh(float x) { const float u = 1.5957691216057308f * (x + 0.044715f * x * x * x); return x / (1.f + __expf(-u)); }
__device__ __forceinline__ float silu_f(float x) { return x / (1.f + __expf(-x)); }
__device__ __forceinline__ float log_sigmoid_f(float z) { return fminf(z, 0.f) - log1pf(expf(-fabsf(z))); }
__device__ __forceinline__ float log_sigmoid_fast(float z) { return fminf(z, 0.f) - __logf(1.f + __expf(-fabsf(z))); }
__device__ __forceinline__ void unpack8(u32x4 w, float* f) {
    f[0] = __uint_as_float(w.x << 16); f[1] = __uint_as_float(w.x & 0xffff0000u); f[2] = __uint_as_float(w.y << 16); f[3] = __uint_as_float(w.y & 0xffff0000u);
    f[4] = __uint_as_float(w.z << 16); f[5] = __uint_as_float(w.z & 0xffff0000u); f[6] = __uint_as_float(w.w << 16); f[7] = __uint_as_float(w.w & 0xffff0000u);
}

#define XB_TMO      128
#define XB_XCNT(j)  (256  + 64 * (j))
#define XB_XSUB(j)  (1280 + 64 * (j))
#define XB_XGEN(j)  (2304 + 64 * (j))
#define XB_TOP      3328
#define XB_TOPGEN   3392
#define XCD_BAR_WORDS 3456
#define XB_SPIN_CAP (1u << 22)
__device__ __forceinline__ unsigned xb_ld(unsigned* p)              { return __hip_atomic_load(p, __ATOMIC_RELAXED, __HIP_MEMORY_SCOPE_AGENT); }
__device__ __forceinline__ unsigned xb_add(unsigned* p, unsigned v) { return __hip_atomic_fetch_add(p, v, __ATOMIC_RELAXED, __HIP_MEMORY_SCOPE_AGENT); }
__device__ __forceinline__ unsigned xb_xcc_id() { return (unsigned)__builtin_amdgcn_s_getreg((3 << 11) | 20) & 0xFu; }
#define XB_SPIN(cond, bar) do { unsigned _sp = 0; while (cond) { __builtin_amdgcn_s_sleep(1); \
    if ((++_sp & 255u) == 0u) { if (xb_ld(&(bar)[XB_TMO])) break; if (_sp > XB_SPIN_CAP) { atomicAdd(&(bar)[XB_TMO], 1u); break; } } } } while (0)
struct XcdBarrier { unsigned* bar; unsigned x; volatile LAS unsigned* st; };
__device__ __forceinline__ XcdBarrier xcd_barrier_post(unsigned* bar, volatile LAS unsigned* st) {
    XcdBarrier b; b.bar = bar; b.x = xb_xcc_id(); b.st = st;
    if (KTID == 0) (void)xb_add(&bar[XB_XCNT(b.x)], 1u);
    return b;
}
__device__ __forceinline__ void xcd_barrier_complete(unsigned* bar, unsigned x, unsigned& nloc, unsigned& nx) {
    const unsigned G = (unsigned)KGRID;
    unsigned sum, cnt, mine, sp = 0u;
    for (;;) {
        sum = 0u; cnt = 0u; mine = 0u;
#pragma unroll
        for (unsigned j = 0; j < 16; ++j) { const unsigned c = xb_ld(&bar[XB_XCNT(j)]); sum += c; cnt += (c > 0u) ? 1u : 0u; mine = (j == x) ? c : mine; }
        if (sum == G) break;
        __builtin_amdgcn_s_sleep(1);
        if ((++sp & 255u) == 0u) { if (xb_ld(&bar[XB_TMO])) break; if (sp > XB_SPIN_CAP) { atomicAdd(&bar[XB_TMO], 1u); break; } }
    }
    nloc = mine > 0u ? mine : 1u; nx = cnt > 0u ? cnt : 1u;
}
__device__ __forceinline__ void xcd_barrier(const XcdBarrier& b) {
    asm volatile("s_waitcnt vmcnt(0)" ::: "memory");
    __syncthreads();
    if (KTID == 0) {
        unsigned* bar = b.bar;
        __builtin_amdgcn_s_waitcnt(0);
        unsigned nloc = b.st[0], nx = b.st[1];
        if (nloc == 0u) { xcd_barrier_complete(bar, b.x, nloc, nx); b.st[0] = nloc; b.st[1] = nx; }
        const unsigned old = xb_add(&bar[XB_XSUB(b.x)], 1u);
        const unsigned gen = old / nloc;
        if (old + 1u == (gen + 1u) * nloc) {
            __builtin_amdgcn_fence(__ATOMIC_RELEASE, "agent");
            asm volatile("s_waitcnt vmcnt(0)" ::: "memory");
            const unsigned og = xb_add(&bar[XB_TOP], 1u);
            const unsigned tg = og / nx;
            if (og + 1u == (tg + 1u) * nx) xb_add(&bar[XB_TOPGEN], 1u);
            else XB_SPIN(xb_ld(&bar[XB_TOPGEN]) == tg, bar);
            __builtin_amdgcn_fence(__ATOMIC_ACQUIRE, "agent");
            xb_add(&bar[XB_XGEN(b.x)], 1u);
            asm volatile("s_waitcnt vmcnt(0)" ::: "memory");
        } else {
            XB_SPIN(xb_ld(&bar[XB_XGEN(b.x)]) == gen, bar);
            __builtin_amdgcn_fence(__ATOMIC_ACQUIRE, "agent");
            asm volatile("s_waitcnt vmcnt(0)" ::: "memory");
        }
    }
    __syncthreads();
}

__device__ __forceinline__ int rope_unperm(int jj) { return (jj < 32) ? ((jj >> 1) + 16 * (jj & 1)) : (32 + ((jj - 32) >> 1) + 16 * (jj & 1)); }
__device__ __forceinline__ int map_in(int n) {
    if (n < 256) return 416 + n;
    if (n < 512) return 1632 + (n - 256);
    if (n < 768) return 736 + (n - 512);
    if (n < 1024) return 992 + (n - 768);
    if (n < 1280) return 128 + (n - 1024);
    if (n < 1536) return 1376 + (n - 1280);
    if (n < 1664) return n - 1536;
    if (n < 1792) return 1248 + (n - 1664);
    if (n < 1856) return 672 + rope_unperm(n - 1792);
    if (n < 1872) return 384 + (n - 1856);
    if (n < 1888) return 400 + (n - 1872);
    return -1;
}
__device__ __forceinline__ int map_uq(int n) { const int h = n / 192, j = n % 192; return (j < 128) ? n : (h * 192 + 128 + rope_unperm(j - 128)); }
template <int MODE> __device__ __forceinline__ void transpose_w(const float* W, int K, int Nsrc, bf16_t* Wt, int Npad, int gtid, int gthreads) {
    const int total = Npad * (K / 8);
    for (int idx = gtid; idx < total; idx += gthreads) {
        const int n = idx % Npad, kc = idx / Npad;
        const int src = (MODE == 0) ? n : (MODE == 1 ? map_in(n) : map_uq(n));
        float f[8];
#pragma unroll
        for (int i = 0; i < 8; ++i) f[i] = (src >= 0) ? W[(size_t)(kc * 8 + i) * Nsrc + src] : 0.f;
        u32x4 o; o.x = pk2(f[0], f[1]); o.y = pk2(f[2], f[3]); o.z = pk2(f[4], f[5]); o.w = pk2(f[6], f[7]);
        *(u32x4*)(Wt + (size_t)n * K + kc * 8) = o;
    }
}
template <int MODE> __device__ __forceinline__ void transpose_item(const float* W, int K, int Nsrc, bf16_t* Wt, int Npad, LAS float* scr, int item, int lane) {
    const int nblk = Npad / 32, kb = item / nblk, nb = item % nblk, k0 = 64 * kb, n0 = 32 * nb;
    const int nn = n0 + (lane & 31), src = (MODE == 0) ? nn : (MODE == 1 ? map_in(nn) : map_uq(nn));
    float tv[32];
#pragma unroll
    for (int i = 0; i < 32; ++i) { const int kk = 2 * i + (lane >> 5); tv[i] = (src >= 0) ? W[(size_t)(k0 + kk) * Nsrc + src] : 0.f; }
#pragma unroll
    for (int i = 0; i < 32; ++i) { const int kk = 2 * i + (lane >> 5); scr[kk * 33 + (lane & 31)] = tv[i]; }
    asm volatile("s_waitcnt lgkmcnt(0)" ::: "memory");
    const int c = lane & 7;
#pragma unroll
    for (int j = 0; j < 4; ++j) { const int n = (lane >> 3) + 8 * j; const LAS float* s = scr + (8 * c) * 33 + n;
        u32x4 o; o.x = pk2(s[0 * 33], s[1 * 33]); o.y = pk2(s[2 * 33], s[3 * 33]); o.z = pk2(s[4 * 33], s[5 * 33]); o.w = pk2(s[6 * 33], s[7 * 33]);
        *(u32x4*)(Wt + (size_t)(n0 + n) * K + k0 + 8 * c) = o; }
    asm volatile("s_waitcnt lgkmcnt(0)" ::: "memory");
}
__device__ __forceinline__ void weight_copies(const Args& a, int l, int nblk, LAS unsigned char* lds) {
    unsigned char* ws = a.ws;
    if ((int)blockIdx.x >= nblk) return;
    const int wave = kwave(), lane = klane(), gw = wave * nblk + (int)blockIdx.x, ngw = nblk * NWAVES;
    LAS float* scr = (LAS float*)(lds + 8192 + wave * 8704);
    for (int it = gw; it < 5856; it += ngw) {
        int r = it;
        if (r < 1024) { transpose_item<1>(a.in[I_WIN] + (size_t)l * DM * IN_COLS, DM, IN_COLS, (bf16_t*)(ws + WS_WIN) + (size_t)l * INP * DM, INP, scr, r, lane); continue; } r -= 1024;
        if (r < 512) { transpose_item<0>(a.in[I_WOUT] + (size_t)l * DM * DM, DM, DM, (bf16_t*)(ws + WS_WOUT) + (size_t)l * DM * DM, DM, scr, r, lane); continue; } r -= 512;
        if (r < 96) { transpose_item<2>(a.in[I_WUQ] + (size_t)l * 256 * 768, 256, 768, (bf16_t*)(ws + WS_WUQ) + (size_t)l * 768 * 256, 768, scr, r, lane); continue; } r -= 96;
        if (r < 128) { transpose_item<0>(a.in[I_WUKV] + (size_t)l * 256 * 1024, 256, 1024, (bf16_t*)(ws + WS_WUKV) + (size_t)l * 1024 * 256, 1024, scr, r, lane); continue; } r -= 128;
        if (r < 2048) { transpose_item<0>(a.in[I_WFF1] + (size_t)l * DM * FF, DM, FF, (bf16_t*)(ws + WS_WFF1) + (size_t)l * FF * DM, FF, scr, r, lane); continue; } r -= 2048;
        transpose_item<0>(a.in[I_WFF2] + (size_t)l * FF * DM, FF, DM, (bf16_t*)(ws + WS_WFF2) + (size_t)l * DM * FF, DM, scr, r, lane);
    }
}
__device__ __forceinline__ void phase_prep(const Args& a, LAS unsigned char* lds) {
    unsigned char* ws = a.ws;
    const int tid = KTID, gtid = blockIdx.x * NTHR + tid, gthreads = KGRID * NTHR;
    weight_copies(a, 0, KGRID, lds);
    for (int idx = gtid; idx < 2 * 4 * 128 * 128 / 4; idx += gthreads) { const f32x4 v = *(const f32x4*)(a.in[I_SGW] + (size_t)idx * 4); u32x2 o; o.x = pk2(v.x, v.y); o.y = pk2(v.z, v.w); *(u32x2*)((bf16_t*)(ws + WS_WSB) + (size_t)idx * 4) = o; }
    { const int ridx = ((int)blockIdx.x - (KGRID - 4)) * NTHR + tid;
      if (ridx >= 0 && ridx < 128 * 16) {
        const int p = ridx >> 4, i = ridx & 15;
        const float freq = powf(10000.0f, -(float)i * 2.0f / 32.0f);
        const float ang = (float)p * freq;
        float sn, cs; sincosf(ang, &sn, &cs);
        float* R = (float*)(ws + WS_ROPE);
        R[ridx * 2 + 0] = cs; R[ridx * 2 + 1] = sn;
      } }
    {
        LAS float* red = (LAS float*)lds;
        LAS float* sil = (LAS float*)(lds + 80 * 1024);
        const int wave = kwave(), lane = klane();
        if ((int)blockIdx.x < 2 * 96) {
            for (int i = tid; i < 3 * DM; i += NTHR) { const float v = i < 2 * DM ? a.in[I_C][i] : a.in[I_CCTX][i - 2 * DM]; sil[i] = silu_f(v); }
        }
        __syncthreads();
        for (int item = blockIdx.x; item < 2 * 96; item += KGRID) {
            const int l = item / 96, j = (item % 96) * 64 + lane;
            const float* W = a.in[I_WMOD] + (size_t)l * DM * 6144 + (size_t)(wave * 128) * 6144 + j;
            float s0 = 0.f, s1 = 0.f, s2 = 0.f;
#pragma unroll 16
            for (int kk = 0; kk < 128; ++kk) {
                const float w = W[(size_t)kk * 6144];
                const int k2 = wave * 128 + kk;
                s0 += sil[k2] * w; s1 += sil[DM + k2] * w; s2 += sil[2 * DM + k2] * w;
            }
            red[(wave * 3 + 0) * 64 + lane] = s0; red[(wave * 3 + 1) * 64 + lane] = s1; red[(wave * 3 + 2) * 64 + lane] = s2;
            __syncthreads();
            if (tid < 192) {
                const int r = tid >> 6; float s = 0.f;
#pragma unroll
                for (int w = 0; w < 8; ++w) s += red[(w * 3 + r) * 64 + lane];
                ((float*)(ws + WS_MOD))[(size_t)(l * 3 + r) * 6144 + j] = s + a.in[I_BMOD][l * 6144 + j];
            }
            __syncthreads();
        }
    }
}

__device__ __forceinline__ void phase_norm_mod(const float* xl, const float* xc, const float* nw, const float* mod, int sh_off, int sc_off, bf16_t* H, int nrows) {
    const int lane = klane(), gw = blockIdx.x * NWAVES + kwave(), ngw = KGRID * NWAVES;
    for (int row = gw; row < nrows; row += ngw) {
        const float* src = row < ML ? xl + (size_t)row * DM : xc + (size_t)(row - ML) * DM;
        const float* m = mod + (row < ML ? row / NL : 2) * 6144;
        f32x4 v[4]; float ss = 0.f;
#pragma unroll
        for (int j = 0; j < 4; ++j) { v[j] = *(const f32x4*)(src + lane * 4 + 256 * j); ss += v[j].x * v[j].x + v[j].y * v[j].y + v[j].z * v[j].z + v[j].w * v[j].w; }
        const float rstd = rsqrtf(wave_sum(ss) * (1.f / DM) + EPS);
#pragma unroll
        for (int j = 0; j < 4; ++j) {
            const int c = lane * 4 + 256 * j;
            const f32x4 w = *(const f32x4*)(nw + c), sc = *(const f32x4*)(m + sc_off + c), sh = *(const f32x4*)(m + sh_off + c);
            const f32x4 o = (v[j] * rstd * w) * (sc + 1.f) + sh;
            u32x2 pk; pk.x = pk2(o.x, o.y); pk.y = pk2(o.z, o.w);
            *(u32x2*)(H + (size_t)row * DM + c) = pk;
        }
    }
}

template <class Epi> __device__ __forceinline__ void gemm_naive(const bf16_t* A, int lda, const bf16_t* Bt, int M, int N, int K, const Epi& E, LAS unsigned char* lds) {
    LAS float* As = (LAS float*)lds;
    LAS float* Bs = As + 32 * 132;
    const int tid = KTID, ty = tid >> 4, tx = tid & 15;
    const int ntm = M / 128, ntn = N / 64, ntiles = ntm * ntn;
    for (int tile = blockIdx.x; tile < ntiles; tile += KGRID) {
        const int tm = tile / ntn, tn = tile % ntn, row0 = tm * 128, col0 = tn * 64;
        float acc[4][4];
#pragma unroll
        for (int i = 0; i < 4; ++i)
#pragma unroll
            for (int j = 0; j < 4; ++j) acc[i][j] = 0.f;
        for (int k0 = 0; k0 < K; k0 += 32) {
            {
                const int r = tid >> 2, kc = (tid & 3) * 8; float f[8];
                unpack8(*(const u32x4*)(A + (size_t)(row0 + r) * lda + k0 + kc), f);
#pragma unroll
                for (int i = 0; i < 8; ++i) As[(kc + i) * 132 + r] = f[i];
                if (tid < 256) {
                    unpack8(*(const u32x4*)(Bt + (size_t)(col0 + r) * K + k0 + kc), f);
#pragma unroll
                    for (int i = 0; i < 8; ++i) Bs[(kc + i) * 68 + r] = f[i];
                }
            }
            __syncthreads();
#pragma unroll 8
            for (int k = 0; k < 32; ++k) {
                const f32x4 av = *(const LAS f32x4*)(As + k * 132 + ty * 4), bv = *(const LAS f32x4*)(Bs + k * 68 + tx * 4);
#pragma unroll
                for (int i = 0; i < 4; ++i)
#pragma unroll
                    for (int j = 0; j < 4; ++j) acc[i][j] += av[i] * bv[j];
            }
            __syncthreads();
        }
#pragma unroll
        for (int i = 0; i < 4; ++i) E(row0 + ty * 4 + i, col0 + tx * 4, (f32x4){acc[i][0], acc[i][1], acc[i][2], acc[i][3]});
    }
}

__device__ __forceinline__ void st4bf(bf16_t* p, f32x4 v) { u32x2 pk; pk.x = pk2(v.x, v.y); pk.y = pk2(v.z, v.w); *(u32x2*)p = pk; }
__device__ __forceinline__ f32x4 rope4(f32x4 v, int jj, int t, const float* R) {
    const int pos = (jj < 32) ? (t >> 6) : (t & 63), i0 = ((jj & 31) >> 1);
    const f32x4 cs = *(const f32x4*)(R + (pos * 16 + i0) * 2);
    return (f32x4){v.x * cs.x - v.y * cs.y, v.x * cs.y + v.y * cs.x, v.z * cs.z - v.w * cs.w, v.z * cs.w + v.w * cs.z};
}
__device__ __forceinline__ void st8bf(bf16_t* p, f32x4 a, f32x4 b) { u32x4 pk; pk.x = pk2(a.x, a.y); pk.y = pk2(a.z, a.w); pk.z = pk2(b.x, b.y); pk.w = pk2(b.z, b.w); *(u32x4*)p = pk; }
struct EpiInProj { bf16_t* PB; const float* R;
    __device__ __forceinline__ f32x4 xf(int row, int col, f32x4 v) const {
        const int tile = col >> 8;
        if (tile == 2 || tile == 3) { v = (f32x4){gelu_tanh(v.x), gelu_tanh(v.y), gelu_tanh(v.z), gelu_tanh(v.w)}; }
        else if (tile == 5) { v = (f32x4){silu_f(v.x), silu_f(v.y), silu_f(v.z), silu_f(v.w)}; }
        else if (tile == 7) { const int cc = col - C_KR; if (cc < 64 && row < ML) v = rope4(v, cc, row & (NL - 1), R); }
        return v; }
    __device__ __forceinline__ void operator()(int row, int col, f32x4 v) const { st4bf(PB + (size_t)row * INP + col, xf(row, col, v)); }
    __device__ __forceinline__ void op8(int row, int col, f32x4 v0, f32x4 v1) const { st8bf(PB + (size_t)row * INP + col, xf(row, col, v0), xf(row, col + 4, v1)); } };
struct EpiUQ { bf16_t* QB;
    __device__ __forceinline__ void operator()(int row, int col, f32x4 v) const { st4bf(QB + (size_t)row * 768 + col, v * QSCALE); }
    __device__ __forceinline__ void op8(int row, int col, f32x4 v0, f32x4 v1) const { st8bf(QB + (size_t)row * 768 + col, v0 * QSCALE, v1 * QSCALE); } };
struct EpiUKV { bf16_t* KVB;
    __device__ __forceinline__ void operator()(int row, int col, f32x4 v) const { st4bf(KVB + (size_t)row * 1024 + col, v); }
    __device__ __forceinline__ void op8(int row, int col, f32x4 v0, f32x4 v1) const { st8bf(KVB + (size_t)row * 1024 + col, v0, v1); } };
struct EpiResid { const float* xin_l; const float* xin_c; float* xout_l; float* xout_c; const float* mod; int g_off;
    __device__ __forceinline__ void operator()(int row, int col, f32x4 v) const {
        if (row < ML) { const f32x4 g = *(const f32x4*)(mod + (row >> 13) * 6144 + g_off + col), xi = *(const f32x4*)(xin_l + (size_t)row * DM + col);
            *(f32x4*)(xout_l + (size_t)row * DM + col) = xi + g * v;
        } else { const int rc = row - ML; const f32x4 g = *(const f32x4*)(mod + 2 * 6144 + g_off + col), xi = *(const f32x4*)(xin_c + (size_t)rc * DM + col);
            *(f32x4*)(xout_c + (size_t)rc * DM + col) = xi + g * v; }
    }
    __device__ __forceinline__ void op8(int row, int col, f32x4 v0, f32x4 v1) const {
        const float* gp; const float* xi; float* xo;
        if (row < ML) { gp = mod + (row >> 13) * 6144 + g_off + col; xi = xin_l + (size_t)row * DM + col; xo = xout_l + (size_t)row * DM + col; }
        else { const int rc = row - ML; gp = mod + 2 * 6144 + g_off + col; xi = xin_c + (size_t)rc * DM + col; xo = xout_c + (size_t)rc * DM + col; }
        const f32x4 g0 = *(const f32x4*)gp, g1 = *(const f32x4*)(gp + 4), x0 = *(const f32x4*)xi, x1 = *(const f32x4*)(xi + 4);
        *(f32x4*)xo = x0 + g0 * v0; *(f32x4*)(xo + 4) = x1 + g1 * v1;
    } };
struct EpiNull {
    __device__ __forceinline__ void operator()(int row, int col, f32x4 v) const { asm volatile("" :: "v"(v)); }
    __device__ __forceinline__ void op8(int row, int col, f32x4 v0, f32x4 v1) const { asm volatile("" :: "v"(v0), "v"(v1)); } };
struct EpiFF1 { bf16_t* Ah;
    __device__ __forceinline__ void operator()(int row, int col, f32x4 v) const {
        f32x4 r = (f32x4){fmaxf(v.x, 0.f), fmaxf(v.y, 0.f), fmaxf(v.z, 0.f), fmaxf(v.w, 0.f)};
        st4bf(Ah + (size_t)row * FF + col, r * r);
    }
    __device__ __forceinline__ void op8(int row, int col, f32x4 v0, f32x4 v1) const {
        f32x4 r0 = (f32x4){fmaxf(v0.x, 0.f), fmaxf(v0.y, 0.f), fmaxf(v0.z, 0.f), fmaxf(v0.w, 0.f)}, r1 = (f32x4){fmaxf(v1.x, 0.f), fmaxf(v1.y, 0.f), fmaxf(v1.z, 0.f), fmaxf(v1.w, 0.f)};
        st8bf(Ah + (size_t)row * FF + col, r0 * r0, r1 * r1);
    } };

__device__ __forceinline__ void phase_post(const Args& a, int l) {
    unsigned char* ws = a.ws;
    bf16_t* PB = (bf16_t*)(ws + WS_PB); float* LG = (float*)(ws + WS_LG);
    const float* kvnw = a.in[I_KVNW] + l * 256; const float* qnw = a.in[I_QNW] + l * 256;
    const float* snw = a.in[I_SGNW] + l * 256; const float* snb = a.in[I_SGNB] + l * 256;
    const float* wgf = a.in[I_GWF] + l * 16 * 128; const float* bgf = a.in[I_GBF] + l * 128;
    const float* wgb = a.in[I_GWB] + l * 16 * 128; const float* bgb = a.in[I_GBB] + l * 128;
    const int lane = klane(), gw = blockIdx.x * NWAVES + kwave(), ngw = KGRID * NWAVES;
    for (int row = gw; row < MT; row += ngw) {
        bf16_t* pr = PB + (size_t)row * INP;
        const int c = lane * 4;
        { u32x2 w = *(const u32x2*)(pr + C_CKV + c); f32x4 v = {__uint_as_float(w.x << 16), __uint_as_float(w.x & 0xffff0000u), __uint_as_float(w.y << 16), __uint_as_float(w.y & 0xffff0000u)};
          const float rstd = rsqrtf(wave_sum(v.x * v.x + v.y * v.y + v.z * v.z + v.w * v.w) * (1.f / 256.f) + EPS);
          st4bf(pr + C_CKV + c, v * rstd * *(const f32x4*)(kvnw + c)); }
        { u32x2 w = *(const u32x2*)(pr + C_DQ + c); f32x4 v = {__uint_as_float(w.x << 16), __uint_as_float(w.x & 0xffff0000u), __uint_as_float(w.y << 16), __uint_as_float(w.y & 0xffff0000u)};
          const float rstd = rsqrtf(wave_sum(v.x * v.x + v.y * v.y + v.z * v.z + v.w * v.w) * (1.f / 256.f) + EPS);
          st4bf(pr + C_DQ + c, v * rstd * *(const f32x4*)(qnw + c)); }
        { u32x2 w = *(const u32x2*)(pr + C_SV + c); f32x4 v = {__uint_as_float(w.x << 16), __uint_as_float(w.x & 0xffff0000u), __uint_as_float(w.y << 16), __uint_as_float(w.y & 0xffff0000u)};
          const float mu = wave_sum(v.x + v.y + v.z + v.w) * (1.f / 256.f);
          v = v - mu;
          const float rstd = rsqrtf(wave_sum(v.x * v.x + v.y * v.y + v.z * v.z + v.w * v.w) * (1.f / 256.f) + EPS);
          st4bf(pr + C_SV + c, v * rstd * *(const f32x4*)(snw + c) + *(const f32x4*)(snb + c)); }
        if (GLA_NAIVE) { const int o = lane * 4, isb = o >> 7, d = o & 127;
          const float* wg = isb ? wgb : wgf; const float* bg = isb ? bgb : bgf; const bf16_t* gg = pr + (isb ? C_GGB : C_GGF);
          f32x4 z = *(const f32x4*)(bg + d);
#pragma unroll
          for (int r = 0; r < 16; ++r) z += *(const f32x4*)(wg + r * 128 + d) * bf2f(gg[r]);
          *(f32x4*)(LG + (size_t)row * 256 + o) = (f32x4){log_sigmoid_f(z.x), log_sigmoid_f(z.y), log_sigmoid_f(z.z), log_sigmoid_f(z.w)} * (1.f / 16.f); }
    }
}

__device__ __forceinline__ void phase_sgu_naive(const Args& a, int l) {
    unsigned char* ws = a.ws;
    const bf16_t* PB = (const bf16_t*)(ws + WS_PB); bf16_t* Y = (bf16_t*)(ws + WS_HY);
    const float* Ws = a.in[I_SGW] + (size_t)l * 4 * 128 * 128; const float* bs = a.in[I_SGB] + l * 4 * 128;
    const int tid = KTID, i = tid >> 2, eg = (tid & 3) * 16;
    for (int unit = blockIdx.x; unit < (MT / 128) * 4; unit += KGRID) {
        const int cc = unit >> 2, h = unit & 3;
        float acc[16];
#pragma unroll
        for (int e = 0; e < 16; ++e) acc[e] = 0.f;
        const float* wrow = Ws + ((size_t)h * 128 + i) * 128;
        for (int j = 0; j < 128; ++j) {
            const float w = wrow[j];
            const bf16_t* vp = PB + (size_t)(cc * 128 + j) * INP + C_SV + h * 64 + eg;
            float f[8], g[8]; unpack8(*(const u32x4*)vp, f); unpack8(*(const u32x4*)(vp + 8), g);
#pragma unroll
            for (int e = 0; e < 8; ++e) { acc[e] += w * f[e]; acc[8 + e] += w * g[e]; }
        }
        const float bias = bs[h * 128 + i];
        const int row = cc * 128 + i;
        const bf16_t* up = PB + (size_t)row * INP + C_SU + h * 64 + eg;
        float f[8], g[8]; unpack8(*(const u32x4*)up, f); unpack8(*(const u32x4*)(up + 8), g);
        bf16_t* yp = Y + (size_t)row * DM + h * 64 + eg;
        u32x4 o0, o1;
        o0.x = pk2(f[0] * (acc[0] + bias), f[1] * (acc[1] + bias)); o0.y = pk2(f[2] * (acc[2] + bias), f[3] * (acc[3] + bias));
        o0.z = pk2(f[4] * (acc[4] + bias), f[5] * (acc[5] + bias)); o0.w = pk2(f[6] * (acc[6] + bias), f[7] * (acc[7] + bias));
        o1.x = pk2(g[0] * (acc[8] + bias), g[1] * (acc[9] + bias)); o1.y = pk2(g[2] * (acc[10] + bias), g[3] * (acc[11] + bias));
        o1.z = pk2(g[4] * (acc[12] + bias), g[5] * (acc[13] + bias)); o1.w = pk2(g[6] * (acc[14] + bias), g[7] * (acc[15] + bias));
        *(u32x4*)yp = o0; *(u32x4*)(yp + 8) = o1;
    }
}

__device__ __forceinline__ void phase_gla_naive(const Args& a, int l) {
    unsigned char* ws = a.ws;
    const bf16_t* PB = (const bf16_t*)(ws + WS_PB); bf16_t* Y = (bf16_t*)(ws + WS_HY);
    const float* LG = (const float*)(ws + WS_LG); float* OB = (float*)(ws + WS_OB);
    const float* gnw = a.in[I_GNW] + l * 64;
    if (blockIdx.x >= 8 || KTID >= 64) return;
    const int b = blockIdx.x >> 2, h = blockIdx.x & 3, e = KTID;
    const float gw_e = gnw[e];
    for (int dir = 1; dir >= 0; --dir) {
        float S[32];
#pragma unroll
        for (int d = 0; d < 32; ++d) S[d] = 0.f;
        for (int tau = 0; tau < NKEY; ++tau) {
            int row;
            if (dir == 0) row = tau < NC ? ML + b * NC + tau : b * NL + (tau - NC);
            else row = tau < NC ? ML + b * NC + (NC - 1 - tau) : b * NL + (NL - 1 - (tau - NC));
            const bf16_t* pr = PB + (size_t)row * INP;
            const float* lg = LG + (size_t)row * 256 + dir * 128 + h * 32;
            const float v = bf2f(pr[C_GV + h * 64 + e]);
            float o = 0.f;
#pragma unroll
            for (int d = 0; d < 32; ++d) {
                const float kk = bf2f(pr[C_GK + h * 32 + d]), qq = bf2f(pr[C_GQ + h * 32 + d]), al = expf(lg[d]);
                S[d] = al * S[d] + kk * v; o += qq * S[d];
            }
            o *= 0.17677669529663687f;
            if (dir == 1) OB[(size_t)row * 256 + h * 64 + e] = o;
            else {
                o += OB[(size_t)row * 256 + h * 64 + e];
                const float ms = wave_sum(o * o) * (1.f / 64.f);
                const float y = o * rsqrtf(ms + EPS) * gw_e * bf2f(pr[C_GR + h * 64 + e]);
                Y[(size_t)row * DM + 256 + h * 64 + e] = (bf16_t)f2bf(y);
            }
        }
    }
}

typedef short bf16x8 __attribute__((ext_vector_type(8)));
typedef float f32x16 __attribute__((ext_vector_type(16)));
typedef float f32x2_t __attribute__((ext_vector_type(2)));
typedef __bf16 bf16x2_t __attribute__((ext_vector_type(2)));
__device__ __forceinline__ unsigned cvtpk(float lo, float hi) { f32x2_t v = {lo, hi}; bf16x2_t b = __builtin_convertvector(v, bf16x2_t); return __builtin_bit_cast(unsigned, b); }
__device__ __forceinline__ int crow(int r, int hi) { return (r & 3) + 8 * (r >> 2) + 4 * hi; }
constexpr int GLA_WLDS = 17920, GLA_NB = 132;
constexpr size_t WS_BC = WS_LG, WS_GL = WS_OB, WS_GD = 1 * MiB + 512 * 1024;
static_assert((size_t)2112 * 2048 * 4 <= WS_END - WS_OB && WS_GD + (size_t)2112 * 32 * 4 <= WS_WIN && WS_ROPE + 16384 <= WS_GD && WS_WSB + 262144 <= WS_WUKV && WS_WUQ + (size_t)2 * 768 * 256 * 2 <= WS_WSB, "gla ws");
__device__ __forceinline__ int gla_row0(int b, int beta) { return beta < 4 ? ML + b * NC + beta * 64 : b * NL + (beta - 4) * 64; }
#define LDS_FENCE() do { asm volatile("s_waitcnt lgkmcnt(0)" ::: "memory"); __builtin_amdgcn_sched_barrier(0); } while (0)
__device__ __forceinline__ void gla_stage_vt(const bf16_t* pv, LAS bf16_t* VT, int lane) {
#pragma unroll
    for (int c8 = 0; c8 < 8; ++c8) { const u32x4 w = *(const u32x4*)(pv + c8 * 8);
        VT[(c8 * 8 + 0) * 64 + lane] = (bf16_t)(w.x & 0xffffu); VT[(c8 * 8 + 1) * 64 + lane] = (bf16_t)(w.x >> 16);
        VT[(c8 * 8 + 2) * 64 + lane] = (bf16_t)(w.y & 0xffffu); VT[(c8 * 8 + 3) * 64 + lane] = (bf16_t)(w.y >> 16);
        VT[(c8 * 8 + 4) * 64 + lane] = (bf16_t)(w.z & 0xffffu); VT[(c8 * 8 + 5) * 64 + lane] = (bf16_t)(w.z >> 16);
        VT[(c8 * 8 + 6) * 64 + lane] = (bf16_t)(w.w & 0xffffu); VT[(c8 * 8 + 7) * 64 + lane] = (bf16_t)(w.w >> 16); }
}
__device__ __forceinline__ void load32bf(const bf16_t* p, float* f) {
    unpack8(*(const u32x4*)(p), f); unpack8(*(const u32x4*)(p + 8), f + 8); unpack8(*(const u32x4*)(p + 16), f + 16); unpack8(*(const u32x4*)(p + 24), f + 24);
}
__device__ __forceinline__ void phase_gla_local(const Args& a, int l, LAS unsigned char* lds) {
    unsigned char* ws = a.ws;
    const bf16_t* PB = (const bf16_t*)(ws + WS_PB); float* BC = (float*)(ws + WS_BC); float* GL = (float*)(ws + WS_GL); float* GD = (float*)(ws + WS_GD);
    const int lane = klane(), wave = kwave(), gw = wave * KGRID + (int)blockIdx.x, ngw = KGRID * NWAVES    ;
    const int r32 = lane & 31, hi = lane >> 5;
    LAS bf16_t* KT = (LAS bf16_t*)(lds + wave * GLA_WLDS); LAS bf16_t* VT = KT + 32 * 64;
    for (int task = gw; task < 16 * GLA_NB; task += ngw) {
        const int beta = task % GLA_NB, t2 = task / GLA_NB, dir = t2 & 1, h = (t2 >> 1) & 3, b = t2 >> 3;
        const int row = gla_row0(b, beta) + lane; const bf16_t* pr = PB + (size_t)row * INP;
        LDS_FENCE();
        gla_stage_vt(pr + C_GV + h * 64, VT, lane);
        float c[32];
        {
          const float* wg = (dir ? a.in[I_GWB] : a.in[I_GWF]) + l * 16 * 128 + h * 32; const float* bg = (dir ? a.in[I_GBB] : a.in[I_GBF]) + l * 128 + h * 32;
          LAS float* WGL = (LAS float*)(VT + 64 * 64); LAS float* BGL = WGL + 16 * 32;
          { const int r = lane >> 2, d0 = (lane & 3) * 8;
            *(LAS f32x4*)(WGL + r * 32 + d0) = *(const f32x4*)(wg + r * 128 + d0); *(LAS f32x4*)(WGL + r * 32 + d0 + 4) = *(const f32x4*)(wg + r * 128 + d0 + 4);
            if (lane < 32) BGL[lane] = bg[lane]; }
          float gg[16]; unpack8(*(const u32x4*)(pr + (dir ? C_GGB : C_GGF)), gg); unpack8(*(const u32x4*)(pr + (dir ? C_GGB : C_GGF) + 8), gg + 8);
          LDS_FENCE();
#pragma unroll
          for (int d = 0; d < 32; d += 4) { f32x4 z = *(const LAS f32x4*)(BGL + d);
#pragma unroll
              for (int r = 0; r < 16; ++r) z += *(const LAS f32x4*)(WGL + r * 32 + d) * gg[r];
              c[d] = log_sigmoid_fast(z.x) * (1.f / 16.f); c[d + 1] = log_sigmoid_fast(z.y) * (1.f / 16.f); c[d + 2] = log_sigmoid_fast(z.z) * (1.f / 16.f); c[d + 3] = log_sigmoid_fast(z.w) * (1.f / 16.f); } }
        float kk[32]; load32bf(pr + C_GK + h * 32, kk);
#pragma unroll
        for (int d = 0; d < 32; ++d) {
            const float g = c[d], p = wave_prefix_sum(g);
            const float T = __builtin_bit_cast(float, __builtin_amdgcn_readlane(__builtin_bit_cast(int, p), 63));
            const float cc = dir ? (T - p + g) : p;
            c[d] = cc;
            KT[d * 64 + lane] = (bf16_t)(cvtpk(kk[d] * __expf(T - cc), 0.f) & 0xffffu);
            kk[d] = __expf(T);
        }
        if (lane == 0) { float* gd = GD + (size_t)task * 32;
#pragma unroll
            for (int d = 0; d < 32; d += 4) *(f32x4*)(gd + d) = (f32x4){kk[d], kk[d + 1], kk[d + 2], kk[d + 3]}; }
        { float* bc = BC + (size_t)row * 256 + dir * 128 + h * 32;
#pragma unroll
          for (int d = 0; d < 32; d += 4) *(f32x4*)(bc + d) = (f32x4){c[d], c[d + 1], c[d + 2], c[d + 3]}; }
        LDS_FENCE();
        f32x16 acc0 = {}, acc1 = {};
#pragma unroll
        for (int s = 0; s < 4; ++s) {
            const bf16x8 af = *(const LAS bf16x8*)(KT + r32 * 64 + 16 * s + 8 * hi);
            const bf16x8 b0 = *(const LAS bf16x8*)(VT + r32 * 64 + 16 * s + 8 * hi), b1 = *(const LAS bf16x8*)(VT + (32 + r32) * 64 + 16 * s + 8 * hi);
            acc0 = __builtin_amdgcn_mfma_f32_32x32x16_bf16(af, b0, acc0, 0, 0, 0); acc1 = __builtin_amdgcn_mfma_f32_32x32x16_bf16(af, b1, acc1, 0, 0, 0);
        }
        float* gl = GL + (size_t)task * 2048;
#pragma unroll
        for (int r = 0; r < 16; ++r) { gl[crow(r, hi) * 64 + r32] = acc0[r]; gl[crow(r, hi) * 64 + 32 + r32] = acc1[r]; }
    }
}
__device__ __forceinline__ void phase_gla_scan(const Args& a) {
    unsigned char* ws = a.ws; float* GL = (float*)(ws + WS_GL); const float* GD = (const float*)(ws + WS_GD);
    const int idx = ((int)blockIdx.x - (KGRID - 64)) * NTHR + KTID;
    if (idx < 0 || idx >= 16 * 2048) return;
    const int seq = idx >> 11, de = idx & 2047, d = de >> 6, dir = seq & 1;
    float S = 0.f;
    for (int c0 = 0; c0 < GLA_NB; c0 += 12) {
        float Lv[12], Dv[12];
#pragma unroll
        for (int u = 0; u < 12; ++u) { const int c = c0 + u, beta = dir ? (c < 4 ? 3 - c : 135 - c) : c; const size_t slot = (size_t)seq * GLA_NB + beta;
            Lv[u] = GL[slot * 2048 + de]; Dv[u] = GD[slot * 32 + d]; }
#pragma unroll
        for (int u = 0; u < 12; ++u) { const int c = c0 + u, beta = dir ? (c < 4 ? 3 - c : 135 - c) : c; const size_t slot = (size_t)seq * GLA_NB + beta;
            GL[slot * 2048 + de] = S; S = Dv[u] * S + Lv[u]; }
    }
}
template <int DIR> __device__ __forceinline__ void gla_dir(const bf16_t* pr, const float* bc, const float* sin, int h, LAS bf16_t* QS, LAS bf16_t* KS, const LAS bf16_t* VT, int lane,
                                                            f32x16& o00, f32x16& o01, f32x16& o10, f32x16& o11) {
    const int r32 = lane & 31, hi = lane >> 5;
    {
        float c[32], q[32], k[32];
#pragma unroll
        for (int d = 0; d < 32; d += 4) { const f32x4 v = *(const f32x4*)(bc + d); c[d] = v.x; c[d + 1] = v.y; c[d + 2] = v.z; c[d + 3] = v.w; }
        load32bf(pr + C_GQ + h * 32, q); load32bf(pr + C_GK + h * 32, k);
#pragma unroll
        for (int d = 0; d < 32; d += 8) {
            u32x4 wq, wk; float eq[8], ek[8];
#pragma unroll
            for (int i = 0; i < 8; ++i) { eq[i] = q[d + i] * __expf(c[d + i]) * 0.17677669529663687f; ek[i] = k[d + i] * __expf(-c[d + i]); }
            wq.x = cvtpk(eq[0], eq[1]); wq.y = cvtpk(eq[2], eq[3]); wq.z = cvtpk(eq[4], eq[5]); wq.w = cvtpk(eq[6], eq[7]);
            wk.x = cvtpk(ek[0], ek[1]); wk.y = cvtpk(ek[2], ek[3]); wk.z = cvtpk(ek[4], ek[5]); wk.w = cvtpk(ek[6], ek[7]);
            *(LAS u32x4*)(QS + lane * 32 + d) = wq; *(LAS u32x4*)(KS + lane * 32 + d) = wk;
        }
    }
    LDS_FENCE();
    bf16x8 qf[2][2], kf[2][2];
#pragma unroll
    for (int t = 0; t < 2; ++t)
#pragma unroll
        for (int s = 0; s < 2; ++s) { qf[t][s] = *(const LAS bf16x8*)(QS + (32 * t + r32) * 32 + 16 * s + 8 * hi); kf[t][s] = *(const LAS bf16x8*)(KS + (32 * t + r32) * 32 + 16 * s + 8 * hi); }
    LDS_FENCE();
    {
        u32x4 w[4];
#pragma unroll
        for (int d = 0; d < 32; d += 8) {
            float sv[8];
#pragma unroll
            for (int i = 0; i < 8; ++i) sv[i] = sin[(d + i) * 64 + lane];
            w[d >> 3].x = cvtpk(sv[0], sv[1]); w[d >> 3].y = cvtpk(sv[2], sv[3]); w[d >> 3].z = cvtpk(sv[4], sv[5]); w[d >> 3].w = cvtpk(sv[6], sv[7]);
        }
#pragma unroll
        for (int i = 0; i < 4; ++i) *(LAS u32x4*)(QS + lane * 32 + 8 * i) = w[i];
    }
#define GLA_X(tj, ti) __builtin_amdgcn_mfma_f32_32x32x16_bf16(kf[tj][1], qf[ti][1], __builtin_amdgcn_mfma_f32_32x32x16_bf16(kf[tj][0], qf[ti][0], (f32x16){}, 0, 0, 0), 0, 0, 0)
#define GLA_MASK(X) do { _Pragma("unroll") for (int r = 0; r < 16; ++r) { const int jl = crow(r, hi); const bool keep = DIR == 0 ? (jl <= r32) : (jl >= r32); X[r] = keep ? X[r] : 0.f; } } while (0)
#define GLA_XA(X, s) __builtin_bit_cast(bf16x8, (u32x4){cvtpk(X[8 * (s) + 0], X[8 * (s) + 1]), cvtpk(X[8 * (s) + 2], X[8 * (s) + 3]), cvtpk(X[8 * (s) + 4], X[8 * (s) + 5]), cvtpk(X[8 * (s) + 6], X[8 * (s) + 7])})
#define GLA_VF(tj, s, te) __builtin_bit_cast(bf16x8, (u32x4){((const LAS u32x2*)(VT + (32 * (te) + r32) * 64 + 32 * (tj) + 16 * (s) + 4 * hi))->x, ((const LAS u32x2*)(VT + (32 * (te) + r32) * 64 + 32 * (tj) + 16 * (s) + 4 * hi))->y, \
                                                              ((const LAS u32x2*)(VT + (32 * (te) + r32) * 64 + 32 * (tj) + 16 * (s) + 8 + 4 * hi))->x, ((const LAS u32x2*)(VT + (32 * (te) + r32) * 64 + 32 * (tj) + 16 * (s) + 8 + 4 * hi))->y})
#define GLA_PV(X, tj, O0, O1) do { _Pragma("unroll") for (int s = 0; s < 2; ++s) { const bf16x8 xa = GLA_XA(X, s); \
        O0 = __builtin_amdgcn_mfma_f32_32x32x16_bf16(xa, GLA_VF(tj, s, 0), O0, 0, 0, 0); O1 = __builtin_amdgcn_mfma_f32_32x32x16_bf16(xa, GLA_VF(tj, s, 1), O1, 0, 0, 0); } } while (0)
    __builtin_amdgcn_sched_barrier(0);
    { f32x16 X = GLA_X(0, 0); GLA_MASK(X); GLA_PV(X, 0, o00, o01); }
    __builtin_amdgcn_sched_barrier(0);
    { f32x16 X = GLA_X(1, 1); GLA_MASK(X); GLA_PV(X, 1, o10, o11); }
    __builtin_amdgcn_sched_barrier(0);
    if (DIR == 0) { f32x16 X = GLA_X(0, 1); GLA_PV(X, 0, o10, o11); }
    else          { f32x16 X = GLA_X(1, 0); GLA_PV(X, 1, o00, o01); }
    LDS_FENCE();
#pragma unroll
    for (int s = 0; s < 2; ++s) {
        const bf16x8 s0 = *(const LAS bf16x8*)(QS + r32 * 32 + 16 * s + 8 * hi), s1 = *(const LAS bf16x8*)(QS + (32 + r32) * 32 + 16 * s + 8 * hi);
        o00 = __builtin_amdgcn_mfma_f32_32x32x16_bf16(qf[0][s], s0, o00, 0, 0, 0); o01 = __builtin_amdgcn_mfma_f32_32x32x16_bf16(qf[0][s], s1, o01, 0, 0, 0);
        o10 = __builtin_amdgcn_mfma_f32_32x32x16_bf16(qf[1][s], s0, o10, 0, 0, 0); o11 = __builtin_amdgcn_mfma_f32_32x32x16_bf16(qf[1][s], s1, o11, 0, 0, 0);
    }
    LDS_FENCE();
#undef GLA_X
#undef GLA_MASK
#undef GLA_XA
#undef GLA_VF
#undef GLA_PV
}
__device__ __forceinline__ void phase_gla_out(const Args& a, int l, LAS unsigned char* lds, const int w0, const int nw) {
    unsigned char* ws = a.ws;
    const bf16_t* PB = (const bf16_t*)(ws + WS_PB); const float* BC = (const float*)(ws + WS_BC); const float* GL = (const float*)(ws + WS_GL); bf16_t* Y = (bf16_t*)(ws + WS_HY);
    const float* gnw = a.in[I_GNW] + l * 64;
    const int lane = klane(), wave = kwave(), gw = wave * KGRID + (int)blockIdx.x, ngw = KGRID * NWAVES    ;
    const int r32 = lane & 31, hi = lane >> 5;
    LAS bf16_t* QS = (LAS bf16_t*)(lds + wave * GLA_WLDS); LAS bf16_t* KS = QS + 64 * 32; LAS bf16_t* VT = KS + 64 * 32; LAS float* OS = (LAS float*)(lds + wave * GLA_WLDS);
    for (int task = (wave - w0) * KGRID + (int)blockIdx.x; wave >= w0 && wave < w0 + nw && task < 8 * GLA_NB; task += nw * KGRID) {
        const int beta = task % GLA_NB, bh = task / GLA_NB, h = bh & 3, b = bh >> 2;
        const int row = gla_row0(b, beta) + lane; const bf16_t* pr = PB + (size_t)row * INP;
        LDS_FENCE();
        gla_stage_vt(pr + C_GV + h * 64, VT, lane);
        f32x16 o00 = {}, o01 = {}, o10 = {}, o11 = {};
        gla_dir<0>(pr, BC + (size_t)row * 256 + h * 32, GL + ((size_t)(bh * 2 + 0) * GLA_NB + beta) * 2048, h, QS, KS, VT, lane, o00, o01, o10, o11);
        gla_dir<1>(pr, BC + (size_t)row * 256 + 128 + h * 32, GL + ((size_t)(bh * 2 + 1) * GLA_NB + beta) * 2048, h, QS, KS, VT, lane, o00, o01, o10, o11);
#pragma unroll
        for (int r = 0; r < 16; ++r) { const int i = crow(r, hi);
            OS[i * 65 + r32] = o00[r]; OS[i * 65 + 32 + r32] = o01[r]; OS[(32 + i) * 65 + r32] = o10[r]; OS[(32 + i) * 65 + 32 + r32] = o11[r]; }
        LDS_FENCE();
        float ss = 0.f;
#pragma unroll
        for (int e = 0; e < 64; ++e) { const float v = OS[lane * 65 + e]; ss += v * v; }
        const float rstd = rsqrtf(ss * (1.f / 64.f) + EPS);
        bf16_t* yp = Y + (size_t)row * DM + 256 + h * 64;
#pragma unroll
        for (int c8 = 0; c8 < 8; ++c8) { float rr[8]; unpack8(*(const u32x4*)(pr + C_GR + h * 64 + c8 * 8), rr);
            float y[8];
#pragma unroll
            for (int i = 0; i < 8; ++i) y[i] = OS[lane * 65 + c8 * 8 + i] * rstd * gnw[c8 * 8 + i] * rr[i];
            u32x4 w; w.x = cvtpk(y[0], y[1]); w.y = cvtpk(y[2], y[3]); w.z = cvtpk(y[4], y[5]); w.w = cvtpk(y[6], y[7]);
            *(u32x4*)(yp + c8 * 8) = w; }
    }
}

__device__ __forceinline__ void phase_sgu_mfma(const Args& a, int l, LAS unsigned char* lds, const int w0, const int nw) {
    unsigned char* ws = a.ws;
    const bf16_t* PB = (const bf16_t*)(ws + WS_PB); bf16_t* Y = (bf16_t*)(ws + WS_HY);
    const bf16_t* WSB = (const bf16_t*)(ws + WS_WSB) + (size_t)l * 4 * 128 * 128; const float* bs = a.in[I_SGB] + l * 4 * 128;
    const int lane = klane(), wave = kwave(), gw = wave * KGRID + (int)blockIdx.x, ngw = KGRID * NWAVES    ;
    const int r32 = lane & 31, hi = lane >> 5;
    LAS bf16_t* VT = (LAS bf16_t*)(lds + wave * GLA_WLDS);
    for (int task = (wave - w0) * KGRID + (int)blockIdx.x; wave >= w0 && wave < w0 + nw && task < (MT / 128) * 4; task += nw * KGRID) {
        const int cc = task >> 2, h = task & 3;
        LDS_FENCE();
#pragma unroll
        for (int half = 0; half < 2; ++half) { const int j = lane + 64 * half; const bf16_t* pv = PB + (size_t)(cc * 128 + j) * INP + C_SV + h * 64;
#pragma unroll
            for (int c8 = 0; c8 < 8; ++c8) { const u32x4 w = *(const u32x4*)(pv + c8 * 8);
                VT[(c8 * 8 + 0) * 128 + j] = (bf16_t)(w.x & 0xffffu); VT[(c8 * 8 + 1) * 128 + j] = (bf16_t)(w.x >> 16);
                VT[(c8 * 8 + 2) * 128 + j] = (bf16_t)(w.y & 0xffffu); VT[(c8 * 8 + 3) * 128 + j] = (bf16_t)(w.y >> 16);
                VT[(c8 * 8 + 4) * 128 + j] = (bf16_t)(w.z & 0xffffu); VT[(c8 * 8 + 5) * 128 + j] = (bf16_t)(w.z >> 16);
                VT[(c8 * 8 + 6) * 128 + j] = (bf16_t)(w.w & 0xffffu); VT[(c8 * 8 + 7) * 128 + j] = (bf16_t)(w.w >> 16); } }
        LDS_FENCE();
#pragma unroll 1
        for (int ti = 0; ti < 4; ++ti) {
            f32x16 acc0 = {}, acc1 = {};
            const bf16_t* wrow = WSB + ((size_t)h * 128 + 32 * ti + r32) * 128 + 8 * hi;
#pragma unroll
            for (int s = 0; s < 8; ++s) {
                const bf16x8 bw = *(const bf16x8*)(wrow + 16 * s);
                const bf16x8 a0 = *(const LAS bf16x8*)(VT + r32 * 128 + 16 * s + 8 * hi), a1 = *(const LAS bf16x8*)(VT + (32 + r32) * 128 + 16 * s + 8 * hi);
                acc0 = __builtin_amdgcn_mfma_f32_32x32x16_bf16(a0, bw, acc0, 0, 0, 0); acc1 = __builtin_amdgcn_mfma_f32_32x32x16_bf16(a1, bw, acc1, 0, 0, 0);
            }
            const int i = 32 * ti + r32, row = cc * 128 + i; const float bias = bs[h * 128 + i];
            const bf16_t* up = PB + (size_t)row * INP + C_SU + h * 64 + 4 * hi; bf16_t* yp = Y + (size_t)row * DM + h * 64 + 4 * hi;
#pragma unroll
            for (int g = 0; g < 4; ++g) {
                { const u32x2 u = *(const u32x2*)(up + 8 * g); u32x2 o;
                  o.x = cvtpk(__uint_as_float(u.x << 16) * (acc0[4 * g + 0] + bias), __uint_as_float(u.x & 0xffff0000u) * (acc0[4 * g + 1] + bias));
                  o.y = cvtpk(__uint_as_float(u.y << 16) * (acc0[4 * g + 2] + bias), __uint_as_float(u.y & 0xffff0000u) * (acc0[4 * g + 3] + bias));
                  *(u32x2*)(yp + 8 * g) = o; }
                { const u32x2 u = *(const u32x2*)(up + 32 + 8 * g); u32x2 o;
                  o.x = cvtpk(__uint_as_float(u.x << 16) * (acc1[4 * g + 0] + bias), __uint_as_float(u.x & 0xffff0000u) * (acc1[4 * g + 1] + bias));
                  o.y = cvtpk(__uint_as_float(u.y << 16) * (acc1[4 * g + 2] + bias), __uint_as_float(u.y & 0xffff0000u) * (acc1[4 * g + 3] + bias));
                  *(u32x2*)(yp + 32 + 8 * g) = o; }
            }
        }
    }
}

__device__ __forceinline__ void phase_attn_naive(const Args& a, int l, LAS unsigned char* lds) {
    unsigned char* ws = a.ws;
    const bf16_t* QB = (const bf16_t*)(ws + WS_QB); const bf16_t* KVB = (const bf16_t*)(ws + WS_KVB); const bf16_t* PB = (const bf16_t*)(ws + WS_PB); bf16_t* Y = (bf16_t*)(ws + WS_HY);
    const float* ROPE = (const float*)(ws + WS_ROPE);
    LAS float* Qs = (LAS float*)lds;
    LAS float* Ks = Qs + 192 * 64;
    LAS float* Vs = Ks + 96 * 64;
    LAS float* Ps = Vs + 64 * 128;
    const int tid = KTID, ty = tid >> 4, tx = tid & 15;
    const int nunits = 1024 + (l == 0 ? 32 : 0);
    for (int unit = blockIdx.x; unit < nunits; unit += KGRID) {
        int bh, nkeys, orow0;
        if (unit < 1024) { bh = unit >> 7; const int qb = unit & 127; nkeys = NKEY; orow0 = (bh >> 2) * NL + qb * 64; }
        else { const int u = unit - 1024; bh = u >> 2; const int qb = u & 3; nkeys = NC; orow0 = ML + (bh >> 2) * NC + qb * 64; }
        const int h = bh & 3, b = bh >> 2;
        const bf16_t* Qp = QB + (size_t)orow0 * 768 + h * 192;
        __syncthreads();
        for (int idx = tid; idx < 64 * 24; idx += NTHR) { const int r = idx / 24, ch = idx % 24; float f[8]; unpack8(*(const u32x4*)(Qp + (size_t)r * 768 + ch * 8), f);
            if (ch >= 16 && unit < 1024) { const int t = (orow0 + r) & (NL - 1), jj = (ch - 16) * 8;
                const f32x4 r0 = rope4((f32x4){f[0], f[1], f[2], f[3]}, jj, t, ROPE), r1 = rope4((f32x4){f[4], f[5], f[6], f[7]}, jj + 4, t, ROPE);
                f[0] = r0.x; f[1] = r0.y; f[2] = r0.z; f[3] = r0.w; f[4] = r1.x; f[5] = r1.y; f[6] = r1.z; f[7] = r1.w; }
#pragma unroll
            for (int i = 0; i < 8; ++i) Qs[(ch * 8 + i) * 64 + r] = f[i]; }
        float m[2] = {-1e30f, -1e30f}, lsum[2] = {0.f, 0.f}, o[2][8];
#pragma unroll
        for (int r = 0; r < 2; ++r)
#pragma unroll
            for (int c = 0; c < 8; ++c) o[r][c] = 0.f;
        for (int k0 = 0; k0 < nkeys; k0 += 64) {
            const int krow0 = k0 < NC ? ML + b * NC + k0 : b * NL + (k0 - NC);
            float s[2][4];
#pragma unroll
            for (int r = 0; r < 2; ++r)
#pragma unroll
                for (int j = 0; j < 4; ++j) s[r][j] = 0.f;
            for (int dh = 0; dh < 2; ++dh) {
                __syncthreads();
                for (int idx = tid; idx < 64 * 12; idx += NTHR) { const int key = idx / 12, ch = idx % 12; float f[8];
                    const int dcol = dh * 96 + ch * 8;
                    unpack8(dcol < 128 ? *(const u32x4*)(KVB + (size_t)(krow0 + key) * 1024 + h * 256 + dcol) : *(const u32x4*)(PB + (size_t)(krow0 + key) * INP + C_KR + (dcol - 128)), f);
#pragma unroll
                    for (int i = 0; i < 8; ++i) Ks[(ch * 8 + i) * 64 + key] = f[i]; }
                if (dh == 0) {
                    for (int idx = tid; idx < 64 * 16; idx += NTHR) { const int key = idx >> 4, ch = idx & 15; float f[8];
                        unpack8(*(const u32x4*)(KVB + (size_t)(krow0 + key) * 1024 + h * 256 + 128 + ch * 8), f);
#pragma unroll
                        for (int i = 0; i < 8; ++i) Vs[key * 128 + ch * 8 + i] = f[i]; }
                }
                __syncthreads();
#pragma unroll 4
                for (int d = 0; d < 96; ++d) {
                    const float q0 = Qs[(dh * 96 + d) * 64 + 2 * ty], q1 = Qs[(dh * 96 + d) * 64 + 2 * ty + 1];
                    const f32x4 kv = *(const LAS f32x4*)(Ks + d * 64 + 4 * tx);
#pragma unroll
                    for (int j = 0; j < 4; ++j) { s[0][j] += q0 * kv[j]; s[1][j] += q1 * kv[j]; }
                }
            }
#pragma unroll
            for (int r = 0; r < 2; ++r) {
                float mx = fmaxf(fmaxf(s[r][0], s[r][1]), fmaxf(s[r][2], s[r][3]));
                mx = fmaxf(mx, __shfl_xor(mx, 1)); mx = fmaxf(mx, __shfl_xor(mx, 2)); mx = fmaxf(mx, __shfl_xor(mx, 4)); mx = fmaxf(mx, __shfl_xor(mx, 8));
                const float mn = fmaxf(m[r], mx), alpha = exp2f(m[r] - mn);
                float p[4], rs = 0.f;
#pragma unroll
                for (int j = 0; j < 4; ++j) { p[j] = exp2f(s[r][j] - mn); rs += p[j]; Ps[(2 * ty + r) * 65 + 4 * tx + j] = p[j]; }
                rs += __shfl_xor(rs, 1); rs += __shfl_xor(rs, 2); rs += __shfl_xor(rs, 4); rs += __shfl_xor(rs, 8);
                lsum[r] = lsum[r] * alpha + rs; m[r] = mn;
#pragma unroll
                for (int c = 0; c < 8; ++c) o[r][c] *= alpha;
            }
            __syncthreads();
#pragma unroll 4
            for (int j = 0; j < 64; ++j) {
                const float p0 = Ps[(2 * ty) * 65 + j], p1 = Ps[(2 * ty + 1) * 65 + j];
                const f32x4 v0 = *(const LAS f32x4*)(Vs + j * 128 + 8 * tx), v1 = *(const LAS f32x4*)(Vs + j * 128 + 8 * tx + 4);
#pragma unroll
                for (int c = 0; c < 4; ++c) { o[0][c] += p0 * v0[c]; o[0][4 + c] += p0 * v1[c]; o[1][c] += p1 * v0[c]; o[1][4 + c] += p1 * v1[c]; }
            }
        }
#pragma unroll
        for (int r = 0; r < 2; ++r) {
            const float il = 1.f / lsum[r];
            u32x4 w; w.x = pk2(o[r][0] * il, o[r][1] * il); w.y = pk2(o[r][2] * il, o[r][3] * il); w.z = pk2(o[r][4] * il, o[r][5] * il); w.w = pk2(o[r][6] * il, o[r][7] * il);
            *(u32x4*)(Y + (size_t)(orow0 + 2 * ty + r) * DM + 512 + h * 128 + 8 * tx) = w;
        }
    }
}

namespace att {
using s16x4 = __attribute__((ext_vector_type(4))) short;
constexpr int QBLK = 32, KVBLK = 64;
constexpr int SHM_V = KVBLK * 128 * 2, SHM_K = KVBLK * 192 * 2, SHM_SCR = 2 * SHM_V + 2 * SHM_K, SHM_QL = SHM_SCR + NWAVES * 64 * 4, SHM_ATTN = SHM_QL + NWAVES * ATT_NQL * 1024;
constexpr float THR2 = 11.5f;
#define KSWZ(row, colB) ((row) * 384 + ((colB) ^ ((((row) >> 1) & 7) << 4)))
#define SBAR() __builtin_amdgcn_sched_barrier(0)
__device__ __forceinline__ float rowmax32(const f32x16& p0, const f32x16& p1) {
  float a = fmaxf(fmaxf(p0[0], p0[1]), p1[0]), b = fmaxf(fmaxf(p0[2], p0[3]), p1[1]); a = fmaxf(fmaxf(a, p1[2]), p1[3]);
#pragma unroll
  for (int r = 4; r < 16; r += 4) { a = fmaxf(fmaxf(a, p0[r]), p0[r + 1]); b = fmaxf(fmaxf(b, p0[r + 2]), p0[r + 3]); a = fmaxf(fmaxf(a, p1[r]), p1[r + 1]); b = fmaxf(fmaxf(b, p1[r + 2]), p1[r + 3]); }
  float m = fmaxf(a, b);
  auto rr = __builtin_amdgcn_permlane32_swap(__float_as_uint(m), __float_as_uint(m), false, false);
  return fmaxf(__uint_as_float(rr[0]), __uint_as_float(rr[1]));
}
template <bool FIRST> __device__ __forceinline__ void partialSM(f32x16& p0, f32x16& p1, float& mhat, f32x16& negm, float& alpha) {
  const float rm = rowmax32(p0, p1);
  alpha = 1.f;
  if (FIRST || __builtin_expect(__any(rm > THR2), 0)) {
    const float dl = FIRST ? rm : fmaxf(rm, 0.f);
    mhat += dl;
#pragma unroll
    for (int r = 0; r < 16; ++r) { p0[r] -= dl; p1[r] -= dl; }
#pragma unroll
    for (int r = 0; r < 16; ++r) negm[r] = -mhat;
    if (!FIRST) alpha = __builtin_amdgcn_exp2f(-dl);
  }
#pragma unroll
  for (int r = 0; r < 16; ++r) p0[r] = __builtin_amdgcn_exp2f(p0[r]);
}
__device__ __forceinline__ void finishSM(f32x16& p0, f32x16& p1, float alpha, float& l_reg, bf16x8& pa0, bf16x8& pa1, bf16x8& pa2, bf16x8& pa3) {
#pragma unroll
  for (int r = 0; r < 16; ++r) p1[r] = __builtin_amdgcn_exp2f(p1[r]);
  float ps = 0;
#pragma unroll
  for (int r = 0; r < 16; ++r) ps += p0[r];
#pragma unroll
  for (int r = 0; r < 16; ++r) ps += p1[r];
  { auto rr = __builtin_amdgcn_permlane32_swap(__float_as_uint(ps), __float_as_uint(ps), false, false);
    ps = __uint_as_float(rr[0]) + __uint_as_float(rr[1]); }
  l_reg = l_reg * alpha + ps;
#define PK4(P, BASE, OUT) do { unsigned a0 = cvtpk(P[BASE + 0], P[BASE + 1]), a1 = cvtpk(P[BASE + 2], P[BASE + 3]);   \
    unsigned b0 = cvtpk(P[BASE + 4], P[BASE + 5]), b1 = cvtpk(P[BASE + 6], P[BASE + 7]);                              \
    auto r0 = __builtin_amdgcn_permlane32_swap(a0, b0, false, false); auto r1 = __builtin_amdgcn_permlane32_swap(a1, b1, false, false); \
    u32x4 w = {r0[0], r1[0], r0[1], r1[1]}; OUT = __builtin_bit_cast(bf16x8, w); } while (0)
  PK4(p0, 0, pa0); PK4(p0, 8, pa1); PK4(p1, 0, pa2); PK4(p1, 8, pa3);
#undef PK4
}
constexpr int NQR = 12 - ATT_NQL;
#define ATT_KRD(K0, K1, d0, KB) asm volatile("ds_read_b128 %0, %2 offset:%3\n\tds_read_b128 %1, %2 offset:%4" : "=&v"(K0), "=&v"(K1) : "v"(ka[(d0) & 3]), "i"((KB) + ((d0) >> 2) * 128), "i"((KB) + ((d0) >> 2) * 128 + 12288) : "memory")
#define ATT_QRD(Q, d0) asm volatile("ds_read_b128 %0, %1 offset:%2" : "=&v"(Q) : "v"(qla), "i"(((d0) - NQR) * 1024) : "memory")
template <int KB> __device__ __forceinline__ void qkt(f32x16& p0, f32x16& p1, const unsigned (&ka)[4], const bf16x8* qr, unsigned qla, const f32x16& negm) {
  p0 = negm; p1 = negm;
  bf16x8 kx0, kx1, ky0, ky1, qx, qy;
  ATT_KRD(kx0, kx1, 0, KB); if (0 >= NQR) ATT_QRD(qx, 0);
#pragma unroll
  for (int d0 = 0; d0 < 12; d0 += 2) {
    ATT_KRD(ky0, ky1, d0 + 1, KB); if (d0 + 1 >= NQR) ATT_QRD(qy, d0 + 1);
    if (d0 + 1 >= NQR) { if (d0 >= NQR) asm volatile("s_waitcnt lgkmcnt(3)" : "+v"(kx0), "+v"(kx1), "+v"(qx)); else asm volatile("s_waitcnt lgkmcnt(3)" : "+v"(kx0), "+v"(kx1)); }
    else asm volatile("s_waitcnt lgkmcnt(2)" : "+v"(kx0), "+v"(kx1));
    { const bf16x8 qf = d0 < NQR ? qr[d0 < NQR ? d0 : 0] : qx;
      p0 = __builtin_amdgcn_mfma_f32_32x32x16_bf16(kx0, qf, p0, 0, 0, 0); p1 = __builtin_amdgcn_mfma_f32_32x32x16_bf16(kx1, qf, p1, 0, 0, 0); }
    if (d0 + 2 < 12) { ATT_KRD(kx0, kx1, d0 + 2, KB); if (d0 + 2 >= NQR) ATT_QRD(qx, d0 + 2);
      if (d0 + 2 >= NQR) { if (d0 + 1 >= NQR) asm volatile("s_waitcnt lgkmcnt(3)" : "+v"(ky0), "+v"(ky1), "+v"(qy)); else asm volatile("s_waitcnt lgkmcnt(3)" : "+v"(ky0), "+v"(ky1)); }
      else asm volatile("s_waitcnt lgkmcnt(2)" : "+v"(ky0), "+v"(ky1)); }
    else { if (d0 + 1 >= NQR) asm volatile("s_waitcnt lgkmcnt(0)" : "+v"(ky0), "+v"(ky1), "+v"(qy)); else asm volatile("s_waitcnt lgkmcnt(0)" : "+v"(ky0), "+v"(ky1)); }
    { const bf16x8 qf = d0 + 1 < NQR ? qr[d0 + 1 < NQR ? d0 + 1 : 0] : qy;
      p0 = __builtin_amdgcn_mfma_f32_32x32x16_bf16(ky0, qf, p0, 0, 0, 0); p1 = __builtin_amdgcn_mfma_f32_32x32x16_bf16(ky1, qf, p1, 0, 0, 0); }
  }
}
__device__ __forceinline__ int v_st(int k, int c) { const int kk = (k & ~0xC) | ((k & 4) << 1) | ((k & 8) >> 1); return ((kk >> 3) * 4 + (c >> 5)) * 512 + ((kk & 7) * 32 + (c & 31)) * 2; }
__device__ __forceinline__ int v_rd_base(int lane) { return ((lane & 3) << 3) | (((lane >> 2) & 3) << 6) | (((lane >> 4) & 1) << 5) | (((lane >> 5) & 1) << 8); }
constexpr int v_rd_off(int d0, int ks, int half) { return d0 * 512 + ks * 4096 + half * 2048; }
template <int OFF> __device__ __forceinline__ s16x4 tr_read(int vb) {
  s16x4 r; asm volatile("ds_read_b64_tr_b16 %0, %1 offset:%2" : "=&v"(r) : "v"(vb), "i"(OFF) : "memory"); return r;
}
template <int D0> __device__ __forceinline__ void pv_one(f32x16& od, int vb, bf16x8 pa0, bf16x8 pa1, bf16x8 pa2, bf16x8 pa3) {
  const s16x4 l0 = tr_read<v_rd_off(D0, 0, 0)>(vb), h0 = tr_read<v_rd_off(D0, 0, 1)>(vb), l1 = tr_read<v_rd_off(D0, 1, 0)>(vb), h1 = tr_read<v_rd_off(D0, 1, 1)>(vb);
  const s16x4 l2 = tr_read<v_rd_off(D0, 2, 0)>(vb), h2 = tr_read<v_rd_off(D0, 2, 1)>(vb), l3 = tr_read<v_rd_off(D0, 3, 0)>(vb), h3 = tr_read<v_rd_off(D0, 3, 1)>(vb);
  asm volatile("s_waitcnt lgkmcnt(0)" ::: "memory"); SBAR();
#define PK(L, H) (bf16x8){L[0], L[1], L[2], L[3], H[0], H[1], H[2], H[3]}
  od = __builtin_amdgcn_mfma_f32_32x32x16_bf16(pa0, PK(l0, h0), od, 0, 0, 0);
  od = __builtin_amdgcn_mfma_f32_32x32x16_bf16(pa1, PK(l1, h1), od, 0, 0, 0);
  od = __builtin_amdgcn_mfma_f32_32x32x16_bf16(pa2, PK(l2, h2), od, 0, 0, 0);
  od = __builtin_amdgcn_mfma_f32_32x32x16_bf16(pa3, PK(l3, h3), od, 0, 0, 0);
#undef PK
}
__device__ __forceinline__ void pv_d0(f32x16* o, int vb, bf16x8 pa0, bf16x8 pa1, bf16x8 pa2, bf16x8 pa3) {
  pv_one<0>(o[0], vb, pa0, pa1, pa2, pa3); pv_one<1>(o[1], vb, pa0, pa1, pa2, pa3); pv_one<2>(o[2], vb, pa0, pa1, pa2, pa3); pv_one<3>(o[3], vb, pa0, pa1, pa2, pa3);
}
template <int ABL> __device__ __forceinline__ void unit(const bf16_t* __restrict__ QB, const bf16_t* __restrict__ KVB, const bf16_t* __restrict__ PB, const float* __restrict__ ROPE, bf16_t* __restrict__ Y,
                                     int qrow0, int b, int h, int nkeys, bool ropeq, LAS unsigned char* lds) {
  const int wid = kwave(), lane = klane(), tid = wid * 64 + lane, r32 = lane & 31, hi = lane >> 5;
  LAS unsigned char* V_lds = lds; LAS unsigned char* K_lds = lds + 2 * SHM_V;
  LAS float* wsc = (LAS float*)(lds + SHM_SCR) + wid * 64; LAS float* li_l = wsc; LAS float* al_l = wsc + 32;
  LAS unsigned char* qlw = lds + SHM_QL + wid * (ATT_NQL * 1024); const LAS unsigned char* ql = qlw + lane * 16;
  float mhat = 0.f, l_reg = 0; f32x16 o[4] = {}; f32x16 negm = {}; bf16x8 qr[NQR];
  {
    const int qrow = qrow0 + wid * QBLK + r32;
    const bf16_t* Qw = QB + (size_t)qrow * 768 + h * 192 + hi * 8;
#pragma unroll
    for (int d0 = 0; d0 < 12; ++d0) {
      u32x4 w = *(const u32x4*)(Qw + d0 * 16);
      if (d0 >= 8 && ropeq) { float f[8]; unpack8(w, f); const int t = qrow & (NL - 1), jj = (d0 - 8) * 16 + hi * 8;
        const f32x4 r0 = rope4((f32x4){f[0], f[1], f[2], f[3]}, jj, t, ROPE), r1 = rope4((f32x4){f[4], f[5], f[6], f[7]}, jj + 4, t, ROPE);
        w.x = cvtpk(r0.x, r0.y); w.y = cvtpk(r0.z, r0.w); w.z = cvtpk(r1.x, r1.y); w.w = cvtpk(r1.z, r1.w); }
      if (d0 < NQR) qr[d0 < NQR ? d0 : 0] = __builtin_bit_cast(bf16x8, w); else *(LAS u32x4*)(qlw + (d0 - NQR) * 1024 + lane * 16) = w;
    }
  }
  const int sr = tid >> 4, sc = (tid & 15) * 8, vst0 = v_st(sr, sc), vst1 = v_st(32 + sr, sc);
  const int krw = tid >> 3, kcg = tid & 7;
  const int kw0 = KSWZ(krw, kcg * 16), kw1 = KSWZ(krw, (kcg + 8) * 16), kw2 = KSWZ(krw, (kcg + 16) * 16);
  const int vb0 = (int)(uintptr_t)V_lds + v_rd_base(lane);
  unsigned ka[4];
#pragma unroll
  for (int c = 0; c < 4; ++c) ka[c] = (unsigned)(uintptr_t)K_lds + r32 * 384 + (((c << 5) | (hi << 4)) ^ (((r32 >> 1) & 7) << 4));
  const unsigned qla = (unsigned)(uintptr_t)ql;
  u32x4 sv0, sv1, sk0, sk1, sk2;
#define KROW(k0) ((k0) < NC ? ML + b * NC + (k0) : b * NL + ((k0) - NC))
  const int gv0 = sr * 1024 + h * 256 + 128 + sc, gv1 = gv0 + 32 * 1024, gk0 = krw * 1024 + h * 256 + kcg * 8, gk1 = gk0 + 64, gk2 = krw * INP + C_KR + kcg * 8;
#define KLOAD(k0) do { const int kr_ = __builtin_amdgcn_readfirstlane(KROW(k0)); const bf16_t* kvb_ = KVB + (size_t)kr_ * 1024; const bf16_t* pb_ = PB + (size_t)kr_ * INP; \
    sk0 = *(const u32x4*)(kvb_ + gk0); sk1 = *(const u32x4*)(kvb_ + gk1); sk2 = *(const u32x4*)(pb_ + gk2); } while (0)
#define VLOAD(k0) do { const int kr_ = __builtin_amdgcn_readfirstlane(KROW(k0)); const bf16_t* kvb_ = KVB + (size_t)kr_ * 1024; \
    sv0 = *(const u32x4*)(kvb_ + gv0); sv1 = *(const u32x4*)(kvb_ + gv1); } while (0)
#define KWRITE(bf) do { *(LAS u32x4*)(K_lds + (bf) * SHM_K + kw0) = sk0; *(LAS u32x4*)(K_lds + (bf) * SHM_K + kw1) = sk1; *(LAS u32x4*)(K_lds + (bf) * SHM_K + kw2) = sk2; } while (0)
#define VWRITE(bf) do { *(LAS u32x4*)(V_lds + (bf) * SHM_V + vst0) = sv0; *(LAS u32x4*)(V_lds + (bf) * SHM_V + vst1) = sv1; } while (0)
#define RESC(a) do { if (__any((a) < 1.f)) { if (hi == 0) al_l[r32] = (a); asm volatile("s_waitcnt lgkmcnt(0)" ::: "memory"); \
    _Pragma("unroll") for (int d = 0; d < 4; ++d) _Pragma("unroll") for (int r = 0; r < 16; ++r) o[d][r] *= al_l[crow(r, hi)]; } } while (0)
  f32x16 pA0, pA1, pB0, pB1; float mnA, mnB, alA, alB; bf16x8 pa0, pa1, pa2, pa3; const int NT = nkeys / KVBLK;
#define QKT0(P0, P1) do { if constexpr (ABL == 2) { P0 = f32x16{}; P1 = f32x16{}; asm volatile("" : "+v"(P0), "+v"(P1)); } else qkt<0>(P0, P1, ka, qr, qla, negm); } while (0)
#define QKT1(P0, P1) do { if constexpr (ABL == 2) { P0 = f32x16{}; P1 = f32x16{}; asm volatile("" : "+v"(P0), "+v"(P1)); } else qkt<SHM_K>(P0, P1, ka, qr, qla, negm); } while (0)
#define PV(VB) do { if constexpr (ABL == 3) { asm volatile("" : "+v"(o[0]), "+v"(o[1]), "+v"(o[2]), "+v"(o[3]) : "v"(pa0), "v"(pa1), "v"(pa2), "v"(pa3)); } else pv_d0(o, VB, pa0, pa1, pa2, pa3); } while (0)
#define PSM(P0, P1, MN, AL) do { if constexpr (ABL == 4) { MN = 0.f; AL = 1.f; asm volatile("" : "+v"(P0), "+v"(P1)); } else partialSM<false>(P0, P1, mhat, negm, AL); } while (0)
#define PSM0(P0, P1, MN, AL) partialSM<true>(P0, P1, mhat, negm, AL)
#define FSM(P0, P1, AL) do { if constexpr (ABL == 4) { u32x4 w0_ = {__float_as_uint(P0[0]), __float_as_uint(P0[1]), __float_as_uint(P0[2]), __float_as_uint(P0[3])}, w1_ = {__float_as_uint(P1[0]), __float_as_uint(P1[1]), __float_as_uint(P1[2]), __float_as_uint(P1[3])}; \
      pa0 = __builtin_bit_cast(bf16x8, w0_); pa1 = __builtin_bit_cast(bf16x8, w1_); pa2 = pa0; pa3 = pa1; l_reg += AL; } else finishSM(P0, P1, AL, l_reg, pa0, pa1, pa2, pa3); } while (0)
  KLOAD(0); KWRITE(0); __syncthreads();
  if (wid >= 4) __syncthreads();
  SBAR(); KLOAD(KVBLK); SBAR(); QKT0(pA0, pA1); SBAR(); KWRITE(1); __syncthreads();
  SBAR(); VLOAD(0); SBAR(); PSM0(pA0, pA1, mnA, alA); SBAR(); VWRITE(0); __syncthreads();
  for (int j = 1; j + 1 < NT; j += 2) {
    SBAR(); if constexpr (ABL != 1) KLOAD((j + 1) * KVBLK); SBAR(); QKT1(pB0, pB1); FSM(pA0, pA1, alA); SBAR(); if constexpr (ABL != 1) KWRITE(0); __syncthreads();
    SBAR(); if constexpr (ABL != 1) VLOAD(j * KVBLK); SBAR(); PV(vb0); PSM(pB0, pB1, mnB, alB); RESC(alB); SBAR(); if constexpr (ABL != 1) VWRITE(1); __syncthreads();
    SBAR(); if constexpr (ABL != 1) KLOAD((j + 2) * KVBLK); SBAR(); QKT0(pA0, pA1); FSM(pB0, pB1, alB); SBAR(); if constexpr (ABL != 1) KWRITE(1); __syncthreads();
    SBAR(); if constexpr (ABL != 1) VLOAD((j + 1) * KVBLK); SBAR(); PV(vb0 + SHM_V); PSM(pA0, pA1, mnA, alA); RESC(alA); SBAR(); if constexpr (ABL != 1) VWRITE(0); __syncthreads();
  }
  SBAR(); QKT1(pB0, pB1); FSM(pA0, pA1, alA); SBAR(); __syncthreads();
  SBAR(); VLOAD((NT - 1) * KVBLK); SBAR(); PV(vb0); PSM(pB0, pB1, mnB, alB); RESC(alB); SBAR(); VWRITE(1); __syncthreads();
  if (wid < 4) __syncthreads();
  FSM(pB0, pB1, alB); SBAR();
  PV(vb0 + SHM_V);
#undef QKT0
#undef PSM0
#undef QKT1
#undef PV
#undef PSM
#undef FSM
  if (hi == 0) li_l[r32] = l_reg; asm volatile("s_waitcnt lgkmcnt(0)" ::: "memory");
  float rli[16];
#pragma unroll
  for (int r = 0; r < 16; ++r) rli[r] = __builtin_amdgcn_rcpf(li_l[crow(r, hi)]);
  bf16_t* Ow = Y + (size_t)(qrow0 + wid * QBLK) * DM + 512 + h * 128;
#pragma unroll
  for (int r = 0; r < 16; ++r) { const int orow = crow(r, hi);
#pragma unroll
    for (int d0 = 0; d0 < 4; ++d0) { const float val = o[d0][r] * rli[r]; if constexpr (ABL == 0) Ow[(size_t)orow * DM + d0 * 32 + r32] = (bf16_t)(cvtpk(val, 0.f) & 0xffffu); else asm volatile("" :: "v"(val)); } }
#undef KROW
#undef KLOAD
#undef VLOAD
#undef KWRITE
#undef VWRITE
#undef RESC
}
#undef KSWZ
#undef SBAR
}
template <int ABL> __device__ __forceinline__ void phase_attn_mfma(const Args& a, int l, LAS unsigned char* lds) {
    unsigned char* ws = a.ws;
    const bf16_t* QB = (const bf16_t*)(ws + WS_QB); const bf16_t* KVB = (const bf16_t*)(ws + WS_KVB); const bf16_t* PB = (const bf16_t*)(ws + WS_PB); bf16_t* Y = (bf16_t*)(ws + WS_HY);
    const float* ROPE = (const float*)(ws + WS_ROPE);
    const int nunits = 256 + (l == 0 ? 8 : 0);
    for (int u = blockIdx.x; u < nunits; u += KGRID) {
        __syncthreads();
        if (u < 256) { const int bh = u & 7, qb = u >> 3, b = bh >> 2, h = bh & 3; att::unit<ABL>(QB, KVB, PB, ROPE, Y, b * NL + qb * 256, b, h, NKEY, true, lds); }
        else { const int bh = u - 256, b = bh >> 2, h = bh & 3; att::unit<ABL>(QB, KVB, PB, ROPE, Y, ML + b * NC, b, h, NC, false, lds); }
    }
}

namespace pg8 {
#define PG8_LAS __attribute__((address_space(3)))
typedef unsigned short bf16_t;
typedef short bf16x8 __attribute__((ext_vector_type(8)));
typedef float f32x4 __attribute__((ext_vector_type(4)));
typedef unsigned u32x4 __attribute__((ext_vector_type(4)));
constexpr int BM = 256, BK = 64, HALF = 128, HTB = HALF * BK * 2  , STAGE_BYTES = 8 * HTB, NXCD = 8, WGM = 8;

__host__ __device__ __forceinline__ int lds_byte(int r, int c) { const int st = (r >> 4) * 2 + (c >> 5), rr = r & 15, cc = c & 31, ob = rr * 64 + cc * 2; return st * 1024 + (ob ^ (((ob >> 9) & 1) << 5)); }
__host__ __device__ __forceinline__ void stage_rc(int b, int& R, int& C) { const int st = b / 1024, sb = b % 1024, swz = sb ^ (((sb >> 9) & 1) << 5); R = (st >> 1) * 16 + swz / 64; C = (st & 1) * 32 + (swz % 64) / 2; }
__host__ __device__ __forceinline__ int perm32(int rho) { const int n = rho >> 4, i = rho & 15; return 8 * (i >> 2) + 4 * n + (i & 3); }

struct Unit { int pm, pn; };
struct Gemm { const bf16_t* A; int lda; const bf16_t* Bt; int M, N, K; };

struct StaticOrder {
    int nM, nN, nwg, G, c;
    __host__ __device__ void init(int M, int N, int G_, int c_) { nM = M / BM; nN = N / BM; nwg = nM * nN; G = G_; c = c_; }
    __host__ __device__ bool next(int i, Unit& u) const {
        const long L = (long)i * G + c; if (L >= nwg) return false;
        int wgid = (int)L; { const int q = nwg / NXCD, r = nwg % NXCD, xcd = wgid % NXCD, off = wgid / NXCD; wgid = (xcd < r ? xcd * (q + 1) : r * (q + 1) + (xcd - r) * q) + off; }
        const int nig = WGM * nN, gid = wgid / nig, fm = gid * WGM, gsz = (nM - fm) < WGM ? (nM - fm) : WGM;
        u.pm = fm + ((wgid % nig) % gsz); u.pn = (wgid % nig) / gsz; return true;
    }
    __device__ __forceinline__ void a_ready(const Unit&) const {}
    __device__ __forceinline__ void done(const Unit&) const {}
};
template <class Epi, class Sched, bool ALIGN_EPI = false, bool SP2 = false>
__device__ __forceinline__ void gemm_phase(PG8_LAS unsigned char* lds, const Gemm g, const Sched& S, const Epi& E) {
    const int wid = kwave(), lane = klane(), tid = wid * 64 + lane, wr = wid >> 2, wc = wid & 3, fr = lane & 15, fq = lane >> 4;
    const int K = g.K, nt = K / BK;
    unsigned voffA[2], voffB[2];
#pragma unroll
    for (int i = 0; i < 2; ++i) { int R, C; stage_rc(tid * 16 + i * 8192, R, C); const int Rb = Epi::PERM ? ((R & ~31) + perm32(R & 31)) : R;
        voffA[i] = (unsigned)(R * g.lda + C) * 2u; voffB[i] = (unsigned)(Rb * K + C) * 2u; }
    const size_t kstep = (size_t)(BK * 2);
    const size_t hstepA = (size_t)HALF * g.lda * 2, hstepB = (size_t)HALF * K * 2;
    const size_t tstepA = 2 * hstepA, tstepB = 2 * hstepB;
    const unsigned ldsw = (unsigned)wid * 1024u;
    const int aoff = lds_byte(wr * 64 + fr, fq * 8), boff = lds_byte(wc * 32 + fr, fq * 8);
#define PG8_SA(b, h) (((b) * 2 + (h)) * HTB)
#define PG8_SB(b, h) ((4 + (b) * 2 + (h)) * HTB)
#define PG8_STAGE(bufoff, gbase, voff) do { _Pragma("unroll") for (int _i = 0; _i < 2; ++_i) \
        __builtin_amdgcn_global_load_lds((const unsigned*)((const char*)(gbase) + (voff)[_i]), (PG8_LAS unsigned*)(lds + (bufoff) + ldsw + _i * 8192), 16, 0, 0); } while (0)
#define PG8_LDA(dst, b, h) do { _Pragma("unroll") for (int m = 0; m < 4; ++m) _Pragma("unroll") for (int k = 0; k < 2; ++k) dst[m][k] = *(const PG8_LAS bf16x8*)(lds + PG8_SA(b, h) + aoff + m * 2048 + k * 1024); } while (0)
#define PG8_LDB(dst, b, h) do { _Pragma("unroll") for (int n = 0; n < 2; ++n) _Pragma("unroll") for (int k = 0; k < 2; ++k) dst[n][k] = *(const PG8_LAS bf16x8*)(lds + PG8_SB(b, h) + boff + n * 2048 + k * 1024); } while (0)
#define PG8_MMA(ai, bj, At, Bt) do { __builtin_amdgcn_s_setprio(1); _Pragma("unroll") for (int m = 0; m < 4; ++m) _Pragma("unroll") for (int n = 0; n < 2; ++n) _Pragma("unroll") for (int k = 0; k < 2; ++k) \
        acc[ai][bj][m][n] = __builtin_amdgcn_mfma_f32_16x16x32_bf16(Bt[n][k], At[m][k], acc[ai][bj][m][n], 0, 0, 0); __builtin_amdgcn_s_setprio(0); } while (0)
#define PG8_WAIT_V(n) asm volatile("s_waitcnt vmcnt(" #n ")" ::: "memory")
#define PG8_WAIT_L(n) asm volatile("s_waitcnt lgkmcnt(" #n ")" ::: "memory")
#define PG8_BAR __builtin_amdgcn_s_barrier()
#define PG8_SCHED __builtin_amdgcn_sched_barrier(0)
    Unit cur, nxt; int ui = 0;
    if (!S.next(0, cur)) return;
    f32x4 acc[2][2][4][2];
#pragma unroll
    for (int a = 0; a < 2; ++a)
#pragma unroll
        for (int b = 0; b < 2; ++b)
#pragma unroll
            for (int m = 0; m < 4; ++m)
#pragma unroll
                for (int n = 0; n < 2; ++n) acc[a][b][m][n] = (f32x4){0.f, 0.f, 0.f, 0.f};
    bf16x8 At[4][2], B0[2][2], B1[2][2];
    const char* cA = (const char*)g.A + (size_t)cur.pm * tstepA; const char* cB = (const char*)g.Bt + (size_t)cur.pn * tstepB;
    S.a_ready(cur);
    if constexpr (SP2) {
        PG8_STAGE(PG8_SB(0, 0), cB, voffB); PG8_STAGE(PG8_SB(0, 1), cB + hstepB, voffB); PG8_STAGE(PG8_SA(0, 0), cA, voffA); PG8_STAGE(PG8_SA(0, 1), cA + hstepA, voffA);
        if (wr == 1) PG8_BAR;
        PG8_WAIT_V(2); PG8_BAR;
        PG8_STAGE(PG8_SB(1, 0), cB + kstep, voffB); PG8_STAGE(PG8_SA(1, 0), cA + kstep, voffA); PG8_STAGE(PG8_SB(1, 1), cB + hstepB + kstep, voffB);
        PG8_WAIT_V(6); PG8_BAR;
    } else {
        PG8_STAGE(PG8_SB(0, 0), cB, voffB); PG8_STAGE(PG8_SA(0, 0), cA, voffA); PG8_STAGE(PG8_SB(0, 1), cB + hstepB, voffB); PG8_STAGE(PG8_SA(0, 1), cA + hstepA, voffA);
        if (wr == 1) PG8_BAR;
        PG8_WAIT_V(4); PG8_BAR;
        PG8_STAGE(PG8_SB(1, 0), cB + kstep, voffB); PG8_STAGE(PG8_SA(1, 0), cA + kstep, voffA); PG8_STAGE(PG8_SB(1, 1), cB + hstepB + kstep, voffB);
        PG8_WAIT_V(6); PG8_BAR;
    }
    for (;;) {
        const bool has_next = S.next(ui + 1, nxt);
        const char* nA = has_next ? (const char*)g.A + (size_t)nxt.pm * tstepA : cA; const char* nB = has_next ? (const char*)g.Bt + (size_t)nxt.pn * tstepB : cB;
#pragma nounroll
        for (int t = 0; t < nt; t += 2) {
            const bool last = (t == nt - 2);
            const char* a1 = cA + (size_t)(t + 1) * kstep;
            const char* a2 = last ? nA : cA + (size_t)(t + 2) * kstep; const char* b2 = last ? nB : cB + (size_t)(t + 2) * kstep;
            const char* a3 = a2 + kstep; const char* b3 = b2 + kstep;
            if (last && has_next) S.a_ready(nxt);
            if constexpr (SP2) {
            PG8_LDB(B0, 0, 0); PG8_LDB(B1, 0, 1); PG8_SCHED; PG8_LDA(At, 0, 0); PG8_STAGE(PG8_SA(1, 1), a1 + hstepA, voffA);
            PG8_WAIT_V(8); PG8_WAIT_L(0); PG8_BAR; PG8_MMA(0, 0, At, B0); PG8_MMA(0, 1, At, B1); PG8_BAR; PG8_SCHED;
            PG8_LDA(At, 0, 1); PG8_STAGE(PG8_SB(0, 0), b2, voffB); PG8_STAGE(PG8_SB(0, 1), b2 + hstepB, voffB); PG8_STAGE(PG8_SA(0, 0), a2, voffA);
            PG8_WAIT_V(8); PG8_WAIT_L(0); PG8_BAR; PG8_MMA(1, 0, At, B0); PG8_MMA(1, 1, At, B1); PG8_BAR; PG8_SCHED;
            PG8_LDB(B0, 1, 0); PG8_LDB(B1, 1, 1); PG8_SCHED; PG8_LDA(At, 1, 0); PG8_STAGE(PG8_SA(0, 1), a2 + hstepA, voffA);
            PG8_WAIT_V(8); PG8_WAIT_L(0); PG8_BAR; PG8_MMA(0, 0, At, B0); PG8_MMA(0, 1, At, B1); PG8_BAR; PG8_SCHED;
            PG8_LDA(At, 1, 1); PG8_STAGE(PG8_SB(1, 0), b3, voffB); PG8_STAGE(PG8_SB(1, 1), b3 + hstepB, voffB); PG8_STAGE(PG8_SA(1, 0), a3, voffA);
            PG8_WAIT_V(8); PG8_WAIT_L(0); PG8_BAR; PG8_MMA(1, 0, At, B0); PG8_MMA(1, 1, At, B1); PG8_BAR; PG8_SCHED;
            } else {
            PG8_LDB(B0, 0, 0); PG8_SCHED; PG8_LDA(At, 0, 0); PG8_STAGE(PG8_SA(1, 1), a1 + hstepA, voffA);
            PG8_WAIT_L(8); PG8_BAR; PG8_WAIT_L(0); PG8_MMA(0, 0, At, B0); PG8_BAR; PG8_SCHED;
            PG8_LDB(B1, 0, 1); PG8_STAGE(PG8_SB(0, 0), b2, voffB);
            PG8_BAR; PG8_WAIT_L(0); PG8_MMA(0, 1, At, B1); PG8_BAR;
            PG8_LDA(At, 0, 1); PG8_STAGE(PG8_SA(0, 0), a2, voffA);
            PG8_BAR; PG8_WAIT_L(0); PG8_MMA(1, 0, At, B0); PG8_BAR; PG8_SCHED;
            PG8_STAGE(PG8_SB(0, 1), b2 + hstepB, voffB);
            PG8_WAIT_V(6); PG8_BAR; PG8_MMA(1, 1, At, B1); PG8_BAR;
            PG8_LDB(B0, 1, 0); PG8_SCHED; PG8_LDA(At, 1, 0); PG8_STAGE(PG8_SA(0, 1), a2 + hstepA, voffA);
            PG8_WAIT_L(8); PG8_BAR; PG8_WAIT_L(0); PG8_MMA(0, 0, At, B0); PG8_BAR; PG8_SCHED;
            PG8_LDB(B1, 1, 1); PG8_STAGE(PG8_SB(1, 0), b3, voffB);
            PG8_BAR; PG8_WAIT_L(0); PG8_MMA(0, 1, At, B1); PG8_BAR;
            PG8_LDA(At, 1, 1); PG8_STAGE(PG8_SA(1, 0), a3, voffA);
            PG8_BAR; PG8_WAIT_L(0); PG8_MMA(1, 0, At, B0); PG8_BAR; PG8_SCHED;
            PG8_STAGE(PG8_SB(1, 1), b3 + hstepB, voffB);
            PG8_WAIT_V(6); PG8_BAR; PG8_MMA(1, 1, At, B1); PG8_BAR;
            }
        }
        if constexpr (ALIGN_EPI) { if (wr == 0) PG8_BAR; }
        if constexpr (!Epi::AFTER_DRAIN) { E(acc, cur, wr, wc, fr, fq); S.done(cur); }
        if (!has_next) break;
#pragma unroll
        for (int a = 0; a < 2; ++a)
#pragma unroll
            for (int b = 0; b < 2; ++b)
#pragma unroll
                for (int m = 0; m < 4; ++m)
#pragma unroll
                    for (int n = 0; n < 2; ++n) acc[a][b][m][n] = (f32x4){0.f, 0.f, 0.f, 0.f};
        cur = nxt; cA = nA; cB = nB; ++ui;
        if constexpr (ALIGN_EPI) { if (wr == 1) PG8_BAR; }
    }
    PG8_WAIT_V(0);
    if constexpr (!ALIGN_EPI) { if (wr == 0) PG8_BAR; }
    PG8_BAR;
    if constexpr (Epi::AFTER_DRAIN) { E.fused(acc, cur, wr, wc, fr, fq, lds, wid, lane); S.done(cur); }
#undef PG8_SA
#undef PG8_SB
#undef PG8_STAGE
#undef PG8_LDA
#undef PG8_LDB
#undef PG8_MMA
#undef PG8_WAIT_V
#undef PG8_WAIT_L
#undef PG8_BAR
#undef PG8_SCHED
}
}

template <class F> struct EpiAdapt {
    static constexpr bool PERM = false, AFTER_DRAIN = false;
    F f;
    __device__ __forceinline__ void operator()(const pg8::f32x4 (&acc)[2][2][4][2], const pg8::Unit& u, int wr, int wc, int fr, int fq) const {
#pragma unroll
        for (int ai = 0; ai < 2; ++ai)
#pragma unroll
            for (int m = 0; m < 4; ++m) { const int row = u.pm * 256 + ai * 128 + wr * 64 + m * 16 + fr;
#pragma unroll
                for (int bj = 0; bj < 2; ++bj)
#pragma unroll
                    for (int n = 0; n < 2; ++n) f(row, u.pn * 256 + bj * 128 + wc * 32 + n * 16 + 4 * fq, acc[ai][bj][m][n]); }
    }
};
template <class F> struct EpiAdapt8 {
    static constexpr bool PERM = true, AFTER_DRAIN = false;
    F f;
    __device__ __forceinline__ void operator()(const pg8::f32x4 (&acc)[2][2][4][2], const pg8::Unit& u, int wr, int wc, int fr, int fq) const {
#pragma unroll
        for (int ai = 0; ai < 2; ++ai)
#pragma unroll
            for (int m = 0; m < 4; ++m) { const int row = u.pm * 256 + ai * 128 + wr * 64 + m * 16 + fr;
#pragma unroll
                for (int bj = 0; bj < 2; ++bj) f.op8(row, u.pn * 256 + bj * 128 + wc * 32 + 8 * fq, acc[ai][bj][m][0], acc[ai][bj][m][1]); }
    }
};
template <class F> __device__ __forceinline__ void gemm_mfma8(const bf16_t* A, int lda, const bf16_t* Bt, int M, int N, int K, const F& f, LAS unsigned char* lds) {
    pg8::Gemm g{A, lda, Bt, M, N, K}; pg8::StaticOrder S; S.init(M, N, KGRID, (int)blockIdx.x);
    EpiAdapt8<F> E{f};
    pg8::gemm_phase<EpiAdapt8<F>, pg8::StaticOrder, true, true>(lds, g, S, E);
}
template <class F> __device__ __forceinline__ void gemm_mfma(const bf16_t* A, int lda, const bf16_t* Bt, int M, int N, int K, const F& f, LAS unsigned char* lds) {
    pg8::Gemm g{A, lda, Bt, M, N, K}; pg8::StaticOrder S; S.init(M, N, KGRID, (int)blockIdx.x);
    EpiAdapt<F> E{f};
    pg8::gemm_phase<EpiAdapt<F>, pg8::StaticOrder, true, true>(lds, g, S, E);
}


#ifndef GEMM_MASK
#define GEMM_MASK 63
#endif
template <int BIT, class F> __device__ __forceinline__ void gemm_sel(const bf16_t* A, int lda, const bf16_t* Bt, int M, int N, int K, const F& f, LAS unsigned char* lds) {
    if constexpr ((GEMM_MASK >> BIT) & 1) gemm_mfma(A, lda, Bt, M, N, K, f, lds); else gemm_naive(A, lda, Bt, M, N, K, f, lds);
}

template <class F> __device__ __forceinline__ void gemm_ctx_small(const bf16_t* A, int lda, const bf16_t* Bt, int N, int K, const F& f, LAS unsigned char* lds) {
    const int lane = klane(), wave = kwave(), r32 = lane & 31, hi = lane >> 5;
    const int nct = N / 64, ntasks = 8 * nct, G = KGRID;
    const int KS = K >= 512 ? 8 : K / 64, kslice = K / KS;
    LAS float* red = (LAS float*)lds;
    for (int task = blockIdx.x; task < ntasks; task += G) {
        const int rt = task / nct, ct = task % nct, row0 = ML + rt * 64, col0 = ct * 64;
        f32x16 acc[2][2];
#pragma unroll
        for (int c = 0; c < 2; ++c) { acc[c][0] = f32x16{}; acc[c][1] = f32x16{}; }
        if (wave < KS) {
            const bf16_t* ap0 = A + (size_t)(row0 + r32) * lda + wave * kslice + 8 * hi; const bf16_t* ap1 = ap0 + (size_t)32 * lda;
            const bf16_t* bp0 = Bt + (size_t)(col0 + r32) * K + wave * kslice + 8 * hi; const bf16_t* bp1 = bp0 + (size_t)32 * K;
            bf16x8 av[4][2], bv[4][2];
#define CTX_LOAD(k0) do { _Pragma("unroll") for (int s = 0; s < 4; ++s) { av[s][0] = *(const bf16x8*)(ap0 + (k0) + 16 * s); av[s][1] = *(const bf16x8*)(ap1 + (k0) + 16 * s); \
                bv[s][0] = *(const bf16x8*)(bp0 + (k0) + 16 * s); bv[s][1] = *(const bf16x8*)(bp1 + (k0) + 16 * s); } } while (0)
            CTX_LOAD(0);
#pragma unroll 1
            for (int k0 = 0; k0 < kslice; k0 += 64) {
                bf16x8 ac[4][2], bc[4][2];
#pragma unroll
                for (int s = 0; s < 4; ++s) { ac[s][0] = av[s][0]; ac[s][1] = av[s][1]; bc[s][0] = bv[s][0]; bc[s][1] = bv[s][1]; }
                if (k0 + 64 < kslice) CTX_LOAD(k0 + 64);
#pragma unroll
                for (int s = 0; s < 4; ++s)
#pragma unroll
                    for (int c = 0; c < 2; ++c) { acc[c][0] = __builtin_amdgcn_mfma_f32_32x32x16_bf16(bc[s][c], ac[s][0], acc[c][0], 0, 0, 0); acc[c][1] = __builtin_amdgcn_mfma_f32_32x32x16_bf16(bc[s][c], ac[s][1], acc[c][1], 0, 0, 0); }
            }
#undef CTX_LOAD
        }
        __syncthreads();
        if (wave < KS) {
#pragma unroll
            for (int c = 0; c < 2; ++c)
#pragma unroll
                for (int t = 0; t < 2; ++t)
#pragma unroll
                    for (int r = 0; r < 16; ++r) red[(wave * 64 + (c * 2 + t) * 16 + r) * 64 + lane] = acc[c][t][r];
        }
        __syncthreads();
#pragma unroll
        for (int q = 0; q < 2; ++q) {
            const int grp = wave * 2 + q, c = grp >> 3, t = (grp >> 2) & 1, g = grp & 3;
            f32x4 v = {0.f, 0.f, 0.f, 0.f};
            for (int w = 0; w < KS; ++w) {
                const LAS float* p = red + (w * 64 + (c * 2 + t) * 16 + 4 * g) * 64 + lane;
                v.x += p[0]; v.y += p[64]; v.z += p[128]; v.w += p[192];
            }
            f(row0 + 32 * t + r32, col0 + 32 * c + 8 * g + 4 * hi, v);
        }
    }
    __syncthreads();
}

__device__ __forceinline__ void phase_final(const Args& a) {
    const float* fw = a.in[I_FNW];
    const int lane = klane(), gw = blockIdx.x * NWAVES + kwave(), ngw = KGRID * NWAVES;
    for (int row = gw; row < ML; row += ngw) {
        float* p = a.out + (size_t)row * DM;
        f32x4 v[4]; float ss = 0.f;
#pragma unroll
        for (int j = 0; j < 4; ++j) { v[j] = *(const f32x4*)(p + lane * 4 + 256 * j); ss += v[j].x * v[j].x + v[j].y * v[j].y + v[j].z * v[j].z + v[j].w * v[j].w; }
        const float rstd = rsqrtf(wave_sum(ss) * (1.f / DM) + EPS);
#pragma unroll
        for (int j = 0; j < 4; ++j) *(f32x4*)(p + lane * 4 + 256 * j) = v[j] * rstd * *(const f32x4*)(fw + lane * 4 + 256 * j);
    }
}

constexpr int NPHASE = 20;
#define PH_BEGIN(k) if (lo <= (k) && (k) < hi) { const Args& a = get_args(); unsigned char* ws = a.ws; (void)ws;
#ifndef XBAR
#define XBAR 0
#endif
#define PH_END(k) if (MK_ONE_LAUNCH && (k) + 1 < hi) { xcd_barrier(bar); for (int xb_ = 0; xb_ < XBAR; ++xb_) xcd_barrier(bar); } }
template <int L> __device__ __forceinline__ void layer_phases(LAS unsigned char* lds, const XcdBarrier& bar, const int lo, const int hi) {
    constexpr int P = 1 + 9 * L;
#define MODL ((const float*)(ws + WS_MOD) + (size_t)L * 3 * 6144)
#define ROPET ((const float*)(ws + WS_ROPE))
#define HYB ((bf16_t*)(ws + WS_HY))
#define PBB ((bf16_t*)(ws + WS_PB))
#define XCB ((float*)(ws + WS_XC))
#define XL_IN ((L == 0) ? a.in[I_X] : (const float*)a.out)
#define XC_IN ((L == 0) ? a.in[I_CTX] : (const float*)XCB)
    PH_BEGIN(P + 0) phase_norm_mod(XL_IN, XC_IN, a.in[I_N1W] + L * DM, MODL, 0, 1024, HYB, MT); PH_END(P + 0)
    PH_BEGIN(P + 1) for (int rep = 0; rep < REP_INP; ++rep) { if (rep) xcd_barrier(bar); EpiInProj E{PBB, ROPET}; const bf16_t* W = (const bf16_t*)(ws + WS_WIN) + (size_t)L * INP * DM;
        gemm_mfma8(HYB, DM, W, ML, INP, DM, E, lds); gemm_ctx_small(HYB, DM, W, INP, DM, E, lds); } PH_END(P + 1)
    PH_BEGIN(P + 2) phase_post(a, L); for (int rep = 0; rep < REP_GLAL; ++rep) { if (rep) xcd_barrier(bar); phase_gla_local(a, L, lds); } PH_END(P + 2)
    PH_BEGIN(P + 3) for (int rep = 0; rep < REP_UP; ++rep) { if (rep) xcd_barrier(bar);
        { EpiUQ E1{(bf16_t*)(ws + WS_QB)}; const bf16_t* W = (const bf16_t*)(ws + WS_WUQ) + (size_t)L * 768 * 256; gemm_mfma8(PBB + C_DQ, INP, W, ML, 768, 256, E1, lds); if (L == 0) gemm_ctx_small(PBB + C_DQ, INP, W, 768, 256, E1, lds); }
        { EpiUKV E2{(bf16_t*)(ws + WS_KVB)}; const bf16_t* W = (const bf16_t*)(ws + WS_WUKV) + (size_t)L * 1024 * 256; gemm_mfma8(PBB + C_CKV, INP, W, ML, 1024, 256, E2, lds); gemm_ctx_small(PBB + C_CKV, INP, W, 1024, 256, E2, lds); }
        if (rep == 0) phase_gla_scan(a);
        if (L == 0) weight_copies(a, 1, KGRID - 64, lds);
    } PH_END(P + 3)
    PH_BEGIN(P + 4) { phase_gla_out(a, L, lds, 0, 5); phase_sgu_mfma(a, L, lds, 5, 3); phase_attn_mfma<0>(a, L, lds); if (REP_ATTN == 2) { xcd_barrier(bar); phase_attn_mfma<ATT_ABL>(a, L, lds); } } PH_END(P + 4)
    PH_BEGIN(P + 5) for (int rep = 0; rep < (L == 0 ? REP_OUT : 1); ++rep) { if (rep) xcd_barrier(bar); EpiResid E{XL_IN, XC_IN, a.out, XCB, MODL, 2048}; const bf16_t* W = (const bf16_t*)(ws + WS_WOUT) + (size_t)L * DM * DM;
        gemm_mfma8(HYB, DM, W, ML, DM, DM, E, lds); if (L == 0) gemm_ctx_small(HYB, DM, W, DM, DM, E, lds); } PH_END(P + 5)
    PH_BEGIN(P + 6) phase_norm_mod(a.out, XCB, a.in[I_N2W] + L * DM, MODL, 3072, 4096, HYB, L == 0 ? MT : ML); PH_END(P + 6)
    PH_BEGIN(P + 7) { EpiFF1 E{(bf16_t*)(ws + WS_A)}; const bf16_t* W = (const bf16_t*)(ws + WS_WFF1) + (size_t)L * FF * DM;
        gemm_mfma8(HYB, DM, W, ML, FF, DM, E, lds); if (L == 0) gemm_ctx_small(HYB, DM, W, FF, DM, E, lds);
        if (REP_FF1 == 2) { xcd_barrier(bar); EpiNull EN; gemm_mfma8(HYB, DM, W, ML, FF, DM, EN, lds); }
        if (REP_FF1 == 3) { xcd_barrier(bar); gemm_mfma8(HYB, DM, W, ML, FF, DM, E, lds); } } PH_END(P + 7)
    PH_BEGIN(P + 8) { EpiResid E{a.out, XCB, a.out, XCB, MODL, 5120}; const bf16_t* W = (const bf16_t*)(ws + WS_WFF2) + (size_t)L * DM * FF;
        gemm_mfma8((const bf16_t*)(ws + WS_A), FF, W, ML, DM, FF, E, lds); if (L == 0) gemm_ctx_small((const bf16_t*)(ws + WS_A), FF, W, DM, FF, E, lds); } PH_END(P + 8)
}
__global__ void __launch_bounds__(NTHR, 2) mega(Args a_kernarg_only) {
    extern __shared__ __attribute__((aligned(16))) unsigned char lds_raw[];
    LAS unsigned char* lds = (LAS unsigned char*)lds_raw;
    volatile LAS unsigned* MISC = (volatile LAS unsigned*)(lds + LDS_CTL_OFF);
    { const int t0 = __builtin_amdgcn_workitem_id_x();
      if (t0 < 64) MISC[t0] = 0u;
      if ((t0 & 63) == 0) { const unsigned id = (unsigned)__builtin_amdgcn_s_getreg((5 << 11) | 4) & 63u; MISC[64 + id] = (unsigned)(t0 >> 6); } }
    __syncthreads();
    XcdBarrier bar; bar.bar = (unsigned*)(get_args().ws + WS_CTL); bar.x = 0; bar.st = nullptr;
    if (MK_ONE_LAUNCH) bar = xcd_barrier_post((unsigned*)(get_args().ws + WS_CTL), MISC + 8);
    const int lo = MK_ONE_LAUNCH ? 0 : get_args().ph_lo, hi = MK_ONE_LAUNCH ? NPHASE : get_args().ph_hi;
    PH_BEGIN(0) phase_prep(a, lds); PH_END(0)
    layer_phases<0>(lds, bar, lo, hi);
    layer_phases<1>(lds, bar, lo, hi);
    PH_BEGIN(NPHASE - 1) phase_final(a); PH_END(NPHASE - 1)
}

extern "C" void kernel_launch(void* const* d_in, const int* in_sizes, int n_in, void* d_out, int out_size, void* d_ws, size_t ws_size, hipStream_t stream) {
    static int grid = 0;
    if (grid == 0) {
        if (n_in != 26 || in_sizes[0] != ML * DM || out_size != ML * DM || ws_size < WS_END) { fprintf(stderr, "kernel_launch: unexpected shapes (n_in %d, in0 %d, out %d, ws %zu)\n", n_in, n_in > 0 ? in_sizes[0] : -1, out_size, ws_size); grid = -1; return; }
        int dev = 0, cus = 0;
        if (hipGetDevice(&dev) != hipSuccess || hipDeviceGetAttribute(&cus, hipDeviceAttributeMultiprocessorCount, dev) != hipSuccess) { grid = -1; return; }
        if (hipFuncSetAttribute((const void*)mega, hipFuncAttributeMaxDynamicSharedMemorySize, LDS_BYTES) != hipSuccess) { fprintf(stderr, "kernel_launch: hipFuncSetAttribute failed\n"); grid = -1; return; }
        int per_cu = 0;
        if (hipOccupancyMaxActiveBlocksPerMultiprocessor(&per_cu, (const void*)mega, NTHR, LDS_BYTES) != hipSuccess || per_cu < 1) fprintf(stderr, "kernel_launch: occupancy query says %d\n", per_cu);
        (void)hipGetLastError();
        grid = cus;
    }
    if (grid < 0) return;
    (void)hipMemsetAsync((char*)d_ws + WS_CTL, 0, CTL_ZERO_BYTES, stream);
    Args a{};
    for (int i = 0; i < 26; ++i) a.in[i] = (const float*)d_in[i];
    a.out = (float*)d_out; a.ws = (unsigned char*)d_ws; a.grid = grid;
    if (MK_ONE_LAUNCH) { a.ph_lo = 0; a.ph_hi = NPHASE; hipLaunchKernelGGL(mega, dim3(grid), dim3(NTHR), LDS_BYTES, stream, a); }
    else for (int ph = 0; ph < NPHASE; ++ph) { a.ph_lo = ph; a.ph_hi = ph + 1; hipLaunchKernelGGL(mega, dim3(grid), dim3(NTHR), LDS_BYTES, stream, a); }
}
```

```cpp
#include <hip/hip_runtime.h>
#include <cstdio>
#include <cstdint>

#ifndef REP_FF1
#define REP_FF1 1
#endif
#ifndef REP_INP
#define REP_INP 1
#endif
#ifndef REP_GLAL
#define REP_GLAL 1
#endif
#ifndef REP_UP
#define REP_UP 1
#endif
#ifndef REP_OUT
#define REP_OUT 1
#endif
#ifndef ATT_ABL
#define ATT_ABL 5
#endif
#ifndef REP_PREP
#define REP_PREP 1
#endif
#ifndef REP_SGU
#define REP_SGU 1
#endif
#ifndef REP_ATTN
#define REP_ATTN 1
#endif
#ifndef REP_GLA
#define REP_GLA 1
#endif
#ifndef REP_NORM
#define REP_NORM 1
#endif
#ifndef ATT_NQL
#define ATT_NQL 6
#endif
#ifndef ATTN_NAIVE
#define ATTN_NAIVE 0
#endif
#ifndef GLA_NAIVE
#define GLA_NAIVE 0
#endif
#ifndef MK_ONE_LAUNCH
#define MK_ONE_LAUNCH 1
#endif

#define GAS __attribute__((address_space(1)))
#define LAS __attribute__((address_space(3)))
typedef unsigned short bf16_t;
typedef float f32x4 __attribute__((ext_vector_type(4)));
typedef unsigned u32x4 __attribute__((ext_vector_type(4)));
typedef unsigned u32x2 __attribute__((ext_vector_type(2)));

constexpr int DM = 1024, NB = 2, NL = 8192, NC = 256, ML = NB * NL, MC = NB * NC, MT = ML + MC;
constexpr int FF = 4096, INP = 2048, IN_COLS = 1888, NKEY = NC + NL;
constexpr float EPS = 1e-6f;
constexpr float QSCALE = 0.07216878364870322f * 1.4426950408889634f;
constexpr int NWAVES = 8, NTHR = 512;
constexpr int C_CKV = 0, C_DQ = 256, C_SU = 512, C_SV = 768, C_GV = 1024, C_GR = 1280, C_GK = 1536, C_GQ = 1664, C_KR = 1792, C_GGF = 1856, C_GGB = 1872;

constexpr size_t MiB = 1u << 20;
constexpr size_t WS_CTL = 0, CTL_ZERO_BYTES = 65536;
constexpr size_t WS_MOD = 1 * MiB;
constexpr size_t WS_ROPE = 1 * MiB + 256 * 1024;
constexpr size_t WS_WSB = 14 * MiB + 768 * 1024;
constexpr size_t WS_WIN = 2 * MiB;
constexpr size_t WS_WOUT = 10 * MiB;
constexpr size_t WS_WUQ = 14 * MiB;
constexpr size_t WS_WUKV = 15 * MiB;
constexpr size_t WS_WFF1 = 16 * MiB;
constexpr size_t WS_WFF2 = 32 * MiB;
constexpr size_t WS_XC = 48 * MiB;
constexpr size_t WS_HY = 50 * MiB;
constexpr size_t WS_PB = 83 * MiB;
constexpr size_t WS_QB = 149 * MiB;
constexpr size_t WS_KVB = 174 * MiB;
constexpr size_t WS_LG = 216 * MiB;
constexpr size_t WS_OB = 233 * MiB;
constexpr size_t WS_XB = 216 * MiB;
constexpr size_t WS_A = 83 * MiB;
constexpr size_t WS_END = 250 * MiB;
static_assert(WS_A + (size_t)MT * FF * 2 <= WS_LG, "ffn hidden overlay");
static_assert(WS_PB + (size_t)MT * INP * 2 <= WS_QB && WS_QB + (size_t)MT * 768 * 2 <= WS_KVB && WS_KVB + (size_t)MT * 1024 * 2 <= WS_LG, "ws map");
static_assert(WS_XB + (size_t)ML * DM * 2 <= WS_END, "ws map 2");

constexpr int LDS_BYTES = 147456;

struct Args { const float* in[26]; float* out; unsigned char* ws; int ph_lo, ph_hi, grid, pad; };
enum { I_X = 0, I_C, I_CTX, I_CCTX, I_WMOD, I_BMOD, I_N1W, I_WIN, I_WOUT, I_SGNW, I_SGNB, I_SGW, I_SGB, I_GWF, I_GBF, I_GWB, I_GBB, I_GNW, I_QNW, I_WUQ, I_KVNW, I_WUKV, I_N2W, I_WFF1, I_WFF2, I_FNW };

typedef __attribute__((address_space(4))) const Args* KArgsPtr;
__device__ __forceinline__ const Args& get_args() { KArgsPtr p = (KArgsPtr)__builtin_amdgcn_kernarg_segment_ptr(); asm volatile("" : "+s"(p)); return *(const Args*)p; }
constexpr int LDS_CTL_OFF = LDS_BYTES - 512;
__device__ __forceinline__ int klane() { int l; asm volatile("v_mbcnt_lo_u32_b32 %0, -1, 0\n\tv_mbcnt_hi_u32_b32 %0, -1, %0" : "=v"(l)); return l; }
__device__ __forceinline__ int kwave() { const unsigned id = (unsigned)__builtin_amdgcn_s_getreg((5 << 11) | 4) & 63u;
    return __builtin_amdgcn_readfirstlane((int)((volatile LAS unsigned*)(uintptr_t)(LDS_CTL_OFF + 256))[id]); }
#define KTID (kwave() * 64 + klane())
#define KGRID (get_args().grid)
__device__ __forceinline__ float bf2f(bf16_t v) { return __uint_as_float(((unsigned)v) << 16); }
__device__ __forceinline__ unsigned f2bf(float f) { unsigned u = __float_as_uint(f); return (u + 0x7fffu + ((u >> 16) & 1u)) >> 16; }
__device__ __forceinline__ unsigned pk2(float lo, float hi) { return f2bf(lo) | (f2bf(hi) << 16); }
#define DPP_F(v, ctrl, rmask) __builtin_bit_cast(float, __builtin_amdgcn_update_dpp(0, __builtin_bit_cast(int, (v)), (ctrl), (rmask), 0xf, true))
__device__ __forceinline__ float wave_prefix_sum(float v) {
    v += DPP_F(v, 0x111, 0xf); v += DPP_F(v, 0x112, 0xf); v += DPP_F(v, 0x114, 0xf); v += DPP_F(v, 0x118, 0xf);
    v += DPP_F(v, 0x142, 0xa); v += DPP_F(v, 0x143, 0xc);
    return v;
}
__device__ __forceinline__ float wave_sum(float v) {
    return __builtin_bit_cast(float, __builtin_amdgcn_readlane(__builtin_bit_cast(int, wave_prefix_sum(v)), 63));
}
__device__ __forceinline__ float gelu_tanh(float x) { const float u = 1.5957691216057308f * (x + 0.044715f * x * x * x); return x / (1.f + __expf(-u)); }
__device__ __forceinline__ float silu_f(float x) { return x / (1.f + __expf(-x)); }
__device__ __forceinline__ float log_sigmoid_f(float z) { return fminf(z, 0.f) - log1pf(expf(-fabsf(z))); }
__device__ __forceinline__ float log_sigmoid_fast(float z) { return fminf(z, 0.f) - __logf(1.f + __expf(-fabsf(z))); }
__device__ __forceinline__ void unpack8(u32x4 w, float* f) {
    f[0] = __uint_as_float(w.x << 16); f[1] = __uint_as_float(w.x & 0xffff0000u); f[2] = __uint_as_float(w.y << 16); f[3] = __uint_as_float(w.y & 0xffff0000u);
    f[4] = __uint_as_float(w.z << 16); f[5] = __uint_as_float(w.z & 0xffff0000u); f[6] = __uint_as_float(w.w << 16); f[7] = __uint_as_float(w.w & 0xffff0000u);
}

#define XB_TMO      128
#define XB_XCNT(j)  (256  + 64 * (j))
#define XB_XSUB(j)  (1280 + 64 * (j))
#define XB_XGEN(j)  (2304 + 64 * (j))
#define XB_TOP      3328
#define XB_TOPGEN   3392
#define XCD_BAR_WORDS 3456
#define XB_SPIN_CAP (1u << 22)
__device__ __forceinline__ unsigned xb_ld(unsigned* p)              { return __hip_atomic_load(p, __ATOMIC_RELAXED, __HIP_MEMORY_SCOPE_AGENT); }
__device__ __forceinline__ unsigned xb_add(unsigned* p, unsigned v) { return __hip_atomic_fetch_add(p, v, __ATOMIC_RELAXED, __HIP_MEMORY_SCOPE_AGENT); }
__device__ __forceinline__ unsigned xb_xcc_id() { return (unsigned)__builtin_amdgcn_s_getreg((3 << 11) | 20) & 0xFu; }
#define XB_SPIN(cond, bar) do { unsigned _sp = 0; while (cond) { __builtin_amdgcn_s_sleep(1); \
    if ((++_sp & 255u) == 0u) { if (xb_ld(&(bar)[XB_TMO])) break; if (_sp > XB_SPIN_CAP) { atomicAdd(&(bar)[XB_TMO], 1u); break; } } } } while (0)
struct XcdBarrier { unsigned* bar; unsigned x; volatile LAS unsigned* st; };
__device__ __forceinline__ XcdBarrier xcd_barrier_post(unsigned* bar, volatile LAS unsigned* st) {
    XcdBarrier b; b.bar = bar; b.x = xb_xcc_id(); b.st = st;
    if (KTID == 0) (void)xb_add(&bar[XB_XCNT(b.x)], 1u);
    return b;
}
__device__ __forceinline__ void xcd_barrier_complete(unsigned* bar, unsigned x, unsigned& nloc, unsigned& nx) {
    const unsigned G = (unsigned)KGRID;
    unsigned sum, cnt, mine, sp = 0u;
    for (;;) {
        sum = 0u; cnt = 0u; mine = 0u;
#pragma unroll
        for (unsigned j = 0; j < 16; ++j) { const unsigned c = xb_ld(&bar[XB_XCNT(j)]); sum += c; cnt += (c > 0u) ? 1u : 0u; mine = (j == x) ? c : mine; }
        if (sum == G) break;
        __builtin_amdgcn_s_sleep(1);
        if ((++sp & 255u) == 0u) { if (xb_ld(&bar[XB_TMO])) break; if (sp > XB_SPIN_CAP) { atomicAdd(&bar[XB_TMO], 1u); break; } }
    }
    nloc = mine > 0u ? mine : 1u; nx = cnt > 0u ? cnt : 1u;
}
__device__ __forceinline__ void xcd_barrier(const XcdBarrier& b) {
    asm volatile("s_waitcnt vmcnt(0)" ::: "memory");
    __syncthreads();
    if (KTID == 0) {
        unsigned* bar = b.bar;
        __builtin_amdgcn_s_waitcnt(0);
        unsigned nloc = b.st[0], nx = b.st[1];
        if (nloc == 0u) { xcd_barrier_complete(bar, b.x, nloc, nx); b.st[0] = nloc; b.st[1] = nx; }
        const unsigned old = xb_add(&bar[XB_XSUB(b.x)], 1u);
        const unsigned gen = old / nloc;
        if (old + 1u == (gen + 1u) * nloc) {
            __builtin_amdgcn_fence(__ATOMIC_RELEASE, "agent");
            asm volatile("s_waitcnt vmcnt(0)" ::: "memory");
            const unsigned og = xb_add(&bar[XB_TOP], 1u);
            const unsigned tg = og / nx;
            if (og + 1u == (tg + 1u) * nx) xb_add(&bar[XB_TOPGEN], 1u);
            else XB_SPIN(xb_ld(&bar[XB_TOPGEN]) == tg, bar);
            __builtin_amdgcn_fence(__ATOMIC_ACQUIRE, "agent");
            xb_add(&bar[XB_XGEN(b.x)], 1u);
            asm volatile("s_waitcnt vmcnt(0)" ::: "memory");
        } else {
            XB_SPIN(xb_ld(&bar[XB_XGEN(b.x)]) == gen, bar);
            __builtin_amdgcn_fence(__ATOMIC_ACQUIRE, "agent");
            asm volatile("s_waitcnt vmcnt(0)" ::: "memory");
        }
    }
    __syncthreads();
}

__device__ __forceinline__ int rope_unperm(int jj) { return (jj < 32) ? ((jj >> 1) + 16 * (jj & 1)) : (32 + ((jj - 32) >> 1) + 16 * (jj & 1)); }
__device__ __forceinline__ int map_in(int n) {
    if (n < 256) return 416 + n;
    if (n < 512) return 1632 + (n - 256);
    if (n < 768) return 736 + (n - 512);
    if (n < 1024) return 992 + (n - 768);
    if (n < 1280) return 128 + (n - 1024);
    if (n < 1536) return 1376 + (n - 1280);
    if (n < 1664) return n - 1536;
    if (n < 1792) return 1248 + (n - 1664);
    if (n < 1856) return 672 + rope_unperm(n - 1792);
    if (n < 1872) return 384 + (n - 1856);
    if (n < 1888) return 400 + (n - 1872);
    return -1;
}
__device__ __forceinline__ int map_uq(int n) { const int h = n / 192, j = n % 192; return (j < 128) ? n : (h * 192 + 128 + rope_unperm(j - 128)); }
template <int MODE> __device__ __forceinline__ void transpose_w(const float* W, int K, int Nsrc, bf16_t* Wt, int Npad, int gtid, int gthreads) {
    const int total = Npad * (K / 8);
    for (int idx = gtid; idx < total; idx += gthreads) {
        const int n = idx % Npad, kc = idx / Npad;
        const int src = (MODE == 0) ? n : (MODE == 1 ? map_in(n) : map_uq(n));
        float f[8];
#pragma unroll
        for (int i = 0; i < 8; ++i) f[i] = (src >= 0) ? W[(size_t)(kc * 8 + i) * Nsrc + src] : 0.f;
        u32x4 o; o.x = pk2(f[0], f[1]); o.y = pk2(f[2], f[3]); o.z = pk2(f[4], f[5]); o.w = pk2(f[6], f[7]);
        *(u32x4*)(Wt + (size_t)n * K + kc * 8) = o;
    }
}
template <int MODE> __device__ __forceinline__ void transpose_item(const float* W, int K, int Nsrc, bf16_t* Wt, int Npad, LAS float* scr, int item, int lane) {
    const int nblk = Npad / 32, kb = item / nblk, nb = item % nblk, k0 = 64 * kb, n0 = 32 * nb;
    const int nn = n0 + (lane & 31), src = (MODE == 0) ? nn : (MODE == 1 ? map_in(nn) : map_uq(nn));
    float tv[32];
#pragma unroll
    for (int i = 0; i < 32; ++i) { const int kk = 2 * i + (lane >> 5); tv[i] = (src >= 0) ? W[(size_t)(k0 + kk) * Nsrc + src] : 0.f; }
#pragma unroll
    for (int i = 0; i < 32; ++i) { const int kk = 2 * i + (lane >> 5); scr[kk * 33 + (lane & 31)] = tv[i]; }
    asm volatile("s_waitcnt lgkmcnt(0)" ::: "memory");
    const int c = lane & 7;
#pragma unroll
    for (int j = 0; j < 4; ++j) { const int n = (lane >> 3) + 8 * j; const LAS float* s = scr + (8 * c) * 33 + n;
        u32x4 o; o.x = pk2(s[0 * 33], s[1 * 33]); o.y = pk2(s[2 * 33], s[3 * 33]); o.z = pk2(s[4 * 33], s[5 * 33]); o.w = pk2(s[6 * 33], s[7 * 33]);
        *(u32x4*)(Wt + (size_t)(n0 + n) * K + k0 + 8 * c) = o; }
    asm volatile("s_waitcnt lgkmcnt(0)" ::: "memory");
}
__device__ __forceinline__ void weight_copies(const Args& a, int l, int nblk, LAS unsigned char* lds) {
    unsigned char* ws = a.ws;
    if ((int)blockIdx.x >= nblk) return;
    const int wave = kwave(), lane = klane(), gw = wave * nblk + (int)blockIdx.x, ngw = nblk * NWAVES;
    LAS float* scr = (LAS float*)(lds + 8192 + wave * 8704);
    for (int it = gw; it < 5856; it += ngw) {
        int r = it;
        if (r < 1024) { transpose_item<1>(a.in[I_WIN] + (size_t)l * DM * IN_COLS, DM, IN_COLS, (bf16_t*)(ws + WS_WIN) + (size_t)l * INP * DM, INP, scr, r, lane); continue; } r -= 1024;
        if (r < 512) { transpose_item<0>(a.in[I_WOUT] + (size_t)l * DM * DM, DM, DM, (bf16_t*)(ws + WS_WOUT) + (size_t)l * DM * DM, DM, scr, r, lane); continue; } r -= 512;
        if (r < 96) { transpose_item<2>(a.in[I_WUQ] + (size_t)l * 256 * 768, 256, 768, (bf16_t*)(ws + WS_WUQ) + (size_t)l * 768 * 256, 768, scr, r, lane); continue; } r -= 96;
        if (r < 128) { transpose_item<0>(a.in[I_WUKV] + (size_t)l * 256 * 1024, 256, 1024, (bf16_t*)(ws + WS_WUKV) + (size_t)l * 1024 * 256, 1024, scr, r, lane); continue; } r -= 128;
        if (r < 2048) { transpose_item<0>(a.in[I_WFF1] + (size_t)l * DM * FF, DM, FF, (bf16_t*)(ws + WS_WFF1) + (size_t)l * FF * DM, FF, scr, r, lane); continue; } r -= 2048;
        transpose_item<0>(a.in[I_WFF2] + (size_t)l * FF * DM, FF, DM, (bf16_t*)(ws + WS_WFF2) + (size_t)l * DM * FF, DM, scr, r, lane);
    }
}
__device__ __forceinline__ void phase_prep(const Args& a, LAS unsigned char* lds) {
    unsigned char* ws = a.ws;
    const int tid = KTID, gtid = blockIdx.x * NTHR + tid, gthreads = KGRID * NTHR;
    weight_copies(a, 0, KGRID, lds);
    for (int idx = gtid; idx < 2 * 4 * 128 * 128 / 4; idx += gthreads) { const f32x4 v = *(const f32x4*)(a.in[I_SGW] + (size_t)idx * 4); u32x2 o; o.x = pk2(v.x, v.y); o.y = pk2(v.z, v.w); *(u32x2*)((bf16_t*)(ws + WS_WSB) + (size_t)idx * 4) = o; }
    { const int ridx = ((int)blockIdx.x - (KGRID - 4)) * NTHR + tid;
      if (ridx >= 0 && ridx < 128 * 16) {
        const int p = ridx >> 4, i = ridx & 15;
        const float freq = powf(10000.0f, -(float)i * 2.0f / 32.0f);
        const float ang = (float)p * freq;
        float sn, cs; sincosf(ang, &sn, &cs);
        float* R = (float*)(ws + WS_ROPE);
        R[ridx * 2 + 0] = cs; R[ridx * 2 + 1] = sn;
      } }
    {
        LAS float* red = (LAS float*)lds;
        LAS float* sil = (LAS float*)(lds + 80 * 1024);
        const int wave = kwave(), lane = klane();
        if ((int)blockIdx.x < 2 * 96) {
            for (int i = tid; i < 3 * DM; i += NTHR) { const float v = i < 2 * DM ? a.in[I_C][i] : a.in[I_CCTX][i - 2 * DM]; sil[i] = silu_f(v); }
        }
        __syncthreads();
        for (int item = blockIdx.x; item < 2 * 96; item += KGRID) {
            const int l = item / 96, j = (item % 96) * 64 + lane;
            const float* W = a.in[I_WMOD] + (size_t)l * DM * 6144 + (size_t)(wave * 128) * 6144 + j;
            float s0 = 0.f, s1 = 0.f, s2 = 0.f;
#pragma unroll 16
            for (int kk = 0; kk < 128; ++kk) {
                const float w = W[(size_t)kk * 6144];
                const int k2 = wave * 128 + kk;
                s0 += sil[k2] * w; s1 += sil[DM + k2] * w; s2 += sil[2 * DM + k2] * w;
            }
            red[(wave * 3 + 0) * 64 + lane] = s0; red[(wave * 3 + 1) * 64 + lane] = s1; red[(wave * 3 + 2) * 64 + lane] = s2;
            __syncthreads();
            if (tid < 192) {
                const int r = tid >> 6; float s = 0.f;
#pragma unroll
                for (int w = 0; w < 8; ++w) s += red[(w * 3 + r) * 64 + lane];
                ((float*)(ws + WS_MOD))[(size_t)(l * 3 + r) * 6144 + j] = s + a.in[I_BMOD][l * 6144 + j];
            }
            __syncthreads();
        }
    }
}

template <bool XBF> __device__ __forceinline__ void phase_norm_mod(const void* xl, const float* xc, const float* nw, const float* mod, int sh_off, int sc_off, bf16_t* H, int nrows) {
    const int lane = klane(), gw = blockIdx.x * NWAVES + kwave(), ngw = KGRID * NWAVES;
    for (int row = gw; row < nrows; row += ngw) {
        const float* m = mod + (row < ML ? row / NL : 2) * 6144;
        f32x4 v[4]; float ss = 0.f;
        if (XBF && row < ML) {
            const bf16_t* src = (const bf16_t*)xl + (size_t)row * DM;
#pragma unroll
            for (int j = 0; j < 4; ++j) { const u32x2 w = *(const u32x2*)(src + lane * 4 + 256 * j); v[j] = (f32x4){__uint_as_float(w.x << 16), __uint_as_float(w.x & 0xffff0000u), __uint_as_float(w.y << 16), __uint_as_float(w.y & 0xffff0000u)}; }
        } else {
            const float* src = row < ML ? (const float*)xl + (size_t)row * DM : xc + (size_t)(row - ML) * DM;
#pragma unroll
            for (int j = 0; j < 4; ++j) v[j] = *(const f32x4*)(src + lane * 4 + 256 * j);
        }
#pragma unroll
        for (int j = 0; j < 4; ++j) ss += v[j].x * v[j].x + v[j].y * v[j].y + v[j].z * v[j].z + v[j].w * v[j].w;
        const float rstd = rsqrtf(wave_sum(ss) * (1.f / DM) + EPS);
#pragma unroll
        for (int j = 0; j < 4; ++j) {
            const int c = lane * 4 + 256 * j;
            const f32x4 w = *(const f32x4*)(nw + c), sc = *(const f32x4*)(m + sc_off + c), sh = *(const f32x4*)(m + sh_off + c);
            const f32x4 o = (v[j] * rstd * w) * (sc + 1.f) + sh;
            u32x2 pk; pk.x = pk2(o.x, o.y); pk.y = pk2(o.z, o.w);
            *(u32x2*)(H + (size_t)row * DM + c) = pk;
        }
    }
}

template <class Epi> __device__ __forceinline__ void gemm_naive(const bf16_t* A, int lda, const bf16_t* Bt, int M, int N, int K, const Epi& E, LAS unsigned char* lds) {
    LAS float* As = (LAS float*)lds;
    LAS float* Bs = As + 32 * 132;
    const int tid = KTID, ty = tid >> 4, tx = tid & 15;
    const int ntm = M / 128, ntn = N / 64, ntiles = ntm * ntn;
    for (int tile = blockIdx.x; tile < ntiles; tile += KGRID) {
        const int tm = tile / ntn, tn = tile % ntn, row0 = tm * 128, col0 = tn * 64;
        float acc[4][4];
#pragma unroll
        for (int i = 0; i < 4; ++i)
#pragma unroll
            for (int j = 0; j < 4; ++j) acc[i][j] = 0.f;
        for (int k0 = 0; k0 < K; k0 += 32) {
            {
                const int r = tid >> 2, kc = (tid & 3) * 8; float f[8];
                unpack8(*(const u32x4*)(A + (size_t)(row0 + r) * lda + k0 + kc), f);
#pragma unroll
                for (int i = 0; i < 8; ++i) As[(kc + i) * 132 + r] = f[i];
                if (tid < 256) {
                    unpack8(*(const u32x4*)(Bt + (size_t)(col0 + r) * K + k0 + kc), f);
#pragma unroll
                    for (int i = 0; i < 8; ++i) Bs[(kc + i) * 68 + r] = f[i];
                }
            }
            __syncthreads();
#pragma unroll 8
            for (int k = 0; k < 32; ++k) {
                const f32x4 av = *(const LAS f32x4*)(As + k * 132 + ty * 4), bv = *(const LAS f32x4*)(Bs + k * 68 + tx * 4);
#pragma unroll
                for (int i = 0; i < 4; ++i)
#pragma unroll
                    for (int j = 0; j < 4; ++j) acc[i][j] += av[i] * bv[j];
            }
            __syncthreads();
        }
#pragma unroll
        for (int i = 0; i < 4; ++i) E(row0 + ty * 4 + i, col0 + tx * 4, (f32x4){acc[i][0], acc[i][1], acc[i][2], acc[i][3]});
    }
}

__device__ __forceinline__ void st4bf(bf16_t* p, f32x4 v) { u32x2 pk; pk.x = pk2(v.x, v.y); pk.y = pk2(v.z, v.w); *(u32x2*)p = pk; }
__device__ __forceinline__ f32x4 rope4(f32x4 v, int jj, int t, const float* R) {
    const int pos = (jj < 32) ? (t >> 6) : (t & 63), i0 = ((jj & 31) >> 1);
    const f32x4 cs = *(const f32x4*)(R + (pos * 16 + i0) * 2);
    return (f32x4){v.x * cs.x - v.y * cs.y, v.x * cs.y + v.y * cs.x, v.z * cs.z - v.w * cs.w, v.z * cs.w + v.w * cs.z};
}
__device__ __forceinline__ void st8bf(bf16_t* p, f32x4 a, f32x4 b) { u32x4 pk; pk.x = pk2(a.x, a.y); pk.y = pk2(a.z, a.w); pk.z = pk2(b.x, b.y); pk.w = pk2(b.z, b.w); *(u32x4*)p = pk; }
struct EpiInProj { bf16_t* PB; const float* R;
    __device__ __forceinline__ f32x4 xf(int row, int col, f32x4 v) const {
        const int tile = col >> 8;
        if (tile == 2 || tile == 3) { v = (f32x4){gelu_tanh(v.x), gelu_tanh(v.y), gelu_tanh(v.z), gelu_tanh(v.w)}; }
        else if (tile == 5) { v = (f32x4){silu_f(v.x), silu_f(v.y), silu_f(v.z), silu_f(v.w)}; }
        else if (tile == 7) { const int cc = col - C_KR; if (cc < 64 && row < ML) v = rope4(v, cc, row & (NL - 1), R); }
        return v; }
    __device__ __forceinline__ void operator()(int row, int col, f32x4 v) const { st4bf(PB + (size_t)row * INP + col, xf(row, col, v)); }
    __device__ __forceinline__ void op8(int row, int col, f32x4 v0, f32x4 v1) const { st8bf(PB + (size_t)row * INP + col, xf(row, col, v0), xf(row, col + 4, v1)); } };
struct EpiUQ { bf16_t* QB;
    __device__ __forceinline__ void operator()(int row, int col, f32x4 v) const { st4bf(QB + (size_t)row * 768 + col, v * QSCALE); }
    __device__ __forceinline__ void op8(int row, int col, f32x4 v0, f32x4 v1) const { st8bf(QB + (size_t)row * 768 + col, v0 * QSCALE, v1 * QSCALE); } };
struct EpiUKV { bf16_t* KVB;
    __device__ __forceinline__ void operator()(int row, int col, f32x4 v) const { st4bf(KVB + (size_t)row * 1024 + col, v); }
    __device__ __forceinline__ void op8(int row, int col, f32x4 v0, f32x4 v1) const { st8bf(KVB + (size_t)row * 1024 + col, v0, v1); } };
template <bool INF32> struct EpiResid { const void* xin_l; const float* xin_c; bf16_t* xout_l; float* xout_c; const float* mod; int g_off;
    __device__ __forceinline__ f32x4 ld4(int row, int col) const {
        if (INF32) return *(const f32x4*)((const float*)xin_l + (size_t)row * DM + col);
        const u32x2 w = *(const u32x2*)((const bf16_t*)xin_l + (size_t)row * DM + col);
        return (f32x4){__uint_as_float(w.x << 16), __uint_as_float(w.x & 0xffff0000u), __uint_as_float(w.y << 16), __uint_as_float(w.y & 0xffff0000u)}; }
    __device__ __forceinline__ void operator()(int row, int col, f32x4 v) const {
        if (row < ML) { const f32x4 g = *(const f32x4*)(mod + (row >> 13) * 6144 + g_off + col); st4bf(xout_l + (size_t)row * DM + col, ld4(row, col) + g * v); }
        else { const int rc = row - ML; const f32x4 g = *(const f32x4*)(mod + 2 * 6144 + g_off + col), xi = *(const f32x4*)(xin_c + (size_t)rc * DM + col);
            *(f32x4*)(xout_c + (size_t)rc * DM + col) = xi + g * v; }
    }
    __device__ __forceinline__ void op8(int row, int col, f32x4 v0, f32x4 v1) const {
        if (row < ML) { const float* gp = mod + (row >> 13) * 6144 + g_off + col; const f32x4 g0 = *(const f32x4*)gp, g1 = *(const f32x4*)(gp + 4);
            f32x4 x0, x1;
            if (INF32) { const float* xi = (const float*)xin_l + (size_t)row * DM + col; x0 = *(const f32x4*)xi; x1 = *(const f32x4*)(xi + 4); }
            else { const u32x4 w = *(const u32x4*)((const bf16_t*)xin_l + (size_t)row * DM + col);
                x0 = (f32x4){__uint_as_float(w.x << 16), __uint_as_float(w.x & 0xffff0000u), __uint_as_float(w.y << 16), __uint_as_float(w.y & 0xffff0000u)};
                x1 = (f32x4){__uint_as_float(w.z << 16), __uint_as_float(w.z & 0xffff0000u), __uint_as_float(w.w << 16), __uint_as_float(w.w & 0xffff0000u)}; }
            st8bf(xout_l + (size_t)row * DM + col, x0 + g0 * v0, x1 + g1 * v1);
        } else { operator()(row, col, v0); operator()(row, col + 4, v1); }
    } };
struct EpiNull {
    __device__ __forceinline__ void operator()(int row, int col, f32x4 v) const { asm volatile("" :: "v"(v)); }
    __device__ __forceinline__ void op8(int row, int col, f32x4 v0, f32x4 v1) const { asm volatile("" :: "v"(v0), "v"(v1)); } };
struct EpiFF1 { bf16_t* Ah;
    __device__ __forceinline__ void operator()(int row, int col, f32x4 v) const {
        f32x4 r = (f32x4){fmaxf(v.x, 0.f), fmaxf(v.y, 0.f), fmaxf(v.z, 0.f), fmaxf(v.w, 0.f)};
        st4bf(Ah + (size_t)row * FF + col, r * r);
    }
    __device__ __forceinline__ void op8(int row, int col, f32x4 v0, f32x4 v1) const {
        f32x4 r0 = (f32x4){fmaxf(v0.x, 0.f), fmaxf(v0.y, 0.f), fmaxf(v0.z, 0.f), fmaxf(v0.w, 0.f)}, r1 = (f32x4){fmaxf(v1.x, 0.f), fmaxf(v1.y, 0.f), fmaxf(v1.z, 0.f), fmaxf(v1.w, 0.f)};
        st8bf(Ah + (size_t)row * FF + col, r0 * r0, r1 * r1);
    } };

__device__ __forceinline__ void phase_post(const Args& a, int l) {
    unsigned char* ws = a.ws;
    bf16_t* PB = (bf16_t*)(ws + WS_PB); float* LG = (float*)(ws + WS_LG);
    const float* kvnw = a.in[I_KVNW] + l * 256; const float* qnw = a.in[I_QNW] + l * 256;
    const float* snw = a.in[I_SGNW] + l * 256; const float* snb = a.in[I_SGNB] + l * 256;
    const float* wgf = a.in[I_GWF] + l * 16 * 128; const float* bgf = a.in[I_GBF] + l * 128;
    const float* wgb = a.in[I_GWB] + l * 16 * 128; const float* bgb = a.in[I_GBB] + l * 128;
    const int lane = klane(), gw = blockIdx.x * NWAVES + kwave(), ngw = KGRID * NWAVES;
    for (int row = gw; row < MT; row += ngw) {
        bf16_t* pr = PB + (size_t)row * INP;
        const int c = lane * 4;
        { u32x2 w = *(const u32x2*)(pr + C_CKV + c); f32x4 v = {__uint_as_float(w.x << 16), __uint_as_float(w.x & 0xffff0000u), __uint_as_float(w.y << 16), __uint_as_float(w.y & 0xffff0000u)};
          const float rstd = rsqrtf(wave_sum(v.x * v.x + v.y * v.y + v.z * v.z + v.w * v.w) * (1.f / 256.f) + EPS);
          st4bf(pr + C_CKV + c, v * rstd * *(const f32x4*)(kvnw + c)); }
        { u32x2 w = *(const u32x2*)(pr + C_DQ + c); f32x4 v = {__uint_as_float(w.x << 16), __uint_as_float(w.x & 0xffff0000u), __uint_as_float(w.y << 16), __uint_as_float(w.y & 0xffff0000u)};
          const float rstd = rsqrtf(wave_sum(v.x * v.x + v.y * v.y + v.z * v.z + v.w * v.w) * (1.f / 256.f) + EPS);
          st4bf(pr + C_DQ + c, v * rstd * *(const f32x4*)(qnw + c)); }
        { u32x2 w = *(const u32x2*)(pr + C_SV + c); f32x4 v = {__uint_as_float(w.x << 16), __uint_as_float(w.x & 0xffff0000u), __uint_as_float(w.y << 16), __uint_as_float(w.y & 0xffff0000u)};
          const float mu = wave_sum(v.x + v.y + v.z + v.w) * (1.f / 256.f);
          v = v - mu;
          const float rstd = rsqrtf(wave_sum(v.x * v.x + v.y * v.y + v.z * v.z + v.w * v.w) * (1.f / 256.f) + EPS);
          st4bf(pr + C_SV + c, v * rstd * *(const f32x4*)(snw + c) + *(const f32x4*)(snb + c)); }
        if (GLA_NAIVE) { const int o = lane * 4, isb = o >> 7, d = o & 127;
          const float* wg = isb ? wgb : wgf; const float* bg = isb ? bgb : bgf; const bf16_t* gg = pr + (isb ? C_GGB : C_GGF);
          f32x4 z = *(const f32x4*)(bg + d);
#pragma unroll
          for (int r = 0; r < 16; ++r) z += *(const f32x4*)(wg + r * 128 + d) * bf2f(gg[r]);
          *(f32x4*)(LG + (size_t)row * 256 + o) = (f32x4){log_sigmoid_f(z.x), log_sigmoid_f(z.y), log_sigmoid_f(z.z), log_sigmoid_f(z.w)} * (1.f / 16.f); }
    }
}

__device__ __forceinline__ void phase_sgu_naive(const Args& a, int l) {
    unsigned char* ws = a.ws;
    const bf16_t* PB = (const bf16_t*)(ws + WS_PB); bf16_t* Y = (bf16_t*)(ws + WS_HY);
    const float* Ws = a.in[I_SGW] + (size_t)l * 4 * 128 * 128; const float* bs = a.in[I_SGB] + l * 4 * 128;
    const int tid = KTID, i = tid >> 2, eg = (tid & 3) * 16;
    for (int unit = blockIdx.x; unit < (MT / 128) * 4; unit += KGRID) {
        const int cc = unit >> 2, h = unit & 3;
        float acc[16];
#pragma unroll
        for (int e = 0; e < 16; ++e) acc[e] = 0.f;
        const float* wrow = Ws + ((size_t)h * 128 + i) * 128;
        for (int j = 0; j < 128; ++j) {
            const float w = wrow[j];
            const bf16_t* vp = PB + (size_t)(cc * 128 + j) * INP + C_SV + h * 64 + eg;
            float f[8], g[8]; unpack8(*(const u32x4*)vp, f); unpack8(*(const u32x4*)(vp + 8), g);
#pragma unroll
            for (int e = 0; e < 8; ++e) { acc[e] += w * f[e]; acc[8 + e] += w * g[e]; }
        }
        const float bias = bs[h * 128 + i];
        const int row = cc * 128 + i;
        const bf16_t* up = PB + (size_t)row * INP + C_SU + h * 64 + eg;
        float f[8], g[8]; unpack8(*(const u32x4*)up, f); unpack8(*(const u32x4*)(up + 8), g);
        bf16_t* yp = Y + (size_t)row * DM + h * 64 + eg;
        u32x4 o0, o1;
        o0.x = pk2(f[0] * (acc[0] + bias), f[1] * (acc[1] + bias)); o0.y = pk2(f[2] * (acc[2] + bias), f[3] * (acc[3] + bias));
        o0.z = pk2(f[4] * (acc[4] + bias), f[5] * (acc[5] + bias)); o0.w = pk2(f[6] * (acc[6] + bias), f[7] * (acc[7] + bias));
        o1.x = pk2(g[0] * (acc[8] + bias), g[1] * (acc[9] + bias)); o1.y = pk2(g[2] * (acc[10] + bias), g[3] * (acc[11] + bias));
        o1.z = pk2(g[4] * (acc[12] + bias), g[5] * (acc[13] + bias)); o1.w = pk2(g[6] * (acc[14] + bias), g[7] * (acc[15] + bias));
        *(u32x4*)yp = o0; *(u32x4*)(yp + 8) = o1;
    }
}

__device__ __forceinline__ void phase_gla_naive(const Args& a, int l) {
    unsigned char* ws = a.ws;
    const bf16_t* PB = (const bf16_t*)(ws + WS_PB); bf16_t* Y = (bf16_t*)(ws + WS_HY);
    const float* LG = (const float*)(ws + WS_LG); float* OB = (float*)(ws + WS_OB);
    const float* gnw = a.in[I_GNW] + l * 64;
    if (blockIdx.x >= 8 || KTID >= 64) return;
    const int b = blockIdx.x >> 2, h = blockIdx.x & 3, e = KTID;
    const float gw_e = gnw[e];
    for (int dir = 1; dir >= 0; --dir) {
        float S[32];
#pragma unroll
        for (int d = 0; d < 32; ++d) S[d] = 0.f;
        for (int tau = 0; tau < NKEY; ++tau) {
            int row;
            if (dir == 0) row = tau < NC ? ML + b * NC + tau : b * NL + (tau - NC);
            else row = tau < NC ? ML + b * NC + (NC - 1 - tau) : b * NL + (NL - 1 - (tau - NC));
            const bf16_t* pr = PB + (size_t)row * INP;
            const float* lg = LG + (size_t)row * 256 + dir * 128 + h * 32;
            const float v = bf2f(pr[C_GV + h * 64 + e]);
            float o = 0.f;
#pragma unroll
            for (int d = 0; d < 32; ++d) {
                const float kk = bf2f(pr[C_GK + h * 32 + d]), qq = bf2f(pr[C_GQ + h * 32 + d]), al = expf(lg[d]);
                S[d] = al * S[d] + kk * v; o += qq * S[d];
            }
            o *= 0.17677669529663687f;
            if (dir == 1) OB[(size_t)row * 256 + h * 64 + e] = o;
            else {
                o += OB[(size_t)row * 256 + h * 64 + e];
                const float ms = wave_sum(o * o) * (1.f / 64.f);
                const float y = o * rsqrtf(ms + EPS) * gw_e * bf2f(pr[C_GR + h * 64 + e]);
                Y[(size_t)row * DM + 256 + h * 64 + e] = (bf16_t)f2bf(y);
            }
        }
    }
}

typedef short bf16x8 __attribute__((ext_vector_type(8)));
typedef float f32x16 __attribute__((ext_vector_type(16)));
typedef float f32x2_t __attribute__((ext_vector_type(2)));
typedef __bf16 bf16x2_t __attribute__((ext_vector_type(2)));
__device__ __forceinline__ unsigned cvtpk(float lo, float hi) { f32x2_t v = {lo, hi}; bf16x2_t b = __builtin_convertvector(v, bf16x2_t); return __builtin_bit_cast(unsigned, b); }
__device__ __forceinline__ int crow(int r, int hi) { return (r & 3) + 8 * (r >> 2) + 4 * hi; }
constexpr int GLA_WLDS = 17920, GLA_NB = 132;
constexpr size_t OUT_BC = 0, OUT_GL = (size_t)MT * 256 * 4, WS_GD = 1 * MiB + 512 * 1024;
static_assert(OUT_GL + (size_t)2112 * 2048 * 4 <= (size_t)ML * DM * 4 && WS_GD + (size_t)2112 * 32 * 4 <= WS_WIN && WS_ROPE + 16384 <= WS_GD && WS_WSB + 262144 <= WS_WUKV && WS_WUQ + (size_t)2 * 768 * 256 * 2 <= WS_WSB, "gla ws");
__device__ __forceinline__ int gla_row0(int b, int beta) { return beta < 4 ? ML + b * NC + beta * 64 : b * NL + (beta - 4) * 64; }
#define LDS_FENCE() do { asm volatile("s_waitcnt lgkmcnt(0)" ::: "memory"); __builtin_amdgcn_sched_barrier(0); } while (0)
__device__ __forceinline__ void gla_stage_vt(const bf16_t* pv, LAS bf16_t* VT, int lane) {
#pragma unroll
    for (int c8 = 0; c8 < 8; ++c8) { const u32x4 w = *(const u32x4*)(pv + c8 * 8);
        VT[(c8 * 8 + 0) * 64 + lane] = (bf16_t)(w.x & 0xffffu); VT[(c8 * 8 + 1) * 64 + lane] = (bf16_t)(w.x >> 16);
        VT[(c8 * 8 + 2) * 64 + lane] = (bf16_t)(w.y & 0xffffu); VT[(c8 * 8 + 3) * 64 + lane] = (bf16_t)(w.y >> 16);
        VT[(c8 * 8 + 4) * 64 + lane] = (bf16_t)(w.z & 0xffffu); VT[(c8 * 8 + 5) * 64 + lane] = (bf16_t)(w.z >> 16);
        VT[(c8 * 8 + 6) * 64 + lane] = (bf16_t)(w.w & 0xffffu); VT[(c8 * 8 + 7) * 64 + lane] = (bf16_t)(w.w >> 16); }
}
__device__ __forceinline__ void load32bf(const bf16_t* p, float* f) {
    unpack8(*(const u32x4*)(p), f); unpack8(*(const u32x4*)(p + 8), f + 8); unpack8(*(const u32x4*)(p + 16), f + 16); unpack8(*(const u32x4*)(p + 24), f + 24);
}
__device__ __forceinline__ void phase_gla_local(const Args& a, int l, LAS unsigned char* lds) {
    unsigned char* ws = a.ws;
    const bf16_t* PB = (const bf16_t*)(ws + WS_PB); float* BC = (float*)((unsigned char*)a.out + OUT_BC); float* GL = (float*)((unsigned char*)a.out + OUT_GL); float* GD = (float*)(ws + WS_GD);
    const int lane = klane(), wave = kwave(), gw = wave * KGRID + (int)blockIdx.x, ngw = KGRID * NWAVES    ;
    const int r32 = lane & 31, hi = lane >> 5;
    LAS bf16_t* KT = (LAS bf16_t*)(lds + wave * GLA_WLDS); LAS bf16_t* VT = KT + 32 * 64;
    for (int task = gw; task < 16 * GLA_NB; task += ngw) {
        const int beta = task % GLA_NB, t2 = task / GLA_NB, dir = t2 & 1, h = (t2 >> 1) & 3, b = t2 >> 3;
        const int row = gla_row0(b, beta) + lane; const bf16_t* pr = PB + (size_t)row * INP;
        LDS_FENCE();
        gla_stage_vt(pr + C_GV + h * 64, VT, lane);
        float c[32];
        {
          const float* wg = (dir ? a.in[I_GWB] : a.in[I_GWF]) + l * 16 * 128 + h * 32; const float* bg = (dir ? a.in[I_GBB] : a.in[I_GBF]) + l * 128 + h * 32;
          LAS float* WGL = (LAS float*)(VT + 64 * 64); LAS float* BGL = WGL + 16 * 32;
          { const int r = lane >> 2, d0 = (lane & 3) * 8;
            *(LAS f32x4*)(WGL + r * 32 + d0) = *(const f32x4*)(wg + r * 128 + d0); *(LAS f32x4*)(WGL + r * 32 + d0 + 4) = *(const f32x4*)(wg + r * 128 + d0 + 4);
            if (lane < 32) BGL[lane] = bg[lane]; }
          float gg[16]; unpack8(*(const u32x4*)(pr + (dir ? C_GGB : C_GGF)), gg); unpack8(*(const u32x4*)(pr + (dir ? C_GGB : C_GGF) + 8), gg + 8);
          LDS_FENCE();
#pragma unroll
          for (int d = 0; d < 32; d += 4) { f32x4 z = *(const LAS f32x4*)(BGL + d);
#pragma unroll
              for (int r = 0; r < 16; ++r) z += *(const LAS f32x4*)(WGL + r * 32 + d) * gg[r];
              c[d] = log_sigmoid_fast(z.x) * (1.f / 16.f); c[d + 1] = log_sigmoid_fast(z.y) * (1.f / 16.f); c[d + 2] = log_sigmoid_fast(z.z) * (1.f / 16.f); c[d + 3] = log_sigmoid_fast(z.w) * (1.f / 16.f); } }
        float kk[32]; load32bf(pr + C_GK + h * 32, kk);
#pragma unroll
        for (int d = 0; d < 32; ++d) {
            const float g = c[d], p = wave_prefix_sum(g);
            const float T = __builtin_bit_cast(float, __builtin_amdgcn_readlane(__builtin_bit_cast(int, p), 63));
            const float cc = dir ? (T - p + g) : p;
            c[d] = cc;
            KT[d * 64 + lane] = (bf16_t)(cvtpk(kk[d] * __expf(T - cc), 0.f) & 0xffffu);
            kk[d] = __expf(T);
        }
        if (lane == 0) { float* gd = GD + (size_t)task * 32;
#pragma unroll
            for (int d = 0; d < 32; d += 4) *(f32x4*)(gd + d) = (f32x4){kk[d], kk[d + 1], kk[d + 2], kk[d + 3]}; }
        { float* bc = BC + (size_t)row * 256 + dir * 128 + h * 32;
#pragma unroll
          for (int d = 0; d < 32; d += 4) *(f32x4*)(bc + d) = (f32x4){c[d], c[d + 1], c[d + 2], c[d + 3]}; }
        LDS_FENCE();
        f32x16 acc0 = {}, acc1 = {};
#pragma unroll
        for (int s = 0; s < 4; ++s) {
            const bf16x8 af = *(const LAS bf16x8*)(KT + r32 * 64 + 16 * s + 8 * hi);
            const bf16x8 b0 = *(const LAS bf16x8*)(VT + r32 * 64 + 16 * s + 8 * hi), b1 = *(const LAS bf16x8*)(VT + (32 + r32) * 64 + 16 * s + 8 * hi);
            acc0 = __builtin_amdgcn_mfma_f32_32x32x16_bf16(af, b0, acc0, 0, 0, 0); acc1 = __builtin_amdgcn_mfma_f32_32x32x16_bf16(af, b1, acc1, 0, 0, 0);
        }
        float* gl = GL + (size_t)task * 2048;
#pragma unroll
        for (int r = 0; r < 16; ++r) { gl[crow(r, hi) * 64 + r32] = acc0[r]; gl[crow(r, hi) * 64 + 32 + r32] = acc1[r]; }
    }
}
__device__ __forceinline__ void phase_gla_scan(const Args& a) {
    unsigned char* ws = a.ws; float* GL = (float*)((unsigned char*)a.out + OUT_GL); const float* GD = (const float*)(ws + WS_GD);
    const int idx = ((int)blockIdx.x - (KGRID - 64)) * NTHR + KTID;
    if (idx < 0 || idx >= 16 * 2048) return;
    const int seq = idx >> 11, de = idx & 2047, d = de >> 6, dir = seq & 1;
    float S = 0.f;
    for (int c0 = 0; c0 < GLA_NB; c0 += 12) {
        float Lv[12], Dv[12];
#pragma unroll
        for (int u = 0; u < 12; ++u) { const int c = c0 + u, beta = dir ? (c < 4 ? 3 - c : 135 - c) : c; const size_t slot = (size_t)seq * GLA_NB + beta;
            Lv[u] = GL[slot * 2048 + de]; Dv[u] = GD[slot * 32 + d]; }
#pragma unroll
        for (int u = 0; u < 12; ++u) { const int c = c0 + u, beta = dir ? (c < 4 ? 3 - c : 135 - c) : c; const size_t slot = (size_t)seq * GLA_NB + beta;
            GL[slot * 2048 + de] = S; S = Dv[u] * S + Lv[u]; }
    }
}
template <int DIR> __device__ __forceinline__ void gla_dir(const bf16_t* pr, const float* bc, const float* sin, int h, LAS bf16_t* QS, LAS bf16_t* KS, const LAS bf16_t* VT, int lane,
                                                            f32x16& o00, f32x16& o01, f32x16& o10, f32x16& o11) {
    const int r32 = lane & 31, hi = lane >> 5;
    {
        float c[32], q[32], k[32];
#pragma unroll
        for (int d = 0; d < 32; d += 4) { const f32x4 v = *(const f32x4*)(bc + d); c[d] = v.x; c[d + 1] = v.y; c[d + 2] = v.z; c[d + 3] = v.w; }
        load32bf(pr + C_GQ + h * 32, q); load32bf(pr + C_GK + h * 32, k);
#pragma unroll
        for (int d = 0; d < 32; d += 8) {
            u32x4 wq, wk; float eq[8], ek[8];
#pragma unroll
            for (int i = 0; i < 8; ++i) { eq[i] = q[d + i] * __expf(c[d + i]) * 0.17677669529663687f; ek[i] = k[d + i] * __expf(-c[d + i]); }
            wq.x = cvtpk(eq[0], eq[1]); wq.y = cvtpk(eq[2], eq[3]); wq.z = cvtpk(eq[4], eq[5]); wq.w = cvtpk(eq[6], eq[7]);
            wk.x = cvtpk(ek[0], ek[1]); wk.y = cvtpk(ek[2], ek[3]); wk.z = cvtpk(ek[4], ek[5]); wk.w = cvtpk(ek[6], ek[7]);
            *(LAS u32x4*)(QS + lane * 32 + d) = wq; *(LAS u32x4*)(KS + lane * 32 + d) = wk;
        }
    }
    LDS_FENCE();
    bf16x8 qf[2][2], kf[2][2];
#pragma unroll
    for (int t = 0; t < 2; ++t)
#pragma unroll
        for (int s = 0; s < 2; ++s) { qf[t][s] = *(const LAS bf16x8*)(QS + (32 * t + r32) * 32 + 16 * s + 8 * hi); kf[t][s] = *(const LAS bf16x8*)(KS + (32 * t + r32) * 32 + 16 * s + 8 * hi); }
    LDS_FENCE();
    {
        u32x4 w[4];
#pragma unroll
        for (int d = 0; d < 32; d += 8) {
            float sv[8];
#pragma unroll
            for (int i = 0; i < 8; ++i) sv[i] = sin[(d + i) * 64 + lane];
            w[d >> 3].x = cvtpk(sv[0], sv[1]); w[d >> 3].y = cvtpk(sv[2], sv[3]); w[d >> 3].z = cvtpk(sv[4], sv[5]); w[d >> 3].w = cvtpk(sv[6], sv[7]);
        }
#pragma unroll
        for (int i = 0; i < 4; ++i) *(LAS u32x4*)(QS + lane * 32 + 8 * i) = w[i];
    }
#define GLA_X(tj, ti) __builtin_amdgcn_mfma_f32_32x32x16_bf16(kf[tj][1], qf[ti][1], __builtin_amdgcn_mfma_f32_32x32x16_bf16(kf[tj][0], qf[ti][0], (f32x16){}, 0, 0, 0), 0, 0, 0)
#define GLA_MASK(X) do { _Pragma("unroll") for (int r = 0; r < 16; ++r) { const int jl = crow(r, hi); const bool keep = DIR == 0 ? (jl <= r32) : (jl >= r32); X[r] = keep ? X[r] : 0.f; } } while (0)
#define GLA_XA(X, s) __builtin_bit_cast(bf16x8, (u32x4){cvtpk(X[8 * (s) + 0], X[8 * (s) + 1]), cvtpk(X[8 * (s) + 2], X[8 * (s) + 3]), cvtpk(X[8 * (s) + 4], X[8 * (s) + 5]), cvtpk(X[8 * (s) + 6], X[8 * (s) + 7])})
#define GLA_VF(tj, s, te) __builtin_bit_cast(bf16x8, (u32x4){((const LAS u32x2*)(VT + (32 * (te) + r32) * 64 + 32 * (tj) + 16 * (s) + 4 * hi))->x, ((const LAS u32x2*)(VT + (32 * (te) + r32) * 64 + 32 * (tj) + 16 * (s) + 4 * hi))->y, \
                                                              ((const LAS u32x2*)(VT + (32 * (te) + r32) * 64 + 32 * (tj) + 16 * (s) + 8 + 4 * hi))->x, ((const LAS u32x2*)(VT + (32 * (te) + r32) * 64 + 32 * (tj) + 16 * (s) + 8 + 4 * hi))->y})
#define GLA_PV(X, tj, O0, O1) do { _Pragma("unroll") for (int s = 0; s < 2; ++s) { const bf16x8 xa = GLA_XA(X, s); \
        O0 = __builtin_amdgcn_mfma_f32_32x32x16_bf16(xa, GLA_VF(tj, s, 0), O0, 0, 0, 0); O1 = __builtin_amdgcn_mfma_f32_32x32x16_bf16(xa, GLA_VF(tj, s, 1), O1, 0, 0, 0); } } while (0)
    __builtin_amdgcn_sched_barrier(0);
    { f32x16 X = GLA_X(0, 0); GLA_MASK(X); GLA_PV(X, 0, o00, o01); }
    __builtin_amdgcn_sched_barrier(0);
    { f32x16 X = GLA_X(1, 1); GLA_MASK(X); GLA_PV(X, 1, o10, o11); }
    __builtin_amdgcn_sched_barrier(0);
    if (DIR == 0) { f32x16 X = GLA_X(0, 1); GLA_PV(X, 0, o10, o11); }
    else          { f32x16 X = GLA_X(1, 0); GLA_PV(X, 1, o00, o01); }
    LDS_FENCE();
#pragma unroll
    for (int s = 0; s < 2; ++s) {
        const bf16x8 s0 = *(const LAS bf16x8*)(QS + r32 * 32 + 16 * s + 8 * hi), s1 = *(const LAS bf16x8*)(QS + (32 + r32) * 32 + 16 * s + 8 * hi);
        o00 = __builtin_amdgcn_mfma_f32_32x32x16_bf16(qf[0][s], s0, o00, 0, 0, 0); o01 = __builtin_amdgcn_mfma_f32_32x32x16_bf16(qf[0][s], s1, o01, 0, 0, 0);
        o10 = __builtin_amdgcn_mfma_f32_32x32x16_bf16(qf[1][s], s0, o10, 0, 0, 0); o11 = __builtin_amdgcn_mfma_f32_32x32x16_bf16(qf[1][s], s1, o11, 0, 0, 0);
    }
    LDS_FENCE();
#undef GLA_X
#undef GLA_MASK
#undef GLA_XA
#undef GLA_VF
#undef GLA_PV
}
__device__ __forceinline__ void phase_gla_out(const Args& a, int l, LAS unsigned char* lds, const int w0, const int nw) {
    unsigned char* ws = a.ws;
    const bf16_t* PB = (const bf16_t*)(ws + WS_PB); const float* BC = (const float*)((const unsigned char*)a.out + OUT_BC); const float* GL = (const float*)((const unsigned char*)a.out + OUT_GL); bf16_t* Y = (bf16_t*)(ws + WS_HY);
    const float* gnw = a.in[I_GNW] + l * 64;
    const int lane = klane(), wave = kwave(), gw = wave * KGRID + (int)blockIdx.x, ngw = KGRID * NWAVES    ;
    const int r32 = lane & 31, hi = lane >> 5;
    LAS bf16_t* QS = (LAS bf16_t*)(lds + wave * GLA_WLDS); LAS bf16_t* KS = QS + 64 * 32; LAS bf16_t* VT = KS + 64 * 32; LAS float* OS = (LAS float*)(lds + wave * GLA_WLDS);
    for (int task = (wave - w0) * KGRID + (int)blockIdx.x; wave >= w0 && wave < w0 + nw && task < 8 * GLA_NB; task += nw * KGRID) {
        const int beta = task % GLA_NB, bh = task / GLA_NB, h = bh & 3, b = bh >> 2;
        const int row = gla_row0(b, beta) + lane; const bf16_t* pr = PB + (size_t)row * INP;
        LDS_FENCE();
        gla_stage_vt(pr + C_GV + h * 64, VT, lane);
        f32x16 o00 = {}, o01 = {}, o10 = {}, o11 = {};
        gla_dir<0>(pr, BC + (size_t)row * 256 + h * 32, GL + ((size_t)(bh * 2 + 0) * GLA_NB + beta) * 2048, h, QS, KS, VT, lane, o00, o01, o10, o11);
        gla_dir<1>(pr, BC + (size_t)row * 256 + 128 + h * 32, GL + ((size_t)(bh * 2 + 1) * GLA_NB + beta) * 2048, h, QS, KS, VT, lane, o00, o01, o10, o11);
#pragma unroll
        for (int r = 0; r < 16; ++r) { const int i = crow(r, hi);
            OS[i * 65 + r32] = o00[r]; OS[i * 65 + 32 + r32] = o01[r]; OS[(32 + i) * 65 + r32] = o10[r]; OS[(32 + i) * 65 + 32 + r32] = o11[r]; }
        LDS_FENCE();
        float ss = 0.f;
#pragma unroll
        for (int e = 0; e < 64; ++e) { const float v = OS[lane * 65 + e]; ss += v * v; }
        const float rstd = rsqrtf(ss * (1.f / 64.f) + EPS);
        bf16_t* yp = Y + (size_t)row * DM + 256 + h * 64;
#pragma unroll
        for (int c8 = 0; c8 < 8; ++c8) { float rr[8]; unpack8(*(const u32x4*)(pr + C_GR + h * 64 + c8 * 8), rr);
            float y[8];
#pragma unroll
            for (int i = 0; i < 8; ++i) y[i] = OS[lane * 65 + c8 * 8 + i] * rstd * gnw[c8 * 8 + i] * rr[i];
            u32x4 w; w.x = cvtpk(y[0], y[1]); w.y = cvtpk(y[2], y[3]); w.z = cvtpk(y[4], y[5]); w.w = cvtpk(y[6], y[7]);
            *(u32x4*)(yp + c8 * 8) = w; }
    }
}

__device__ __forceinline__ void phase_sgu_mfma(const Args& a, int l, LAS unsigned char* lds, const int w0, const int nw) {
    unsigned char* ws = a.ws;
    const bf16_t* PB = (const bf16_t*)(ws + WS_PB); bf16_t* Y = (bf16_t*)(ws + WS_HY);
    const bf16_t* WSB = (const bf16_t*)(ws + WS_WSB) + (size_t)l * 4 * 128 * 128; const float* bs = a.in[I_SGB] + l * 4 * 128;
    const int lane = klane(), wave = kwave(), gw = wave * KGRID + (int)blockIdx.x, ngw = KGRID * NWAVES    ;
    const int r32 = lane & 31, hi = lane >> 5;
    LAS bf16_t* VT = (LAS bf16_t*)(lds + wave * GLA_WLDS);
    for (int task = (wave - w0) * KGRID + (int)blockIdx.x; wave >= w0 && wave < w0 + nw && task < (MT / 128) * 4; task += nw * KGRID) {
        const int cc = task >> 2, h = task & 3;
        LDS_FENCE();
#pragma unroll
        for (int half = 0; half < 2; ++half) { const int j = lane + 64 * half; const bf16_t* pv = PB + (size_t)(cc * 128 + j) * INP + C_SV + h * 64;
#pragma unroll
            for (int c8 = 0; c8 < 8; ++c8) { const u32x4 w = *(const u32x4*)(pv + c8 * 8);
                VT[(c8 * 8 + 0) * 128 + j] = (bf16_t)(w.x & 0xffffu); VT[(c8 * 8 + 1) * 128 + j] = (bf16_t)(w.x >> 16);
                VT[(c8 * 8 + 2) * 128 + j] = (bf16_t)(w.y & 0xffffu); VT[(c8 * 8 + 3) * 128 + j] = (bf16_t)(w.y >> 16);
                VT[(c8 * 8 + 4) * 128 + j] = (bf16_t)(w.z & 0xffffu); VT[(c8 * 8 + 5) * 128 + j] = (bf16_t)(w.z >> 16);
                VT[(c8 * 8 + 6) * 128 + j] = (bf16_t)(w.w & 0xffffu); VT[(c8 * 8 + 7) * 128 + j] = (bf16_t)(w.w >> 16); } }
        LDS_FENCE();
#pragma unroll 1
        for (int ti = 0; ti < 4; ++ti) {
            f32x16 acc0 = {}, acc1 = {};
            const bf16_t* wrow = WSB + ((size_t)h * 128 + 32 * ti + r32) * 128 + 8 * hi;
#pragma unroll
            for (int s = 0; s < 8; ++s) {
                const bf16x8 bw = *(const bf16x8*)(wrow + 16 * s);
                const bf16x8 a0 = *(const LAS bf16x8*)(VT + r32 * 128 + 16 * s + 8 * hi), a1 = *(const LAS bf16x8*)(VT + (32 + r32) * 128 + 16 * s + 8 * hi);
                acc0 = __builtin_amdgcn_mfma_f32_32x32x16_bf16(a0, bw, acc0, 0, 0, 0); acc1 = __builtin_amdgcn_mfma_f32_32x32x16_bf16(a1, bw, acc1, 0, 0, 0);
            }
            const int i = 32 * ti + r32, row = cc * 128 + i; const float bias = bs[h * 128 + i];
            const bf16_t* up = PB + (size_t)row * INP + C_SU + h * 64 + 4 * hi; bf16_t* yp = Y + (size_t)row * DM + h * 64 + 4 * hi;
#pragma unroll
            for (int g = 0; g < 4; ++g) {
                { const u32x2 u = *(const u32x2*)(up + 8 * g); u32x2 o;
                  o.x = cvtpk(__uint_as_float(u.x << 16) * (acc0[4 * g + 0] + bias), __uint_as_float(u.x & 0xffff0000u) * (acc0[4 * g + 1] + bias));
                  o.y = cvtpk(__uint_as_float(u.y << 16) * (acc0[4 * g + 2] + bias), __uint_as_float(u.y & 0xffff0000u) * (acc0[4 * g + 3] + bias));
                  *(u32x2*)(yp + 8 * g) = o; }
                { const u32x2 u = *(const u32x2*)(up + 32 + 8 * g); u32x2 o;
                  o.x = cvtpk(__uint_as_float(u.x << 16) * (acc1[4 * g + 0] + bias), __uint_as_float(u.x & 0xffff0000u) * (acc1[4 * g + 1] + bias));
                  o.y = cvtpk(__uint_as_float(u.y << 16) * (acc1[4 * g + 2] + bias), __uint_as_float(u.y & 0xffff0000u) * (acc1[4 * g + 3] + bias));
                  *(u32x2*)(yp + 32 + 8 * g) = o; }
            }
        }
    }
}

__device__ __forceinline__ void phase_attn_naive(const Args& a, int l, LAS unsigned char* lds) {
    unsigned char* ws = a.ws;
    const bf16_t* QB = (const bf16_t*)(ws + WS_QB); const bf16_t* KVB = (const bf16_t*)(ws + WS_KVB); const bf16_t* PB = (const bf16_t*)(ws + WS_PB); bf16_t* Y = (bf16_t*)(ws + WS_HY);
    const float* ROPE = (const float*)(ws + WS_ROPE);
    LAS float* Qs = (LAS float*)lds;
    LAS float* Ks = Qs + 192 * 64;
    LAS float* Vs = Ks + 96 * 64;
    LAS float* Ps = Vs + 64 * 128;
    const int tid = KTID, ty = tid >> 4, tx = tid & 15;
    const int nunits = 1024 + (l == 0 ? 32 : 0);
    for (int unit = blockIdx.x; unit < nunits; unit += KGRID) {
        int bh, nkeys, orow0;
        if (unit < 1024) { bh = unit >> 7; const int qb = unit & 127; nkeys = NKEY; orow0 = (bh >> 2) * NL + qb * 64; }
        else { const int u = unit - 1024; bh = u >> 2; const int qb = u & 3; nkeys = NC; orow0 = ML + (bh >> 2) * NC + qb * 64; }
        const int h = bh & 3, b = bh >> 2;
        const bf16_t* Qp = QB + (size_t)orow0 * 768 + h * 192;
        __syncthreads();
        for (int idx = tid; idx < 64 * 24; idx += NTHR) { const int r = idx / 24, ch = idx % 24; float f[8]; unpack8(*(const u32x4*)(Qp + (size_t)r * 768 + ch * 8), f);
            if (ch >= 16 && unit < 1024) { const int t = (orow0 + r) & (NL - 1), jj = (ch - 16) * 8;
                const f32x4 r0 = rope4((f32x4){f[0], f[1], f[2], f[3]}, jj, t, ROPE), r1 = rope4((f32x4){f[4], f[5], f[6], f[7]}, jj + 4, t, ROPE);
                f[0] = r0.x; f[1] = r0.y; f[2] = r0.z; f[3] = r0.w; f[4] = r1.x; f[5] = r1.y; f[6] = r1.z; f[7] = r1.w; }
#pragma unroll
            for (int i = 0; i < 8; ++i) Qs[(ch * 8 + i) * 64 + r] = f[i]; }
        float m[2] = {-1e30f, -1e30f}, lsum[2] = {0.f, 0.f}, o[2][8];
#pragma unroll
        for (int r = 0; r < 2; ++r)
#pragma unroll
            for (int c = 0; c < 8; ++c) o[r][c] = 0.f;
        for (int k0 = 0; k0 < nkeys; k0 += 64) {
            const int krow0 = k0 < NC ? ML + b * NC + k0 : b * NL + (k0 - NC);
            float s[2][4];
#pragma unroll
            for (int r = 0; r < 2; ++r)
#pragma unroll
                for (int j = 0; j < 4; ++j) s[r][j] = 0.f;
            for (int dh = 0; dh < 2; ++dh) {
                __syncthreads();
                for (int idx = tid; idx < 64 * 12; idx += NTHR) { const int key = idx / 12, ch = idx % 12; float f[8];
                    const int dcol = dh * 96 + ch * 8;
                    unpack8(dcol < 128 ? *(const u32x4*)(KVB + (size_t)(krow0 + key) * 1024 + h * 256 + dcol) : *(const u32x4*)(PB + (size_t)(krow0 + key) * INP + C_KR + (dcol - 128)), f);
#pragma unroll
                    for (int i = 0; i < 8; ++i) Ks[(ch * 8 + i) * 64 + key] = f[i]; }
                if (dh == 0) {
                    for (int idx = tid; idx < 64 * 16; idx += NTHR) { const int key = idx >> 4, ch = idx & 15; float f[8];
                        unpack8(*(const u32x4*)(KVB + (size_t)(krow0 + key) * 1024 + h * 256 + 128 + ch * 8), f);
#pragma unroll
                        for (int i = 0; i < 8; ++i) Vs[key * 128 + ch * 8 + i] = f[i]; }
                }
                __syncthreads();
#pragma unroll 4
                for (int d = 0; d < 96; ++d) {
                    const float q0 = Qs[(dh * 96 + d) * 64 + 2 * ty], q1 = Qs[(dh * 96 + d) * 64 + 2 * ty + 1];
                    const f32x4 kv = *(const LAS f32x4*)(Ks + d * 64 + 4 * tx);
#pragma unroll
                    for (int j = 0; j < 4; ++j) { s[0][j] += q0 * kv[j]; s[1][j] += q1 * kv[j]; }
                }
            }
#pragma unroll
            for (int r = 0; r < 2; ++r) {
                float mx = fmaxf(fmaxf(s[r][0], s[r][1]), fmaxf(s[r][2], s[r][3]));
                mx = fmaxf(mx, __shfl_xor(mx, 1)); mx = fmaxf(mx, __shfl_xor(mx, 2)); mx = fmaxf(mx, __shfl_xor(mx, 4)); mx = fmaxf(mx, __shfl_xor(mx, 8));
                const float mn = fmaxf(m[r], mx), alpha = exp2f(m[r] - mn);
                float p[4], rs = 0.f;
#pragma unroll
                for (int j = 0; j < 4; ++j) { p[j] = exp2f(s[r][j] - mn); rs += p[j]; Ps[(2 * ty + r) * 65 + 4 * tx + j] = p[j]; }
                rs += __shfl_xor(rs, 1); rs += __shfl_xor(rs, 2); rs += __shfl_xor(rs, 4); rs += __shfl_xor(rs, 8);
                lsum[r] = lsum[r] * alpha + rs; m[r] = mn;
#pragma unroll
                for (int c = 0; c < 8; ++c) o[r][c] *= alpha;
            }
            __syncthreads();
#pragma unroll 4
            for (int j = 0; j < 64; ++j) {
                const float p0 = Ps[(2 * ty) * 65 + j], p1 = Ps[(2 * ty + 1) * 65 + j];
                const f32x4 v0 = *(const LAS f32x4*)(Vs + j * 128 + 8 * tx), v1 = *(const LAS f32x4*)(Vs + j * 128 + 8 * tx + 4);
#pragma unroll
                for (int c = 0; c < 4; ++c) { o[0][c] += p0 * v0[c]; o[0][4 + c] += p0 * v1[c]; o[1][c] += p1 * v0[c]; o[1][4 + c] += p1 * v1[c]; }
            }
        }
#pragma unroll
        for (int r = 0; r < 2; ++r) {
            const float il = 1.f / lsum[r];
            u32x4 w; w.x = pk2(o[r][0] * il, o[r][1] * il); w.y = pk2(o[r][2] * il, o[r][3] * il); w.z = pk2(o[r][4] * il, o[r][5] * il); w.w = pk2(o[r][6] * il, o[r][7] * il);
            *(u32x4*)(Y + (size_t)(orow0 + 2 * ty + r) * DM + 512 + h * 128 + 8 * tx) = w;
        }
    }
}

namespace att {
using s16x4 = __attribute__((ext_vector_type(4))) short;
constexpr int QBLK = 32, KVBLK = 64;
constexpr int SHM_V = KVBLK * 128 * 2, SHM_K = KVBLK * 192 * 2, SHM_SCR = 2 * SHM_V + 2 * SHM_K, SHM_QL = SHM_SCR + NWAVES * 64 * 4, SHM_ATTN = SHM_QL + NWAVES * ATT_NQL * 1024;
constexpr float THR2 = 11.5f;
#define KSWZ(row, colB) ((row) * 384 + ((colB) ^ ((((row) >> 1) & 7) << 4)))
#define SBAR() __builtin_amdgcn_sched_barrier(0)
__device__ __forceinline__ float rowmax32(const f32x16& p0, const f32x16& p1) {
  float a = fmaxf(fmaxf(p0[0], p0[1]), p1[0]), b = fmaxf(fmaxf(p0[2], p0[3]), p1[1]); a = fmaxf(fmaxf(a, p1[2]), p1[3]);
#pragma unroll
  for (int r = 4; r < 16; r += 4) { a = fmaxf(fmaxf(a, p0[r]), p0[r + 1]); b = fmaxf(fmaxf(b, p0[r + 2]), p0[r + 3]); a = fmaxf(fmaxf(a, p1[r]), p1[r + 1]); b = fmaxf(fmaxf(b, p1[r + 2]), p1[r + 3]); }
  float m = fmaxf(a, b);
  auto rr = __builtin_amdgcn_permlane32_swap(__float_as_uint(m), __float_as_uint(m), false, false);
  return fmaxf(__uint_as_float(rr[0]), __uint_as_float(rr[1]));
}
template <bool FIRST> __device__ __forceinline__ void partialSM(f32x16& p0, f32x16& p1, float& mhat, f32x16& negm, float& alpha) {
  const float rm = rowmax32(p0, p1);
  alpha = 1.f;
  if (FIRST || __builtin_expect(__any(rm > THR2), 0)) {
    const float dl = FIRST ? rm : fmaxf(rm, 0.f);
    mhat += dl;
#pragma unroll
    for (int r = 0; r < 16; ++r) { p0[r] -= dl; p1[r] -= dl; }
#pragma unroll
    for (int r = 0; r < 16; ++r) negm[r] = -mhat;
    if (!FIRST) alpha = __builtin_amdgcn_exp2f(-dl);
  }
#pragma unroll
  for (int r = 0; r < 16; ++r) p0[r] = __builtin_amdgcn_exp2f(p0[r]);
}
__device__ __forceinline__ void finishSM(f32x16& p0, f32x16& p1, float alpha, float& l_reg, bf16x8& pa0, bf16x8& pa1, bf16x8& pa2, bf16x8& pa3) {
#pragma unroll
  for (int r = 0; r < 16; ++r) p1[r] = __builtin_amdgcn_exp2f(p1[r]);
  float ps = 0;
#pragma unroll
  for (int r = 0; r < 16; ++r) ps += p0[r];
#pragma unroll
  for (int r = 0; r < 16; ++r) ps += p1[r];
  { auto rr = __builtin_amdgcn_permlane32_swap(__float_as_uint(ps), __float_as_uint(ps), false, false);
    ps = __uint_as_float(rr[0]) + __uint_as_float(rr[1]); }
  l_reg = l_reg * alpha + ps;
#define PK4(P, BASE, OUT) do { unsigned a0 = cvtpk(P[BASE + 0], P[BASE + 1]), a1 = cvtpk(P[BASE + 2], P[BASE + 3]);   \
    unsigned b0 = cvtpk(P[BASE + 4], P[BASE + 5]), b1 = cvtpk(P[BASE + 6], P[BASE + 7]);                              \
    auto r0 = __builtin_amdgcn_permlane32_swap(a0, b0, false, false); auto r1 = __builtin_amdgcn_permlane32_swap(a1, b1, false, false); \
    u32x4 w = {r0[0], r1[0], r0[1], r1[1]}; OUT = __builtin_bit_cast(bf16x8, w); } while (0)
  PK4(p0, 0, pa0); PK4(p0, 8, pa1); PK4(p1, 0, pa2); PK4(p1, 8, pa3);
#undef PK4
}
constexpr int NQR = 12 - ATT_NQL;
#define ATT_KRD(K0, K1, d0, KB) asm volatile("ds_read_b128 %0, %2 offset:%3\n\tds_read_b128 %1, %2 offset:%4" : "=&v"(K0), "=&v"(K1) : "v"(ka[(d0) & 3]), "i"((KB) + ((d0) >> 2) * 128), "i"((KB) + ((d0) >> 2) * 128 + 12288) : "memory")
#define ATT_QRD(Q, d0) asm volatile("ds_read_b128 %0, %1 offset:%2" : "=&v"(Q) : "v"(qla), "i"(((d0) - NQR) * 1024) : "memory")
template <int KB> __device__ __forceinline__ void qkt(f32x16& p0, f32x16& p1, const unsigned (&ka)[4], const bf16x8* qr, unsigned qla, const f32x16& negm) {
  p0 = negm; p1 = negm;
  bf16x8 kx0, kx1, ky0, ky1, qx, qy;
  ATT_KRD(kx0, kx1, 0, KB); if (0 >= NQR) ATT_QRD(qx, 0);
#pragma unroll
  for (int d0 = 0; d0 < 12; d0 += 2) {
    ATT_KRD(ky0, ky1, d0 + 1, KB); if (d0 + 1 >= NQR) ATT_QRD(qy, d0 + 1);
    if (d0 + 1 >= NQR) { if (d0 >= NQR) asm volatile("s_waitcnt lgkmcnt(3)" : "+v"(kx0), "+v"(kx1), "+v"(qx)); else asm volatile("s_waitcnt lgkmcnt(3)" : "+v"(kx0), "+v"(kx1)); }
    else asm volatile("s_waitcnt lgkmcnt(2)" : "+v"(kx0), "+v"(kx1));
    { const bf16x8 qf = d0 < NQR ? qr[d0 < NQR ? d0 : 0] : qx;
      p0 = __builtin_amdgcn_mfma_f32_32x32x16_bf16(kx0, qf, p0, 0, 0, 0); p1 = __builtin_amdgcn_mfma_f32_32x32x16_bf16(kx1, qf, p1, 0, 0, 0); }
    if (d0 + 2 < 12) { ATT_KRD(kx0, kx1, d0 + 2, KB); if (d0 + 2 >= NQR) ATT_QRD(qx, d0 + 2);
      if (d0 + 2 >= NQR) { if (d0 + 1 >= NQR) asm volatile("s_waitcnt lgkmcnt(3)" : "+v"(ky0), "+v"(ky1), "+v"(qy)); else asm volatile("s_waitcnt lgkmcnt(3)" : "+v"(ky0), "+v"(ky1)); }
      else asm volatile("s_waitcnt lgkmcnt(2)" : "+v"(ky0), "+v"(ky1)); }
    else { if (d0 + 1 >= NQR) asm volatile("s_waitcnt lgkmcnt(0)" : "+v"(ky0), "+v"(ky1), "+v"(qy)); else asm volatile("s_waitcnt lgkmcnt(0)" : "+v"(ky0), "+v"(ky1)); }
    { const bf16x8 qf = d0 + 1 < NQR ? qr[d0 + 1 < NQR ? d0 + 1 : 0] : qy;
      p0 = __builtin_amdgcn_mfma_f32_32x32x16_bf16(ky0, qf, p0, 0, 0, 0); p1 = __builtin_amdgcn_mfma_f32_32x32x16_bf16(ky1, qf, p1, 0, 0, 0); }
  }
}
__device__ __forceinline__ int v_st(int k, int c) { const int kk = (k & ~0xC) | ((k & 4) << 1) | ((k & 8) >> 1); return ((kk >> 3) * 4 + (c >> 5)) * 512 + ((kk & 7) * 32 + (c & 31)) * 2; }
__device__ __forceinline__ int v_rd_base(int lane) { return ((lane & 3) << 3) | (((lane >> 2) & 3) << 6) | (((lane >> 4) & 1) << 5) | (((lane >> 5) & 1) << 8); }
constexpr int v_rd_off(int d0, int ks, int half) { return d0 * 512 + ks * 4096 + half * 2048; }
template <int OFF> __device__ __forceinline__ s16x4 tr_read(int vb) {
  s16x4 r; asm volatile("ds_read_b64_tr_b16 %0, %1 offset:%2" : "=&v"(r) : "v"(vb), "i"(OFF) : "memory"); return r;
}
template <int D0> __device__ __forceinline__ void pv_one(f32x16& od, int vb, bf16x8 pa0, bf16x8 pa1, bf16x8 pa2, bf16x8 pa3) {
  const s16x4 l0 = tr_read<v_rd_off(D0, 0, 0)>(vb), h0 = tr_read<v_rd_off(D0, 0, 1)>(vb), l1 = tr_read<v_rd_off(D0, 1, 0)>(vb), h1 = tr_read<v_rd_off(D0, 1, 1)>(vb);
  const s16x4 l2 = tr_read<v_rd_off(D0, 2, 0)>(vb), h2 = tr_read<v_rd_off(D0, 2, 1)>(vb), l3 = tr_read<v_rd_off(D0, 3, 0)>(vb), h3 = tr_read<v_rd_off(D0, 3, 1)>(vb);
  asm volatile("s_waitcnt lgkmcnt(0)" ::: "memory"); SBAR();
#define PK(L, H) (bf16x8){L[0], L[1], L[2], L[3], H[0], H[1], H[2], H[3]}
  od = __builtin_amdgcn_mfma_f32_32x32x16_bf16(pa0, PK(l0, h0), od, 0, 0, 0);
  od = __builtin_amdgcn_mfma_f32_32x32x16_bf16(pa1, PK(l1, h1), od, 0, 0, 0);
  od = __builtin_amdgcn_mfma_f32_32x32x16_bf16(pa2, PK(l2, h2), od, 0, 0, 0);
  od = __builtin_amdgcn_mfma_f32_32x32x16_bf16(pa3, PK(l3, h3), od, 0, 0, 0);
#undef PK
}
__device__ __forceinline__ void pv_d0(f32x16* o, int vb, bf16x8 pa0, bf16x8 pa1, bf16x8 pa2, bf16x8 pa3) {
  pv_one<0>(o[0], vb, pa0, pa1, pa2, pa3); pv_one<1>(o[1], vb, pa0, pa1, pa2, pa3); pv_one<2>(o[2], vb, pa0, pa1, pa2, pa3); pv_one<3>(o[3], vb, pa0, pa1, pa2, pa3);
}
template <int ABL> __device__ __forceinline__ void unit(const bf16_t* __restrict__ QB, const bf16_t* __restrict__ KVB, const bf16_t* __restrict__ PB, const float* __restrict__ ROPE, bf16_t* __restrict__ Y,
                                     int qrow0, int b, int h, int nkeys, bool ropeq, LAS unsigned char* lds) {
  const int wid = kwave(), lane = klane(), tid = wid * 64 + lane, r32 = lane & 31, hi = lane >> 5;
  LAS unsigned char* V_lds = lds; LAS unsigned char* K_lds = lds + 2 * SHM_V;
  LAS float* wsc = (LAS float*)(lds + SHM_SCR) + wid * 64; LAS float* li_l = wsc; LAS float* al_l = wsc + 32;
  LAS unsigned char* qlw = lds + SHM_QL + wid * (ATT_NQL * 1024); const LAS unsigned char* ql = qlw + lane * 16;
  float mhat = 0.f, l_reg = 0; f32x16 o[4] = {}; f32x16 negm = {}; bf16x8 qr[NQR];
  {
    const int qrow = qrow0 + wid * QBLK + r32;
    const bf16_t* Qw = QB + (size_t)qrow * 768 + h * 192 + hi * 8;
#pragma unroll
    for (int d0 = 0; d0 < 12; ++d0) {
      u32x4 w = *(const u32x4*)(Qw + d0 * 16);
      if (d0 >= 8 && ropeq) { float f[8]; unpack8(w, f); const int t = qrow & (NL - 1), jj = (d0 - 8) * 16 + hi * 8;
        const f32x4 r0 = rope4((f32x4){f[0], f[1], f[2], f[3]}, jj, t, ROPE), r1 = rope4((f32x4){f[4], f[5], f[6], f[7]}, jj + 4, t, ROPE);
        w.x = cvtpk(r0.x, r0.y); w.y = cvtpk(r0.z, r0.w); w.z = cvtpk(r1.x, r1.y); w.w = cvtpk(r1.z, r1.w); }
      if (d0 < NQR) qr[d0 < NQR ? d0 : 0] = __builtin_bit_cast(bf16x8, w); else *(LAS u32x4*)(qlw + (d0 - NQR) * 1024 + lane * 16) = w;
    }
  }
  const int sr = tid >> 4, sc = (tid & 15) * 8, vst0 = v_st(sr, sc), vst1 = v_st(32 + sr, sc);
  const int krw = tid >> 3, kcg = tid & 7;
  const int kw0 = KSWZ(krw, kcg * 16), kw1 = KSWZ(krw, (kcg + 8) * 16), kw2 = KSWZ(krw, (kcg + 16) * 16);
  const int vb0 = (int)(uintptr_t)V_lds + v_rd_base(lane);
  unsigned ka[4];
#pragma unroll
  for (int c = 0; c < 4; ++c) ka[c] = (unsigned)(uintptr_t)K_lds + r32 * 384 + (((c << 5) | (hi << 4)) ^ (((r32 >> 1) & 7) << 4));
  const unsigned qla = (unsigned)(uintptr_t)ql;
  u32x4 sv0, sv1, sk0, sk1, sk2;
#define KROW(k0) ((k0) < NC ? ML + b * NC + (k0) : b * NL + ((k0) - NC))
  const int gv0 = sr * 1024 + h * 256 + 128 + sc, gv1 = gv0 + 32 * 1024, gk0 = krw * 1024 + h * 256 + kcg * 8, gk1 = gk0 + 64, gk2 = krw * INP + C_KR + kcg * 8;
#define KLOAD(k0) do { const int kr_ = __builtin_amdgcn_readfirstlane(KROW(k0)); const bf16_t* kvb_ = KVB + (size_t)kr_ * 1024; const bf16_t* pb_ = PB + (size_t)kr_ * INP; \
    sk0 = *(const u32x4*)(kvb_ + gk0); sk1 = *(const u32x4*)(kvb_ + gk1); sk2 = *(const u32x4*)(pb_ + gk2); } while (0)
#define VLOAD(k0) do { const int kr_ = __builtin_amdgcn_readfirstlane(KROW(k0)); const bf16_t* kvb_ = KVB + (size_t)kr_ * 1024; \
    sv0 = *(const u32x4*)(kvb_ + gv0); sv1 = *(const u32x4*)(kvb_ + gv1); } while (0)
#define KWRITE(bf) do { *(LAS u32x4*)(K_lds + (bf) * SHM_K + kw0) = sk0; *(LAS u32x4*)(K_lds + (bf) * SHM_K + kw1) = sk1; *(LAS u32x4*)(K_lds + (bf) * SHM_K + kw2) = sk2; } while (0)
#define VWRITE(bf) do { *(LAS u32x4*)(V_lds + (bf) * SHM_V + vst0) = sv0; *(LAS u32x4*)(V_lds + (bf) * SHM_V + vst1) = sv1; } while (0)
#define RESC(a) do { if (__any((a) < 1.f)) { if (hi == 0) al_l[r32] = (a); asm volatile("s_waitcnt lgkmcnt(0)" ::: "memory"); \
    _Pragma("unroll") for (int d = 0; d < 4; ++d) _Pragma("unroll") for (int r = 0; r < 16; ++r) o[d][r] *= al_l[crow(r, hi)]; } } while (0)
  f32x16 pA0, pA1, pB0, pB1; float mnA, mnB, alA, alB; bf16x8 pa0, pa1, pa2, pa3; const int NT = nkeys / KVBLK;
#define QKT0(P0, P1) do { if constexpr (ABL == 2) { P0 = f32x16{}; P1 = f32x16{}; asm volatile("" : "+v"(P0), "+v"(P1)); } else qkt<0>(P0, P1, ka, qr, qla, negm); } while (0)
#define QKT1(P0, P1) do { if constexpr (ABL == 2) { P0 = f32x16{}; P1 = f32x16{}; asm volatile("" : "+v"(P0), "+v"(P1)); } else qkt<SHM_K>(P0, P1, ka, qr, qla, negm); } while (0)
#define PV(VB) do { if constexpr (ABL == 3) { asm volatile("" : "+v"(o[0]), "+v"(o[1]), "+v"(o[2]), "+v"(o[3]) : "v"(pa0), "v"(pa1), "v"(pa2), "v"(pa3)); } else pv_d0(o, VB, pa0, pa1, pa2, pa3); } while (0)
#define PSM(P0, P1, MN, AL) do { if constexpr (ABL == 4) { MN = 0.f; AL = 1.f; asm volatile("" : "+v"(P0), "+v"(P1)); } else partialSM<false>(P0, P1, mhat, negm, AL); } while (0)
#define PSM0(P0, P1, MN, AL) partialSM<true>(P0, P1, mhat, negm, AL)
#define FSM(P0, P1, AL) do { if constexpr (ABL == 4) { u32x4 w0_ = {__float_as_uint(P0[0]), __float_as_uint(P0[1]), __float_as_uint(P0[2]), __float_as_uint(P0[3])}, w1_ = {__float_as_uint(P1[0]), __float_as_uint(P1[1]), __float_as_uint(P1[2]), __float_as_uint(P1[3])}; \
      pa0 = __builtin_bit_cast(bf16x8, w0_); pa1 = __builtin_bit_cast(bf16x8, w1_); pa2 = pa0; pa3 = pa1; l_reg += AL; } else finishSM(P0, P1, AL, l_reg, pa0, pa1, pa2, pa3); } while (0)
  KLOAD(0); KWRITE(0); __syncthreads();
  if (wid >= 4) __syncthreads();
  SBAR(); KLOAD(KVBLK); SBAR(); QKT0(pA0, pA1); SBAR(); KWRITE(1); __syncthreads();
  SBAR(); VLOAD(0); SBAR(); PSM0(pA0, pA1, mnA, alA); SBAR(); VWRITE(0); __syncthreads();
  for (int j = 1; j + 1 < NT; j += 2) {
    SBAR(); if constexpr (ABL != 1) KLOAD((j + 1) * KVBLK); SBAR(); QKT1(pB0, pB1); FSM(pA0, pA1, alA); SBAR(); if constexpr (ABL != 1) KWRITE(0); __syncthreads();
    SBAR(); if constexpr (ABL != 1) VLOAD(j * KVBLK); SBAR(); PV(vb0); PSM(pB0, pB1, mnB, alB); RESC(alB); SBAR(); if constexpr (ABL != 1) VWRITE(1); __syncthreads();
    SBAR(); if constexpr (ABL != 1) KLOAD((j + 2) * KVBLK); SBAR(); QKT0(pA0, pA1); FSM(pB0, pB1, alB); SBAR(); if constexpr (ABL != 1) KWRITE(1); __syncthreads();
    SBAR(); if constexpr (ABL != 1) VLOAD((j + 1) * KVBLK); SBAR(); PV(vb0 + SHM_V); PSM(pA0, pA1, mnA, alA); RESC(alA); SBAR(); if constexpr (ABL != 1) VWRITE(0); __syncthreads();
  }
  SBAR(); QKT1(pB0, pB1); FSM(pA0, pA1, alA); SBAR(); __syncthreads();
  SBAR(); VLOAD((NT - 1) * KVBLK); SBAR(); PV(vb0); PSM(pB0, pB1, mnB, alB); RESC(alB); SBAR(); VWRITE(1); __syncthreads();
  if (wid < 4) __syncthreads();
  FSM(pB0, pB1, alB); SBAR();
  PV(vb0 + SHM_V);
#undef QKT0
#undef PSM0
#undef QKT1
#undef PV
#undef PSM
#undef FSM
  if (hi == 0) li_l[r32] = l_reg; asm volatile("s_waitcnt lgkmcnt(0)" ::: "memory");
  float rli[16];
#pragma unroll
  for (int r = 0; r < 16; ++r) rli[r] = __builtin_amdgcn_rcpf(li_l[crow(r, hi)]);
  bf16_t* Ow = Y + (size_t)(qrow0 + wid * QBLK) * DM + 512 + h * 128;
#pragma unroll
  for (int r = 0; r < 16; ++r) { const int orow = crow(r, hi);
#pragma unroll
    for (int d0 = 0; d0 < 4; ++d0) { const float val = o[d0][r] * rli[r]; if constexpr (ABL == 0) Ow[(size_t)orow * DM + d0 * 32 + r32] = (bf16_t)(cvtpk(val, 0.f) & 0xffffu); else asm volatile("" :: "v"(val)); } }
#undef KROW
#undef KLOAD
#undef VLOAD
#undef KWRITE
#undef VWRITE
#undef RESC
}
#undef KSWZ
#undef SBAR
}
template <int ABL> __device__ __forceinline__ void phase_attn_mfma(const Args& a, int l, LAS unsigned char* lds) {
    unsigned char* ws = a.ws;
    const bf16_t* QB = (const bf16_t*)(ws + WS_QB); const bf16_t* KVB = (const bf16_t*)(ws + WS_KVB); const bf16_t* PB = (const bf16_t*)(ws + WS_PB); bf16_t* Y = (bf16_t*)(ws + WS_HY);
    const float* ROPE = (const float*)(ws + WS_ROPE);
    const int nunits = 256 + (l == 0 ? 8 : 0);
    for (int u = blockIdx.x; u < nunits; u += KGRID) {
        __syncthreads();
        if (u < 256) { const int bh = u & 7, qb = u >> 3, b = bh >> 2, h = bh & 3; att::unit<ABL>(QB, KVB, PB, ROPE, Y, b * NL + qb * 256, b, h, NKEY, true, lds); }
        else { const int bh = u - 256, b = bh >> 2, h = bh & 3; att::unit<ABL>(QB, KVB, PB, ROPE, Y, ML + b * NC, b, h, NC, false, lds); }
    }
}

namespace pg8 {
#define PG8_LAS __attribute__((address_space(3)))
typedef unsigned short bf16_t;
typedef short bf16x8 __attribute__((ext_vector_type(8)));
typedef float f32x4 __attribute__((ext_vector_type(4)));
typedef unsigned u32x4 __attribute__((ext_vector_type(4)));
constexpr int BM = 256, BK = 64, HALF = 128, HTB = HALF * BK * 2  , STAGE_BYTES = 8 * HTB, NXCD = 8, WGM = 8;

__host__ __device__ __forceinline__ int lds_byte(int r, int c) { const int st = (r >> 4) * 2 + (c >> 5), rr = r & 15, cc = c & 31, ob = rr * 64 + cc * 2; return st * 1024 + (ob ^ (((ob >> 9) & 1) << 5)); }
__host__ __device__ __forceinline__ void stage_rc(int b, int& R, int& C) { const int st = b / 1024, sb = b % 1024, swz = sb ^ (((sb >> 9) & 1) << 5); R = (st >> 1) * 16 + swz / 64; C = (st & 1) * 32 + (swz % 64) / 2; }
__host__ __device__ __forceinline__ int perm32(int rho) { const int n = rho >> 4, i = rho & 15; return 8 * (i >> 2) + 4 * n + (i & 3); }

struct Unit { int pm, pn; };
struct Gemm { const bf16_t* A; int lda; const bf16_t* Bt; int M, N, K; };

struct StaticOrder {
    int nM, nN, nwg, G, c;
    __host__ __device__ void init(int M, int N, int G_, int c_) { nM = M / BM; nN = N / BM; nwg = nM * nN; G = G_; c = c_; }
    __host__ __device__ bool next(int i, Unit& u) const {
        const long L = (long)i * G + c; if (L >= nwg) return false;
        int wgid = (int)L; { const int q = nwg / NXCD, r = nwg % NXCD, xcd = wgid % NXCD, off = wgid / NXCD; wgid = (xcd < r ? xcd * (q + 1) : r * (q + 1) + (xcd - r) * q) + off; }
        const int nig = WGM * nN, gid = wgid / nig, fm = gid * WGM, gsz = (nM - fm) < WGM ? (nM - fm) : WGM;
        u.pm = fm + ((wgid % nig) % gsz); u.pn = (wgid % nig) / gsz; return true;
    }
    __device__ __forceinline__ void a_ready(const Unit&) const {}
    __device__ __forceinline__ void done(const Unit&) const {}
};
template <class Epi, class Sched, bool ALIGN_EPI = false, bool SP2 = false>
__device__ __forceinline__ void gemm_phase(PG8_LAS unsigned char* lds, const Gemm g, const Sched& S, const Epi& E) {
    const int wid = kwave(), lane = klane(), tid = wid * 64 + lane, wr = wid >> 2, wc = wid & 3, fr = lane & 15, fq = lane >> 4;
    const int K = g.K, nt = K / BK;
    unsigned voffA[2], voffB[2];
#pragma unroll
    for (int i = 0; i < 2; ++i) { int R, C; stage_rc(tid * 16 + i * 8192, R, C); const int Rb = Epi::PERM ? ((R & ~31) + perm32(R & 31)) : R;
        voffA[i] = (unsigned)(R * g.lda + C) * 2u; voffB[i] = (unsigned)(Rb * K + C) * 2u; }
    const size_t kstep = (size_t)(BK * 2);
    const size_t hstepA = (size_t)HALF * g.lda * 2, hstepB = (size_t)HALF * K * 2;
    const size_t tstepA = 2 * hstepA, tstepB = 2 * hstepB;
    const unsigned ldsw = (unsigned)wid * 1024u;
    const int aoff = lds_byte(wr * 64 + fr, fq * 8), boff = lds_byte(wc * 32 + fr, fq * 8);
#define PG8_SA(b, h) (((b) * 2 + (h)) * HTB)
#define PG8_SB(b, h) ((4 + (b) * 2 + (h)) * HTB)
#define PG8_STAGE(bufoff, gbase, voff) do { _Pragma("unroll") for (int _i = 0; _i < 2; ++_i) \
        __builtin_amdgcn_global_load_lds((const unsigned*)((const char*)(gbase) + (voff)[_i]), (PG8_LAS unsigned*)(lds + (bufoff) + ldsw + _i * 8192), 16, 0, 0); } while (0)
#define PG8_LDA(dst, b, h) do { _Pragma("unroll") for (int m = 0; m < 4; ++m) _Pragma("unroll") for (int k = 0; k < 2; ++k) dst[m][k] = *(const PG8_LAS bf16x8*)(lds + PG8_SA(b, h) + aoff + m * 2048 + k * 1024); } while (0)
#define PG8_LDB(dst, b, h) do { _Pragma("unroll") for (int n = 0; n < 2; ++n) _Pragma("unroll") for (int k = 0; k < 2; ++k) dst[n][k] = *(const PG8_LAS bf16x8*)(lds + PG8_SB(b, h) + boff + n * 2048 + k * 1024); } while (0)
#define PG8_MMA(ai, bj, At, Bt) do { __builtin_amdgcn_s_setprio(1); _Pragma("unroll") for (int m = 0; m < 4; ++m) _Pragma("unroll") for (int n = 0; n < 2; ++n) _Pragma("unroll") for (int k = 0; k < 2; ++k) \
        acc[ai][bj][m][n] = __builtin_amdgcn_mfma_f32_16x16x32_bf16(Bt[n][k], At[m][k], acc[ai][bj][m][n], 0, 0, 0); __builtin_amdgcn_s_setprio(0); } while (0)
#define PG8_WAIT_V(n) asm volatile("s_waitcnt vmcnt(" #n ")" ::: "memory")
#define PG8_WAIT_L(n) asm volatile("s_waitcnt lgkmcnt(" #n ")" ::: "memory")
#define PG8_BAR __builtin_amdgcn_s_barrier()
#define PG8_SCHED __builtin_amdgcn_sched_barrier(0)
    Unit cur, nxt; int ui = 0;
    if (!S.next(0, cur)) return;
    f32x4 acc[2][2][4][2];
#pragma unroll
    for (int a = 0; a < 2; ++a)
#pragma unroll
        for (int b = 0; b < 2; ++b)
#pragma unroll
            for (int m = 0; m < 4; ++m)
#pragma unroll
                for (int n = 0; n < 2; ++n) acc[a][b][m][n] = (f32x4){0.f, 0.f, 0.f, 0.f};
    bf16x8 At[4][2], B0[2][2], B1[2][2];
    const char* cA = (const char*)g.A + (size_t)cur.pm * tstepA; const char* cB = (const char*)g.Bt + (size_t)cur.pn * tstepB;
    S.a_ready(cur);
    if constexpr (SP2) {
        PG8_STAGE(PG8_SB(0, 0), cB, voffB); PG8_STAGE(PG8_SB(0, 1), cB + hstepB, voffB); PG8_STAGE(PG8_SA(0, 0), cA, voffA); PG8_STAGE(PG8_SA(0, 1), cA + hstepA, voffA);
        if (wr == 1) PG8_BAR;
        PG8_WAIT_V(2); PG8_BAR;
        PG8_STAGE(PG8_SB(1, 0), cB + kstep, voffB); PG8_STAGE(PG8_SA(1, 0), cA + kstep, voffA); PG8_STAGE(PG8_SB(1, 1), cB + hstepB + kstep, voffB);
        PG8_WAIT_V(6); PG8_BAR;
    } else {
        PG8_STAGE(PG8_SB(0, 0), cB, voffB); PG8_STAGE(PG8_SA(0, 0), cA, voffA); PG8_STAGE(PG8_SB(0, 1), cB + hstepB, voffB); PG8_STAGE(PG8_SA(0, 1), cA + hstepA, voffA);
        if (wr == 1) PG8_BAR;
        PG8_WAIT_V(4); PG8_BAR;
        PG8_STAGE(PG8_SB(1, 0), cB + kstep, voffB); PG8_STAGE(PG8_SA(1, 0), cA + kstep, voffA); PG8_STAGE(PG8_SB(1, 1), cB + hstepB + kstep, voffB);
        PG8_WAIT_V(6); PG8_BAR;
    }
    for (;;) {
        const bool has_next = S.next(ui + 1, nxt);
        const char* nA = has_next ? (const char*)g.A + (size_t)nxt.pm * tstepA : cA; const char* nB = has_next ? (const char*)g.Bt + (size_t)nxt.pn * tstepB : cB;
#pragma nounroll
        for (int t = 0; t < nt; t += 2) {
            const bool last = (t == nt - 2);
            const char* a1 = cA + (size_t)(t + 1) * kstep;
            const char* a2 = last ? nA : cA + (size_t)(t + 2) * kstep; const char* b2 = last ? nB : cB + (size_t)(t + 2) * kstep;
            const char* a3 = a2 + kstep; const char* b3 = b2 + kstep;
            if (last && has_next) S.a_ready(nxt);
            if constexpr (SP2) {
            PG8_LDB(B0, 0, 0); PG8_LDB(B1, 0, 1); PG8_SCHED; PG8_LDA(At, 0, 0); PG8_STAGE(PG8_SA(1, 1), a1 + hstepA, voffA);
            PG8_WAIT_V(8); PG8_WAIT_L(0); PG8_BAR; PG8_MMA(0, 0, At, B0); PG8_MMA(0, 1, At, B1); PG8_BAR; PG8_SCHED;
            PG8_LDA(At, 0, 1); PG8_STAGE(PG8_SB(0, 0), b2, voffB); PG8_STAGE(PG8_SB(0, 1), b2 + hstepB, voffB); PG8_STAGE(PG8_SA(0, 0), a2, voffA);
            PG8_WAIT_V(8); PG8_WAIT_L(0); PG8_BAR; PG8_MMA(1, 0, At, B0); PG8_MMA(1, 1, At, B1); PG8_BAR; PG8_SCHED;
            PG8_LDB(B0, 1, 0); PG8_LDB(B1, 1, 1); PG8_SCHED; PG8_LDA(At, 1, 0); PG8_STAGE(PG8_SA(0, 1), a2 + hstepA, voffA);
            PG8_WAIT_V(8); PG8_WAIT_L(0); PG8_BAR; PG8_MMA(0, 0, At, B0); PG8_MMA(0, 1, At, B1); PG8_BAR; PG8_SCHED;
            PG8_LDA(At, 1, 1); PG8_STAGE(PG8_SB(1, 0), b3, voffB); PG8_STAGE(PG8_SB(1, 1), b3 + hstepB, voffB); PG8_STAGE(PG8_SA(1, 0), a3, voffA);
            PG8_WAIT_V(8); PG8_WAIT_L(0); PG8_BAR; PG8_MMA(1, 0, At, B0); PG8_MMA(1, 1, At, B1); PG8_BAR; PG8_SCHED;
            } else {
            PG8_LDB(B0, 0, 0); PG8_SCHED; PG8_LDA(At, 0, 0); PG8_STAGE(PG8_SA(1, 1), a1 + hstepA, voffA);
            PG8_WAIT_L(8); PG8_BAR; PG8_WAIT_L(0); PG8_MMA(0, 0, At, B0); PG8_BAR; PG8_SCHED;
            PG8_LDB(B1, 0, 1); PG8_STAGE(PG8_SB(0, 0), b2, voffB);
            PG8_BAR; PG8_WAIT_L(0); PG8_MMA(0, 1, At, B1); PG8_BAR;
            PG8_LDA(At, 0, 1); PG8_STAGE(PG8_SA(0, 0), a2, voffA);
            PG8_BAR; PG8_WAIT_L(0); PG8_MMA(1, 0, At, B0); PG8_BAR; PG8_SCHED;
            PG8_STAGE(PG8_SB(0, 1), b2 + hstepB, voffB);
            PG8_WAIT_V(6); PG8_BAR; PG8_MMA(1, 1, At, B1); PG8_BAR;
            PG8_LDB(B0, 1, 0); PG8_SCHED; PG8_LDA(At, 1, 0); PG8_STAGE(PG8_SA(0, 1), a2 + hstepA, voffA);
            PG8_WAIT_L(8); PG8_BAR; PG8_WAIT_L(0); PG8_MMA(0, 0, At, B0); PG8_BAR; PG8_SCHED;
            PG8_LDB(B1, 1, 1); PG8_STAGE(PG8_SB(1, 0), b3, voffB);
            PG8_BAR; PG8_WAIT_L(0); PG8_MMA(0, 1, At, B1); PG8_BAR;
            PG8_LDA(At, 1, 1); PG8_STAGE(PG8_SA(1, 0), a3, voffA);
            PG8_BAR; PG8_WAIT_L(0); PG8_MMA(1, 0, At, B0); PG8_BAR; PG8_SCHED;
            PG8_STAGE(PG8_SB(1, 1), b3 + hstepB, voffB);
            PG8_WAIT_V(6); PG8_BAR; PG8_MMA(1, 1, At, B1); PG8_BAR;
            }
        }
        if constexpr (ALIGN_EPI) { if (wr == 0) PG8_BAR; }
        if constexpr (!Epi::AFTER_DRAIN) { E(acc, cur, wr, wc, fr, fq); S.done(cur); }
        if (!has_next) break;
#pragma unroll
        for (int a = 0; a < 2; ++a)
#pragma unroll
            for (int b = 0; b < 2; ++b)
#pragma unroll
                for (int m = 0; m < 4; ++m)
#pragma unroll
                    for (int n = 0; n < 2; ++n) acc[a][b][m][n] = (f32x4){0.f, 0.f, 0.f, 0.f};
        cur = nxt; cA = nA; cB = nB; ++ui;
        if constexpr (ALIGN_EPI) { if (wr == 1) PG8_BAR; }
    }
    PG8_WAIT_V(0);
    if constexpr (!ALIGN_EPI) { if (wr == 0) PG8_BAR; }
    PG8_BAR;
    if constexpr (Epi::AFTER_DRAIN) { E.fused(acc, cur, wr, wc, fr, fq, lds, wid, lane); S.done(cur); }
#undef PG8_SA
#undef PG8_SB
#undef PG8_STAGE
#undef PG8_LDA
#undef PG8_LDB
#undef PG8_MMA
#undef PG8_WAIT_V
#undef PG8_WAIT_L
#undef PG8_BAR
#undef PG8_SCHED
}
}

template <class F> struct EpiAdapt {
    static constexpr bool PERM = false, AFTER_DRAIN = false;
    F f;
    __device__ __forceinline__ void operator()(const pg8::f32x4 (&acc)[2][2][4][2], const pg8::Unit& u, int wr, int wc, int fr, int fq) const {
#pragma unroll
        for (int ai = 0; ai < 2; ++ai)
#pragma unroll
            for (int m = 0; m < 4; ++m) { const int row = u.pm * 256 + ai * 128 + wr * 64 + m * 16 + fr;
#pragma unroll
                for (int bj = 0; bj < 2; ++bj)
#pragma unroll
                    for (int n = 0; n < 2; ++n) f(row, u.pn * 256 + bj * 128 + wc * 32 + n * 16 + 4 * fq, acc[ai][bj][m][n]); }
    }
};
template <class F> struct EpiAdapt8 {
    static constexpr bool PERM = true, AFTER_DRAIN = false;
    F f;
    __device__ __forceinline__ void operator()(const pg8::f32x4 (&acc)[2][2][4][2], const pg8::Unit& u, int wr, int wc, int fr, int fq) const {
#pragma unroll
        for (int ai = 0; ai < 2; ++ai)
#pragma unroll
            for (int m = 0; m < 4; ++m) { const int row = u.pm * 256 + ai * 128 + wr * 64 + m * 16 + fr;
#pragma unroll
                for (int bj = 0; bj < 2; ++bj) f.op8(row, u.pn * 256 + bj * 128 + wc * 32 + 8 * fq, acc[ai][bj][m][0], acc[ai][bj][m][1]); }
    }
};
template <class F> __device__ __forceinline__ void gemm_mfma8(const bf16_t* A, int lda, const bf16_t* Bt, int M, int N, int K, const F& f, LAS unsigned char* lds) {
    pg8::Gemm g{A, lda, Bt, M, N, K}; pg8::StaticOrder S; S.init(M, N, KGRID, (int)blockIdx.x);
    EpiAdapt8<F> E{f};
    pg8::gemm_phase<EpiAdapt8<F>, pg8::StaticOrder, true, true>(lds, g, S, E);
}
template <class F> __device__ __forceinline__ void gemm_mfma(const bf16_t* A, int lda, const bf16_t* Bt, int M, int N, int K, const F& f, LAS unsigned char* lds) {
    pg8::Gemm g{A, lda, Bt, M, N, K}; pg8::StaticOrder S; S.init(M, N, KGRID, (int)blockIdx.x);
    EpiAdapt<F> E{f};
    pg8::gemm_phase<EpiAdapt<F>, pg8::StaticOrder, true, true>(lds, g, S, E);
}


#ifndef GEMM_MASK
#define GEMM_MASK 63
#endif
template <int BIT, class F> __device__ __forceinline__ void gemm_sel(const bf16_t* A, int lda, const bf16_t* Bt, int M, int N, int K, const F& f, LAS unsigned char* lds) {
    if constexpr ((GEMM_MASK >> BIT) & 1) gemm_mfma(A, lda, Bt, M, N, K, f, lds); else gemm_naive(A, lda, Bt, M, N, K, f, lds);
}

template <class F> __device__ __forceinline__ void gemm_ctx_small(const bf16_t* A, int lda, const bf16_t* Bt, int N, int K, const F& f, LAS unsigned char* lds) {
    const int lane = klane(), wave = kwave(), r32 = lane & 31, hi = lane >> 5;
    const int nct = N / 64, ntasks = 8 * nct, G = KGRID;
    const int KS = K >= 512 ? 8 : K / 64, kslice = K / KS;
    LAS float* red = (LAS float*)lds;
    for (int task = blockIdx.x; task < ntasks; task += G) {
        const int rt = task / nct, ct = task % nct, row0 = ML + rt * 64, col0 = ct * 64;
        f32x16 acc[2][2];
#pragma unroll
        for (int c = 0; c < 2; ++c) { acc[c][0] = f32x16{}; acc[c][1] = f32x16{}; }
        if (wave < KS) {
            const bf16_t* ap0 = A + (size_t)(row0 + r32) * lda + wave * kslice + 8 * hi; const bf16_t* ap1 = ap0 + (size_t)32 * lda;
            const bf16_t* bp0 = Bt + (size_t)(col0 + r32) * K + wave * kslice + 8 * hi; const bf16_t* bp1 = bp0 + (size_t)32 * K;
            bf16x8 av[4][2], bv[4][2];
#define CTX_LOAD(k0) do { _Pragma("unroll") for (int s = 0; s < 4; ++s) { av[s][0] = *(const bf16x8*)(ap0 + (k0) + 16 * s); av[s][1] = *(const bf16x8*)(ap1 + (k0) + 16 * s); \
                bv[s][0] = *(const bf16x8*)(bp0 + (k0) + 16 * s); bv[s][1] = *(const bf16x8*)(bp1 + (k0) + 16 * s); } } while (0)
            CTX_LOAD(0);
#pragma unroll 1
            for (int k0 = 0; k0 < kslice; k0 += 64) {
                bf16x8 ac[4][2], bc[4][2];
#pragma unroll
                for (int s = 0; s < 4; ++s) { ac[s][0] = av[s][0]; ac[s][1] = av[s][1]; bc[s][0] = bv[s][0]; bc[s][1] = bv[s][1]; }
                if (k0 + 64 < kslice) CTX_LOAD(k0 + 64);
#pragma unroll
                for (int s = 0; s < 4; ++s)
#pragma unroll
                    for (int c = 0; c < 2; ++c) { acc[c][0] = __builtin_amdgcn_mfma_f32_32x32x16_bf16(bc[s][c], ac[s][0], acc[c][0], 0, 0, 0); acc[c][1] = __builtin_amdgcn_mfma_f32_32x32x16_bf16(bc[s][c], ac[s][1], acc[c][1], 0, 0, 0); }
            }
#undef CTX_LOAD
        }
        __syncthreads();
        if (wave < KS) {
#pragma unroll
            for (int c = 0; c < 2; ++c)
#pragma unroll
                for (int t = 0; t < 2; ++t)
#pragma unroll
                    for (int r = 0; r < 16; ++r) red[(wave * 64 + (c * 2 + t) * 16 + r) * 64 + lane] = acc[c][t][r];
        }
        __syncthreads();
#pragma unroll
        for (int q = 0; q < 2; ++q) {
            const int grp = wave * 2 + q, c = grp >> 3, t = (grp >> 2) & 1, g = grp & 3;
            f32x4 v = {0.f, 0.f, 0.f, 0.f};
            for (int w = 0; w < KS; ++w) {
                const LAS float* p = red + (w * 64 + (c * 2 + t) * 16 + 4 * g) * 64 + lane;
                v.x += p[0]; v.y += p[64]; v.z += p[128]; v.w += p[192];
            }
            f(row0 + 32 * t + r32, col0 + 32 * c + 8 * g + 4 * hi, v);
        }
    }
    __syncthreads();
}

__device__ __forceinline__ void phase_final(const Args& a) {
    const float* fw = a.in[I_FNW]; const bf16_t* XB = (const bf16_t*)(a.ws + WS_XB);
    const int lane = klane(), gw = blockIdx.x * NWAVES + kwave(), ngw = KGRID * NWAVES;
    for (int row = gw; row < ML; row += ngw) {
        const bf16_t* src = XB + (size_t)row * DM; float* p = a.out + (size_t)row * DM;
        f32x4 v[4]; float ss = 0.f;
#pragma unroll
        for (int j = 0; j < 4; ++j) { const u32x2 w = *(const u32x2*)(src + lane * 4 + 256 * j); v[j] = (f32x4){__uint_as_float(w.x << 16), __uint_as_float(w.x & 0xffff0000u), __uint_as_float(w.y << 16), __uint_as_float(w.y & 0xffff0000u)};
            ss += v[j].x * v[j].x + v[j].y * v[j].y + v[j].z * v[j].z + v[j].w * v[j].w; }
        const float rstd = rsqrtf(wave_sum(ss) * (1.f / DM) + EPS);
#pragma unroll
        for (int j = 0; j < 4; ++j) *(f32x4*)(p + lane * 4 + 256 * j) = v[j] * rstd * *(const f32x4*)(fw + lane * 4 + 256 * j);
    }
}

constexpr int NPHASE = 20;
#define PH_BEGIN(k) if (lo <= (k) && (k) < hi) { const Args& a = get_args(); unsigned char* ws = a.ws; (void)ws;
#ifndef XBAR
#define XBAR 0
#endif
#define PH_END(k) if (MK_ONE_LAUNCH && (k) + 1 < hi) { xcd_barrier(bar); for (int xb_ = 0; xb_ < XBAR; ++xb_) xcd_barrier(bar); } }
template <int L> __device__ __forceinline__ void layer_phases(LAS unsigned char* lds, const XcdBarrier& bar, const int lo, const int hi) {
    constexpr int P = 1 + 9 * L;
#define MODL ((const float*)(ws + WS_MOD) + (size_t)L * 3 * 6144)
#define ROPET ((const float*)(ws + WS_ROPE))
#define HYB ((bf16_t*)(ws + WS_HY))
#define PBB ((bf16_t*)(ws + WS_PB))
#define XCB ((float*)(ws + WS_XC))
#define XBB ((bf16_t*)(ws + WS_XB))
#define XC_IN ((L == 0) ? a.in[I_CTX] : (const float*)XCB)
    PH_BEGIN(P + 0) { if (L == 0) phase_norm_mod<false>(a.in[I_X], XC_IN, a.in[I_N1W] + L * DM, MODL, 0, 1024, HYB, MT); else phase_norm_mod<true>(XBB, XC_IN, a.in[I_N1W] + L * DM, MODL, 0, 1024, HYB, MT); } PH_END(P + 0)
    PH_BEGIN(P + 1) for (int rep = 0; rep < REP_INP; ++rep) { if (rep) xcd_barrier(bar); EpiInProj E{PBB, ROPET}; const bf16_t* W = (const bf16_t*)(ws + WS_WIN) + (size_t)L * INP * DM;
        gemm_mfma8(HYB, DM, W, ML, INP, DM, E, lds); gemm_ctx_small(HYB, DM, W, INP, DM, E, lds); } PH_END(P + 1)
    PH_BEGIN(P + 2) phase_post(a, L); for (int rep = 0; rep < REP_GLAL; ++rep) { if (rep) xcd_barrier(bar); phase_gla_local(a, L, lds); } PH_END(P + 2)
    PH_BEGIN(P + 3) for (int rep = 0; rep < REP_UP; ++rep) { if (rep) xcd_barrier(bar);
        { EpiUQ E1{(bf16_t*)(ws + WS_QB)}; const bf16_t* W = (const bf16_t*)(ws + WS_WUQ) + (size_t)L * 768 * 256; gemm_mfma8(PBB + C_DQ, INP, W, ML, 768, 256, E1, lds); if (L == 0) gemm_ctx_small(PBB + C_DQ, INP, W, 768, 256, E1, lds); }
        { EpiUKV E2{(bf16_t*)(ws + WS_KVB)}; const bf16_t* W = (const bf16_t*)(ws + WS_WUKV) + (size_t)L * 1024 * 256; gemm_mfma8(PBB + C_CKV, INP, W, ML, 1024, 256, E2, lds); gemm_ctx_small(PBB + C_CKV, INP, W, 1024, 256, E2, lds); }
        if (rep == 0) phase_gla_scan(a);
        if (L == 0) weight_copies(a, 1, KGRID - 64, lds);
    } PH_END(P + 3)
    PH_BEGIN(P + 4) { phase_gla_out(a, L, lds, 0, 5); phase_sgu_mfma(a, L, lds, 5, 3); phase_attn_mfma<0>(a, L, lds); if (REP_ATTN == 2) { xcd_barrier(bar); phase_attn_mfma<ATT_ABL>(a, L, lds); } } PH_END(P + 4)
    PH_BEGIN(P + 5) for (int rep = 0; rep < (L == 0 ? REP_OUT : 1); ++rep) { if (rep) xcd_barrier(bar); EpiResid<L == 0> E{L == 0 ? (const void*)a.in[I_X] : (const void*)XBB, XC_IN, XBB, XCB, MODL, 2048}; const bf16_t* W = (const bf16_t*)(ws + WS_WOUT) + (size_t)L * DM * DM;
        gemm_mfma8(HYB, DM, W, ML, DM, DM, E, lds); if (L == 0) gemm_ctx_small(HYB, DM, W, DM, DM, E, lds); } PH_END(P + 5)
    PH_BEGIN(P + 6) phase_norm_mod<true>(XBB, XCB, a.in[I_N2W] + L * DM, MODL, 3072, 4096, HYB, L == 0 ? MT : ML); PH_END(P + 6)
    PH_BEGIN(P + 7) { EpiFF1 E{(bf16_t*)(ws + WS_A)}; const bf16_t* W = (const bf16_t*)(ws + WS_WFF1) + (size_t)L * FF * DM;
        gemm_mfma8(HYB, DM, W, ML, FF, DM, E, lds); if (L == 0) gemm_ctx_small(HYB, DM, W, FF, DM, E, lds);
        if (REP_FF1 == 2) { xcd_barrier(bar); EpiNull EN; gemm_mfma8(HYB, DM, W, ML, FF, DM, EN, lds); }
        if (REP_FF1 == 3) { xcd_barrier(bar); gemm_mfma8(HYB, DM, W, ML, FF, DM, E, lds); } } PH_END(P + 7)
    PH_BEGIN(P + 8) { EpiResid<false> E{XBB, XCB, XBB, XCB, MODL, 5120}; const bf16_t* W = (const bf16_t*)(ws + WS_WFF2) + (size_t)L * DM * FF;
        gemm_mfma8((const bf16_t*)(ws + WS_A), FF, W, ML, DM, FF, E, lds); if (L == 0) gemm_ctx_small((const bf16_t*)(ws + WS_A), FF, W, DM, FF, E, lds); } PH_END(P + 8)
}
__global__ void __launch_bounds__(NTHR, 2) mega(Args a_kernarg_only) {
    extern __shared__ __attribute__((aligned(16))) unsigned char lds_raw[];
    LAS unsigned char* lds = (LAS unsigned char*)lds_raw;
    volatile LAS unsigned* MISC = (volatile LAS unsigned*)(lds + LDS_CTL_OFF);
    { const int t0 = __builtin_amdgcn_workitem_id_x();
      if (t0 < 64) MISC[t0] = 0u;
      if ((t0 & 63) == 0) { const unsigned id = (unsigned)__builtin_amdgcn_s_getreg((5 << 11) | 4) & 63u; MISC[64 + id] = (unsigned)(t0 >> 6); } }
    __syncthreads();
    XcdBarrier bar; bar.bar = (unsigned*)(get_args().ws + WS_CTL); bar.x = 0; bar.st = nullptr;
    if (MK_ONE_LAUNCH) bar = xcd_barrier_post((unsigned*)(get_args().ws + WS_CTL), MISC + 8);
    const int lo = MK_ONE_LAUNCH ? 0 : get_args().ph_lo, hi = MK_ONE_LAUNCH ? NPHASE : get_args().ph_hi;
    PH_BEGIN(0) phase_prep(a, lds); PH_END(0)
    layer_phases<0>(lds, bar, lo, hi);
    layer_phases<1>(lds, bar, lo, hi);
    PH_BEGIN(NPHASE - 1) phase_final(a); PH_END(NPHASE - 1)
}

extern "C" void kernel_launch(void* const* d_in, const int* in_sizes, int n_in, void* d_out, int out_size, void* d_ws, size_t ws_size, hipStream_t stream) {
    static int grid = 0;
    if (grid == 0) {
        if (n_in != 26 || in_sizes[0] != ML * DM || out_size != ML * DM || ws_size < WS_END) { fprintf(stderr, "kernel_launch: unexpected shapes (n_in %d, in0 %d, out %d, ws %zu)\n", n_in, n_in > 0 ? in_sizes[0] : -1, out_size, ws_size); grid = -1; return; }
        int dev = 0, cus = 0;
        if (hipGetDevice(&dev) != hipSuccess || hipDeviceGetAttribute(&cus, hipDeviceAttributeMultiprocessorCount, dev) != hipSuccess) { grid = -1; return; }
        if (hipFuncSetAttribute((const void*)mega, hipFuncAttributeMaxDynamicSharedMemorySize, LDS_BYTES) != hipSuccess) { fprintf(stderr, "kernel_launch: hipFuncSetAttribute failed\n"); grid = -1; return; }
        int per_cu = 0;
        if (hipOccupancyMaxActiveBlocksPerMultiprocessor(&per_cu, (const void*)mega, NTHR, LDS_BYTES) != hipSuccess || per_cu < 1) fprintf(stderr, "kernel_launch: occupancy query says %d\n", per_cu);
        (void)hipGetLastError();
        grid = cus;
    }
    if (grid < 0) return;
    (void)hipMemsetAsync((char*)d_ws + WS_CTL, 0, CTL_ZERO_BYTES, stream);
    Args a{};
    for (int i = 0; i < 26; ++i) a.in[i] = (const float*)d_in[i];
    a.out = (float*)d_out; a.ws = (unsigned char*)d_ws; a.grid = grid;
    if (MK_ONE_LAUNCH) { a.ph_lo = 0; a.ph_hi = NPHASE; hipLaunchKernelGGL(mega, dim3(grid), dim3(NTHR), LDS_BYTES, stream, a); }
    else for (int ph = 0; ph < NPHASE; ++ph) { a.ph_lo = ph; a.ph_hi = ph + 1; hipLaunchKernelGGL(mega, dim3(grid), dim3(NTHR), LDS_BYTES, stream, a); }
}
```

```cpp
#include <hip/hip_runtime.h>
#include <cstdio>
#include <cstdint>

#ifndef REP_FF1
#define REP_FF1 1
#endif
#ifndef REP_INP
#define REP_INP 1
#endif
#ifndef REP_GLAL
#define REP_GLAL 1
#endif
#ifndef REP_UP
#define REP_UP 1
#endif
#ifndef REP_OUT
#define REP_OUT 1
#endif
#ifndef ATT_ABL
#define ATT_ABL 5
#endif
#ifndef REP_PREP
#define REP_PREP 1
#endif
#ifndef REP_SGU
#define REP_SGU 1
#endif
#ifndef REP_ATTN
#define REP_ATTN 1
#endif
#ifndef REP_GLA
#define REP_GLA 1
#endif
#ifndef REP_NORM
#define REP_NORM 1
#endif
#ifndef ATT_NQL
#define ATT_NQL 6
#endif
#ifndef ATTN_NAIVE
#define ATTN_NAIVE 0
#endif
#ifndef GLA_NAIVE
#define GLA_NAIVE 0
#endif
#ifndef MK_ONE_LAUNCH
#define MK_ONE_LAUNCH 1
#endif

#define GAS __attribute__((address_space(1)))
#define LAS __attribute__((address_space(3)))
typedef unsigned short bf16_t;
typedef float f32x4 __attribute__((ext_vector_type(4)));
typedef unsigned u32x4 __attribute__((ext_vector_type(4)));
typedef unsigned u32x2 __attribute__((ext_vector_type(2)));

constexpr int DM = 1024, NB = 2, NL = 8192, NC = 256, ML = NB * NL, MC = NB * NC, MT = ML + MC;
constexpr int FF = 4096, INP = 2048, IN_COLS = 1888, NKEY = NC + NL;
constexpr float EPS = 1e-6f;
constexpr float QSCALE = 0.07216878364870322f * 1.4426950408889634f;
constexpr int NWAVES = 8, NTHR = 512;
constexpr int C_CKV = 0, C_DQ = 256, C_SU = 512, C_SV = 768, C_GV = 1024, C_GR = 1280, C_GK = 1536, C_GQ = 1664, C_KR = 1792, C_GGF = 1856, C_GGB = 1872;

constexpr size_t MiB = 1u << 20;
constexpr size_t WS_CTL = 0, CTL_ZERO_BYTES = 65536;
constexpr size_t WS_MOD = 1 * MiB;
constexpr size_t WS_ROPE = 1 * MiB + 256 * 1024;
constexpr size_t WS_WSB = 14 * MiB + 768 * 1024;
constexpr size_t WS_WIN = 2 * MiB;
constexpr size_t WS_WOUT = 10 * MiB;
constexpr size_t WS_WUQ = 14 * MiB;
constexpr size_t WS_WUKV = 15 * MiB;
constexpr size_t WS_WFF1 = 16 * MiB;
constexpr size_t WS_WFF2 = 32 * MiB;
constexpr size_t WS_XC = 48 * MiB;
constexpr size_t WS_HY = 50 * MiB;
constexpr size_t WS_PB = 83 * MiB;
constexpr size_t WS_QB = 149 * MiB;
constexpr size_t WS_KVB = 174 * MiB;
constexpr size_t WS_LG = 216 * MiB;
constexpr size_t WS_OB = 233 * MiB;
constexpr size_t WS_XB = 216 * MiB;
constexpr size_t WS_A = 83 * MiB;
constexpr size_t WS_END = 250 * MiB;
static_assert(WS_A + (size_t)MT * FF * 2 <= WS_LG, "ffn hidden overlay");
static_assert(WS_PB + (size_t)MT * INP * 2 <= WS_QB && WS_QB + (size_t)MT * 768 * 2 <= WS_KVB && WS_KVB + (size_t)MT * 1024 * 2 <= WS_LG, "ws map");
static_assert(WS_XB + (size_t)ML * DM * 2 <= WS_END, "ws map 2");

constexpr int LDS_BYTES = 147456;

struct Args { const float* in[26]; float* out; unsigned char* ws; int ph_lo, ph_hi, grid, pad; };
enum { I_X = 0, I_C, I_CTX, I_CCTX, I_WMOD, I_BMOD, I_N1W, I_WIN, I_WOUT, I_SGNW, I_SGNB, I_SGW, I_SGB, I_GWF, I_GBF, I_GWB, I_GBB, I_GNW, I_QNW, I_WUQ, I_KVNW, I_WUKV, I_N2W, I_WFF1, I_WFF2, I_FNW };

typedef __attribute__((address_space(4))) const Args* KArgsPtr;
__device__ __forceinline__ const Args& get_args() { KArgsPtr p = (KArgsPtr)__builtin_amdgcn_kernarg_segment_ptr(); asm volatile("" : "+s"(p)); return *(const Args*)p; }
constexpr int LDS_CTL_OFF = LDS_BYTES - 512;
__device__ __forceinline__ int klane() { int l; asm volatile("v_mbcnt_lo_u32_b32 %0, -1, 0\n\tv_mbcnt_hi_u32_b32 %0, -1, %0" : "=v"(l)); return l; }
__device__ __forceinline__ int kwave() { const unsigned id = (unsigned)__builtin_amdgcn_s_getreg((5 << 11) | 4) & 63u;
    return __builtin_amdgcn_readfirstlane((int)((volatile LAS unsigned*)(uintptr_t)(LDS_CTL_OFF + 256))[id]); }
#define KTID (kwave() * 64 + klane())
#define KGRID (get_args().grid)
__device__ __forceinline__ float bf2f(bf16_t v) { return __uint_as_float(((unsigned)v) << 16); }
__device__ __forceinline__ unsigned f2bf(float f) { unsigned u = __float_as_uint(f); return (u + 0x7fffu + ((u >> 16) & 1u)) >> 16; }
__device__ __forceinline__ unsigned pk2(float lo, float hi) { return f2bf(lo) | (f2bf(hi) << 16); }
#define DPP_F(v, ctrl, rmask) __builtin_bit_cast(float, __builtin_amdgcn_update_dpp(0, __builtin_bit_cast(int, (v)), (ctrl), (rmask), 0xf, true))
__device__ __forceinline__ float wave_prefix_sum(float v) {
    v += DPP_F(v, 0x111, 0xf); v += DPP_F(v, 0x112, 0xf); v += DPP_F(v, 0x114, 0xf); v += DPP_F(v, 0x118, 0xf);
    v += DPP_F(v, 0x142, 0xa); v += DPP_F(v, 0x143, 0xc);
    return v;
}
__device__ __forceinline__ float wave_sum(float v) {
    return __builtin_bit_cast(float, __builtin_amdgcn_readlane(__builtin_bit_cast(int, wave_prefix_sum(v)), 63));
}
__device__ __forceinline__ float gelu_tanh(float x) { const float u = 1.5957691216057308f * (x + 0.044715f * x * x * x); return x / (1.f + __expf(-u)); }
__device__ __forceinline__ float silu_f(float x) { return x / (1.f + __expf(-x)); }
__device__ __forceinline__ float log_sigmoid_f(float z) { return fminf(z, 0.f) - log1pf(expf(-fabsf(z))); }
__device__ __forceinline__ float log_sigmoid_fast(float z) { return fminf(z, 0.f) - __logf(1.f + __expf(-fabsf(z))); }
__device__ __forceinline__ void unpack8(u32x4 w, float* f) {
    f[0] = __uint_as_float(w.x << 16); f[1] = __uint_as_float(w.x & 0xffff0000u); f[2] = __uint_as_float(w.y << 16); f[3] = __uint_as_float(w.y & 0xffff0000u);
    f[4] = __uint_as_float(w.z << 16); f[5] = __uint_as_float(w.z & 0xffff0000u); f[6] = __uint_as_float(w.w << 16); f[7] = __uint_as_float(w.w & 0xffff0000u);
}

#define XB_TMO      128
#define XB_XCNT(j)  (256  + 64 * (j))
#define XB_XSUB(j)  (1280 + 64 * (j))
#define XB_XGEN(j)  (2304 + 64 * (j))
#define XB_TOP      3328
#define XB_TOPGEN   3392
#define XCD_BAR_WORDS 3456
#define XB_SPIN_CAP (1u << 22)
__device__ __forceinline__ unsigned xb_ld(unsigned* p)              { return __hip_atomic_load(p, __ATOMIC_RELAXED, __HIP_MEMORY_SCOPE_AGENT); }
__device__ __forceinline__ unsigned xb_add(unsigned* p, unsigned v) { return __hip_atomic_fetch_add(p, v, __ATOMIC_RELAXED, __HIP_MEMORY_SCOPE_AGENT); }
__device__ __forceinline__ unsigned xb_xcc_id() { return (unsigned)__builtin_amdgcn_s_getreg((3 << 11) | 20) & 0xFu; }
#define XB_SPIN(cond, bar) do { unsigned _sp = 0; while (cond) { __builtin_amdgcn_s_sleep(1); \
    if ((++_sp & 255u) == 0u) { if (xb_ld(&(bar)[XB_TMO])) break; if (_sp > XB_SPIN_CAP) { atomicAdd(&(bar)[XB_TMO], 1u); break; } } } } while (0)
struct XcdBarrier { unsigned* bar; unsigned x; volatile LAS unsigned* st; };
__device__ __forceinline__ XcdBarrier xcd_barrier_post(unsigned* bar, volatile LAS unsigned* st) {
    XcdBarrier b; b.bar = bar; b.x = xb_xcc_id(); b.st = st;
    if (KTID == 0) (void)xb_add(&bar[XB_XCNT(b.x)], 1u);
    return b;
}
__device__ __forceinline__ void xcd_barrier_complete(unsigned* bar, unsigned x, unsigned& nloc, unsigned& nx) {
    const unsigned G = (unsigned)KGRID;
    unsigned sum, cnt, mine, sp = 0u;
    for (;;) {
        sum = 0u; cnt = 0u; mine = 0u;
#pragma unroll
        for (unsigned j = 0; j < 16; ++j) { const unsigned c = xb_ld(&bar[XB_XCNT(j)]); sum += c; cnt += (c > 0u) ? 1u : 0u; mine = (j == x) ? c : mine; }
        if (sum == G) break;
        __builtin_amdgcn_s_sleep(1);
        if ((++sp & 255u) == 0u) { if (xb_ld(&bar[XB_TMO])) break; if (sp > XB_SPIN_CAP) { atomicAdd(&bar[XB_TMO], 1u); break; } }
    }
    nloc = mine > 0u ? mine : 1u; nx = cnt > 0u ? cnt : 1u;
}
__device__ __forceinline__ void xcd_barrier(const XcdBarrier& b) {
    asm volatile("s_waitcnt vmcnt(0)" ::: "memory");
    __syncthreads();
    if (KTID == 0) {
        unsigned* bar = b.bar;
        __builtin_amdgcn_s_waitcnt(0);
        unsigned nloc = b.st[0], nx = b.st[1];
        if (nloc == 0u) { xcd_barrier_complete(bar, b.x, nloc, nx); b.st[0] = nloc; b.st[1] = nx; }
        const unsigned old = xb_add(&bar[XB_XSUB(b.x)], 1u);
        const unsigned gen = old / nloc;
        if (old + 1u == (gen + 1u) * nloc) {
            __builtin_amdgcn_fence(__ATOMIC_RELEASE, "agent");
            asm volatile("s_waitcnt vmcnt(0)" ::: "memory");
            const unsigned og = xb_add(&bar[XB_TOP], 1u);
            const unsigned tg = og / nx;
            if (og + 1u == (tg + 1u) * nx) xb_add(&bar[XB_TOPGEN], 1u);
            else XB_SPIN(xb_ld(&bar[XB_TOPGEN]) == tg, bar);
            __builtin_amdgcn_fence(__ATOMIC_ACQUIRE, "agent");
            xb_add(&bar[XB_XGEN(b.x)], 1u);
            asm volatile("s_waitcnt vmcnt(0)" ::: "memory");
        } else {
            XB_SPIN(xb_ld(&bar[XB_XGEN(b.x)]) == gen, bar);
            __builtin_amdgcn_fence(__ATOMIC_ACQUIRE, "agent");
            asm volatile("s_waitcnt vmcnt(0)" ::: "memory");
        }
    }
    __syncthreads();
}

__device__ __forceinline__ int rope_unperm(int jj) { return (jj < 32) ? ((jj >> 1) + 16 * (jj & 1)) : (32 + ((jj - 32) >> 1) + 16 * (jj & 1)); }
__device__ __forceinline__ int map_in(int n) {
    if (n < 256) return 416 + n;
    if (n < 512) return 1632 + (n - 256);
    if (n < 768) return 736 + (n - 512);
    if (n < 1024) return 992 + (n - 768);
    if (n < 1280) return 128 + (n - 1024);
    if (n < 1536) return 1376 + (n - 1280);
    if (n < 1664) return n - 1536;
    if (n < 1792) return 1248 + (n - 1664);
    if (n < 1856) return 672 + rope_unperm(n - 1792);
    if (n < 1872) return 384 + (n - 1856);
    if (n < 1888) return 400 + (n - 1872);
    return -1;
}
__device__ __forceinline__ int map_uq(int n) { const int h = n / 192, j = n % 192; return (j < 128) ? n : (h * 192 + 128 + rope_unperm(j - 128)); }
template <int MODE> __device__ __forceinline__ void transpose_w(const float* W, int K, int Nsrc, bf16_t* Wt, int Npad, int gtid, int gthreads) {
    const int total = Npad * (K / 8);
    for (int idx = gtid; idx < total; idx += gthreads) {
        const int n = idx % Npad, kc = idx / Npad;
        const int src = (MODE == 0) ? n : (MODE == 1 ? map_in(n) : map_uq(n));
        float f[8];
#pragma unroll
        for (int i = 0; i < 8; ++i) f[i] = (src >= 0) ? W[(size_t)(kc * 8 + i) * Nsrc + src] : 0.f;
        u32x4 o; o.x = pk2(f[0], f[1]); o.y = pk2(f[2], f[3]); o.z = pk2(f[4], f[5]); o.w = pk2(f[6], f[7]);
        *(u32x4*)(Wt + (size_t)n * K + kc * 8) = o;
    }
}
template <int MODE> __device__ __forceinline__ void transpose_item(const float* W, int K, int Nsrc, bf16_t* Wt, int Npad, LAS float* scr, int item, int lane) {
    const int nblk = Npad / 32, kb = item / nblk, nb = item % nblk, k0 = 64 * kb, n0 = 32 * nb;
    const int nn = n0 + (lane & 31), src = (MODE == 0) ? nn : (MODE == 1 ? map_in(nn) : map_uq(nn));
    float tv[32];
#pragma unroll
    for (int i = 0; i < 32; ++i) { const int kk = 2 * i + (lane >> 5); tv[i] = (src >= 0) ? W[(size_t)(k0 + kk) * Nsrc + src] : 0.f; }
#pragma unroll
    for (int i = 0; i < 32; ++i) { const int kk = 2 * i + (lane >> 5); scr[kk * 33 + (lane & 31)] = tv[i]; }
    asm volatile("s_waitcnt lgkmcnt(0)" ::: "memory");
    const int c = lane & 7;
#pragma unroll
    for (int j = 0; j < 4; ++j) { const int n = (lane >> 3) + 8 * j; const LAS float* s = scr + (8 * c) * 33 + n;
        u32x4 o; o.x = pk2(s[0 * 33], s[1 * 33]); o.y = pk2(s[2 * 33], s[3 * 33]); o.z = pk2(s[4 * 33], s[5 * 33]); o.w = pk2(s[6 * 33], s[7 * 33]);
        *(u32x4*)(Wt + (size_t)(n0 + n) * K + k0 + 8 * c) = o; }
    asm volatile("s_waitcnt lgkmcnt(0)" ::: "memory");
}
__device__ __forceinline__ void weight_copies(const Args& a, int l, int nblk, LAS unsigned char* lds) {
    unsigned char* ws = a.ws;
    if ((int)blockIdx.x >= nblk) return;
    const int wave = kwave(), lane = klane(), gw = wave * nblk + (int)blockIdx.x, ngw = nblk * NWAVES;
    LAS float* scr = (LAS float*)(lds + 8192 + wave * 8704);
    for (int it = gw; it < 5856; it += ngw) {
        int r = it;
        if (r < 1024) { transpose_item<1>(a.in[I_WIN] + (size_t)l * DM * IN_COLS, DM, IN_COLS, (bf16_t*)(ws + WS_WIN) + (size_t)l * INP * DM, INP, scr, r, lane); continue; } r -= 1024;
        if (r < 512) { transpose_item<0>(a.in[I_WOUT] + (size_t)l * DM * DM, DM, DM, (bf16_t*)(ws + WS_WOUT) + (size_t)l * DM * DM, DM, scr, r, lane); continue; } r -= 512;
        if (r < 96) { transpose_item<2>(a.in[I_WUQ] + (size_t)l * 256 * 768, 256, 768, (bf16_t*)(ws + WS_WUQ) + (size_t)l * 768 * 256, 768, scr, r, lane); continue; } r -= 96;
        if (r < 128) { transpose_item<0>(a.in[I_WUKV] + (size_t)l * 256 * 1024, 256, 1024, (bf16_t*)(ws + WS_WUKV) + (size_t)l * 1024 * 256, 1024, scr, r, lane); continue; } r -= 128;
        if (r < 2048) { transpose_item<0>(a.in[I_WFF1] + (size_t)l * DM * FF, DM, FF, (bf16_t*)(ws + WS_WFF1) + (size_t)l * FF * DM, FF, scr, r, lane); continue; } r -= 2048;
        transpose_item<0>(a.in[I_WFF2] + (size_t)l * FF * DM, FF, DM, (bf16_t*)(ws + WS_WFF2) + (size_t)l * DM * FF, DM, scr, r, lane);
    }
}
__device__ __forceinline__ void phase_prep(const Args& a, LAS unsigned char* lds) {
    unsigned char* ws = a.ws;
    const int tid = KTID, gtid = blockIdx.x * NTHR + tid, gthreads = KGRID * NTHR;
    weight_copies(a, 0, KGRID, lds);
    for (int idx = gtid; idx < 2 * 4 * 128 * 128 / 4; idx += gthreads) { const f32x4 v = *(const f32x4*)(a.in[I_SGW] + (size_t)idx * 4); u32x2 o; o.x = pk2(v.x, v.y); o.y = pk2(v.z, v.w); *(u32x2*)((bf16_t*)(ws + WS_WSB) + (size_t)idx * 4) = o; }
    { const int ridx = ((int)blockIdx.x - (KGRID - 4)) * NTHR + tid;
      if (ridx >= 0 && ridx < 128 * 16) {
        const int p = ridx >> 4, i = ridx & 15;
        const float freq = powf(10000.0f, -(float)i * 2.0f / 32.0f);
        const float ang = (float)p * freq;
        float sn, cs; sincosf(ang, &sn, &cs);
        float* R = (float*)(ws + WS_ROPE);
        R[ridx * 2 + 0] = cs; R[ridx * 2 + 1] = sn;
      } }
    {
        LAS float* red = (LAS float*)lds;
        LAS float* sil = (LAS float*)(lds + 80 * 1024);
        const int wave = kwave(), lane = klane();
        if ((int)blockIdx.x < 2 * 96) {
            for (int i = tid; i < 3 * DM; i += NTHR) { const float v = i < 2 * DM ? a.in[I_C][i] : a.in[I_CCTX][i - 2 * DM]; sil[i] = silu_f(v); }
        }
        __syncthreads();
        for (int item = blockIdx.x; item < 2 * 96; item += KGRID) {
            const int l = item / 96, j = (item % 96) * 64 + lane;
            const float* W = a.in[I_WMOD] + (size_t)l * DM * 6144 + (size_t)(wave * 128) * 6144 + j;
            float s0 = 0.f, s1 = 0.f, s2 = 0.f;
#pragma unroll 16
            for (int kk = 0; kk < 128; ++kk) {
                const float w = W[(size_t)kk * 6144];
                const int k2 = wave * 128 + kk;
                s0 += sil[k2] * w; s1 += sil[DM + k2] * w; s2 += sil[2 * DM + k2] * w;
            }
            red[(wave * 3 + 0) * 64 + lane] = s0; red[(wave * 3 + 1) * 64 + lane] = s1; red[(wave * 3 + 2) * 64 + lane] = s2;
            __syncthreads();
            if (tid < 192) {
                const int r = tid >> 6; float s = 0.f;
#pragma unroll
                for (int w = 0; w < 8; ++w) s += red[(w * 3 + r) * 64 + lane];
                ((float*)(ws + WS_MOD))[(size_t)(l * 3 + r) * 6144 + j] = s + a.in[I_BMOD][l * 6144 + j];
            }
            __syncthreads();
        }
    }
}

template <bool XBF> __device__ __forceinline__ void phase_norm_mod(const void* xl, const float* xc, const float* nw, const float* mod, int sh_off, int sc_off, bf16_t* H, int nrows) {
    const int lane = klane(), gw = blockIdx.x * NWAVES + kwave(), ngw = KGRID * NWAVES;
    for (int row = gw; row < nrows; row += ngw) {
        const float* m = mod + (row < ML ? row / NL : 2) * 6144;
        f32x4 v[4]; float ss = 0.f;
        if (XBF && row < ML) {
            const bf16_t* src = (const bf16_t*)xl + (size_t)row * DM;
#pragma unroll
            for (int j = 0; j < 4; ++j) { const u32x2 w = *(const u32x2*)(src + lane * 4 + 256 * j); v[j] = (f32x4){__uint_as_float(w.x << 16), __uint_as_float(w.x & 0xffff0000u), __uint_as_float(w.y << 16), __uint_as_float(w.y & 0xffff0000u)}; }
        } else {
            const float* src = row < ML ? (const float*)xl + (size_t)row * DM : xc + (size_t)(row - ML) * DM;
#pragma unroll
            for (int j = 0; j < 4; ++j) v[j] = *(const f32x4*)(src + lane * 4 + 256 * j);
        }
#pragma unroll
        for (int j = 0; j < 4; ++j) ss += v[j].x * v[j].x + v[j].y * v[j].y + v[j].z * v[j].z + v[j].w * v[j].w;
        const float rstd = rsqrtf(wave_sum(ss) * (1.f / DM) + EPS);
#pragma unroll
        for (int j = 0; j < 4; ++j) {
            const int c = lane * 4 + 256 * j;
            const f32x4 w = *(const f32x4*)(nw + c), sc = *(const f32x4*)(m + sc_off + c), sh = *(const f32x4*)(m + sh_off + c);
            const f32x4 o = (v[j] * rstd * w) * (sc + 1.f) + sh;
            u32x2 pk; pk.x = pk2(o.x, o.y); pk.y = pk2(o.z, o.w);
            *(u32x2*)(H + (size_t)row * DM + c) = pk;
        }
    }
}

template <class Epi> __device__ __forceinline__ void gemm_naive(const bf16_t* A, int lda, const bf16_t* Bt, int M, int N, int K, const Epi& E, LAS unsigned char* lds) {
    LAS float* As = (LAS float*)lds;
    LAS float* Bs = As + 32 * 132;
    const int tid = KTID, ty = tid >> 4, tx = tid & 15;
    const int ntm = M / 128, ntn = N / 64, ntiles = ntm * ntn;
    for (int tile = blockIdx.x; tile < ntiles; tile += KGRID) {
        const int tm = tile / ntn, tn = tile % ntn, row0 = tm * 128, col0 = tn * 64;
        float acc[4][4];
#pragma unroll
        for (int i = 0; i < 4; ++i)
#pragma unroll
            for (int j = 0; j < 4; ++j) acc[i][j] = 0.f;
        for (int k0 = 0; k0 < K; k0 += 32) {
            {
                const int r = tid >> 2, kc = (tid & 3) * 8; float f[8];
                unpack8(*(const u32x4*)(A + (size_t)(row0 + r) * lda + k0 + kc), f);
#pragma unroll
                for (int i = 0; i < 8; ++i) As[(kc + i) * 132 + r] = f[i];
                if (tid < 256) {
                    unpack8(*(const u32x4*)(Bt + (size_t)(col0 + r) * K + k0 + kc), f);
#pragma unroll
                    for (int i = 0; i < 8; ++i) Bs[(kc + i) * 68 + r] = f[i];
                }
            }
            __syncthreads();
#pragma unroll 8
            for (int k = 0; k < 32; ++k) {
                const f32x4 av = *(const LAS f32x4*)(As + k * 132 + ty * 4), bv = *(const LAS f32x4*)(Bs + k * 68 + tx * 4);
#pragma unroll
                for (int i = 0; i < 4; ++i)
#pragma unroll
                    for (int j = 0; j < 4; ++j) acc[i][j] += av[i] * bv[j];
            }
            __syncthreads();
        }
#pragma unroll
        for (int i = 0; i < 4; ++i) E(row0 + ty * 4 + i, col0 + tx * 4, (f32x4){acc[i][0], acc[i][1], acc[i][2], acc[i][3]});
    }
}

__device__ __forceinline__ void st4bf(bf16_t* p, f32x4 v) { u32x2 pk; pk.x = pk2(v.x, v.y); pk.y = pk2(v.z, v.w); *(u32x2*)p = pk; }
__device__ __forceinline__ f32x4 rope4(f32x4 v, int jj, int t, const float* R) {
    const int pos = (jj < 32) ? (t >> 6) : (t & 63), i0 = ((jj & 31) >> 1);
    const f32x4 cs = *(const f32x4*)(R + (pos * 16 + i0) * 2);
    return (f32x4){v.x * cs.x - v.y * cs.y, v.x * cs.y + v.y * cs.x, v.z * cs.z - v.w * cs.w, v.z * cs.w + v.w * cs.z};
}
__device__ __forceinline__ void st8bf(bf16_t* p, f32x4 a, f32x4 b) { u32x4 pk; pk.x = pk2(a.x, a.y); pk.y = pk2(a.z, a.w); pk.z = pk2(b.x, b.y); pk.w = pk2(b.z, b.w); *(u32x4*)p = pk; }
struct EpiInProj { bf16_t* PB; const float* R;
    __device__ __forceinline__ f32x4 xf(int row, int col, f32x4 v) const {
        const int tile = col >> 8;
        if (tile == 2 || tile == 3) { v = (f32x4){gelu_tanh(v.x), gelu_tanh(v.y), gelu_tanh(v.z), gelu_tanh(v.w)}; }
        else if (tile == 5) { v = (f32x4){silu_f(v.x), silu_f(v.y), silu_f(v.z), silu_f(v.w)}; }
        else if (tile == 7) { const int cc = col - C_KR; if (cc < 64 && row < ML) v = rope4(v, cc, row & (NL - 1), R); }
        return v; }
    __device__ __forceinline__ void operator()(int row, int col, f32x4 v) const { st4bf(PB + (size_t)row * INP + col, xf(row, col, v)); }
    __device__ __forceinline__ void op8(int row, int col, f32x4 v0, f32x4 v1) const { st8bf(PB + (size_t)row * INP + col, xf(row, col, v0), xf(row, col + 4, v1)); } };
struct EpiUQ { bf16_t* QB;
    __device__ __forceinline__ void operator()(int row, int col, f32x4 v) const { st4bf(QB + (size_t)row * 768 + col, v * QSCALE); }
    __device__ __forceinline__ void op8(int row, int col, f32x4 v0, f32x4 v1) const { st8bf(QB + (size_t)row * 768 + col, v0 * QSCALE, v1 * QSCALE); } };
struct EpiUKV { bf16_t* KVB;
    __device__ __forceinline__ void operator()(int row, int col, f32x4 v) const { st4bf(KVB + (size_t)row * 1024 + col, v); }
    __device__ __forceinline__ void op8(int row, int col, f32x4 v0, f32x4 v1) const { st8bf(KVB + (size_t)row * 1024 + col, v0, v1); } };
template <bool INF32> struct EpiResid { const void* xin_l; const float* xin_c; bf16_t* xout_l; float* xout_c; const float* mod; int g_off;
    __device__ __forceinline__ f32x4 ld4(int row, int col) const {
        if (INF32) return *(const f32x4*)((const float*)xin_l + (size_t)row * DM + col);
        const u32x2 w = *(const u32x2*)((const bf16_t*)xin_l + (size_t)row * DM + col);
        return (f32x4){__uint_as_float(w.x << 16), __uint_as_float(w.x & 0xffff0000u), __uint_as_float(w.y << 16), __uint_as_float(w.y & 0xffff0000u)}; }
    __device__ __forceinline__ void operator()(int row, int col, f32x4 v) const {
        if (row < ML) { const f32x4 g = *(const f32x4*)(mod + (row >> 13) * 6144 + g_off + col); st4bf(xout_l + (size_t)row * DM + col, ld4(row, col) + g * v); }
        else { const int rc = row - ML; const f32x4 g = *(const f32x4*)(mod + 2 * 6144 + g_off + col), xi = *(const f32x4*)(xin_c + (size_t)rc * DM + col);
            *(f32x4*)(xout_c + (size_t)rc * DM + col) = xi + g * v; }
    }
    __device__ __forceinline__ void op8(int row, int col, f32x4 v0, f32x4 v1) const {
        if (row < ML) { const float* gp = mod + (row >> 13) * 6144 + g_off + col; const f32x4 g0 = *(const f32x4*)gp, g1 = *(const f32x4*)(gp + 4);
            f32x4 x0, x1;
            if (INF32) { const float* xi = (const float*)xin_l + (size_t)row * DM + col; x0 = *(const f32x4*)xi; x1 = *(const f32x4*)(xi + 4); }
            else { const u32x4 w = *(const u32x4*)((const bf16_t*)xin_l + (size_t)row * DM + col);
                x0 = (f32x4){__uint_as_float(w.x << 16), __uint_as_float(w.x & 0xffff0000u), __uint_as_float(w.y << 16), __uint_as_float(w.y & 0xffff0000u)};
                x1 = (f32x4){__uint_as_float(w.z << 16), __uint_as_float(w.z & 0xffff0000u), __uint_as_float(w.w << 16), __uint_as_float(w.w & 0xffff0000u)}; }
            st8bf(xout_l + (size_t)row * DM + col, x0 + g0 * v0, x1 + g1 * v1);
        } else { operator()(row, col, v0); operator()(row, col + 4, v1); }
    } };
struct EpiNull {
    __device__ __forceinline__ void operator()(int row, int col, f32x4 v) const { asm volatile("" :: "v"(v)); }
    __device__ __forceinline__ void op8(int row, int col, f32x4 v0, f32x4 v1) const { asm volatile("" :: "v"(v0), "v"(v1)); } };
struct EpiFF1 { bf16_t* Ah;
    __device__ __forceinline__ void operator()(int row, int col, f32x4 v) const {
        f32x4 r = (f32x4){fmaxf(v.x, 0.f), fmaxf(v.y, 0.f), fmaxf(v.z, 0.f), fmaxf(v.w, 0.f)};
        st4bf(Ah + (size_t)row * FF + col, r * r);
    }
    __device__ __forceinline__ void op8(int row, int col, f32x4 v0, f32x4 v1) const {
        f32x4 r0 = (f32x4){fmaxf(v0.x, 0.f), fmaxf(v0.y, 0.f), fmaxf(v0.z, 0.f), fmaxf(v0.w, 0.f)}, r1 = (f32x4){fmaxf(v1.x, 0.f), fmaxf(v1.y, 0.f), fmaxf(v1.z, 0.f), fmaxf(v1.w, 0.f)};
        st8bf(Ah + (size_t)row * FF + col, r0 * r0, r1 * r1);
    } };

__device__ __forceinline__ void phase_post(const Args& a, int l) {
    unsigned char* ws = a.ws;
    bf16_t* PB = (bf16_t*)(ws + WS_PB); float* LG = (float*)(ws + WS_LG);
    const float* kvnw = a.in[I_KVNW] + l * 256; const float* qnw = a.in[I_QNW] + l * 256;
    const float* snw = a.in[I_SGNW] + l * 256; const float* snb = a.in[I_SGNB] + l * 256;
    const float* wgf = a.in[I_GWF] + l * 16 * 128; const float* bgf = a.in[I_GBF] + l * 128;
    const float* wgb = a.in[I_GWB] + l * 16 * 128; const float* bgb = a.in[I_GBB] + l * 128;
    const int lane = klane(), gw = blockIdx.x * NWAVES + kwave(), ngw = KGRID * NWAVES;
    for (int row = ML + gw; row < MT; row += ngw) {
        bf16_t* pr = PB + (size_t)row * INP;
        const int c = lane * 4;
        { u32x2 w = *(const u32x2*)(pr + C_CKV + c); f32x4 v = {__uint_as_float(w.x << 16), __uint_as_float(w.x & 0xffff0000u), __uint_as_float(w.y << 16), __uint_as_float(w.y & 0xffff0000u)};
          const float rstd = rsqrtf(wave_sum(v.x * v.x + v.y * v.y + v.z * v.z + v.w * v.w) * (1.f / 256.f) + EPS);
          st4bf(pr + C_CKV + c, v * rstd * *(const f32x4*)(kvnw + c)); }
        { u32x2 w = *(const u32x2*)(pr + C_DQ + c); f32x4 v = {__uint_as_float(w.x << 16), __uint_as_float(w.x & 0xffff0000u), __uint_as_float(w.y << 16), __uint_as_float(w.y & 0xffff0000u)};
          const float rstd = rsqrtf(wave_sum(v.x * v.x + v.y * v.y + v.z * v.z + v.w * v.w) * (1.f / 256.f) + EPS);
          st4bf(pr + C_DQ + c, v * rstd * *(const f32x4*)(qnw + c)); }
        { u32x2 w = *(const u32x2*)(pr + C_SV + c); f32x4 v = {__uint_as_float(w.x << 16), __uint_as_float(w.x & 0xffff0000u), __uint_as_float(w.y << 16), __uint_as_float(w.y & 0xffff0000u)};
          const float mu = wave_sum(v.x + v.y + v.z + v.w) * (1.f / 256.f);
          v = v - mu;
          const float rstd = rsqrtf(wave_sum(v.x * v.x + v.y * v.y + v.z * v.z + v.w * v.w) * (1.f / 256.f) + EPS);
          st4bf(pr + C_SV + c, v * rstd * *(const f32x4*)(snw + c) + *(const f32x4*)(snb + c)); }
        if (GLA_NAIVE) { const int o = lane * 4, isb = o >> 7, d = o & 127;
          const float* wg = isb ? wgb : wgf; const float* bg = isb ? bgb : bgf; const bf16_t* gg = pr + (isb ? C_GGB : C_GGF);
          f32x4 z = *(const f32x4*)(bg + d);
#pragma unroll
          for (int r = 0; r < 16; ++r) z += *(const f32x4*)(wg + r * 128 + d) * bf2f(gg[r]);
          *(f32x4*)(LG + (size_t)row * 256 + o) = (f32x4){log_sigmoid_f(z.x), log_sigmoid_f(z.y), log_sigmoid_f(z.z), log_sigmoid_f(z.w)} * (1.f / 16.f); }
    }
}

__device__ __forceinline__ void phase_sgu_naive(const Args& a, int l) {
    unsigned char* ws = a.ws;
    const bf16_t* PB = (const bf16_t*)(ws + WS_PB); bf16_t* Y = (bf16_t*)(ws + WS_HY);
    const float* Ws = a.in[I_SGW] + (size_t)l * 4 * 128 * 128; const float* bs = a.in[I_SGB] + l * 4 * 128;
    const int tid = KTID, i = tid >> 2, eg = (tid & 3) * 16;
    for (int unit = blockIdx.x; unit < (MT / 128) * 4; unit += KGRID) {
        const int cc = unit >> 2, h = unit & 3;
        float acc[16];
#pragma unroll
        for (int e = 0; e < 16; ++e) acc[e] = 0.f;
        const float* wrow = Ws + ((size_t)h * 128 + i) * 128;
        for (int j = 0; j < 128; ++j) {
            const float w = wrow[j];
            const bf16_t* vp = PB + (size_t)(cc * 128 + j) * INP + C_SV + h * 64 + eg;
            float f[8], g[8]; unpack8(*(const u32x4*)vp, f); unpack8(*(const u32x4*)(vp + 8), g);
#pragma unroll
            for (int e = 0; e < 8; ++e) { acc[e] += w * f[e]; acc[8 + e] += w * g[e]; }
        }
        const float bias = bs[h * 128 + i];
        const int row = cc * 128 + i;
        const bf16_t* up = PB + (size_t)row * INP + C_SU + h * 64 + eg;
        float f[8], g[8]; unpack8(*(const u32x4*)up, f); unpack8(*(const u32x4*)(up + 8), g);
        bf16_t* yp = Y + (size_t)row * DM + h * 64 + eg;
        u32x4 o0, o1;
        o0.x = pk2(f[0] * (acc[0] + bias), f[1] * (acc[1] + bias)); o0.y = pk2(f[2] * (acc[2] + bias), f[3] * (acc[3] + bias));
        o0.z = pk2(f[4] * (acc[4] + bias), f[5] * (acc[5] + bias)); o0.w = pk2(f[6] * (acc[6] + bias), f[7] * (acc[7] + bias));
        o1.x = pk2(g[0] * (acc[8] + bias), g[1] * (acc[9] + bias)); o1.y = pk2(g[2] * (acc[10] + bias), g[3] * (acc[11] + bias));
        o1.z = pk2(g[4] * (acc[12] + bias), g[5] * (acc[13] + bias)); o1.w = pk2(g[6] * (acc[14] + bias), g[7] * (acc[15] + bias));
        *(u32x4*)yp = o0; *(u32x4*)(yp + 8) = o1;
    }
}

__device__ __forceinline__ void phase_gla_naive(const Args& a, int l) {
    unsigned char* ws = a.ws;
    const bf16_t* PB = (const bf16_t*)(ws + WS_PB); bf16_t* Y = (bf16_t*)(ws + WS_HY);
    const float* LG = (const float*)(ws + WS_LG); float* OB = (float*)(ws + WS_OB);
    const float* gnw = a.in[I_GNW] + l * 64;
    if (blockIdx.x >= 8 || KTID >= 64) return;
    const int b = blockIdx.x >> 2, h = blockIdx.x & 3, e = KTID;
    const float gw_e = gnw[e];
    for (int dir = 1; dir >= 0; --dir) {
        float S[32];
#pragma unroll
        for (int d = 0; d < 32; ++d) S[d] = 0.f;
        for (int tau = 0; tau < NKEY; ++tau) {
            int row;
            if (dir == 0) row = tau < NC ? ML + b * NC + tau : b * NL + (tau - NC);
            else row = tau < NC ? ML + b * NC + (NC - 1 - tau) : b * NL + (NL - 1 - (tau - NC));
            const bf16_t* pr = PB + (size_t)row * INP;
            const float* lg = LG + (size_t)row * 256 + dir * 128 + h * 32;
            const float v = bf2f(pr[C_GV + h * 64 + e]);
            float o = 0.f;
#pragma unroll
            for (int d = 0; d < 32; ++d) {
                const float kk = bf2f(pr[C_GK + h * 32 + d]), qq = bf2f(pr[C_GQ + h * 32 + d]), al = expf(lg[d]);
                S[d] = al * S[d] + kk * v; o += qq * S[d];
            }
            o *= 0.17677669529663687f;
            if (dir == 1) OB[(size_t)row * 256 + h * 64 + e] = o;
            else {
                o += OB[(size_t)row * 256 + h * 64 + e];
                const float ms = wave_sum(o * o) * (1.f / 64.f);
                const float y = o * rsqrtf(ms + EPS) * gw_e * bf2f(pr[C_GR + h * 64 + e]);
                Y[(size_t)row * DM + 256 + h * 64 + e] = (bf16_t)f2bf(y);
            }
        }
    }
}

typedef short bf16x8 __attribute__((ext_vector_type(8)));
typedef float f32x16 __attribute__((ext_vector_type(16)));
typedef float f32x2_t __attribute__((ext_vector_type(2)));
typedef __bf16 bf16x2_t __attribute__((ext_vector_type(2)));
__device__ __forceinline__ unsigned cvtpk(float lo, float hi) { f32x2_t v = {lo, hi}; bf16x2_t b = __builtin_convertvector(v, bf16x2_t); return __builtin_bit_cast(unsigned, b); }
__device__ __forceinline__ int crow(int r, int hi) { return (r & 3) + 8 * (r >> 2) + 4 * hi; }
constexpr int GLA_WLDS = 17920, GLA_NB = 132;
constexpr size_t OUT_BC = 0, OUT_GL = (size_t)MT * 256 * 4, WS_GD = 1 * MiB + 512 * 1024;
static_assert(OUT_GL + (size_t)2112 * 2048 * 4 <= (size_t)ML * DM * 4 && WS_GD + (size_t)2112 * 32 * 4 <= WS_WIN && WS_ROPE + 16384 <= WS_GD && WS_WSB + 262144 <= WS_WUKV && WS_WUQ + (size_t)2 * 768 * 256 * 2 <= WS_WSB, "gla ws");
__device__ __forceinline__ int gla_row0(int b, int beta) { return beta < 4 ? ML + b * NC + beta * 64 : b * NL + (beta - 4) * 64; }
#define LDS_FENCE() do { asm volatile("s_waitcnt lgkmcnt(0)" ::: "memory"); __builtin_amdgcn_sched_barrier(0); } while (0)
__device__ __forceinline__ void gla_stage_vt(const bf16_t* pv, LAS bf16_t* VT, int lane) {
#pragma unroll
    for (int c8 = 0; c8 < 8; ++c8) { const u32x4 w = *(const u32x4*)(pv + c8 * 8);
        VT[(c8 * 8 + 0) * 64 + lane] = (bf16_t)(w.x & 0xffffu); VT[(c8 * 8 + 1) * 64 + lane] = (bf16_t)(w.x >> 16);
        VT[(c8 * 8 + 2) * 64 + lane] = (bf16_t)(w.y & 0xffffu); VT[(c8 * 8 + 3) * 64 + lane] = (bf16_t)(w.y >> 16);
        VT[(c8 * 8 + 4) * 64 + lane] = (bf16_t)(w.z & 0xffffu); VT[(c8 * 8 + 5) * 64 + lane] = (bf16_t)(w.z >> 16);
        VT[(c8 * 8 + 6) * 64 + lane] = (bf16_t)(w.w & 0xffffu); VT[(c8 * 8 + 7) * 64 + lane] = (bf16_t)(w.w >> 16); }
}
__device__ __forceinline__ void load32bf(const bf16_t* p, float* f) {
    unpack8(*(const u32x4*)(p), f); unpack8(*(const u32x4*)(p + 8), f + 8); unpack8(*(const u32x4*)(p + 16), f + 16); unpack8(*(const u32x4*)(p + 24), f + 24);
}
__device__ __forceinline__ void phase_gla_local(const Args& a, int l, LAS unsigned char* lds) {
    unsigned char* ws = a.ws;
    const bf16_t* PB = (const bf16_t*)(ws + WS_PB); float* BC = (float*)((unsigned char*)a.out + OUT_BC); float* GL = (float*)((unsigned char*)a.out + OUT_GL); float* GD = (float*)(ws + WS_GD);
    const int lane = klane(), wave = kwave(), gw = wave * KGRID + (int)blockIdx.x, ngw = KGRID * NWAVES    ;
    const int r32 = lane & 31, hi = lane >> 5;
    LAS bf16_t* KT = (LAS bf16_t*)(lds + wave * GLA_WLDS); LAS bf16_t* VT = KT + 32 * 64;
    for (int task = gw; task < 16 * GLA_NB; task += ngw) {
        const int beta = task % GLA_NB, t2 = task / GLA_NB, dir = t2 & 1, h = (t2 >> 1) & 3, b = t2 >> 3;
        const int row = gla_row0(b, beta) + lane; const bf16_t* pr = PB + (size_t)row * INP;
        LDS_FENCE();
        gla_stage_vt(pr + C_GV + h * 64, VT, lane);
        float c[32];
        {
          const float* wg = (dir ? a.in[I_GWB] : a.in[I_GWF]) + l * 16 * 128 + h * 32; const float* bg = (dir ? a.in[I_GBB] : a.in[I_GBF]) + l * 128 + h * 32;
          LAS float* WGL = (LAS float*)(VT + 64 * 64); LAS float* BGL = WGL + 16 * 32;
          { const int r = lane >> 2, d0 = (lane & 3) * 8;
            *(LAS f32x4*)(WGL + r * 32 + d0) = *(const f32x4*)(wg + r * 128 + d0); *(LAS f32x4*)(WGL + r * 32 + d0 + 4) = *(const f32x4*)(wg + r * 128 + d0 + 4);
            if (lane < 32) BGL[lane] = bg[lane]; }
          float gg[16]; unpack8(*(const u32x4*)(pr + (dir ? C_GGB : C_GGF)), gg); unpack8(*(const u32x4*)(pr + (dir ? C_GGB : C_GGF) + 8), gg + 8);
          LDS_FENCE();
#pragma unroll
          for (int d = 0; d < 32; d += 4) { f32x4 z = *(const LAS f32x4*)(BGL + d);
#pragma unroll
              for (int r = 0; r < 16; ++r) z += *(const LAS f32x4*)(WGL + r * 32 + d) * gg[r];
              c[d] = log_sigmoid_fast(z.x) * (1.f / 16.f); c[d + 1] = log_sigmoid_fast(z.y) * (1.f / 16.f); c[d + 2] = log_sigmoid_fast(z.z) * (1.f / 16.f); c[d + 3] = log_sigmoid_fast(z.w) * (1.f / 16.f); } }
        float kk[32]; load32bf(pr + C_GK + h * 32, kk);
#pragma unroll
        for (int d = 0; d < 32; ++d) {
            const float g = c[d], p = wave_prefix_sum(g);
            const float T = __builtin_bit_cast(float, __builtin_amdgcn_readlane(__builtin_bit_cast(int, p), 63));
            const float cc = dir ? (T - p + g) : p;
            c[d] = cc;
            KT[d * 64 + lane] = (bf16_t)(cvtpk(kk[d] * __expf(T - cc), 0.f) & 0xffffu);
            kk[d] = __expf(T);
        }
        if (lane == 0) { float* gd = GD + (size_t)task * 32;
#pragma unroll
            for (int d = 0; d < 32; d += 4) *(f32x4*)(gd + d) = (f32x4){kk[d], kk[d + 1], kk[d + 2], kk[d + 3]}; }
        { float* bc = BC + (size_t)row * 256 + dir * 128 + h * 32;
#pragma unroll
          for (int d = 0; d < 32; d += 4) *(f32x4*)(bc + d) = (f32x4){c[d], c[d + 1], c[d + 2], c[d + 3]}; }
        LDS_FENCE();
        f32x16 acc0 = {}, acc1 = {};
#pragma unroll
        for (int s = 0; s < 4; ++s) {
            const bf16x8 af = *(const LAS bf16x8*)(KT + r32 * 64 + 16 * s + 8 * hi);
            const bf16x8 b0 = *(const LAS bf16x8*)(VT + r32 * 64 + 16 * s + 8 * hi), b1 = *(const LAS bf16x8*)(VT + (32 + r32) * 64 + 16 * s + 8 * hi);
            acc0 = __builtin_amdgcn_mfma_f32_32x32x16_bf16(af, b0, acc0, 0, 0, 0); acc1 = __builtin_amdgcn_mfma_f32_32x32x16_bf16(af, b1, acc1, 0, 0, 0);
        }
        float* gl = GL + (size_t)task * 2048;
#pragma unroll
        for (int r = 0; r < 16; ++r) { gl[crow(r, hi) * 64 + r32] = acc0[r]; gl[crow(r, hi) * 64 + 32 + r32] = acc1[r]; }
    }
}
__device__ __forceinline__ void phase_gla_scan(const Args& a) {
    unsigned char* ws = a.ws; float* GL = (float*)((unsigned char*)a.out + OUT_GL); const float* GD = (const float*)(ws + WS_GD);
    const int idx = ((int)blockIdx.x - (KGRID - 64)) * NTHR + KTID;
    if (idx < 0 || idx >= 16 * 2048) return;
    const int seq = idx >> 11, de = idx & 2047, d = de >> 6, dir = seq & 1;
    float S = 0.f;
    for (int c0 = 0; c0 < GLA_NB; c0 += 12) {
        float Lv[12], Dv[12];
#pragma unroll
        for (int u = 0; u < 12; ++u) { const int c = c0 + u, beta = dir ? (c < 4 ? 3 - c : 135 - c) : c; const size_t slot = (size_t)seq * GLA_NB + beta;
            Lv[u] = GL[slot * 2048 + de]; Dv[u] = GD[slot * 32 + d]; }
#pragma unroll
        for (int u = 0; u < 12; ++u) { const int c = c0 + u, beta = dir ? (c < 4 ? 3 - c : 135 - c) : c; const size_t slot = (size_t)seq * GLA_NB + beta;
            GL[slot * 2048 + de] = S; S = Dv[u] * S + Lv[u]; }
    }
}
template <int DIR> __device__ __forceinline__ void gla_dir(const bf16_t* pr, const float* bc, const float* sin, int h, LAS bf16_t* QS, LAS bf16_t* KS, const LAS bf16_t* VT, int lane,
                                                            f32x16& o00, f32x16& o01, f32x16& o10, f32x16& o11) {
    const int r32 = lane & 31, hi = lane >> 5;
    {
        float c[32], q[32], k[32];
#pragma unroll
        for (int d = 0; d < 32; d += 4) { const f32x4 v = *(const f32x4*)(bc + d); c[d] = v.x; c[d + 1] = v.y; c[d + 2] = v.z; c[d + 3] = v.w; }
        load32bf(pr + C_GQ + h * 32, q); load32bf(pr + C_GK + h * 32, k);
#pragma unroll
        for (int d = 0; d < 32; d += 8) {
            u32x4 wq, wk; float eq[8], ek[8];
#pragma unroll
            for (int i = 0; i < 8; ++i) { eq[i] = q[d + i] * __expf(c[d + i]) * 0.17677669529663687f; ek[i] = k[d + i] * __expf(-c[d + i]); }
            wq.x = cvtpk(eq[0], eq[1]); wq.y = cvtpk(eq[2], eq[3]); wq.z = cvtpk(eq[4], eq[5]); wq.w = cvtpk(eq[6], eq[7]);
            wk.x = cvtpk(ek[0], ek[1]); wk.y = cvtpk(ek[2], ek[3]); wk.z = cvtpk(ek[4], ek[5]); wk.w = cvtpk(ek[6], ek[7]);
            *(LAS u32x4*)(QS + lane * 32 + d) = wq; *(LAS u32x4*)(KS + lane * 32 + d) = wk;
        }
    }
    LDS_FENCE();
    bf16x8 qf[2][2], kf[2][2];
#pragma unroll
    for (int t = 0; t < 2; ++t)
#pragma unroll
        for (int s = 0; s < 2; ++s) { qf[t][s] = *(const LAS bf16x8*)(QS + (32 * t + r32) * 32 + 16 * s + 8 * hi); kf[t][s] = *(const LAS bf16x8*)(KS + (32 * t + r32) * 32 + 16 * s + 8 * hi); }
    LDS_FENCE();
    {
        u32x4 w[4];
#pragma unroll
        for (int d = 0; d < 32; d += 8) {
            float sv[8];
#pragma unroll
            for (int i = 0; i < 8; ++i) sv[i] = sin[(d + i) * 64 + lane];
            w[d >> 3].x = cvtpk(sv[0], sv[1]); w[d >> 3].y = cvtpk(sv[2], sv[3]); w[d >> 3].z = cvtpk(sv[4], sv[5]); w[d >> 3].w = cvtpk(sv[6], sv[7]);
        }
#pragma unroll
        for (int i = 0; i < 4; ++i) *(LAS u32x4*)(QS + lane * 32 + 8 * i) = w[i];
    }
#define GLA_X(tj, ti) __builtin_amdgcn_mfma_f32_32x32x16_bf16(kf[tj][1], qf[ti][1], __builtin_amdgcn_mfma_f32_32x32x16_bf16(kf[tj][0], qf[ti][0], (f32x16){}, 0, 0, 0), 0, 0, 0)
#define GLA_MASK(X) do { _Pragma("unroll") for (int r = 0; r < 16; ++r) { const int jl = crow(r, hi); const bool keep = DIR == 0 ? (jl <= r32) : (jl >= r32); X[r] = keep ? X[r] : 0.f; } } while (0)
#define GLA_XA(X, s) __builtin_bit_cast(bf16x8, (u32x4){cvtpk(X[8 * (s) + 0], X[8 * (s) + 1]), cvtpk(X[8 * (s) + 2], X[8 * (s) + 3]), cvtpk(X[8 * (s) + 4], X[8 * (s) + 5]), cvtpk(X[8 * (s) + 6], X[8 * (s) + 7])})
#define GLA_VF(tj, s, te) __builtin_bit_cast(bf16x8, (u32x4){((const LAS u32x2*)(VT + (32 * (te) + r32) * 64 + 32 * (tj) + 16 * (s) + 4 * hi))->x, ((const LAS u32x2*)(VT + (32 * (te) + r32) * 64 + 32 * (tj) + 16 * (s) + 4 * hi))->y, \
                                                              ((const LAS u32x2*)(VT + (32 * (te) + r32) * 64 + 32 * (tj) + 16 * (s) + 8 + 4 * hi))->x, ((const LAS u32x2*)(VT + (32 * (te) + r32) * 64 + 32 * (tj) + 16 * (s) + 8 + 4 * hi))->y})
#define GLA_PV(X, tj, O0, O1) do { _Pragma("unroll") for (int s = 0; s < 2; ++s) { const bf16x8 xa = GLA_XA(X, s); \
        O0 = __builtin_amdgcn_mfma_f32_32x32x16_bf16(xa, GLA_VF(tj, s, 0), O0, 0, 0, 0); O1 = __builtin_amdgcn_mfma_f32_32x32x16_bf16(xa, GLA_VF(tj, s, 1), O1, 0, 0, 0); } } while (0)
    __builtin_amdgcn_sched_barrier(0);
    { f32x16 X = GLA_X(0, 0); GLA_MASK(X); GLA_PV(X, 0, o00, o01); }
    __builtin_amdgcn_sched_barrier(0);
    { f32x16 X = GLA_X(1, 1); GLA_MASK(X); GLA_PV(X, 1, o10, o11); }
    __builtin_amdgcn_sched_barrier(0);
    if (DIR == 0) { f32x16 X = GLA_X(0, 1); GLA_PV(X, 0, o10, o11); }
    else          { f32x16 X = GLA_X(1, 0); GLA_PV(X, 1, o00, o01); }
    LDS_FENCE();
#pragma unroll
    for (int s = 0; s < 2; ++s) {
        const bf16x8 s0 = *(const LAS bf16x8*)(QS + r32 * 32 + 16 * s + 8 * hi), s1 = *(const LAS bf16x8*)(QS + (32 + r32) * 32 + 16 * s + 8 * hi);
        o00 = __builtin_amdgcn_mfma_f32_32x32x16_bf16(qf[0][s], s0, o00, 0, 0, 0); o01 = __builtin_amdgcn_mfma_f32_32x32x16_bf16(qf[0][s], s1, o01, 0, 0, 0);
        o10 = __builtin_amdgcn_mfma_f32_32x32x16_bf16(qf[1][s], s0, o10, 0, 0, 0); o11 = __builtin_amdgcn_mfma_f32_32x32x16_bf16(qf[1][s], s1, o11, 0, 0, 0);
    }
    LDS_FENCE();
#undef GLA_X
#undef GLA_MASK
#undef GLA_XA
#undef GLA_VF
#undef GLA_PV
}
__device__ __forceinline__ void phase_gla_out(const Args& a, int l, LAS unsigned char* lds, const int w0, const int nw) {
    unsigned char* ws = a.ws;
    const bf16_t* PB = (const bf16_t*)(ws + WS_PB); const float* BC = (const float*)((const unsigned char*)a.out + OUT_BC); const float* GL = (const float*)((const unsigned char*)a.out + OUT_GL); bf16_t* Y = (bf16_t*)(ws + WS_HY);
    const float* gnw = a.in[I_GNW] + l * 64;
    const int lane = klane(), wave = kwave(), gw = wave * KGRID + (int)blockIdx.x, ngw = KGRID * NWAVES    ;
    const int r32 = lane & 31, hi = lane >> 5;
    LAS bf16_t* QS = (LAS bf16_t*)(lds + wave * GLA_WLDS); LAS bf16_t* KS = QS + 64 * 32; LAS bf16_t* VT = KS + 64 * 32; LAS float* OS = (LAS float*)(lds + wave * GLA_WLDS);
    for (int task = (wave - w0) * KGRID + (int)blockIdx.x; wave >= w0 && wave < w0 + nw && task < 8 * GLA_NB; task += nw * KGRID) {
        const int beta = task % GLA_NB, bh = task / GLA_NB, h = bh & 3, b = bh >> 2;
        const int row = gla_row0(b, beta) + lane; const bf16_t* pr = PB + (size_t)row * INP;
        LDS_FENCE();
        gla_stage_vt(pr + C_GV + h * 64, VT, lane);
        f32x16 o00 = {}, o01 = {}, o10 = {}, o11 = {};
        gla_dir<0>(pr, BC + (size_t)row * 256 + h * 32, GL + ((size_t)(bh * 2 + 0) * GLA_NB + beta) * 2048, h, QS, KS, VT, lane, o00, o01, o10, o11);
        gla_dir<1>(pr, BC + (size_t)row * 256 + 128 + h * 32, GL + ((size_t)(bh * 2 + 1) * GLA_NB + beta) * 2048, h, QS, KS, VT, lane, o00, o01, o10, o11);
#pragma unroll
        for (int r = 0; r < 16; ++r) { const int i = crow(r, hi);
            OS[i * 65 + r32] = o00[r]; OS[i * 65 + 32 + r32] = o01[r]; OS[(32 + i) * 65 + r32] = o10[r]; OS[(32 + i) * 65 + 32 + r32] = o11[r]; }
        LDS_FENCE();
        float ss = 0.f;
#pragma unroll
        for (int e = 0; e < 64; ++e) { const float v = OS[lane * 65 + e]; ss += v * v; }
        const float rstd = rsqrtf(ss * (1.f / 64.f) + EPS);
        bf16_t* yp = Y + (size_t)row * DM + 256 + h * 64;
#pragma unroll
        for (int c8 = 0; c8 < 8; ++c8) { float rr[8]; unpack8(*(const u32x4*)(pr + C_GR + h * 64 + c8 * 8), rr);
            float y[8];
#pragma unroll
            for (int i = 0; i < 8; ++i) y[i] = OS[lane * 65 + c8 * 8 + i] * rstd * gnw[c8 * 8 + i] * rr[i];
            u32x4 w; w.x = cvtpk(y[0], y[1]); w.y = cvtpk(y[2], y[3]); w.z = cvtpk(y[4], y[5]); w.w = cvtpk(y[6], y[7]);
            *(u32x4*)(yp + c8 * 8) = w; }
    }
}

__device__ __forceinline__ void phase_sgu_mfma(const Args& a, int l, LAS unsigned char* lds, const int w0, const int nw) {
    unsigned char* ws = a.ws;
    const bf16_t* PB = (const bf16_t*)(ws + WS_PB); bf16_t* Y = (bf16_t*)(ws + WS_HY);
    const bf16_t* WSB = (const bf16_t*)(ws + WS_WSB) + (size_t)l * 4 * 128 * 128; const float* bs = a.in[I_SGB] + l * 4 * 128;
    const int lane = klane(), wave = kwave(), gw = wave * KGRID + (int)blockIdx.x, ngw = KGRID * NWAVES    ;
    const int r32 = lane & 31, hi = lane >> 5;
    LAS bf16_t* VT = (LAS bf16_t*)(lds + wave * GLA_WLDS);
    for (int task = (wave - w0) * KGRID + (int)blockIdx.x; wave >= w0 && wave < w0 + nw && task < (MT / 128) * 4; task += nw * KGRID) {
        const int cc = task >> 2, h = task & 3;
        LDS_FENCE();
#pragma unroll
        for (int half = 0; half < 2; ++half) { const int j = lane + 64 * half; const bf16_t* pv = PB + (size_t)(cc * 128 + j) * INP + C_SV + h * 64;
#pragma unroll
            for (int c8 = 0; c8 < 8; ++c8) { const u32x4 w = *(const u32x4*)(pv + c8 * 8);
                VT[(c8 * 8 + 0) * 128 + j] = (bf16_t)(w.x & 0xffffu); VT[(c8 * 8 + 1) * 128 + j] = (bf16_t)(w.x >> 16);
                VT[(c8 * 8 + 2) * 128 + j] = (bf16_t)(w.y & 0xffffu); VT[(c8 * 8 + 3) * 128 + j] = (bf16_t)(w.y >> 16);
                VT[(c8 * 8 + 4) * 128 + j] = (bf16_t)(w.z & 0xffffu); VT[(c8 * 8 + 5) * 128 + j] = (bf16_t)(w.z >> 16);
                VT[(c8 * 8 + 6) * 128 + j] = (bf16_t)(w.w & 0xffffu); VT[(c8 * 8 + 7) * 128 + j] = (bf16_t)(w.w >> 16); } }
        LDS_FENCE();
#pragma unroll 1
        for (int ti = 0; ti < 4; ++ti) {
            f32x16 acc0 = {}, acc1 = {};
            const bf16_t* wrow = WSB + ((size_t)h * 128 + 32 * ti + r32) * 128 + 8 * hi;
#pragma unroll
            for (int s = 0; s < 8; ++s) {
                const bf16x8 bw = *(const bf16x8*)(wrow + 16 * s);
                const bf16x8 a0 = *(const LAS bf16x8*)(VT + r32 * 128 + 16 * s + 8 * hi), a1 = *(const LAS bf16x8*)(VT + (32 + r32) * 128 + 16 * s + 8 * hi);
                acc0 = __builtin_amdgcn_mfma_f32_32x32x16_bf16(a0, bw, acc0, 0, 0, 0); acc1 = __builtin_amdgcn_mfma_f32_32x32x16_bf16(a1, bw, acc1, 0, 0, 0);
            }
            const int i = 32 * ti + r32, row = cc * 128 + i; const float bias = bs[h * 128 + i];
            const bf16_t* up = PB + (size_t)row * INP + C_SU + h * 64 + 4 * hi; bf16_t* yp = Y + (size_t)row * DM + h * 64 + 4 * hi;
#pragma unroll
            for (int g = 0; g < 4; ++g) {
                { const u32x2 u = *(const u32x2*)(up + 8 * g); u32x2 o;
                  o.x = cvtpk(__uint_as_float(u.x << 16) * (acc0[4 * g + 0] + bias), __uint_as_float(u.x & 0xffff0000u) * (acc0[4 * g + 1] + bias));
                  o.y = cvtpk(__uint_as_float(u.y << 16) * (acc0[4 * g + 2] + bias), __uint_as_float(u.y & 0xffff0000u) * (acc0[4 * g + 3] + bias));
                  *(u32x2*)(yp + 8 * g) = o; }
                { const u32x2 u = *(const u32x2*)(up + 32 + 8 * g); u32x2 o;
                  o.x = cvtpk(__uint_as_float(u.x << 16) * (acc1[4 * g + 0] + bias), __uint_as_float(u.x & 0xffff0000u) * (acc1[4 * g + 1] + bias));
                  o.y = cvtpk(__uint_as_float(u.y << 16) * (acc1[4 * g + 2] + bias), __uint_as_float(u.y & 0xffff0000u) * (acc1[4 * g + 3] + bias));
                  *(u32x2*)(yp + 32 + 8 * g) = o; }
            }
        }
    }
}

__device__ __forceinline__ void phase_attn_naive(const Args& a, int l, LAS unsigned char* lds) {
    unsigned char* ws = a.ws;
    const bf16_t* QB = (const bf16_t*)(ws + WS_QB); const bf16_t* KVB = (const bf16_t*)(ws + WS_KVB); const bf16_t* PB = (const bf16_t*)(ws + WS_PB); bf16_t* Y = (bf16_t*)(ws + WS_HY);
    const float* ROPE = (const float*)(ws + WS_ROPE);
    LAS float* Qs = (LAS float*)lds;
    LAS float* Ks = Qs + 192 * 64;
    LAS float* Vs = Ks + 96 * 64;
    LAS float* Ps = Vs + 64 * 128;
    const int tid = KTID, ty = tid >> 4, tx = tid & 15;
    const int nunits = 1024 + (l == 0 ? 32 : 0);
    for (int unit = blockIdx.x; unit < nunits; unit += KGRID) {
        int bh, nkeys, orow0;
        if (unit < 1024) { bh = unit >> 7; const int qb = unit & 127; nkeys = NKEY; orow0 = (bh >> 2) * NL + qb * 64; }
        else { const int u = unit - 1024; bh = u >> 2; const int qb = u & 3; nkeys = NC; orow0 = ML + (bh >> 2) * NC + qb * 64; }
        const int h = bh & 3, b = bh >> 2;
        const bf16_t* Qp = QB + (size_t)orow0 * 768 + h * 192;
        __syncthreads();
        for (int idx = tid; idx < 64 * 24; idx += NTHR) { const int r = idx / 24, ch = idx % 24; float f[8]; unpack8(*(const u32x4*)(Qp + (size_t)r * 768 + ch * 8), f);
            if (ch >= 16 && unit < 1024) { const int t = (orow0 + r) & (NL - 1), jj = (ch - 16) * 8;
                const f32x4 r0 = rope4((f32x4){f[0], f[1], f[2], f[3]}, jj, t, ROPE), r1 = rope4((f32x4){f[4], f[5], f[6], f[7]}, jj + 4, t, ROPE);
                f[0] = r0.x; f[1] = r0.y; f[2] = r0.z; f[3] = r0.w; f[4] = r1.x; f[5] = r1.y; f[6] = r1.z; f[7] = r1.w; }
#pragma unroll
            for (int i = 0; i < 8; ++i) Qs[(ch * 8 + i) * 64 + r] = f[i]; }
        float m[2] = {-1e30f, -1e30f}, lsum[2] = {0.f, 0.f}, o[2][8];
#pragma unroll
        for (int r = 0; r < 2; ++r)
#pragma unroll
            for (int c = 0; c < 8; ++c) o[r][c] = 0.f;
        for (int k0 = 0; k0 < nkeys; k0 += 64) {
            const int krow0 = k0 < NC ? ML + b * NC + k0 : b * NL + (k0 - NC);
            float s[2][4];
#pragma unroll
            for (int r = 0; r < 2; ++r)
#pragma unroll
                for (int j = 0; j < 4; ++j) s[r][j] = 0.f;
            for (int dh = 0; dh < 2; ++dh) {
                __syncthreads();
                for (int idx = tid; idx < 64 * 12; idx += NTHR) { const int key = idx / 12, ch = idx % 12; float f[8];
                    const int dcol = dh * 96 + ch * 8;
                    unpack8(dcol < 128 ? *(const u32x4*)(KVB + (size_t)(krow0 + key) * 1024 + h * 256 + dcol) : *(const u32x4*)(PB + (size_t)(krow0 + key) * INP + C_KR + (dcol - 128)), f);
#pragma unroll
                    for (int i = 0; i < 8; ++i) Ks[(ch * 8 + i) * 64 + key] = f[i]; }
                if (dh == 0) {
                    for (int idx = tid; idx < 64 * 16; idx += NTHR) { const int key = idx >> 4, ch = idx & 15; float f[8];
                        unpack8(*(const u32x4*)(KVB + (size_t)(krow0 + key) * 1024 + h * 256 + 128 + ch * 8), f);
#pragma unroll
                        for (int i = 0; i < 8; ++i) Vs[key * 128 + ch * 8 + i] = f[i]; }
                }
                __syncthreads();
#pragma unroll 4
                for (int d = 0; d < 96; ++d) {
                    const float q0 = Qs[(dh * 96 + d) * 64 + 2 * ty], q1 = Qs[(dh * 96 + d) * 64 + 2 * ty + 1];
                    const f32x4 kv = *(const LAS f32x4*)(Ks + d * 64 + 4 * tx);
#pragma unroll
                    for (int j = 0; j < 4; ++j) { s[0][j] += q0 * kv[j]; s[1][j] += q1 * kv[j]; }
                }
            }
#pragma unroll
            for (int r = 0; r < 2; ++r) {
                float mx = fmaxf(fmaxf(s[r][0], s[r][1]), fmaxf(s[r][2], s[r][3]));
                mx = fmaxf(mx, __shfl_xor(mx, 1)); mx = fmaxf(mx, __shfl_xor(mx, 2)); mx = fmaxf(mx, __shfl_xor(mx, 4)); mx = fmaxf(mx, __shfl_xor(mx, 8));
                const float mn = fmaxf(m[r], mx), alpha = exp2f(m[r] - mn);
                float p[4], rs = 0.f;
#pragma unroll
                for (int j = 0; j < 4; ++j) { p[j] = exp2f(s[r][j] - mn); rs += p[j]; Ps[(2 * ty + r) * 65 + 4 * tx + j] = p[j]; }
                rs += __shfl_xor(rs, 1); rs += __shfl_xor(rs, 2); rs += __shfl_xor(rs, 4); rs += __shfl_xor(rs, 8);
                lsum[r] = lsum[r] * alpha + rs; m[r] = mn;
#pragma unroll
                for (int c = 0; c < 8; ++c) o[r][c] *= alpha;
            }
            __syncthreads();
#pragma unroll 4
            for (int j = 0; j < 64; ++j) {
                const float p0 = Ps[(2 * ty) * 65 + j], p1 = Ps[(2 * ty + 1) * 65 + j];
                const f32x4 v0 = *(const LAS f32x4*)(Vs + j * 128 + 8 * tx), v1 = *(const LAS f32x4*)(Vs + j * 128 + 8 * tx + 4);
#pragma unroll
                for (int c = 0; c < 4; ++c) { o[0][c] += p0 * v0[c]; o[0][4 + c] += p0 * v1[c]; o[1][c] += p1 * v0[c]; o[1][4 + c] += p1 * v1[c]; }
            }
        }
#pragma unroll
        for (int r = 0; r < 2; ++r) {
            const float il = 1.f / lsum[r];
            u32x4 w; w.x = pk2(o[r][0] * il, o[r][1] * il); w.y = pk2(o[r][2] * il, o[r][3] * il); w.z = pk2(o[r][4] * il, o[r][5] * il); w.w = pk2(o[r][6] * il, o[r][7] * il);
            *(u32x4*)(Y + (size_t)(orow0 + 2 * ty + r) * DM + 512 + h * 128 + 8 * tx) = w;
        }
    }
}

namespace att {
using s16x4 = __attribute__((ext_vector_type(4))) short;
constexpr int QBLK = 32, KVBLK = 64;
constexpr int SHM_V = KVBLK * 128 * 2, SHM_K = KVBLK * 192 * 2, SHM_SCR = 2 * SHM_V + 2 * SHM_K, SHM_QL = SHM_SCR + NWAVES * 64 * 4, SHM_ATTN = SHM_QL + NWAVES * ATT_NQL * 1024;
constexpr float THR2 = 11.5f;
#define KSWZ(row, colB) ((row) * 384 + ((colB) ^ ((((row) >> 1) & 7) << 4)))
#define SBAR() __builtin_amdgcn_sched_barrier(0)
__device__ __forceinline__ float rowmax32(const f32x16& p0, const f32x16& p1) {
  float a = fmaxf(fmaxf(p0[0], p0[1]), p1[0]), b = fmaxf(fmaxf(p0[2], p0[3]), p1[1]); a = fmaxf(fmaxf(a, p1[2]), p1[3]);
#pragma unroll
  for (int r = 4; r < 16; r += 4) { a = fmaxf(fmaxf(a, p0[r]), p0[r + 1]); b = fmaxf(fmaxf(b, p0[r + 2]), p0[r + 3]); a = fmaxf(fmaxf(a, p1[r]), p1[r + 1]); b = fmaxf(fmaxf(b, p1[r + 2]), p1[r + 3]); }
  float m = fmaxf(a, b);
  auto rr = __builtin_amdgcn_permlane32_swap(__float_as_uint(m), __float_as_uint(m), false, false);
  return fmaxf(__uint_as_float(rr[0]), __uint_as_float(rr[1]));
}
template <bool FIRST> __device__ __forceinline__ void partialSM(f32x16& p0, f32x16& p1, float& mhat, f32x16& negm, float& alpha) {
  const float rm = rowmax32(p0, p1);
  alpha = 1.f;
  if (FIRST || __builtin_expect(__any(rm > THR2), 0)) {
    const float dl = FIRST ? rm : fmaxf(rm, 0.f);
    mhat += dl;
#pragma unroll
    for (int r = 0; r < 16; ++r) { p0[r] -= dl; p1[r] -= dl; }
#pragma unroll
    for (int r = 0; r < 16; ++r) negm[r] = -mhat;
    if (!FIRST) alpha = __builtin_amdgcn_exp2f(-dl);
  }
#pragma unroll
  for (int r = 0; r < 16; ++r) p0[r] = __builtin_amdgcn_exp2f(p0[r]);
}
__device__ __forceinline__ void finishSM(f32x16& p0, f32x16& p1, float alpha, float& l_reg, bf16x8& pa0, bf16x8& pa1, bf16x8& pa2, bf16x8& pa3) {
#pragma unroll
  for (int r = 0; r < 16; ++r) p1[r] = __builtin_amdgcn_exp2f(p1[r]);
  float ps = 0;
#pragma unroll
  for (int r = 0; r < 16; ++r) ps += p0[r];
#pragma unroll
  for (int r = 0; r < 16; ++r) ps += p1[r];
  { auto rr = __builtin_amdgcn_permlane32_swap(__float_as_uint(ps), __float_as_uint(ps), false, false);
    ps = __uint_as_float(rr[0]) + __uint_as_float(rr[1]); }
  l_reg = l_reg * alpha + ps;
#define PK4(P, BASE, OUT) do { unsigned a0 = cvtpk(P[BASE + 0], P[BASE + 1]), a1 = cvtpk(P[BASE + 2], P[BASE + 3]);   \
    unsigned b0 = cvtpk(P[BASE + 4], P[BASE + 5]), b1 = cvtpk(P[BASE + 6], P[BASE + 7]);                              \
    auto r0 = __builtin_amdgcn_permlane32_swap(a0, b0, false, false); auto r1 = __builtin_amdgcn_permlane32_swap(a1, b1, false, false); \
    u32x4 w = {r0[0], r1[0], r0[1], r1[1]}; OUT = __builtin_bit_cast(bf16x8, w); } while (0)
  PK4(p0, 0, pa0); PK4(p0, 8, pa1); PK4(p1, 0, pa2); PK4(p1, 8, pa3);
#undef PK4
}
constexpr int NQR = 12 - ATT_NQL;
#define ATT_KRD(K0, K1, d0, KB) asm volatile("ds_read_b128 %0, %2 offset:%3\n\tds_read_b128 %1, %2 offset:%4" : "=&v"(K0), "=&v"(K1) : "v"(ka[(d0) & 3]), "i"((KB) + ((d0) >> 2) * 128), "i"((KB) + ((d0) >> 2) * 128 + 12288) : "memory")
#define ATT_QRD(Q, d0) asm volatile("ds_read_b128 %0, %1 offset:%2" : "=&v"(Q) : "v"(qla), "i"(((d0) - NQR) * 1024) : "memory")
template <int KB> __device__ __forceinline__ void qkt(f32x16& p0, f32x16& p1, const unsigned (&ka)[4], const bf16x8* qr, unsigned qla, const f32x16& negm) {
  p0 = negm; p1 = negm;
  bf16x8 kx0, kx1, ky0, ky1, qx, qy;
  ATT_KRD(kx0, kx1, 0, KB); if (0 >= NQR) ATT_QRD(qx, 0);
#pragma unroll
  for (int d0 = 0; d0 < 12; d0 += 2) {
    ATT_KRD(ky0, ky1, d0 + 1, KB); if (d0 + 1 >= NQR) ATT_QRD(qy, d0 + 1);
    if (d0 + 1 >= NQR) { if (d0 >= NQR) asm volatile("s_waitcnt lgkmcnt(3)" : "+v"(kx0), "+v"(kx1), "+v"(qx)); else asm volatile("s_waitcnt lgkmcnt(3)" : "+v"(kx0), "+v"(kx1)); }
    else asm volatile("s_waitcnt lgkmcnt(2)" : "+v"(kx0), "+v"(kx1));
    { const bf16x8 qf = d0 < NQR ? qr[d0 < NQR ? d0 : 0] : qx;
      p0 = __builtin_amdgcn_mfma_f32_32x32x16_bf16(kx0, qf, p0, 0, 0, 0); p1 = __builtin_amdgcn_mfma_f32_32x32x16_bf16(kx1, qf, p1, 0, 0, 0); }
    if (d0 + 2 < 12) { ATT_KRD(kx0, kx1, d0 + 2, KB); if (d0 + 2 >= NQR) ATT_QRD(qx, d0 + 2);
      if (d0 + 2 >= NQR) { if (d0 + 1 >= NQR) asm volatile("s_waitcnt lgkmcnt(3)" : "+v"(ky0), "+v"(ky1), "+v"(qy)); else asm volatile("s_waitcnt lgkmcnt(3)" : "+v"(ky0), "+v"(ky1)); }
      else asm volatile("s_waitcnt lgkmcnt(2)" : "+v"(ky0), "+v"(ky1)); }
    else { if (d0 + 1 >= NQR) asm volatile("s_waitcnt lgkmcnt(0)" : "+v"(ky0), "+v"(ky1), "+v"(qy)); else asm volatile("s_waitcnt lgkmcnt(0)" : "+v"(ky0), "+v"(ky1)); }
    { const bf16x8 qf = d0 + 1 < NQR ? qr[d0 + 1 < NQR ? d0 + 1 : 0] : qy;
      p0 = __builtin_amdgcn_mfma_f32_32x32x16_bf16(ky0, qf, p0, 0, 0, 0); p1 = __builtin_amdgcn_mfma_f32_32x32x16_bf16(ky1, qf, p1, 0, 0, 0); }
  }
}
__device__ __forceinline__ int v_st(int k, int c) { const int kk = (k & ~0xC) | ((k & 4) << 1) | ((k & 8) >> 1); return ((kk >> 3) * 4 + (c >> 5)) * 512 + ((kk & 7) * 32 + (c & 31)) * 2; }
__device__ __forceinline__ int v_rd_base(int lane) { return ((lane & 3) << 3) | (((lane >> 2) & 3) << 6) | (((lane >> 4) & 1) << 5) | (((lane >> 5) & 1) << 8); }
constexpr int v_rd_off(int d0, int ks, int half) { return d0 * 512 + ks * 4096 + half * 2048; }
template <int OFF> __device__ __forceinline__ s16x4 tr_read(int vb) {
  s16x4 r; asm volatile("ds_read_b64_tr_b16 %0, %1 offset:%2" : "=&v"(r) : "v"(vb), "i"(OFF) : "memory"); return r;
}
template <int D0> __device__ __forceinline__ void pv_one(f32x16& od, int vb, bf16x8 pa0, bf16x8 pa1, bf16x8 pa2, bf16x8 pa3) {
  const s16x4 l0 = tr_read<v_rd_off(D0, 0, 0)>(vb), h0 = tr_read<v_rd_off(D0, 0, 1)>(vb), l1 = tr_read<v_rd_off(D0, 1, 0)>(vb), h1 = tr_read<v_rd_off(D0, 1, 1)>(vb);
  const s16x4 l2 = tr_read<v_rd_off(D0, 2, 0)>(vb), h2 = tr_read<v_rd_off(D0, 2, 1)>(vb), l3 = tr_read<v_rd_off(D0, 3, 0)>(vb), h3 = tr_read<v_rd_off(D0, 3, 1)>(vb);
  asm volatile("s_waitcnt lgkmcnt(0)" ::: "memory"); SBAR();
#define PK(L, H) (bf16x8){L[0], L[1], L[2], L[3], H[0], H[1], H[2], H[3]}
  od = __builtin_amdgcn_mfma_f32_32x32x16_bf16(pa0, PK(l0, h0), od, 0, 0, 0);
  od = __builtin_amdgcn_mfma_f32_32x32x16_bf16(pa1, PK(l1, h1), od, 0, 0, 0);
  od = __builtin_amdgcn_mfma_f32_32x32x16_bf16(pa2, PK(l2, h2), od, 0, 0, 0);
  od = __builtin_amdgcn_mfma_f32_32x32x16_bf16(pa3, PK(l3, h3), od, 0, 0, 0);
#undef PK
}
__device__ __forceinline__ void pv_d0(f32x16* o, int vb, bf16x8 pa0, bf16x8 pa1, bf16x8 pa2, bf16x8 pa3) {
  pv_one<0>(o[0], vb, pa0, pa1, pa2, pa3); pv_one<1>(o[1], vb, pa0, pa1, pa2, pa3); pv_one<2>(o[2], vb, pa0, pa1, pa2, pa3); pv_one<3>(o[3], vb, pa0, pa1, pa2, pa3);
}
template <int ABL> __device__ __forceinline__ void unit(const bf16_t* __restrict__ QB, const bf16_t* __restrict__ KVB, const bf16_t* __restrict__ PB, const float* __restrict__ ROPE, bf16_t* __restrict__ Y,
                                     int qrow0, int b, int h, int nkeys, bool ropeq, LAS unsigned char* lds) {
  const int wid = kwave(), lane = klane(), tid = wid * 64 + lane, r32 = lane & 31, hi = lane >> 5;
  LAS unsigned char* V_lds = lds; LAS unsigned char* K_lds = lds + 2 * SHM_V;
  LAS float* wsc = (LAS float*)(lds + SHM_SCR) + wid * 64; LAS float* li_l = wsc; LAS float* al_l = wsc + 32;
  LAS unsigned char* qlw = lds + SHM_QL + wid * (ATT_NQL * 1024); const LAS unsigned char* ql = qlw + lane * 16;
  float mhat = 0.f, l_reg = 0; f32x16 o[4] = {}; f32x16 negm = {}; bf16x8 qr[NQR];
  {
    const int qrow = qrow0 + wid * QBLK + r32;
    const bf16_t* Qw = QB + (size_t)qrow * 768 + h * 192 + hi * 8;
#pragma unroll
    for (int d0 = 0; d0 < 12; ++d0) {
      u32x4 w = *(const u32x4*)(Qw + d0 * 16);
      if (d0 >= 8 && ropeq) { float f[8]; unpack8(w, f); const int t = qrow & (NL - 1), jj = (d0 - 8) * 16 + hi * 8;
        const f32x4 r0 = rope4((f32x4){f[0], f[1], f[2], f[3]}, jj, t, ROPE), r1 = rope4((f32x4){f[4], f[5], f[6], f[7]}, jj + 4, t, ROPE);
        w.x = cvtpk(r0.x, r0.y); w.y = cvtpk(r0.z, r0.w); w.z = cvtpk(r1.x, r1.y); w.w = cvtpk(r1.z, r1.w); }
      if (d0 < NQR) qr[d0 < NQR ? d0 : 0] = __builtin_bit_cast(bf16x8, w); else *(LAS u32x4*)(qlw + (d0 - NQR) * 1024 + lane * 16) = w;
    }
  }
  const int sr = tid >> 4, sc = (tid & 15) * 8, vst0 = v_st(sr, sc), vst1 = v_st(32 + sr, sc);
  const int krw = tid >> 3, kcg = tid & 7;
  const int kw0 = KSWZ(krw, kcg * 16), kw1 = KSWZ(krw, (kcg + 8) * 16), kw2 = KSWZ(krw, (kcg + 16) * 16);
  const int vb0 = (int)(uintptr_t)V_lds + v_rd_base(lane);
  unsigned ka[4];
#pragma unroll
  for (int c = 0; c < 4; ++c) ka[c] = (unsigned)(uintptr_t)K_lds + r32 * 384 + (((c << 5) | (hi << 4)) ^ (((r32 >> 1) & 7) << 4));
  const unsigned qla = (unsigned)(uintptr_t)ql;
  u32x4 sv0, sv1, sk0, sk1, sk2;
#define KROW(k0) ((k0) < NC ? ML + b * NC + (k0) : b * NL + ((k0) - NC))
  const int gv0 = sr * 1024 + h * 256 + 128 + sc, gv1 = gv0 + 32 * 1024, gk0 = krw * 1024 + h * 256 + kcg * 8, gk1 = gk0 + 64, gk2 = krw * INP + C_KR + kcg * 8;
#define KLOAD(k0) do { const int kr_ = __builtin_amdgcn_readfirstlane(KROW(k0)); const bf16_t* kvb_ = KVB + (size_t)kr_ * 1024; const bf16_t* pb_ = PB + (size_t)kr_ * INP; \
    sk0 = *(const u32x4*)(kvb_ + gk0); sk1 = *(const u32x4*)(kvb_ + gk1); sk2 = *(const u32x4*)(pb_ + gk2); } while (0)
#define VLOAD(k0) do { const int kr_ = __builtin_amdgcn_readfirstlane(KROW(k0)); const bf16_t* kvb_ = KVB + (size_t)kr_ * 1024; \
    sv0 = *(const u32x4*)(kvb_ + gv0); sv1 = *(const u32x4*)(kvb_ + gv1); } while (0)
#define KWRITE(bf) do { *(LAS u32x4*)(K_lds + (bf) * SHM_K + kw0) = sk0; *(LAS u32x4*)(K_lds + (bf) * SHM_K + kw1) = sk1; *(LAS u32x4*)(K_lds + (bf) * SHM_K + kw2) = sk2; } while (0)
#define VWRITE(bf) do { *(LAS u32x4*)(V_lds + (bf) * SHM_V + vst0) = sv0; *(LAS u32x4*)(V_lds + (bf) * SHM_V + vst1) = sv1; } while (0)
#define RESC(a) do { if (__any((a) < 1.f)) { if (hi == 0) al_l[r32] = (a); asm volatile("s_waitcnt lgkmcnt(0)" ::: "memory"); \
    _Pragma("unroll") for (int d = 0; d < 4; ++d) _Pragma("unroll") for (int r = 0; r < 16; ++r) o[d][r] *= al_l[crow(r, hi)]; } } while (0)
  f32x16 pA0, pA1, pB0, pB1; float mnA, mnB, alA, alB; bf16x8 pa0, pa1, pa2, pa3; const int NT = nkeys / KVBLK;
#define QKT0(P0, P1) do { if constexpr (ABL == 2) { P0 = f32x16{}; P1 = f32x16{}; asm volatile("" : "+v"(P0), "+v"(P1)); } else qkt<0>(P0, P1, ka, qr, qla, negm); } while (0)
#define QKT1(P0, P1) do { if constexpr (ABL == 2) { P0 = f32x16{}; P1 = f32x16{}; asm volatile("" : "+v"(P0), "+v"(P1)); } else qkt<SHM_K>(P0, P1, ka, qr, qla, negm); } while (0)
#define PV(VB) do { if constexpr (ABL == 3) { asm volatile("" : "+v"(o[0]), "+v"(o[1]), "+v"(o[2]), "+v"(o[3]) : "v"(pa0), "v"(pa1), "v"(pa2), "v"(pa3)); } else pv_d0(o, VB, pa0, pa1, pa2, pa3); } while (0)
#define PSM(P0, P1, MN, AL) do { if constexpr (ABL == 4) { MN = 0.f; AL = 1.f; asm volatile("" : "+v"(P0), "+v"(P1)); } else partialSM<false>(P0, P1, mhat, negm, AL); } while (0)
#define PSM0(P0, P1, MN, AL) partialSM<true>(P0, P1, mhat, negm, AL)
#define FSM(P0, P1, AL) do { if constexpr (ABL == 4) { u32x4 w0_ = {__float_as_uint(P0[0]), __float_as_uint(P0[1]), __float_as_uint(P0[2]), __float_as_uint(P0[3])}, w1_ = {__float_as_uint(P1[0]), __float_as_uint(P1[1]), __float_as_uint(P1[2]), __float_as_uint(P1[3])}; \
      pa0 = __builtin_bit_cast(bf16x8, w0_); pa1 = __builtin_bit_cast(bf16x8, w1_); pa2 = pa0; pa3 = pa1; l_reg += AL; } else finishSM(P0, P1, AL, l_reg, pa0, pa1, pa2, pa3); } while (0)
  KLOAD(0); KWRITE(0); __syncthreads();
  if (wid >= 4) __syncthreads();
  SBAR(); KLOAD(KVBLK); SBAR(); QKT0(pA0, pA1); SBAR(); KWRITE(1); __syncthreads();
  SBAR(); VLOAD(0); SBAR(); PSM0(pA0, pA1, mnA, alA); SBAR(); VWRITE(0); __syncthreads();
  for (int j = 1; j + 1 < NT; j += 2) {
    SBAR(); if constexpr (ABL != 1) KLOAD((j + 1) * KVBLK); SBAR(); QKT1(pB0, pB1); FSM(pA0, pA1, alA); SBAR(); if constexpr (ABL != 1) KWRITE(0); __syncthreads();
    SBAR(); if constexpr (ABL != 1) VLOAD(j * KVBLK); SBAR(); PV(vb0); PSM(pB0, pB1, mnB, alB); RESC(alB); SBAR(); if constexpr (ABL != 1) VWRITE(1); __syncthreads();
    SBAR(); if constexpr (ABL != 1) KLOAD((j + 2) * KVBLK); SBAR(); QKT0(pA0, pA1); FSM(pB0, pB1, alB); SBAR(); if constexpr (ABL != 1) KWRITE(1); __syncthreads();
    SBAR(); if constexpr (ABL != 1) VLOAD((j + 1) * KVBLK); SBAR(); PV(vb0 + SHM_V); PSM(pA0, pA1, mnA, alA); RESC(alA); SBAR(); if constexpr (ABL != 1) VWRITE(0); __syncthreads();
  }
  SBAR(); QKT1(pB0, pB1); FSM(pA0, pA1, alA); SBAR(); __syncthreads();
  SBAR(); VLOAD((NT - 1) * KVBLK); SBAR(); PV(vb0); PSM(pB0, pB1, mnB, alB); RESC(alB); SBAR(); VWRITE(1); __syncthreads();
  if (wid < 4) __syncthreads();
  FSM(pB0, pB1, alB); SBAR();
  PV(vb0 + SHM_V);
#undef QKT0
#undef PSM0
#undef QKT1
#undef PV
#undef PSM
#undef FSM
  if (hi == 0) li_l[r32] = l_reg; asm volatile("s_waitcnt lgkmcnt(0)" ::: "memory");
  float rli[16];
#pragma unroll
  for (int r = 0; r < 16; ++r) rli[r] = __builtin_amdgcn_rcpf(li_l[crow(r, hi)]);
  bf16_t* Ow = Y + (size_t)(qrow0 + wid * QBLK) * DM + 512 + h * 128;
#pragma unroll
  for (int r = 0; r < 16; ++r) { const int orow = crow(r, hi);
#pragma unroll
    for (int d0 = 0; d0 < 4; ++d0) { const float val = o[d0][r] * rli[r]; if constexpr (ABL == 0) Ow[(size_t)orow * DM + d0 * 32 + r32] = (bf16_t)(cvtpk(val, 0.f) & 0xffffu); else asm volatile("" :: "v"(val)); } }
#undef KROW
#undef KLOAD
#undef VLOAD
#undef KWRITE
#undef VWRITE
#undef RESC
}
#undef KSWZ
#undef SBAR
}
template <int ABL> __device__ __forceinline__ void phase_attn_mfma(const Args& a, int l, LAS unsigned char* lds) {
    unsigned char* ws = a.ws;
    const bf16_t* QB = (const bf16_t*)(ws + WS_QB); const bf16_t* KVB = (const bf16_t*)(ws + WS_KVB); const bf16_t* PB = (const bf16_t*)(ws + WS_PB); bf16_t* Y = (bf16_t*)(ws + WS_HY);
    const float* ROPE = (const float*)(ws + WS_ROPE);
    const int nunits = 256 + (l == 0 ? 8 : 0);
    for (int u = blockIdx.x; u < nunits; u += KGRID) {
        __syncthreads();
        if (u < 256) { const int bh = u & 7, qb = u >> 3, b = bh >> 2, h = bh & 3; att::unit<ABL>(QB, KVB, PB, ROPE, Y, b * NL + qb * 256, b, h, NKEY, true, lds); }
        else { const int bh = u - 256, b = bh >> 2, h = bh & 3; att::unit<ABL>(QB, KVB, PB, ROPE, Y, ML + b * NC, b, h, NC, false, lds); }
    }
}

namespace pg8 {
#define PG8_LAS __attribute__((address_space(3)))
typedef unsigned short bf16_t;
typedef short bf16x8 __attribute__((ext_vector_type(8)));
typedef float f32x4 __attribute__((ext_vector_type(4)));
typedef unsigned u32x4 __attribute__((ext_vector_type(4)));
constexpr int BM = 256, BK = 64, HALF = 128, HTB = HALF * BK * 2  , STAGE_BYTES = 8 * HTB, NXCD = 8, WGM = 8;

__host__ __device__ __forceinline__ int lds_byte(int r, int c) { const int st = (r >> 4) * 2 + (c >> 5), rr = r & 15, cc = c & 31, ob = rr * 64 + cc * 2; return st * 1024 + (ob ^ (((ob >> 9) & 1) << 5)); }
__host__ __device__ __forceinline__ void stage_rc(int b, int& R, int& C) { const int st = b / 1024, sb = b % 1024, swz = sb ^ (((sb >> 9) & 1) << 5); R = (st >> 1) * 16 + swz / 64; C = (st & 1) * 32 + (swz % 64) / 2; }
__host__ __device__ __forceinline__ int perm32(int rho) { const int n = rho >> 4, i = rho & 15; return 8 * (i >> 2) + 4 * n + (i & 3); }

struct Unit { int pm, pn; };
struct Gemm { const bf16_t* A; int lda; const bf16_t* Bt; int M, N, K; };

struct StaticOrder {
    int nM, nN, nwg, G, c;
    __host__ __device__ void init(int M, int N, int G_, int c_) { nM = M / BM; nN = N / BM; nwg = nM * nN; G = G_; c = c_; }
    __host__ __device__ bool next(int i, Unit& u) const {
        const long L = (long)i * G + c; if (L >= nwg) return false;
        int wgid = (int)L; { const int q = nwg / NXCD, r = nwg % NXCD, xcd = wgid % NXCD, off = wgid / NXCD; wgid = (xcd < r ? xcd * (q + 1) : r * (q + 1) + (xcd - r) * q) + off; }
        const int nig = WGM * nN, gid = wgid / nig, fm = gid * WGM, gsz = (nM - fm) < WGM ? (nM - fm) : WGM;
        u.pm = fm + ((wgid % nig) % gsz); u.pn = (wgid % nig) / gsz; return true;
    }
    __device__ __forceinline__ void a_ready(const Unit&) const {}
    __device__ __forceinline__ void done(const Unit&) const {}
};
template <class Epi, class Sched, bool ALIGN_EPI = false, bool SP2 = false>
__device__ __forceinline__ void gemm_phase(PG8_LAS unsigned char* lds, const Gemm g, const Sched& S, const Epi& E) {
    const int wid = kwave(), lane = klane(), tid = wid * 64 + lane, wr = wid >> 2, wc = wid & 3, fr = lane & 15, fq = lane >> 4;
    const int K = g.K, nt = K / BK;
    unsigned voffA[2], voffB[2];
#pragma unroll
    for (int i = 0; i < 2; ++i) { int R, C; stage_rc(tid * 16 + i * 8192, R, C); const int Rb = Epi::PERM ? ((R & ~31) + perm32(R & 31)) : R;
        voffA[i] = (unsigned)(R * g.lda + C) * 2u; voffB[i] = (unsigned)(Rb * K + C) * 2u; }
    const size_t kstep = (size_t)(BK * 2);
    const size_t hstepA = (size_t)HALF * g.lda * 2, hstepB = (size_t)HALF * K * 2;
    const size_t tstepA = 2 * hstepA, tstepB = 2 * hstepB;
    const unsigned ldsw = (unsigned)wid * 1024u;
    const int aoff = lds_byte(wr * 64 + fr, fq * 8), boff = lds_byte(wc * 32 + fr, fq * 8);
#define PG8_SA(b, h) (((b) * 2 + (h)) * HTB)
#define PG8_SB(b, h) ((4 + (b) * 2 + (h)) * HTB)
#define PG8_STAGE(bufoff, gbase, voff) do { _Pragma("unroll") for (int _i = 0; _i < 2; ++_i) \
        __builtin_amdgcn_global_load_lds((const unsigned*)((const char*)(gbase) + (voff)[_i]), (PG8_LAS unsigned*)(lds + (bufoff) + ldsw + _i * 8192), 16, 0, 0); } while (0)
#define PG8_LDA(dst, b, h) do { _Pragma("unroll") for (int m = 0; m < 4; ++m) _Pragma("unroll") for (int k = 0; k < 2; ++k) dst[m][k] = *(const PG8_LAS bf16x8*)(lds + PG8_SA(b, h) + aoff + m * 2048 + k * 1024); } while (0)
#define PG8_LDB(dst, b, h) do { _Pragma("unroll") for (int n = 0; n < 2; ++n) _Pragma("unroll") for (int k = 0; k < 2; ++k) dst[n][k] = *(const PG8_LAS bf16x8*)(lds + PG8_SB(b, h) + boff + n * 2048 + k * 1024); } while (0)
#define PG8_MMA(ai, bj, At, Bt) do { __builtin_amdgcn_s_setprio(1); _Pragma("unroll") for (int m = 0; m < 4; ++m) _Pragma("unroll") for (int n = 0; n < 2; ++n) _Pragma("unroll") for (int k = 0; k < 2; ++k) \
        acc[ai][bj][m][n] = __builtin_amdgcn_mfma_f32_16x16x32_bf16(Bt[n][k], At[m][k], acc[ai][bj][m][n], 0, 0, 0); __builtin_amdgcn_s_setprio(0); } while (0)
#define PG8_WAIT_V(n) asm volatile("s_waitcnt vmcnt(" #n ")" ::: "memory")
#define PG8_WAIT_L(n) asm volatile("s_waitcnt lgkmcnt(" #n ")" ::: "memory")
#define PG8_BAR __builtin_amdgcn_s_barrier()
#define PG8_SCHED __builtin_amdgcn_sched_barrier(0)
    Unit cur, nxt; int ui = 0;
    if (!S.next(0, cur)) return;
    f32x4 acc[2][2][4][2];
#pragma unroll
    for (int a = 0; a < 2; ++a)
#pragma unroll
        for (int b = 0; b < 2; ++b)
#pragma unroll
            for (int m = 0; m < 4; ++m)
#pragma unroll
                for (int n = 0; n < 2; ++n) acc[a][b][m][n] = (f32x4){0.f, 0.f, 0.f, 0.f};
    bf16x8 At[4][2], B0[2][2], B1[2][2];
    const char* cA = (const char*)g.A + (size_t)cur.pm * tstepA; const char* cB = (const char*)g.Bt + (size_t)cur.pn * tstepB;
    S.a_ready(cur);
    if constexpr (SP2) {
        PG8_STAGE(PG8_SB(0, 0), cB, voffB); PG8_STAGE(PG8_SB(0, 1), cB + hstepB, voffB); PG8_STAGE(PG8_SA(0, 0), cA, voffA); PG8_STAGE(PG8_SA(0, 1), cA + hstepA, voffA);
        if (wr == 1) PG8_BAR;
        PG8_WAIT_V(2); PG8_BAR;
        PG8_STAGE(PG8_SB(1, 0), cB + kstep, voffB); PG8_STAGE(PG8_SA(1, 0), cA + kstep, voffA); PG8_STAGE(PG8_SB(1, 1), cB + hstepB + kstep, voffB);
        PG8_WAIT_V(6); PG8_BAR;
    } else {
        PG8_STAGE(PG8_SB(0, 0), cB, voffB); PG8_STAGE(PG8_SA(0, 0), cA, voffA); PG8_STAGE(PG8_SB(0, 1), cB + hstepB, voffB); PG8_STAGE(PG8_SA(0, 1), cA + hstepA, voffA);
        if (wr == 1) PG8_BAR;
        PG8_WAIT_V(4); PG8_BAR;
        PG8_STAGE(PG8_SB(1, 0), cB + kstep, voffB); PG8_STAGE(PG8_SA(1, 0), cA + kstep, voffA); PG8_STAGE(PG8_SB(1, 1), cB + hstepB + kstep, voffB);
        PG8_WAIT_V(6); PG8_BAR;
    }
    for (;;) {
        const bool has_next = S.next(ui + 1, nxt);
        const char* nA = has_next ? (const char*)g.A + (size_t)nxt.pm * tstepA : cA; const char* nB = has_next ? (const char*)g.Bt + (size_t)nxt.pn * tstepB : cB;
#pragma nounroll
        for (int t = 0; t < nt; t += 2) {
            const bool last = (t == nt - 2);
            const char* a1 = cA + (size_t)(t + 1) * kstep;
            const char* a2 = last ? nA : cA + (size_t)(t + 2) * kstep; const char* b2 = last ? nB : cB + (size_t)(t + 2) * kstep;
            const char* a3 = a2 + kstep; const char* b3 = b2 + kstep;
            if (last && has_next) S.a_ready(nxt);
            if constexpr (SP2) {
            PG8_LDB(B0, 0, 0); PG8_LDB(B1, 0, 1); PG8_SCHED; PG8_LDA(At, 0, 0); PG8_STAGE(PG8_SA(1, 1), a1 + hstepA, voffA);
            PG8_WAIT_V(8); PG8_WAIT_L(0); PG8_BAR; PG8_MMA(0, 0, At, B0); PG8_MMA(0, 1, At, B1); PG8_BAR; PG8_SCHED;
            PG8_LDA(At, 0, 1); PG8_STAGE(PG8_SB(0, 0), b2, voffB); PG8_STAGE(PG8_SB(0, 1), b2 + hstepB, voffB); PG8_STAGE(PG8_SA(0, 0), a2, voffA);
            PG8_WAIT_V(8); PG8_WAIT_L(0); PG8_BAR; PG8_MMA(1, 0, At, B0); PG8_MMA(1, 1, At, B1); PG8_BAR; PG8_SCHED;
            PG8_LDB(B0, 1, 0); PG8_LDB(B1, 1, 1); PG8_SCHED; PG8_LDA(At, 1, 0); PG8_STAGE(PG8_SA(0, 1), a2 + hstepA, voffA);
            PG8_WAIT_V(8); PG8_WAIT_L(0); PG8_BAR; PG8_MMA(0, 0, At, B0); PG8_MMA(0, 1, At, B1); PG8_BAR; PG8_SCHED;
            PG8_LDA(At, 1, 1); PG8_STAGE(PG8_SB(1, 0), b3, voffB); PG8_STAGE(PG8_SB(1, 1), b3 + hstepB, voffB); PG8_STAGE(PG8_SA(1, 0), a3, voffA);
            PG8_WAIT_V(8); PG8_WAIT_L(0); PG8_BAR; PG8_MMA(1, 0, At, B0); PG8_MMA(1, 1, At, B1); PG8_BAR; PG8_SCHED;
            } else {
            PG8_LDB(B0, 0, 0); PG8_SCHED; PG8_LDA(At, 0, 0); PG8_STAGE(PG8_SA(1, 1), a1 + hstepA, voffA);
            PG8_WAIT_L(8); PG8_BAR; PG8_WAIT_L(0); PG8_MMA(0, 0, At, B0); PG8_BAR; PG8_SCHED;
            PG8_LDB(B1, 0, 1); PG8_STAGE(PG8_SB(0, 0), b2, voffB);
            PG8_BAR; PG8_WAIT_L(0); PG8_MMA(0, 1, At, B1); PG8_BAR;
            PG8_LDA(At, 0, 1); PG8_STAGE(PG8_SA(0, 0), a2, voffA);
            PG8_BAR; PG8_WAIT_L(0); PG8_MMA(1, 0, At, B0); PG8_BAR; PG8_SCHED;
            PG8_STAGE(PG8_SB(0, 1), b2 + hstepB, voffB);
            PG8_WAIT_V(6); PG8_BAR; PG8_MMA(1, 1, At, B1); PG8_BAR;
            PG8_LDB(B0, 1, 0); PG8_SCHED; PG8_LDA(At, 1, 0); PG8_STAGE(PG8_SA(0, 1), a2 + hstepA, voffA);
            PG8_WAIT_L(8); PG8_BAR; PG8_WAIT_L(0); PG8_MMA(0, 0, At, B0); PG8_BAR; PG8_SCHED;
            PG8_LDB(B1, 1, 1); PG8_STAGE(PG8_SB(1, 0), b3, voffB);
            PG8_BAR; PG8_WAIT_L(0); PG8_MMA(0, 1, At, B1); PG8_BAR;
            PG8_LDA(At, 1, 1); PG8_STAGE(PG8_SA(1, 0), a3, voffA);
            PG8_BAR; PG8_WAIT_L(0); PG8_MMA(1, 0, At, B0); PG8_BAR; PG8_SCHED;
            PG8_STAGE(PG8_SB(1, 1), b3 + hstepB, voffB);
            PG8_WAIT_V(6); PG8_BAR; PG8_MMA(1, 1, At, B1); PG8_BAR;
            }
        }
        if constexpr (ALIGN_EPI) { if (wr == 0) PG8_BAR; }
        if constexpr (!Epi::AFTER_DRAIN) { E(acc, cur, wr, wc, fr, fq); S.done(cur); }
        if (!has_next) break;
#pragma unroll
        for (int a = 0; a < 2; ++a)
#pragma unroll
            for (int b = 0; b < 2; ++b)
#pragma unroll
                for (int m = 0; m < 4; ++m)
#pragma unroll
                    for (int n = 0; n < 2; ++n) acc[a][b][m][n] = (f32x4){0.f, 0.f, 0.f, 0.f};
        cur = nxt; cA = nA; cB = nB; ++ui;
        if constexpr (ALIGN_EPI) { if (wr == 1) PG8_BAR; }
    }
    PG8_WAIT_V(0);
    if constexpr (!ALIGN_EPI) { if (wr == 0) PG8_BAR; }
    PG8_BAR;
    if constexpr (Epi::AFTER_DRAIN) { E.fused(acc, cur, wr, wc, fr, fq, lds, wid, lane); S.done(cur); }
#undef PG8_SA
#undef PG8_SB
#undef PG8_STAGE
#undef PG8_LDA
#undef PG8_LDB
#undef PG8_MMA
#undef PG8_WAIT_V
#undef PG8_WAIT_L
#undef PG8_BAR
#undef PG8_SCHED
}
}

template <class F> struct EpiAdapt {
    static constexpr bool PERM = false, AFTER_DRAIN = false;
    F f;
    __device__ __forceinline__ void operator()(const pg8::f32x4 (&acc)[2][2][4][2], const pg8::Unit& u, int wr, int wc, int fr, int fq) const {
#pragma unroll
        for (int ai = 0; ai < 2; ++ai)
#pragma unroll
            for (int m = 0; m < 4; ++m) { const int row = u.pm * 256 + ai * 128 + wr * 64 + m * 16 + fr;
#pragma unroll
                for (int bj = 0; bj < 2; ++bj)
#pragma unroll
                    for (int n = 0; n < 2; ++n) f(row, u.pn * 256 + bj * 128 + wc * 32 + n * 16 + 4 * fq, acc[ai][bj][m][n]); }
    }
};
template <class F> struct EpiAdapt8 {
    static constexpr bool PERM = true, AFTER_DRAIN = false;
    F f;
    __device__ __forceinline__ void operator()(const pg8::f32x4 (&acc)[2][2][4][2], const pg8::Unit& u, int wr, int wc, int fr, int fq) const {
#pragma unroll
        for (int ai = 0; ai < 2; ++ai)
#pragma unroll
            for (int m = 0; m < 4; ++m) { const int row = u.pm * 256 + ai * 128 + wr * 64 + m * 16 + fr;
#pragma unroll
                for (int bj = 0; bj < 2; ++bj) f.op8(row, u.pn * 256 + bj * 128 + wc * 32 + 8 * fq, acc[ai][bj][m][0], acc[ai][bj][m][1]); }
    }
};
struct EpiInProjFused {
    static constexpr bool PERM = true, AFTER_DRAIN = false;
    EpiInProj f; const float* kvnw; const float* qnw; const float* snw; const float* snb; LAS float* scr;
    __device__ __forceinline__ void operator()(pg8::f32x4 (&acc)[2][2][4][2], const pg8::Unit& u, int wr, int wc, int fr, int fq) const {
        const int tile = u.pn;
        if (tile != 0 && tile != 1 && tile != 3) {
#pragma unroll
            for (int ai = 0; ai < 2; ++ai)
#pragma unroll
                for (int m = 0; m < 4; ++m) { const int row = u.pm * 256 + ai * 128 + wr * 64 + m * 16 + fr;
#pragma unroll
                    for (int bj = 0; bj < 2; ++bj) f.op8(row, u.pn * 256 + bj * 128 + wc * 32 + 8 * fq, acc[ai][bj][m][0], acc[ai][bj][m][1]); }
            return;
        }
        if (tile == 3) {
#pragma unroll
            for (int ai = 0; ai < 2; ++ai)
#pragma unroll
                for (int bj = 0; bj < 2; ++bj)
#pragma unroll
                    for (int m = 0; m < 4; ++m)
#pragma unroll
                        for (int n = 0; n < 2; ++n) { f32x4 v = acc[ai][bj][m][n]; acc[ai][bj][m][n] = (f32x4){gelu_tanh(v.x), gelu_tanh(v.y), gelu_tanh(v.z), gelu_tanh(v.w)}; }
        }
#pragma unroll
        for (int ai = 0; ai < 2; ++ai)
#pragma unroll
            for (int m = 0; m < 4; ++m) {
                float s1 = 0.f, s2 = 0.f;
#pragma unroll
                for (int bj = 0; bj < 2; ++bj)
#pragma unroll
                    for (int n = 0; n < 2; ++n) { const f32x4 v = acc[ai][bj][m][n]; s1 += (v.x + v.y) + (v.z + v.w); s2 += (v.x * v.x + v.y * v.y) + (v.z * v.z + v.w * v.w); }
                s1 += __shfl_xor(s1, 16); s1 += __shfl_xor(s1, 32); s2 += __shfl_xor(s2, 16); s2 += __shfl_xor(s2, 32);
                const int rl = ai * 128 + wr * 64 + m * 16 + fr;
                if (fq == 0) { scr[rl * 4 + wc] = s1; scr[1024 + rl * 4 + wc] = s2; }
                asm volatile("" ::: "memory");
            }
        asm volatile("s_waitcnt lgkmcnt(0)" ::: "memory"); __builtin_amdgcn_s_barrier(); asm volatile("" ::: "memory");
        f32x4 wv[2][2], bv[2][2];
#pragma unroll
        for (int bj = 0; bj < 2; ++bj) { const int cl = bj * 128 + wc * 32 + 8 * fq;
            if (tile == 0) { wv[bj][0] = *(const f32x4*)(kvnw + cl); wv[bj][1] = *(const f32x4*)(kvnw + cl + 4); }
            else if (tile == 1) { wv[bj][0] = *(const f32x4*)(qnw + cl); wv[bj][1] = *(const f32x4*)(qnw + cl + 4); }
            else { wv[bj][0] = *(const f32x4*)(snw + cl); wv[bj][1] = *(const f32x4*)(snw + cl + 4); }
            if (tile == 3) { bv[bj][0] = *(const f32x4*)(snb + cl); bv[bj][1] = *(const f32x4*)(snb + cl + 4); } else { bv[bj][0] = (f32x4){0.f, 0.f, 0.f, 0.f}; bv[bj][1] = (f32x4){0.f, 0.f, 0.f, 0.f}; } }
#pragma unroll
        for (int ai = 0; ai < 2; ++ai)
#pragma unroll
            for (int m = 0; m < 4; ++m) {
                const int rl = ai * 128 + wr * 64 + m * 16 + fr, row = u.pm * 256 + rl;
                const f32x4 a1 = *(const LAS f32x4*)(scr + rl * 4), a2 = *(const LAS f32x4*)(scr + 1024 + rl * 4);
                const float t1 = (a1.x + a1.y) + (a1.z + a1.w), t2 = (a2.x + a2.y) + (a2.z + a2.w);
                float mu = 0.f, rstd;
                if (tile == 3) { mu = t1 * (1.f / 256.f); rstd = rsqrtf(fmaxf(t2 * (1.f / 256.f) - mu * mu, 0.f) + EPS); }
                else rstd = rsqrtf(t2 * (1.f / 256.f) + EPS);
#pragma unroll
                for (int bj = 0; bj < 2; ++bj) { const int cl = bj * 128 + wc * 32 + 8 * fq;
                    const f32x4 o0 = (acc[ai][bj][m][0] - mu) * rstd * wv[bj][0] + bv[bj][0], o1 = (acc[ai][bj][m][1] - mu) * rstd * wv[bj][1] + bv[bj][1];
                    st8bf(f.PB + (size_t)row * INP + u.pn * 256 + cl, o0, o1); }
                asm volatile("" ::: "memory");
            }
        asm volatile("s_waitcnt lgkmcnt(0)" ::: "memory"); __builtin_amdgcn_s_barrier(); asm volatile("" ::: "memory");
    }
};
template <class F> __device__ __forceinline__ void gemm_mfma8(const bf16_t* A, int lda, const bf16_t* Bt, int M, int N, int K, const F& f, LAS unsigned char* lds) {
    pg8::Gemm g{A, lda, Bt, M, N, K}; pg8::StaticOrder S; S.init(M, N, KGRID, (int)blockIdx.x);
    EpiAdapt8<F> E{f};
    pg8::gemm_phase<EpiAdapt8<F>, pg8::StaticOrder, true, true>(lds, g, S, E);
}
template <class F> __device__ __forceinline__ void gemm_mfma(const bf16_t* A, int lda, const bf16_t* Bt, int M, int N, int K, const F& f, LAS unsigned char* lds) {
    pg8::Gemm g{A, lda, Bt, M, N, K}; pg8::StaticOrder S; S.init(M, N, KGRID, (int)blockIdx.x);
    EpiAdapt<F> E{f};
    pg8::gemm_phase<EpiAdapt<F>, pg8::StaticOrder, true, true>(lds, g, S, E);
}


#ifndef GEMM_MASK
#define GEMM_MASK 63
#endif
template <int BIT, class F> __device__ __forceinline__ void gemm_sel(const bf16_t* A, int lda, const bf16_t* Bt, int M, int N, int K, const F& f, LAS unsigned char* lds) {
    if constexpr ((GEMM_MASK >> BIT) & 1) gemm_mfma(A, lda, Bt, M, N, K, f, lds); else gemm_naive(A, lda, Bt, M, N, K, f, lds);
}

template <class F> __device__ __forceinline__ void gemm_ctx_small(const bf16_t* A, int lda, const bf16_t* Bt, int N, int K, const F& f, LAS unsigned char* lds) {
    const int lane = klane(), wave = kwave(), r32 = lane & 31, hi = lane >> 5;
    const int nct = N / 64, ntasks = 8 * nct, G = KGRID;
    const int KS = K >= 512 ? 8 : K / 64, kslice = K / KS;
    LAS float* red = (LAS float*)lds;
    for (int task = blockIdx.x; task < ntasks; task += G) {
        const int rt = task / nct, ct = task % nct, row0 = ML + rt * 64, col0 = ct * 64;
        f32x16 acc[2][2];
#pragma unroll
        for (int c = 0; c < 2; ++c) { acc[c][0] = f32x16{}; acc[c][1] = f32x16{}; }
        if (wave < KS) {
            const bf16_t* ap0 = A + (size_t)(row0 + r32) * lda + wave * kslice + 8 * hi; const bf16_t* ap1 = ap0 + (size_t)32 * lda;
            const bf16_t* bp0 = Bt + (size_t)(col0 + r32) * K + wave * kslice + 8 * hi; const bf16_t* bp1 = bp0 + (size_t)32 * K;
            bf16x8 av[4][2], bv[4][2];
#define CTX_LOAD(k0) do { _Pragma("unroll") for (int s = 0; s < 4; ++s) { av[s][0] = *(const bf16x8*)(ap0 + (k0) + 16 * s); av[s][1] = *(const bf16x8*)(ap1 + (k0) + 16 * s); \
                bv[s][0] = *(const bf16x8*)(bp0 + (k0) + 16 * s); bv[s][1] = *(const bf16x8*)(bp1 + (k0) + 16 * s); } } while (0)
            CTX_LOAD(0);
#pragma unroll 1
            for (int k0 = 0; k0 < kslice; k0 += 64) {
                bf16x8 ac[4][2], bc[4][2];
#pragma unroll
                for (int s = 0; s < 4; ++s) { ac[s][0] = av[s][0]; ac[s][1] = av[s][1]; bc[s][0] = bv[s][0]; bc[s][1] = bv[s][1]; }
                if (k0 + 64 < kslice) CTX_LOAD(k0 + 64);
#pragma unroll
                for (int s = 0; s < 4; ++s)
#pragma unroll
                    for (int c = 0; c < 2; ++c) { acc[c][0] = __builtin_amdgcn_mfma_f32_32x32x16_bf16(bc[s][c], ac[s][0], acc[c][0], 0, 0, 0); acc[c][1] = __builtin_amdgcn_mfma_f32_32x32x16_bf16(bc[s][c], ac[s][1], acc[c][1], 0, 0, 0); }
            }
#undef CTX_LOAD
        }
        __syncthreads();
        if (wave < KS) {
#pragma unroll
            for (int c = 0; c < 2; ++c)
#pragma unroll
                for (int t = 0; t < 2; ++t)
#pragma unroll
                    for (int r = 0; r < 16; ++r) red[(wave * 64 + (c * 2 + t) * 16 + r) * 64 + lane] = acc[c][t][r];
        }
        __syncthreads();
#pragma unroll
        for (int q = 0; q < 2; ++q) {
            const int grp = wave * 2 + q, c = grp >> 3, t = (grp >> 2) & 1, g = grp & 3;
            f32x4 v = {0.f, 0.f, 0.f, 0.f};
            for (int w = 0; w < KS; ++w) {
                const LAS float* p = red + (w * 64 + (c * 2 + t) * 16 + 4 * g) * 64 + lane;
                v.x += p[0]; v.y += p[64]; v.z += p[128]; v.w += p[192];
            }
            f(row0 + 32 * t + r32, col0 + 32 * c + 8 * g + 4 * hi, v);
        }
    }
    __syncthreads();
}

__device__ __forceinline__ void phase_final(const Args& a) {
    const float* fw = a.in[I_FNW]; const bf16_t* XB = (const bf16_t*)(a.ws + WS_XB);
    const int lane = klane(), gw = blockIdx.x * NWAVES + kwave(), ngw = KGRID * NWAVES;
    for (int row = gw; row < ML; row += ngw) {
        const bf16_t* src = XB + (size_t)row * DM; float* p = a.out + (size_t)row * DM;
        f32x4 v[4]; float ss = 0.f;
#pragma unroll
        for (int j = 0; j < 4; ++j) { const u32x2 w = *(const u32x2*)(src + lane * 4 + 256 * j); v[j] = (f32x4){__uint_as_float(w.x << 16), __uint_as_float(w.x & 0xffff0000u), __uint_as_float(w.y << 16), __uint_as_float(w.y & 0xffff0000u)};
            ss += v[j].x * v[j].x + v[j].y * v[j].y + v[j].z * v[j].z + v[j].w * v[j].w; }
        const float rstd = rsqrtf(wave_sum(ss) * (1.f / DM) + EPS);
#pragma unroll
        for (int j = 0; j < 4; ++j) *(f32x4*)(p + lane * 4 + 256 * j) = v[j] * rstd * *(const f32x4*)(fw + lane * 4 + 256 * j);
    }
}

constexpr int NPHASE = 20;
#define PH_BEGIN(k) if (lo <= (k) && (k) < hi) { const Args& a = get_args(); unsigned char* ws = a.ws; (void)ws;
#ifndef XBAR
#define XBAR 0
#endif
#define PH_END(k) if (MK_ONE_LAUNCH && (k) + 1 < hi) { xcd_barrier(bar); for (int xb_ = 0; xb_ < XBAR; ++xb_) xcd_barrier(bar); } }
template <int L> __device__ __forceinline__ void layer_phases(LAS unsigned char* lds, const XcdBarrier& bar, const int lo, const int hi) {
    constexpr int P = 1 + 9 * L;
#define MODL ((const float*)(ws + WS_MOD) + (size_t)L * 3 * 6144)
#define ROPET ((const float*)(ws + WS_ROPE))
#define HYB ((bf16_t*)(ws + WS_HY))
#define PBB ((bf16_t*)(ws + WS_PB))
#define XCB ((float*)(ws + WS_XC))
#define XBB ((bf16_t*)(ws + WS_XB))
#define XC_IN ((L == 0) ? a.in[I_CTX] : (const float*)XCB)
    PH_BEGIN(P + 0) { if (L == 0) phase_norm_mod<false>(a.in[I_X], XC_IN, a.in[I_N1W] + L * DM, MODL, 0, 1024, HYB, MT); else phase_norm_mod<true>(XBB, XC_IN, a.in[I_N1W] + L * DM, MODL, 0, 1024, HYB, MT); } PH_END(P + 0)
    PH_BEGIN(P + 1) for (int rep = 0; rep < REP_INP; ++rep) { if (rep) xcd_barrier(bar); EpiInProj E{PBB, ROPET}; const bf16_t* W = (const bf16_t*)(ws + WS_WIN) + (size_t)L * INP * DM;
        { pg8::Gemm g{HYB, DM, W, ML, INP, DM}; pg8::StaticOrder S; S.init(ML, INP, KGRID, (int)blockIdx.x);
          EpiInProjFused EF{E, a.in[I_KVNW] + L * 256, a.in[I_QNW] + L * 256, a.in[I_SGNW] + L * 256, a.in[I_SGNB] + L * 256, (LAS float*)(lds + 131072)};
          pg8::gemm_phase<EpiInProjFused, pg8::StaticOrder, true, true>(lds, g, S, EF); }
        gemm_ctx_small(HYB, DM, W, INP, DM, E, lds); } PH_END(P + 1)
    PH_BEGIN(P + 2) phase_post(a, L); for (int rep = 0; rep < REP_GLAL; ++rep) { if (rep) xcd_barrier(bar); phase_gla_local(a, L, lds); } PH_END(P + 2)
    PH_BEGIN(P + 3) for (int rep = 0; rep < REP_UP; ++rep) { if (rep) xcd_barrier(bar);
        { EpiUQ E1{(bf16_t*)(ws + WS_QB)}; const bf16_t* W = (const bf16_t*)(ws + WS_WUQ) + (size_t)L * 768 * 256; gemm_mfma8(PBB + C_DQ, INP, W, ML, 768, 256, E1, lds); if (L == 0) gemm_ctx_small(PBB + C_DQ, INP, W, 768, 256, E1, lds); }
        { EpiUKV E2{(bf16_t*)(ws + WS_KVB)}; const bf16_t* W = (const bf16_t*)(ws + WS_WUKV) + (size_t)L * 1024 * 256; gemm_mfma8(PBB + C_CKV, INP, W, ML, 1024, 256, E2, lds); gemm_ctx_small(PBB + C_CKV, INP, W, 1024, 256, E2, lds); }
        if (rep == 0) phase_gla_scan(a);
        if (L == 0) weight_copies(a, 1, KGRID - 64, lds);
    } PH_END(P + 3)
    PH_BEGIN(P + 4) { phase_gla_out(a, L, lds, 0, 5); phase_sgu_mfma(a, L, lds, 5, 3); phase_attn_mfma<0>(a, L, lds); if (REP_ATTN == 2) { xcd_barrier(bar); phase_attn_mfma<ATT_ABL>(a, L, lds); } } PH_END(P + 4)
    PH_BEGIN(P + 5) for (int rep = 0; rep < (L == 0 ? REP_OUT : 1); ++rep) { if (rep) xcd_barrier(bar); EpiResid<L == 0> E{L == 0 ? (const void*)a.in[I_X] : (const void*)XBB, XC_IN, XBB, XCB, MODL, 2048}; const bf16_t* W = (const bf16_t*)(ws + WS_WOUT) + (size_t)L * DM * DM;
        gemm_mfma8(HYB, DM, W, ML, DM, DM, E, lds); if (L == 0) gemm_ctx_small(HYB, DM, W, DM, DM, E, lds); } PH_END(P + 5)
    PH_BEGIN(P + 6) phase_norm_mod<true>(XBB, XCB, a.in[I_N2W] + L * DM, MODL, 3072, 4096, HYB, L == 0 ? MT : ML); PH_END(P + 6)
    PH_BEGIN(P + 7) { EpiFF1 E{(bf16_t*)(ws + WS_A)}; const bf16_t* W = (const bf16_t*)(ws + WS_WFF1) + (size_t)L * FF * DM;
        gemm_mfma8(HYB, DM, W, ML, FF, DM, E, lds); if (L == 0) gemm_ctx_small(HYB, DM, W, FF, DM, E, lds);
        if (REP_FF1 == 2) { xcd_barrier(bar); EpiNull EN; gemm_mfma8(HYB, DM, W, ML, FF, DM, EN, lds); }
        if (REP_FF1 == 3) { xcd_barrier(bar); gemm_mfma8(HYB, DM, W, ML, FF, DM, E, lds); } } PH_END(P + 7)
    PH_BEGIN(P + 8) { EpiResid<false> E{XBB, XCB, XBB, XCB, MODL, 5120}; const bf16_t* W = (const bf16_t*)(ws + WS_WFF2) + (size_t)L * DM * FF;
        gemm_mfma8((const bf16_t*)(ws + WS_A), FF, W, ML, DM, FF, E, lds); if (L == 0) gemm_ctx_small((const bf16_t*)(ws + WS_A), FF, W, DM, FF, E, lds); } PH_END(P + 8)
}
__global__ void __launch_bounds__(NTHR, 2) mega(Args a_kernarg_only) {
    extern __shared__ __attribute__((aligned(16))) unsigned char lds_raw[];
    LAS unsigned char* lds = (LAS unsigned char*)lds_raw;
    volatile LAS unsigned* MISC = (volatile LAS unsigned*)(lds + LDS_CTL_OFF);
    { const int t0 = __builtin_amdgcn_workitem_id_x();
      if (t0 < 64) MISC[t0] = 0u;
      if ((t0 & 63) == 0) { const unsigned id = (unsigned)__builtin_amdgcn_s_getreg((5 << 11) | 4) & 63u; MISC[64 + id] = (unsigned)(t0 >> 6); } }
    __syncthreads();
    XcdBarrier bar; bar.bar = (unsigned*)(get_args().ws + WS_CTL); bar.x = 0; bar.st = nullptr;
    if (MK_ONE_LAUNCH) bar = xcd_barrier_post((unsigned*)(get_args().ws + WS_CTL), MISC + 8);
    const int lo = MK_ONE_LAUNCH ? 0 : get_args().ph_lo, hi = MK_ONE_LAUNCH ? NPHASE : get_args().ph_hi;
    PH_BEGIN(0) phase_prep(a, lds); PH_END(0)
    layer_phases<0>(lds, bar, lo, hi);
    layer_phases<1>(lds, bar, lo, hi);
    PH_BEGIN(NPHASE - 1) phase_final(a); PH_END(NPHASE - 1)
}

extern "C" void kernel_launch(void* const* d_in, const int* in_sizes, int n_in, void* d_out, int out_size, void* d_ws, size_t ws_size, hipStream_t stream) {
    static int grid = 0;
    if (grid == 0) {
        if (n_in != 26 || in_sizes[0] != ML * DM || out_size != ML * DM || ws_size < WS_END) { fprintf(stderr, "kernel_launch: unexpected shapes (n_in %d, in0 %d, out %d, ws %zu)\n", n_in, n_in > 0 ? in_sizes[0] : -1, out_size, ws_size); grid = -1; return; }
        int dev = 0, cus = 0;
        if (hipGetDevice(&dev) != hipSuccess || hipDeviceGetAttribute(&cus, hipDeviceAttributeMultiprocessorCount, dev) != hipSuccess) { grid = -1; return; }
        if (hipFuncSetAttribute((const void*)mega, hipFuncAttributeMaxDynamicSharedMemorySize, LDS_BYTES) != hipSuccess) { fprintf(stderr, "kernel_launch: hipFuncSetAttribute failed\n"); grid = -1; return; }
        int per_cu = 0;
        if (hipOccupancyMaxActiveBlocksPerMultiprocessor(&per_cu, (const void*)mega, NTHR, LDS_BYTES) != hipSuccess || per_cu < 1) fprintf(stderr, "kernel_launch: occupancy query says %d\n", per_cu);
        (void)hipGetLastError();
        grid = cus;
    }
    if (grid < 0) return;
    (void)hipMemsetAsync((char*)d_ws + WS_CTL, 0, CTL_ZERO_BYTES, stream);
    Args a{};
    for (int i = 0; i < 26; ++i) a.in[i] = (const float*)d_in[i];
    a.out = (float*)d_out; a.ws = (unsigned char*)d_ws; a.grid = grid;
    if (MK_ONE_LAUNCH) { a.ph_lo = 0; a.ph_hi = NPHASE; hipLaunchKernelGGL(mega, dim3(grid), dim3(NTHR), LDS_BYTES, stream, a); }
    else for (int ph = 0; ph < NPHASE; ++ph) { a.ph_lo = ph; a.ph_hi = ph + 1; hipLaunchKernelGGL(mega, dim3(grid), dim3(NTHR), LDS_BYTES, stream, a); }
}
```
